# Optimizing an MI355X kernel written in HIP

```python
import math
import jax
import jax.numpy as jnp
from jax import lax
import numpy as np

D_MODEL = 1024
BATCH = 16
SEQ = 2048
DEPTH = 4

N_MIXERS = 3
D_FF = 2816
NORM_EPS = 1e-6
HALF_STEP = 0.5

ML_HEADS = 4
ML_DQK = D_MODEL // 8
ML_DV = D_MODEL // 4
ML_CHUNK = 64
ML_CONV = 4
ML_GATE_CAP = 15.0
ML_IN = 2 * ML_HEADS * ML_DQK + 2 * ML_HEADS * ML_DV + 2 * ML_HEADS

RW_HEAD = 64
RW_HEADS = D_MODEL // RW_HEAD
RW_LORA_W = 64
RW_LORA_A = 64
RW_LORA_G = 128
RW_LN_EPS = 64e-5

RT_HEADS = 4
RT_DK = D_MODEL // RT_HEADS
RT_DV = 2 * RT_DK
RT_CHUNK = 128
RT_ROPE_BASE = 10000.0
RT_IN = 2 * RT_HEADS * RT_DK + 2 * RT_HEADS * RT_DV

N_ML_LAYERS = (DEPTH + 2) // 3
N_RW_LAYERS = (DEPTH + 1) // 3
N_RT_LAYERS = DEPTH // 3

kernel_name = 'hybrid_mlstm_rwkv7_retention_macaron'

F32 = jnp.float32


def rms_norm(x, g, eps=NORM_EPS):
    xf = x.astype(F32)
    y = xf * lax.rsqrt(jnp.mean(xf * xf, axis=-1, keepdims=True) + eps)
    return (y * g.astype(F32)).astype(x.dtype)


def head_rms(y, eps=NORM_EPS):
    return y * lax.rsqrt(jnp.mean(y * y, axis=-1, keepdims=True) + eps)


def swiglu_ffn(x, w_gu, w_down):
    gate, up = jnp.split(x @ w_gu, 2, axis=-1)
    return (jax.nn.silu(gate) * up) @ w_down


def causal_depthwise_conv(x, w):
    K, C = w.shape
    return lax.conv_general_dilated(x, w[:, None, :].astype(x.dtype), window_strides=(1,),
                                    padding=[(K - 1, 0)], dimension_numbers=('NWC', 'WIO', 'NWC'),
                                    feature_group_count=C)


def to_chunks(a, L):
    B, T, H = a.shape[:3]
    a = a.reshape((B, T // L, L, H) + a.shape[3:])
    perm = (1, 0, 3, 2) + tuple(range(4, a.ndim))
    return jnp.transpose(a, perm)


def from_chunks(a):
    NC, B, H, L, d = a.shape
    return jnp.transpose(a, (1, 0, 3, 2, 4)).reshape(B, NC * L, H, d)


def mlstm_chunkwise(q, k, v, i_log, f_log):
    B, T, H, dk = q.shape
    dv = v.shape[-1]
    L = ML_CHUNK
    mask = jnp.tril(jnp.ones((L, L), dtype=bool))
    xs = tuple(to_chunks(a.astype(F32), L) for a in (q, k, v, i_log, f_log))

    def step(carry, xc):
        C, n, m = carry
        qc, kc, vc, ic, fc = xc
        b = jnp.cumsum(fc, axis=-1)
        log_d = jnp.where(mask, b[..., :, None] - b[..., None, :] + ic[..., None, :], -jnp.inf)
        log_inter = b + m[..., None]
        m_t = jnp.maximum(log_inter, jnp.max(log_d, axis=-1))
        s = jnp.einsum('bhtd,bhsd->bhts', qc, kc) * jnp.exp(log_d - m_t[..., None])
        inter = jnp.exp(log_inter - m_t)
        num = jnp.einsum('bhts,bhsv->bhtv', s, vc) + inter[..., None] * jnp.einsum('bhtd,bhdv->bhtv', qc, C)
        den = jnp.sum(s, axis=-1) + inter * jnp.einsum('bhtd,bhd->bht', qc, n)
        h = num / jnp.maximum(jnp.abs(den), jnp.exp(-m_t))[..., None]
        b_end = b[..., -1]
        log_w = b_end[..., None] - b + ic
        m_new = jnp.maximum(b_end + m, jnp.max(log_w, axis=-1))
        kw = kc * jnp.exp(log_w - m_new[..., None])[..., None]
        carry_decay = jnp.exp(b_end + m - m_new)
        C = carry_decay[..., None, None] * C + jnp.einsum('bhsd,bhsv->bhdv', kw, vc)
        n = carry_decay[..., None] * n + jnp.sum(kw, axis=-2)
        return (C, n, m_new), h

    init = (jnp.zeros((B, H, dk, dv), F32), jnp.zeros((B, H, dk), F32), jnp.zeros((B, H), F32))
    _, h = lax.scan(step, init, xs)
    return from_chunks(h)


def mlstm_mixer(x, w_in, b_if, conv_w, norm_g, w_out):
    B, T, _ = x.shape
    H, dk, dv = ML_HEADS, ML_DQK, ML_DV
    proj = x @ w_in
    qk, v, o, if_pre = jnp.split(proj, [2 * H * dk, 2 * H * dk + H * dv, 2 * H * dk + 2 * H * dv], axis=-1)
    qk = jax.nn.silu(causal_depthwise_conv(qk, conv_w))
    q, k = jnp.split(qk, 2, axis=-1)
    if_pre = if_pre.astype(F32) + b_if.astype(F32)
    if_pre = ML_GATE_CAP * jnp.tanh(if_pre / ML_GATE_CAP)
    i_log, f_pre = jnp.split(if_pre, 2, axis=-1)
    f_log = jax.nn.log_sigmoid(f_pre)
    q = q.reshape(B, T, H, dk).astype(F32) * (dk ** -0.5)
    h = mlstm_chunkwise(q, k.reshape(B, T, H, dk), v.reshape(B, T, H, dv), i_log, f_log)
    h = head_rms(h).reshape(B, T, H * dv) * norm_g.astype(F32)
    h = (h * jax.nn.sigmoid(o.astype(F32))).astype(x.dtype)
    return h @ w_out


def rwkv7_mixer(x, mu, w_rkv, w0, w1, w2, a0, a1, a2, g1, g2, k_k, k_a, r_k, ln_g, ln_b, w_out):
    B, T, D = x.shape
    H, N = RW_HEADS, RW_HEAD
    x_prev = jnp.pad(x, ((0, 0), (1, 0), (0, 0)))[:, :-1]
    xx = x_prev - x
    mix = lambda i: x + xx * mu[i]
    r = (mix(0) @ w_rkv[0]).astype(F32)
    k = (mix(1) @ w_rkv[1]).astype(F32)
    v = (mix(2) @ w_rkv[2]).astype(F32)
    w_log = -jax.nn.softplus(-(w0 + jnp.tanh(mix(3) @ w1) @ w2).astype(F32)) - 0.5
    decay = jnp.exp(-jnp.exp(w_log))
    a = jax.nn.sigmoid((a0 + (mix(4) @ a1) @ a2).astype(F32))
    g = (jax.nn.sigmoid(mix(5) @ g1) @ g2).astype(F32)
    heads = lambda t: t.reshape(B, T, H, N)
    kk = heads(k * k_k.astype(F32))
    kk = kk / jnp.maximum(jnp.sqrt(jnp.sum(kk * kk, axis=-1, keepdims=True)), 1e-12)
    k = k * (1.0 + (a - 1.0) * k_a.astype(F32))
    rh, kh, vh, ah = heads(r), heads(k), heads(v), heads(a)
    tm = lambda t: jnp.swapaxes(t, 0, 1)
    xs = (tm(rh), tm(heads(decay)), tm(kh), tm(vh), tm(-kk), tm(kk * ah))

    def step(S, xt):
        r_t, w_t, k_t, v_t, a_t, b_t = xt
        sa = jnp.einsum('bhij,bhj->bhi', S, a_t)
        S = S * w_t[:, :, None, :] + sa[..., :, None] * b_t[..., None, :] + v_t[..., :, None] * k_t[..., None, :]
        return S, jnp.einsum('bhij,bhj->bhi', S, r_t)

    _, ys = lax.scan(step, jnp.zeros((B, H, N, N), F32), xs)
    y = jnp.swapaxes(ys, 0, 1)
    y_mean = jnp.mean(y, axis=-1, keepdims=True)
    y_c = y - y_mean
    y = y_c * lax.rsqrt(jnp.mean(y_c * y_c, axis=-1, keepdims=True) + RW_LN_EPS)
    y = y.reshape(B, T, D) * ln_g.astype(F32) + ln_b.astype(F32)
    bonus = (jnp.sum(rh * kh * r_k.astype(F32), axis=-1, keepdims=True) * vh).reshape(B, T, D)
    return ((y + bonus) * g).astype(x.dtype) @ w_out


def retention_rotate(u, positions):
    d = u.shape[-1]
    inv_freq = 1.0 / (RT_ROPE_BASE ** jnp.linspace(0.0, 1.0, d // 2, dtype=F32))
    ang = positions.astype(F32)[:, :, None, None] * inv_freq
    cos, sin = jnp.cos(ang), jnp.sin(ang)
    u1, u2 = jnp.split(u, 2, axis=-1)
    return jnp.concatenate([u1 * cos - u2 * sin, u1 * sin + u2 * cos], axis=-1)


def retention_chunkwise(q, k, v):
    B, T, H, dk = q.shape
    dv = v.shape[-1]
    L = RT_CHUNK
    log_gamma = jnp.log(1.0 - 2.0 ** (-5.0 - jnp.arange(H, dtype=F32)))
    idx = jnp.arange(L, dtype=F32)
    diff = idx[:, None] - idx[None, :]
    d_mask = jnp.where(diff >= 0, jnp.exp(log_gamma[:, None, None] * jnp.maximum(diff, 0.0)), 0.0)
    q_decay = jnp.exp(log_gamma[:, None] * (idx[None, :] + 1.0))[None, :, :, None]
    k_decay = jnp.exp(log_gamma[:, None] * (L - 1.0 - idx[None, :]))[None, :, :, None]
    chunk_decay = jnp.exp(log_gamma * L)[None, :, None, None]
    xs = tuple(to_chunks(a, L) for a in (q, k, v))

    def step(R, xc):
        qc, kc, vc = xc
        inner = jnp.einsum('bhts,bhsv->bhtv', jnp.einsum('bhtd,bhsd->bhts', qc, kc) * d_mask, vc)
        cross = jnp.einsum('bhtd,bhdv->bhtv', qc, R) * q_decay
        R = chunk_decay * R + jnp.einsum('bhsd,bhsv->bhdv', kc * k_decay, vc)
        return R, inner + cross

    _, y = lax.scan(step, jnp.zeros((B, H, dk, dv), F32), xs)
    return from_chunks(y)


def retention_mixer(x, positions, w_in, w_out):
    B, T, _ = x.shape
    H, dk, dv = RT_HEADS, RT_DK, RT_DV
    q, k, v, g = jnp.split(x @ w_in, [H * dk, 2 * H * dk, 2 * H * dk + H * dv], axis=-1)
    q = retention_rotate(q.reshape(B, T, H, dk).astype(F32), positions)
    k = retention_rotate(k.reshape(B, T, H, dk).astype(F32), positions) * (dk ** -0.5)
    y = retention_chunkwise(q, k, v.reshape(B, T, H, dv).astype(F32))
    y = head_rms(y).reshape(B, T, H * dv)
    return (jax.nn.silu(g.astype(F32)) * y).astype(x.dtype) @ w_out


def _dense(k, shape, fan_in, scale=1.0):
    return jax.random.normal(k, shape, F32) * (scale * fan_in ** -0.5)


def setup_inputs(seed: int = 0) -> dict:
    key = jax.random.key(seed)
    ks = jax.random.split(key, 40)
    D = D_MODEL
    nm, nr, nt = N_ML_LAYERS, N_RW_LAYERS, N_RT_LAYERS
    nrm = lambda k, shape, s: jax.random.normal(k, shape, F32) * s
    x = jax.random.normal(ks[0], (BATCH, SEQ, D), F32)
    positions = (jnp.arange(SEQ, dtype=jnp.int32)[None, :]
                 + jax.random.randint(ks[1], (BATCH, 1), 0, SEQ, dtype=jnp.int32))
    norm_g = 1.0 + nrm(ks[2], (DEPTH, 6, D), 0.01)
    ffn_w_gu = _dense(ks[3], (DEPTH, 2, D, 2 * D_FF), D)
    ffn_w_down = _dense(ks[4], (DEPTH, 2, D_FF, D), D_FF)
    ml_w_in = _dense(ks[5], (nm, D, ML_IN), D)
    ml_b_if = jnp.concatenate([nrm(ks[6], (nm, ML_HEADS), 0.01),
                               jnp.linspace(3.0, 6.0, ML_HEADS, dtype=F32)[None, :] + nrm(ks[7], (nm, ML_HEADS), 0.01)],
                              axis=-1)
    ml_conv_w = _dense(ks[8], (nm, ML_CONV, 2 * ML_HEADS * ML_DQK), ML_CONV)
    ml_norm_g = 1.0 + nrm(ks[9], (nm, ML_HEADS * ML_DV), 0.01)
    ml_w_out = _dense(ks[10], (nm, ML_HEADS * ML_DV, D), ML_HEADS * ML_DV)
    rw_mu = jax.random.uniform(ks[11], (nr, 6, D), F32)
    rw_w_rkv = _dense(ks[12], (nr, 3, D, D), D)
    rw_w0 = jnp.linspace(-6.5, -1.5, D, dtype=F32)[None, :] + nrm(ks[13], (nr, D), 0.1)
    rw_w1 = _dense(ks[14], (nr, D, RW_LORA_W), D)
    rw_w2 = _dense(ks[15], (nr, RW_LORA_W, D), RW_LORA_W, 0.1)
    rw_a0 = nrm(ks[16], (nr, D), 0.01)
    rw_a1 = _dense(ks[17], (nr, D, RW_LORA_A), D)
    rw_a2 = _dense(ks[18], (nr, RW_LORA_A, D), RW_LORA_A, 0.1)
    rw_g1 = _dense(ks[19], (nr, D, RW_LORA_G), D)
    rw_g2 = _dense(ks[20], (nr, RW_LORA_G, D), RW_LORA_G)
    rw_k_k = 0.85 + nrm(ks[21], (nr, D), 0.01)
    rw_k_a = 1.0 + nrm(ks[22], (nr, D), 0.01)
    rw_r_k = nrm(ks[23], (nr, RW_HEADS, RW_HEAD), 0.1)
    rw_ln_g = 1.0 + nrm(ks[24], (nr, D), 0.01)
    rw_ln_b = nrm(ks[25], (nr, D), 0.01)
    rw_w_out = _dense(ks[26], (nr, D, D), D)
    rt_w_in = _dense(ks[27], (nt, D, RT_IN), D)
    rt_w_out = _dense(ks[28], (nt, RT_HEADS * RT_DV, D), RT_HEADS * RT_DV)
    return {'x': x, 'positions': positions, 'norm_g': norm_g, 'ffn_w_gu': ffn_w_gu, 'ffn_w_down': ffn_w_down,
            'ml_w_in': ml_w_in, 'ml_b_if': ml_b_if, 'ml_conv_w': ml_conv_w, 'ml_norm_g': ml_norm_g, 'ml_w_out': ml_w_out,
            'rw_mu': rw_mu, 'rw_w_rkv': rw_w_rkv, 'rw_w0': rw_w0, 'rw_w1': rw_w1, 'rw_w2': rw_w2,
            'rw_a0': rw_a0, 'rw_a1': rw_a1, 'rw_a2': rw_a2, 'rw_g1': rw_g1, 'rw_g2': rw_g2,
            'rw_k_k': rw_k_k, 'rw_k_a': rw_k_a, 'rw_r_k': rw_r_k, 'rw_ln_g': rw_ln_g, 'rw_ln_b': rw_ln_b,
            'rw_w_out': rw_w_out, 'rt_w_in': rt_w_in, 'rt_w_out': rt_w_out}


def reference(x, positions, norm_g, ffn_w_gu, ffn_w_down,
              ml_w_in, ml_b_if, ml_conv_w, ml_norm_g, ml_w_out,
              rw_mu, rw_w_rkv, rw_w0, rw_w1, rw_w2, rw_a0, rw_a1, rw_a2, rw_g1, rw_g2,
              rw_k_k, rw_k_a, rw_r_k, rw_ln_g, rw_ln_b, rw_w_out, rt_w_in, rt_w_out):
    for layer in range(DEPTH):
        g = norm_g[layer]
        h = swiglu_ffn(rms_norm(x, g[0]), ffn_w_gu[layer, 0], ffn_w_down[layer, 0])
        x = x + HALF_STEP * rms_norm(h, g[1])
        h = rms_norm(x, g[2])
        kind, j = layer % N_MIXERS, layer // N_MIXERS
        if kind == 0:
            h = mlstm_mixer(h, ml_w_in[j], ml_b_if[j], ml_conv_w[j], ml_norm_g[j], ml_w_out[j])
        elif kind == 1:
            h = rwkv7_mixer(h, rw_mu[j], rw_w_rkv[j], rw_w0[j], rw_w1[j], rw_w2[j], rw_a0[j], rw_a1[j], rw_a2[j],
                            rw_g1[j], rw_g2[j], rw_k_k[j], rw_k_a[j], rw_r_k[j], rw_ln_g[j], rw_ln_b[j], rw_w_out[j])
        else:
            h = retention_mixer(h, positions, rt_w_in[j], rt_w_out[j])
        x = x + rms_norm(h, g[3])
        h = swiglu_ffn(rms_norm(x, g[4]), ffn_w_gu[layer, 1], ffn_w_down[layer, 1])
        x = x + HALF_STEP * rms_norm(h, g[5])
    return x
```

```cpp
#include <hip/hip_runtime.h>
#include <cstdio>
#include <cstdint>

#ifndef MK_PER_PHASE
#define MK_PER_PHASE 1
#endif

#define LAS __attribute__((address_space(3)))
#define GAS __attribute__((address_space(1)))
typedef unsigned short bf16;
typedef short bf16x8 __attribute__((ext_vector_type(8)));
typedef float f32x4 __attribute__((ext_vector_type(4)));
typedef float f32x2 __attribute__((ext_vector_type(2)));
typedef unsigned u32x4 __attribute__((ext_vector_type(4)));
typedef unsigned u32x2 __attribute__((ext_vector_type(2)));

constexpr int DM = 1024, NB = 16, SEQ = 2048, DEPTH = 4, DFF = 2816;
constexpr int M = NB * SEQ;
constexpr float NORM_EPS = 1e-6f;
constexpr int ML_IN = 3080;
constexpr int NWAVES = 8;

constexpr size_t MiB = 1u << 20;
constexpr size_t WS_CTL = 0, CTL_ZERO_BYTES = 1 * MiB;
constexpr size_t WS_W = 1 * MiB;
constexpr size_t W_GU0 = WS_W, W_DN0 = W_GU0 + (size_t)5632 * 1024 * 2, W_GU1 = W_DN0 + (size_t)1024 * 2816 * 2, W_DN1 = W_GU1 + (size_t)5632 * 1024 * 2;
constexpr size_t W_MIX = W_DN1 + (size_t)1024 * 2816 * 2;
constexpr size_t WS_XN = 58 * MiB;
constexpr size_t WS_MO = WS_XN + 64 * MiB;
constexpr size_t WS_A = 186 * MiB;
constexpr size_t WS_B = 570 * MiB;
constexpr size_t WS_END = 698 * MiB;
static_assert(W_MIX + (size_t)17 * MiB <= WS_XN, "weight region");
constexpr int CW_BAR = 4096;

constexpr int RING_BYTES = 131072;
constexpr int LDS_BYTES = 147456;
constexpr int MISC_OFF = 145408;

typedef __bf16 bf16x2_t __attribute__((ext_vector_type(2)));
__device__ __forceinline__ unsigned cvt_pk_bf16(float lo, float hi) { const f32x2 v = {lo, hi}; return __builtin_bit_cast(unsigned, __builtin_convertvector(v, bf16x2_t)); }
__device__ __forceinline__ float bf_lo(unsigned u) { return __uint_as_float(u << 16); }
__device__ __forceinline__ float bf_hi(unsigned u) { return __uint_as_float(u & 0xffff0000u); }
__device__ __forceinline__ float fexp(float x) { return __builtin_amdgcn_exp2f(x * 1.4426950408889634f); }
__device__ __forceinline__ float fsigmoid(float x) { return __builtin_amdgcn_rcpf(1.0f + fexp(-x)); }
__device__ __forceinline__ float ftanh(float x) { return 2.0f * fsigmoid(2.0f * x) - 1.0f; }
__device__ __forceinline__ float fsilu(float x) { return x * fsigmoid(x); }
__device__ __forceinline__ float wave_sum(float v) {
#pragma unroll
    for (int o = 1; o < 64; o <<= 1) v += __shfl_xor(v, o);
    return v;
}
__device__ __forceinline__ f32x4 mma16(bf16x8 x, bf16x8 y, f32x4 c) { return __builtin_amdgcn_mfma_f32_16x16x32_bf16(x, y, c, 0, 0, 0); }
#define LDS_WAIT() asm volatile("s_waitcnt lgkmcnt(0)" ::: "memory")
#define WG_BAR() do { asm volatile("s_waitcnt vmcnt(0) lgkmcnt(0)" ::: "memory"); __builtin_amdgcn_s_barrier(); asm volatile("" ::: "memory"); } while (0)
#define WG_BAR_L() do { asm volatile("s_waitcnt lgkmcnt(0)" ::: "memory"); __builtin_amdgcn_s_barrier(); asm volatile("" ::: "memory"); } while (0)

namespace pg8 {
#define PG8_LAS __attribute__((address_space(3)))
typedef unsigned short bf16_t;
constexpr int BM = 256, BK = 64, HALF = 128, HTB = HALF * BK * 2, STAGE_BYTES = 8 * HTB, NXCD = 8, WGM = 8;
__host__ __device__ __forceinline__ int lds_byte(int r, int c) { const int st = (r >> 4) * 2 + (c >> 5), rr = r & 15, cc = c & 31, ob = rr * 64 + cc * 2; return st * 1024 + (ob ^ (((ob >> 9) & 1) << 5)); }
__host__ __device__ __forceinline__ void stage_rc(int b, int& R, int& C) { const int st = b / 1024, sb = b % 1024, swz = sb ^ (((sb >> 9) & 1) << 5); R = (st >> 1) * 16 + swz / 64; C = (st & 1) * 32 + (swz % 64) / 2; }
__host__ __device__ __forceinline__ int perm32(int rho) { const int n = rho >> 4, i = rho & 15; return 8 * (i >> 2) + 4 * n + (i & 3); }

struct Unit { int pm, pn; };
struct Gemm { const bf16_t* A; const bf16_t* Bt; int M, N, K; };

struct StaticOrder {
    int nM, nN, nwg, G, c;
    __host__ __device__ void init(int M_, int N_, int G_, int c_) { nM = M_ / BM; nN = N_ / BM; nwg = nM * nN; G = G_; c = c_; }
    __host__ __device__ bool next(int i, Unit& u) const {
        const long L = (long)i * G + c; if (L >= nwg) return false;
        int wgid = (int)L; { const int q = nwg / NXCD, r = nwg % NXCD, xcd = wgid % NXCD, off = wgid / NXCD; wgid = (xcd < r ? xcd * (q + 1) : r * (q + 1) + (xcd - r) * q) + off; }
        const int nig = WGM * nN, gid = wgid / nig, fm = gid * WGM, gsz = (nM - fm) < WGM ? (nM - fm) : WGM;
        u.pm = fm + ((wgid % nig) % gsz); u.pn = (wgid % nig) / gsz; return true;
    }
    __device__ __forceinline__ void a_ready(const Unit&) const {}
    __device__ __forceinline__ void done(const Unit&) const {}
};

__device__ __forceinline__ u32x4 pack8(f32x4 v0, f32x4 v1) { u32x4 w; w.x = cvt_pk_bf16(v0[0], v0[1]); w.y = cvt_pk_bf16(v0[2], v0[3]); w.z = cvt_pk_bf16(v1[0], v1[1]); w.w = cvt_pk_bf16(v1[2], v1[3]); return w; }

struct EpiPlain {
    static constexpr bool PERM = true, AFTER_DRAIN = false;
    bf16_t* O; int ldc;
    __device__ __forceinline__ void operator()(const f32x4 (&acc)[2][2][4][2], const Unit& u, int wr, int wc, int fr, int fq) const {
        const int row0 = u.pm * BM + wr * 64 + fr, col0 = u.pn * BM + wc * 32 + 8 * fq;
#pragma unroll
        for (int ai = 0; ai < 2; ++ai)
#pragma unroll
            for (int m = 0; m < 4; ++m) { bf16_t* rowp = O + (size_t)(row0 + ai * HALF + m * 16) * ldc + col0;
#pragma unroll
                for (int bj = 0; bj < 2; ++bj) *(u32x4*)(rowp + bj * HALF) = pack8(acc[ai][bj][m][0], acc[ai][bj][m][1]); }
    }
};
struct EpiSwiglu {
    static constexpr bool PERM = true, AFTER_DRAIN = false;
    bf16_t* O; int ldc;
    __device__ __forceinline__ void operator()(const f32x4 (&acc)[2][2][4][2], const Unit& u, int wr, int wc, int fr, int fq) const {
        const int row0 = u.pm * BM + wr * 64 + fr, col0 = u.pn * HALF + wc * 32 + 8 * fq;
#pragma unroll
        for (int ai = 0; ai < 2; ++ai)
#pragma unroll
            for (int m = 0; m < 4; ++m) { bf16_t* rowp = O + (size_t)(row0 + ai * HALF + m * 16) * ldc + col0;
                f32x4 o[2];
#pragma unroll
                for (int n = 0; n < 2; ++n)
#pragma unroll
                    for (int e = 0; e < 4; ++e) { const float g = acc[ai][0][m][n][e]; o[n][e] = g * fsigmoid(g) * acc[ai][1][m][n][e]; }
                *(u32x4*)rowp = pack8(o[0], o[1]); }
    }
};
struct EpiRw1 {
    static constexpr bool PERM = true, AFTER_DRAIN = false;
    bf16_t* rkv; bf16_t* lmid;
    __device__ __forceinline__ void operator()(const f32x4 (&acc)[2][2][4][2], const Unit& u, int wr, int wc, int fr, int fq) const {
        const int row0 = u.pm * BM + wr * 64 + fr;
        if (u.pn < 12) {
            const int col0 = u.pn * BM + wc * 32 + 8 * fq;
#pragma unroll
            for (int ai = 0; ai < 2; ++ai)
#pragma unroll
                for (int m = 0; m < 4; ++m) { bf16_t* rowp = rkv + (size_t)(row0 + ai * HALF + m * 16) * 3072 + col0;
#pragma unroll
                    for (int bj = 0; bj < 2; ++bj) *(u32x4*)(rowp + bj * HALF) = pack8(acc[ai][bj][m][0], acc[ai][bj][m][1]); }
        } else {
            const int col0 = wc * 32 + 8 * fq;
#pragma unroll
            for (int ai = 0; ai < 2; ++ai)
#pragma unroll
                for (int m = 0; m < 4; ++m) { bf16_t* rowp = lmid + (size_t)(row0 + ai * HALF + m * 16) * 256 + col0;
#pragma unroll
                    for (int bj = 0; bj < 2; ++bj) { f32x4 o[2];
#pragma unroll
                        for (int n = 0; n < 2; ++n)
#pragma unroll
                            for (int e = 0; e < 4; ++e) { const float v = acc[ai][bj][m][n][e]; o[n][e] = (bj == 1) ? fsigmoid(v) : (wc < 2 ? ftanh(v) : v); }
                        *(u32x4*)(rowp + bj * HALF) = pack8(o[0], o[1]); } }
        }
    }
};
struct EpiRw2 {
    static constexpr bool PERM = true, AFTER_DRAIN = false;
    bf16_t* O; const float* w0; const float* a0;
    __device__ __forceinline__ void operator()(const f32x4 (&acc)[2][2][4][2], const Unit& u, int wr, int wc, int fr, int fq) const {
        const int row0 = u.pm * BM + wr * 64 + fr, col0 = u.pn * BM + wc * 32 + 8 * fq, kind = u.pn >> 2, cc0 = (u.pn & 3) * BM + wc * 32 + 8 * fq;
        if (kind == 2) {
#pragma unroll
            for (int ai = 0; ai < 2; ++ai)
#pragma unroll
                for (int m = 0; m < 4; ++m) { bf16_t* rowp = O + (size_t)(row0 + ai * HALF + m * 16) * 3072 + col0;
#pragma unroll
                    for (int bj = 0; bj < 2; ++bj) *(u32x4*)(rowp + bj * HALF) = pack8(acc[ai][bj][m][0], acc[ai][bj][m][1]); }
        } else {
            const float* bp = (kind == 0 ? w0 : a0) + cc0; const float sc = kind == 0 ? -0.60653065971f : 1.0f;
#pragma unroll
            for (int bj = 0; bj < 2; ++bj) {
                const f32x4 b0 = *(const f32x4*)(bp + bj * HALF), b1 = *(const f32x4*)(bp + bj * HALF + 4);
#pragma unroll
                for (int ai = 0; ai < 2; ++ai)
#pragma unroll
                    for (int m = 0; m < 4; ++m) { bf16_t* rowp = O + (size_t)(row0 + ai * HALF + m * 16) * 3072 + col0; f32x4 o0, o1;
#pragma unroll
                        for (int e = 0; e < 4; ++e) { o0[e] = sc * fsigmoid(acc[ai][bj][m][0][e] + b0[e]); o1[e] = sc * fsigmoid(acc[ai][bj][m][1][e] + b1[e]); }
                        *(u32x4*)(rowp + bj * HALF) = pack8(o0, o1); }
            }
        }
    }
};
struct EpiRtIn {
    static constexpr bool PERM = true, AFTER_DRAIN = false;
    bf16_t* O; const int* pos;
    __device__ __forceinline__ void operator()(const f32x4 (&acc)[2][2][4][2], const Unit& u, int wr, int wc, int fr, int fq) const {
        const int row0 = u.pm * BM + wr * 64 + fr, col0 = u.pn * BM + wc * 32 + 8 * fq;
        if (u.pn >= 8) {
#pragma unroll
            for (int ai = 0; ai < 2; ++ai)
#pragma unroll
                for (int m = 0; m < 4; ++m) { bf16_t* rowp = O + (size_t)(row0 + ai * HALF + m * 16) * 6144 + col0;
#pragma unroll
                    for (int bj = 0; bj < 2; ++bj) *(u32x4*)(rowp + bj * HALF) = pack8(acc[ai][bj][m][0], acc[ai][bj][m][1]); }
        } else {
            const float sc = u.pn >= 4 ? 0.0625f : 1.0f;
            float invf[2][4];
#pragma unroll
            for (int n = 0; n < 2; ++n)
#pragma unroll
                for (int e = 0; e < 4; ++e) { const int i = wc * 32 + 8 * fq + 4 * n + e; invf[n][e] = __builtin_amdgcn_exp2f((float)i * (-13.287712379549449f / 127.0f)) * 0.15915494309189535f; }
#pragma unroll
            for (int ai = 0; ai < 2; ++ai)
#pragma unroll
                for (int m = 0; m < 4; ++m) { const int row = row0 + ai * HALF + m * 16; const float p = (float)pos[row]; bf16_t* rowp = O + (size_t)row * 6144 + col0;
                    f32x4 o1[2], o2[2];
#pragma unroll
                    for (int n = 0; n < 2; ++n)
#pragma unroll
                        for (int e = 0; e < 4; ++e) { float rev = p * invf[n][e]; rev = rev - __builtin_floorf(rev);
                            const float sn = __builtin_amdgcn_sinf(rev), cs = __builtin_amdgcn_cosf(rev);
                            const float u1 = acc[ai][0][m][n][e], u2 = acc[ai][1][m][n][e];
                            o1[n][e] = (u1 * cs - u2 * sn) * sc; o2[n][e] = (u1 * sn + u2 * cs) * sc; }
                    *(u32x4*)rowp = pack8(o1[0], o1[1]); *(u32x4*)(rowp + HALF) = pack8(o2[0], o2[1]); }
        }
    }
};

template <class Epi, class Sched, bool ALIGN_EPI = false, bool SP2 = false>
__device__ __forceinline__ void gemm_phase(PG8_LAS unsigned char* lds, const Gemm g, const Sched& S, const Epi& E) {
    int tid_ = threadIdx.x; asm volatile("" : "+v"(tid_));
    const int tid = tid_, wid = __builtin_amdgcn_readfirstlane(tid >> 6), lane = tid & 63, wr = wid >> 2, wc = wid & 3, fr = lane & 15, fq = lane >> 4;
    const int K = g.K, nt = K / BK;
    unsigned voffA[2], voffB[2];
#pragma unroll
    for (int i = 0; i < 2; ++i) { int R, C; stage_rc(tid * 16 + i * 8192, R, C); const int Rb = Epi::PERM ? ((R & ~31) + perm32(R & 31)) : R;
        voffA[i] = (unsigned)(R * K + C) * 2u; voffB[i] = (unsigned)(Rb * K + C) * 2u; }
    const size_t kstep = (size_t)(BK * 2);
    const size_t hstep = (size_t)HALF * K * 2;
    const size_t tstep = 2 * hstep;
    const unsigned ldsw = (unsigned)wid * 1024u;
    const int aoff = lds_byte(wr * 64 + fr, fq * 8), boff = lds_byte(wc * 32 + fr, fq * 8);
#define PG8_SA(b, h) (((b) * 2 + (h)) * HTB)
#define PG8_SB(b, h) ((4 + (b) * 2 + (h)) * HTB)
#define PG8_STAGE(bufoff, gbase, voff) do { _Pragma("unroll") for (int _i = 0; _i < 2; ++_i) \
        __builtin_amdgcn_global_load_lds((const unsigned*)((const char*)(gbase) + (voff)[_i]), (PG8_LAS unsigned*)(lds + (bufoff) + ldsw + _i * 8192), 16, 0, 0); } while (0)
#define PG8_LDA(dst, b, h) do { _Pragma("unroll") for (int m = 0; m < 4; ++m) _Pragma("unroll") for (int k = 0; k < 2; ++k) dst[m][k] = *(const PG8_LAS bf16x8*)(lds + PG8_SA(b, h) + aoff + m * 2048 + k * 1024); } while (0)
#define PG8_LDB(dst, b, h) do { _Pragma("unroll") for (int n = 0; n < 2; ++n) _Pragma("unroll") for (int k = 0; k < 2; ++k) dst[n][k] = *(const PG8_LAS bf16x8*)(lds + PG8_SB(b, h) + boff + n * 2048 + k * 1024); } while (0)
#define PG8_MMA(ai, bj, At, Bt) do { __builtin_amdgcn_s_setprio(1); _Pragma("unroll") for (int m = 0; m < 4; ++m) _Pragma("unroll") for (int n = 0; n < 2; ++n) _Pragma("unroll") for (int k = 0; k < 2; ++k) \
        acc[ai][bj][m][n] = __builtin_amdgcn_mfma_f32_16x16x32_bf16(Bt[n][k], At[m][k], acc[ai][bj][m][n], 0, 0, 0); __builtin_amdgcn_s_setprio(0); } while (0)
#define PG8_WAIT_V(n) asm volatile("s_waitcnt vmcnt(" #n ")" ::: "memory")
#define PG8_WAIT_L(n) asm volatile("s_waitcnt lgkmcnt(" #n ")" ::: "memory")
#define PG8_BAR __builtin_amdgcn_s_barrier()
#define PG8_SCHED __builtin_amdgcn_sched_barrier(0)
    Unit cur, nxt; int ui = 0;
    if (!S.next(0, cur)) return;
    f32x4 acc[2][2][4][2];
#pragma unroll
    for (int a = 0; a < 2; ++a)
#pragma unroll
        for (int b = 0; b < 2; ++b)
#pragma unroll
            for (int m = 0; m < 4; ++m)
#pragma unroll
                for (int n = 0; n < 2; ++n) acc[a][b][m][n] = (f32x4){0.f, 0.f, 0.f, 0.f};
    bf16x8 At[4][2], B0[2][2], B1[2][2];
    const char* cA = (const char*)g.A + (size_t)cur.pm * tstep; const char* cB = (const char*)g.Bt + (size_t)cur.pn * tstep;
    S.a_ready(cur);
    if constexpr (SP2) {
        PG8_STAGE(PG8_SB(0, 0), cB, voffB); PG8_STAGE(PG8_SB(0, 1), cB + hstep, voffB); PG8_STAGE(PG8_SA(0, 0), cA, voffA); PG8_STAGE(PG8_SA(0, 1), cA + hstep, voffA);
        if (wr == 1) PG8_BAR;
        PG8_WAIT_V(2); PG8_BAR;
        PG8_STAGE(PG8_SB(1, 0), cB + kstep, voffB); PG8_STAGE(PG8_SA(1, 0), cA + kstep, voffA); PG8_STAGE(PG8_SB(1, 1), cB + hstep + kstep, voffB);
        PG8_WAIT_V(6); PG8_BAR;
    } else {
        PG8_STAGE(PG8_SB(0, 0), cB, voffB); PG8_STAGE(PG8_SA(0, 0), cA, voffA); PG8_STAGE(PG8_SB(0, 1), cB + hstep, voffB); PG8_STAGE(PG8_SA(0, 1), cA + hstep, voffA);
        if (wr == 1) PG8_BAR;
        PG8_WAIT_V(4); PG8_BAR;
        PG8_STAGE(PG8_SB(1, 0), cB + kstep, voffB); PG8_STAGE(PG8_SA(1, 0), cA + kstep, voffA); PG8_STAGE(PG8_SB(1, 1), cB + hstep + kstep, voffB);
        PG8_WAIT_V(6); PG8_BAR;
    }
    for (;;) {
        const bool has_next = S.next(ui + 1, nxt);
        const char* nA = has_next ? (const char*)g.A + (size_t)nxt.pm * tstep : cA; const char* nB = has_next ? (const char*)g.Bt + (size_t)nxt.pn * tstep : cB;
        for (int t = 0; t < nt; t += 2) {
            const bool last = (t == nt - 2);
            const char* a1 = cA + (size_t)(t + 1) * kstep;
            const char* a2 = last ? nA : cA + (size_t)(t + 2) * kstep; const char* b2 = last ? nB : cB + (size_t)(t + 2) * kstep;
            const char* a3 = a2 + kstep; const char* b3 = b2 + kstep;
            if (last && has_next) S.a_ready(nxt);
            if constexpr (SP2) {
            PG8_LDB(B0, 0, 0); PG8_LDB(B1, 0, 1); PG8_SCHED; PG8_LDA(At, 0, 0); PG8_STAGE(PG8_SA(1, 1), a1 + hstep, voffA);
            PG8_WAIT_V(8); PG8_WAIT_L(0); PG8_BAR; PG8_MMA(0, 0, At, B0); PG8_MMA(0, 1, At, B1); PG8_BAR; PG8_SCHED;
            PG8_LDA(At, 0, 1); PG8_STAGE(PG8_SB(0, 0), b2, voffB); PG8_STAGE(PG8_SB(0, 1), b2 + hstep, voffB); PG8_STAGE(PG8_SA(0, 0), a2, voffA);
            PG8_WAIT_V(8); PG8_WAIT_L(0); PG8_BAR; PG8_MMA(1, 0, At, B0); PG8_MMA(1, 1, At, B1); PG8_BAR; PG8_SCHED;
            PG8_LDB(B0, 1, 0); PG8_LDB(B1, 1, 1); PG8_SCHED; PG8_LDA(At, 1, 0); PG8_STAGE(PG8_SA(0, 1), a2 + hstep, voffA);
            PG8_WAIT_V(8); PG8_WAIT_L(0); PG8_BAR; PG8_MMA(0, 0, At, B0); PG8_MMA(0, 1, At, B1); PG8_BAR; PG8_SCHED;
            PG8_LDA(At, 1, 1); PG8_STAGE(PG8_SB(1, 0), b3, voffB); PG8_STAGE(PG8_SB(1, 1), b3 + hstep, voffB); PG8_STAGE(PG8_SA(1, 0), a3, voffA);
            PG8_WAIT_V(8); PG8_WAIT_L(0); PG8_BAR; PG8_MMA(1, 0, At, B0); PG8_MMA(1, 1, At, B1); PG8_BAR; PG8_SCHED;
            } else {
            PG8_LDB(B0, 0, 0); PG8_SCHED; PG8_LDA(At, 0, 0); PG8_STAGE(PG8_SA(1, 1), a1 + hstep, voffA);
            PG8_WAIT_L(8); PG8_BAR; PG8_WAIT_L(0); PG8_MMA(0, 0, At, B0); PG8_BAR; PG8_SCHED;
            PG8_LDB(B1, 0, 1); PG8_STAGE(PG8_SB(0, 0), b2, voffB);
            PG8_BAR; PG8_WAIT_L(0); PG8_MMA(0, 1, At, B1); PG8_BAR;
            PG8_LDA(At, 0, 1); PG8_STAGE(PG8_SA(0, 0), a2, voffA);
            PG8_BAR; PG8_WAIT_L(0); PG8_MMA(1, 0, At, B0); PG8_BAR; PG8_SCHED;
            PG8_STAGE(PG8_SB(0, 1), b2 + hstep, voffB);
            PG8_WAIT_V(6); PG8_BAR; PG8_MMA(1, 1, At, B1); PG8_BAR;
            PG8_LDB(B0, 1, 0); PG8_SCHED; PG8_LDA(At, 1, 0); PG8_STAGE(PG8_SA(0, 1), a2 + hstep, voffA);
            PG8_WAIT_L(8); PG8_BAR; PG8_WAIT_L(0); PG8_MMA(0, 0, At, B0); PG8_BAR; PG8_SCHED;
            PG8_LDB(B1, 1, 1); PG8_STAGE(PG8_SB(1, 0), b3, voffB);
            PG8_BAR; PG8_WAIT_L(0); PG8_MMA(0, 1, At, B1); PG8_BAR;
            PG8_LDA(At, 1, 1); PG8_STAGE(PG8_SA(1, 0), a3, voffA);
            PG8_BAR; PG8_WAIT_L(0); PG8_MMA(1, 0, At, B0); PG8_BAR; PG8_SCHED;
            PG8_STAGE(PG8_SB(1, 1), b3 + hstep, voffB);
            PG8_WAIT_V(6); PG8_BAR; PG8_MMA(1, 1, At, B1); PG8_BAR;
            }
        }
        if constexpr (ALIGN_EPI) { if (wr == 0) PG8_BAR; }
        if constexpr (!Epi::AFTER_DRAIN) { E(acc, cur, wr, wc, fr, fq); S.done(cur); }
        if (!has_next) break;
#pragma unroll
        for (int a = 0; a < 2; ++a)
#pragma unroll
            for (int b = 0; b < 2; ++b)
#pragma unroll
                for (int m = 0; m < 4; ++m)
#pragma unroll
                    for (int n = 0; n < 2; ++n) acc[a][b][m][n] = (f32x4){0.f, 0.f, 0.f, 0.f};
        cur = nxt; cA = nA; cB = nB; ++ui;
        if constexpr (ALIGN_EPI) { if (wr == 1) PG8_BAR; }
    }
    PG8_WAIT_V(0);
    if constexpr (!ALIGN_EPI) { if (wr == 0) PG8_BAR; }
    PG8_BAR;
#undef PG8_SA
#undef PG8_SB
#undef PG8_STAGE
#undef PG8_LDA
#undef PG8_LDB
#undef PG8_MMA
#undef PG8_WAIT_V
#undef PG8_WAIT_L
#undef PG8_BAR
#undef PG8_SCHED
}
}

#define XB_TMO      128
#define XB_XCNT(j)  (256  + 64 * (j))
#define XB_XSUB(j)  (1280 + 64 * (j))
#define XB_XGEN(j)  (2304 + 64 * (j))
#define XB_TOP      3328
#define XB_TOPGEN   3392
#define XCD_BAR_WORDS 3456
#define XB_SPIN_CAP (1u << 18)

__device__ __forceinline__ unsigned xb_ld(unsigned* p)              { return __hip_atomic_load(p, __ATOMIC_RELAXED, __HIP_MEMORY_SCOPE_AGENT); }
__device__ __forceinline__ unsigned xb_add(unsigned* p, unsigned v) { return __hip_atomic_fetch_add(p, v, __ATOMIC_RELAXED, __HIP_MEMORY_SCOPE_AGENT); }
__device__ __forceinline__ unsigned xb_xcc_id() { return (unsigned)__builtin_amdgcn_s_getreg((3 << 11) | 20) & 0xFu; }
#define XB_SPIN(cond, bar) do { unsigned _sp = 0; while (cond) { __builtin_amdgcn_s_sleep(1); \
    if ((++_sp & 255u) == 0u) { if (xb_ld(&(bar)[XB_TMO])) break; if (_sp > XB_SPIN_CAP) { atomicAdd(&(bar)[XB_TMO], 1u); break; } } } } while (0)

struct XcdBarrier { unsigned* bar; unsigned x; volatile LAS unsigned* st; };

__device__ __forceinline__ XcdBarrier xcd_barrier_post(unsigned* bar, volatile LAS unsigned* st) {
    XcdBarrier b; b.bar = bar; b.x = xb_xcc_id(); b.st = st;
    if (threadIdx.x == 0) (void)xb_add(&bar[XB_XCNT(b.x)], 1u);
    return b;
}
__device__ __forceinline__ void xcd_barrier_complete(unsigned* bar, unsigned x, unsigned& nloc, unsigned& nx) {
    const unsigned G = gridDim.x * gridDim.y * gridDim.z;
    unsigned sum, cnt, mine, sp = 0u;
    for (;;) {
        sum = 0u; cnt = 0u; mine = 0u;
#pragma unroll
        for (unsigned j = 0; j < 16; ++j) { const unsigned c = xb_ld(&bar[XB_XCNT(j)]); sum += c; cnt += (c > 0u) ? 1u : 0u; mine = (j == x) ? c : mine; }
        if (sum == G) break;
        __builtin_amdgcn_s_sleep(1);
        if ((++sp & 255u) == 0u) { if (xb_ld(&bar[XB_TMO])) break; if (sp > XB_SPIN_CAP) { atomicAdd(&bar[XB_TMO], 1u); break; } }
    }
    nloc = mine > 0u ? mine : 1u; nx = cnt > 0u ? cnt : 1u;
}
__device__ __forceinline__ void xcd_barrier(const XcdBarrier& b) {
    asm volatile("s_waitcnt vmcnt(0)" ::: "memory");
    __syncthreads();
    if (threadIdx.x == 0) {
        unsigned* bar = b.bar;
        __builtin_amdgcn_s_waitcnt(0);
        unsigned nloc = b.st[0], nx = b.st[1];
        if (nloc == 0u) { xcd_barrier_complete(bar, b.x, nloc, nx); b.st[0] = nloc; b.st[1] = nx; }
        const unsigned old = xb_add(&bar[XB_XSUB(b.x)], 1u);
        const unsigned gen = old / nloc;
        if (old + 1u == (gen + 1u) * nloc) {
            __builtin_amdgcn_fence(__ATOMIC_RELEASE, "agent");
            asm volatile("s_waitcnt vmcnt(0)" ::: "memory");
            const unsigned og = xb_add(&bar[XB_TOP], 1u);
            const unsigned tg = og / nx;
            if (og + 1u == (tg + 1u) * nx) xb_add(&bar[XB_TOPGEN], 1u);
            else XB_SPIN(xb_ld(&bar[XB_TOPGEN]) == tg, bar);
            __builtin_amdgcn_fence(__ATOMIC_ACQUIRE, "agent");
            xb_add(&bar[XB_XGEN(b.x)], 1u);
            asm volatile("s_waitcnt vmcnt(0)" ::: "memory");
        } else {
            XB_SPIN(xb_ld(&bar[XB_XGEN(b.x)]) == gen, bar);
            __builtin_amdgcn_fence(__ATOMIC_ACQUIRE, "agent");
            asm volatile("s_waitcnt vmcnt(0)" ::: "memory");
        }
    }
    __syncthreads();
}

struct Frame {
    LAS unsigned char* lds;
    int vcu, G;
};
__device__ __forceinline__ int opaque_tid() { int t = threadIdx.x; asm volatile("" : "+v"(t)); return t; }
#define PH_IDS const int tid = opaque_tid(), lane = tid & 63, w = __builtin_amdgcn_readfirstlane(tid >> 6); (void)tid; (void)lane; (void)w

template <class SrcF>
__device__ __forceinline__ void prep_matrix(const Frame& F, int K, int N, bf16* WT, SrcF src) {
    PH_IDS;
    LAS float* scr = (LAS float*)(F.lds + w * 8448);
    const int gw = F.vcu * NWAVES + w, NGW = F.G * NWAVES;
    const int nblk = N / 32, nitems = (K / 64) * nblk;
    for (int it = gw; it < nitems; it += NGW) {
        const int kb = it / nblk, nb = it % nblk, k0 = 64 * kb, n0 = 32 * nb;
#pragma unroll 8
        for (int i = 0; i < 32; ++i) { const int kk = 2 * i + (lane >> 5); scr[kk * 33 + (lane & 31)] = src(k0 + kk, n0 + (lane & 31)); }
        LDS_WAIT();
        const int c = lane & 7;
#pragma unroll
        for (int j = 0; j < 4; ++j) { const int n = (lane >> 3) + 8 * j; const LAS float* s = scr + (8 * c) * 33 + n;
            u32x4 o; o.x = cvt_pk_bf16(s[0 * 33], s[1 * 33]); o.y = cvt_pk_bf16(s[2 * 33], s[3 * 33]); o.z = cvt_pk_bf16(s[4 * 33], s[5 * 33]); o.w = cvt_pk_bf16(s[6 * 33], s[7 * 33]);
            *(u32x4*)(WT + (size_t)(n0 + n) * K + k0 + 8 * c) = o; }
        LDS_WAIT();
    }
}

struct Args { const void* in[28]; float* out; unsigned char* ws; int p_lo, p_hi; };
__device__ __forceinline__ const float* kin(const Args& a, int i) { asm volatile("" : "+s"(i)); return (const float*)a.in[i]; }

__device__ __forceinline__ void prep_layer(const Frame& F, const Args& in, unsigned char* ws, int L) {
    const int kind = L % 3, j = L / 3;
#pragma unroll 1
    for (int f = 0; f < 2; ++f) {
        const float* wgu = kin(in, 3) + (size_t)(L * 2 + f) * DM * 2 * DFF;
        prep_matrix(F, DM, 2 * DFF, (bf16*)(ws + (f ? W_GU1 : W_GU0)), [=](int k, int n) { const int pn = n >> 8, r = n & 255; const int sc = (r < 128) ? (pn * 128 + r) : (DFF + pn * 128 + (r - 128)); return wgu[(size_t)k * (2 * DFF) + sc]; });
        const float* wdn = kin(in, 4) + (size_t)(L * 2 + f) * DFF * DM;
        prep_matrix(F, DFF, DM, (bf16*)(ws + (f ? W_DN1 : W_DN0)), [=](int k, int n) { return wdn[(size_t)k * DM + n]; });
    }
    if (kind == 0) {
        const float* win = kin(in, 5) + (size_t)j * DM * ML_IN;
        prep_matrix(F, DM, 3072, (bf16*)(ws + W_MIX), [=](int k, int n) { return win[(size_t)k * ML_IN + n]; });
        const float* wo = kin(in, 9) + (size_t)j * DM * DM;
        prep_matrix(F, DM, DM, (bf16*)(ws + W_MIX + (size_t)3072 * 1024 * 2), [=](int k, int n) { return wo[(size_t)k * DM + n]; });
    } else if (kind == 1) {
        const float* mu = kin(in, 10) + (size_t)j * 6 * DM; const float* wrkv = kin(in, 11) + (size_t)j * 3 * DM * DM;
        const float* w1 = kin(in, 13) + (size_t)j * DM * 64; const float* a1 = kin(in, 16) + (size_t)j * DM * 64; const float* g1 = kin(in, 18) + (size_t)j * DM * 128;
        prep_matrix(F, 2048, 3328, (bf16*)(ws + W_MIX), [=](int k, int n) {
            const int kk = k & 1023; const bool hi = k >= 1024; float w; int mi;
            if (n < 3072) { mi = n >> 10; w = wrkv[((size_t)mi * DM + kk) * DM + (n & 1023)]; }
            else { const int c = n - 3072; if (c < 64) { mi = 3; w = w1[kk * 64 + c]; } else if (c < 128) { mi = 4; w = a1[kk * 64 + (c - 64)]; } else { mi = 5; w = g1[kk * 128 + (c - 128)]; } }
            const float m = mu[mi * DM + kk]; return w * (hi ? m : 1.0f - m); });
        const float* w2 = kin(in, 14) + (size_t)j * 64 * DM; const float* a2 = kin(in, 17) + (size_t)j * 64 * DM; const float* g2 = kin(in, 19) + (size_t)j * 128 * DM;
        prep_matrix(F, 256, 3072, (bf16*)(ws + W_MIX + (size_t)3328 * 2048 * 2), [=](int k, int n) {
            const int t = n >> 10, c = n & 1023;
            if (t == 0) return k < 64 ? w2[k * DM + c] : 0.f;
            if (t == 1) return (k >= 64 && k < 128) ? a2[(k - 64) * DM + c] : 0.f;
            return k >= 128 ? g2[(k - 128) * DM + c] : 0.f; });
        const float* wo = kin(in, 25) + (size_t)j * DM * DM;
        prep_matrix(F, DM, DM, (bf16*)(ws + W_MIX + (size_t)3328 * 2048 * 2 + (size_t)3072 * 256 * 2), [=](int k, int n) { return wo[(size_t)k * DM + n]; });
    } else {
        const float* win = kin(in, 26) + (size_t)j * DM * 6144;
        prep_matrix(F, DM, 6144, (bf16*)(ws + W_MIX), [=](int k, int n) { return win[(size_t)k * 6144 + n]; });
        const float* wo = kin(in, 27) + (size_t)j * 2048 * DM;
        prep_matrix(F, 2048, DM, (bf16*)(ws + W_MIX + (size_t)6144 * 1024 * 2), [=](int k, int n) { return wo[(size_t)k * DM + n]; });
    }
}

__device__ __forceinline__ void norm_phase(const Frame& F, const float* xin, float* xout, const bf16* h, float c, const float* gpost, const float* gpre, bf16* xn, int mode) {
    PH_IDS;
    const int gw = F.vcu * NWAVES + w, NGW = F.G * NWAVES;
    f32x4 gp[4], gq[4];
#pragma unroll
    for (int j = 0; j < 4; ++j) { gp[j] = h ? *(const f32x4*)(gpost + 4 * lane + 256 * j) : (f32x4){0.f, 0.f, 0.f, 0.f}; gq[j] = (mode != 3) ? *(const f32x4*)(gpre + 4 * lane + 256 * j) : (f32x4){0.f, 0.f, 0.f, 0.f}; }
    for (int m = gw; m < M; m += NGW) {
        f32x4 v[4];
#pragma unroll
        for (int j = 0; j < 4; ++j) v[j] = *(const f32x4*)(xin + (size_t)m * DM + 4 * lane + 256 * j);
        if (h) {
            f32x4 hv[4]; float s = 0.f;
#pragma unroll
            for (int j = 0; j < 4; ++j) { const u32x2 r = *(const u32x2*)(h + (size_t)m * DM + 4 * lane + 256 * j); hv[j] = (f32x4){bf_lo(r.x), bf_hi(r.x), bf_lo(r.y), bf_hi(r.y)};
                s += (hv[j][0] * hv[j][0] + hv[j][1] * hv[j][1]) + (hv[j][2] * hv[j][2] + hv[j][3] * hv[j][3]); }
            const float rs = __builtin_amdgcn_rsqf(wave_sum(s) * (1.0f / DM) + NORM_EPS) * c;
#pragma unroll
            for (int j = 0; j < 4; ++j) v[j] += hv[j] * rs * gp[j];
        }
#pragma unroll
        for (int j = 0; j < 4; ++j) *(f32x4*)(xout + (size_t)m * DM + 4 * lane + 256 * j) = v[j];
        if (mode != 3) {
            float s = 0.f;
#pragma unroll
            for (int j = 0; j < 4; ++j) s += (v[j][0] * v[j][0] + v[j][1] * v[j][1]) + (v[j][2] * v[j][2] + v[j][3] * v[j][3]);
            const float rs = __builtin_amdgcn_rsqf(wave_sum(s) * (1.0f / DM) + NORM_EPS);
            u32x2 yb[4];
#pragma unroll
            for (int j = 0; j < 4; ++j) { const f32x4 y = v[j] * rs * gq[j]; yb[j].x = cvt_pk_bf16(y[0], y[1]); yb[j].y = cvt_pk_bf16(y[2], y[3]); }
            if (mode == 2) {
                const int t = m & (SEQ - 1);
#pragma unroll
                for (int j = 0; j < 4; ++j) {
                    *(u32x2*)(xn + (size_t)m * 2048 + 4 * lane + 256 * j) = yb[j];
                    if (t != SEQ - 1) *(u32x2*)(xn + (size_t)(m + 1) * 2048 + 1024 + 4 * lane + 256 * j) = yb[j];
                    if (t == 0) { unsigned z = 0u; asm volatile("" : "+v"(z)); *(u32x2*)(xn + (size_t)m * 2048 + 1024 + 4 * lane + 256 * j) = (u32x2){z, z}; }
                }
            } else {
#pragma unroll
                for (int j = 0; j < 4; ++j) *(u32x2*)(xn + (size_t)m * DM + 4 * lane + 256 * j) = yb[j];
            }
        }
    }
}

__device__ __forceinline__ void ml_gate_phase(const Frame& F, const bf16* xn, const float* w_in, const float* b_if, float* ifg) {
    PH_IDS;
    const int gw = F.vcu * NWAVES + w, NGW = F.G * NWAVES;
    f32x4 wif[8][4];
#pragma unroll
    for (int j = 0; j < 4; ++j)
#pragma unroll
        for (int e = 0; e < 4; ++e) { const int k = 4 * lane + 256 * j + e; const f32x4 a = *(const f32x4*)(w_in + (size_t)k * ML_IN + 3072), b = *(const f32x4*)(w_in + (size_t)k * ML_IN + 3076);
            wif[0][j][e] = a[0]; wif[1][j][e] = a[1]; wif[2][j][e] = a[2]; wif[3][j][e] = a[3]; wif[4][j][e] = b[0]; wif[5][j][e] = b[1]; wif[6][j][e] = b[2]; wif[7][j][e] = b[3]; }
    const float bias = lane < 8 ? b_if[lane] : 0.f;
    for (int m = gw; m < M; m += NGW) {
        f32x4 y[4];
#pragma unroll
        for (int j = 0; j < 4; ++j) { const u32x2 r = *(const u32x2*)(xn + (size_t)m * DM + 4 * lane + 256 * j); y[j] = (f32x4){bf_lo(r.x), bf_hi(r.x), bf_lo(r.y), bf_hi(r.y)}; }
        float my = 0.f;
#pragma unroll
        for (int cc = 0; cc < 8; ++cc) { float d = 0.f;
#pragma unroll
            for (int j = 0; j < 4; ++j) d += (y[j][0] * wif[cc][j][0] + y[j][1] * wif[cc][j][1]) + (y[j][2] * wif[cc][j][2] + y[j][3] * wif[cc][j][3]);
            d = wave_sum(d); if (lane == cc) my = d; }
        if (lane < 8) { float val = my + bias; val = 15.0f * tanhf(val * (1.0f / 15.0f));
            if (lane >= 4) val = -log1pf(expf(-val));
            ifg[(size_t)m * 8 + lane] = val; }
    }
}

__device__ __forceinline__ void ml_chunk_phase(const Frame& F, const bf16* proj, const float* ifg, const float* conv_w, bf16* hb) {
    constexpr int QP = 272, SP = 144;
    constexpr int QS = 0, KS = QS + 64 * QP, KWT = KS + 64 * QP, VT = KWT + 128 * SP, PS = VT + 80 * SP, CT = PS + 64 * SP, TAB = CT + 80 * QP, CWT = TAB + 1024;
    static_assert(CWT + 4096 <= RING_BYTES, "ml lds");
    LAS unsigned char* lds = F.lds;
    LAS float* tU = (LAS float*)(lds + TAB); LAS float* tM = tU + 64; LAS float* tB = tU + 128; LAS float* tD = tU + 192;
    PH_IDS;
    const int fr = lane & 15, fq = lane >> 4;
    for (int item = F.vcu; item < NB * 16; item += F.G) {
        const int b = item >> 4, hh = (item >> 2) & 3, vs = item & 3;
        const size_t rowb = (size_t)b * SEQ;
        for (int i = tid; i < 16 * 36; i += 512) { const int r = i / 36, cidx = i % 36; ((LAS unsigned*)(lds + VT + (64 + r) * SP))[cidx] = (r == 0) ? 0x3f803f80u : 0u; }
        const int which = tid >> 8, tq = (tid >> 4) & 15, c8 = tid & 15;
        const int ch = which * 512 + hh * 128 + c8 * 8;
        for (int i = tid; i < 4 * 256; i += 512) { const int jj = i >> 8, cc = i & 255; ((LAS float*)(lds + CWT))[i] = conv_w[jj * 1024 + (cc >> 7) * 512 + hh * 128 + (cc & 127)]; }
        const float qscale = which == 0 ? 0.08838834764831845f : 1.0f;
        const int tqv = tid >> 5, vp = tid & 31;
        const int vcol = 1024 + hh * 256 + vs * 64 + 2 * vp;
        f32x4 C[5];
#pragma unroll
        for (int jj = 0; jj < 5; ++jj) C[jj] = (f32x4){0.f, 0.f, 0.f, 0.f};
        float mst = 0.f;
        u32x4 rq[7]; unsigned rv[4]; float gi, gf;
        const unsigned loQ = (unsigned)((4 * tq) * 3072 + ch) * 2u, loV = (unsigned)((4 * tqv) * 3072 + vcol) * 2u;
        auto prefetch = [&](int c) {
            const char* base = (const char*)proj + (rowb + 64 * c) * (size_t)(3072 * 2);
            const int t0 = 64 * c + 4 * tq - 3;
#pragma unroll
            for (int r = 0; r < 7; ++r) rq[r] = (t0 + r >= 0) ? *(const u32x4*)(base + (ptrdiff_t)(r - 3) * (3072 * 2) + loQ) : (u32x4){0u, 0u, 0u, 0u};
#pragma unroll
            for (int r = 0; r < 4; ++r) rv[r] = *(const unsigned*)(base + (size_t)r * (3072 * 2) + loV);
            const float* gb = ifg + (rowb + 64 * c) * 8 + hh;
            gi = gb[lane * 8]; gf = gb[lane * 8 + 4];
        };
        prefetch(0);
        for (int c = 0; c < SEQ / 64; ++c) {
            float bsum = gf;
#pragma unroll
            for (int o = 1; o < 64; o <<= 1) { const float t = __shfl_up(bsum, o); if (lane >= o) bsum += t; }
            const float uu = gi - bsum; float cm = uu;
#pragma unroll
            for (int o = 1; o < 64; o <<= 1) { const float t = __shfl_up(cm, o); if (lane >= o) cm = fmaxf(cm, t); }
            const float Mx = fmaxf(mst, cm);
            const float M63 = __shfl(Mx, 63), b63 = __shfl(bsum, 63);
            if (w == 0) { tU[lane] = uu; tM[lane] = Mx; tB[lane] = bsum; }
#pragma unroll
            for (int jj = 0; jj < 5; ++jj) { u32x2 o; o.x = cvt_pk_bf16(C[jj][0], C[jj][1]); o.y = cvt_pk_bf16(C[jj][2], C[jj][3]);
                *(LAS u32x2*)(lds + CT + (16 * jj + fr) * QP + (16 * w + 4 * fq) * 2) = o; }
            WG_BAR();
            {
                float kws[4];
#pragma unroll
                for (int tt = 0; tt < 4; ++tt) kws[tt] = fexp(tU[4 * tq + tt] - M63);
                float cw[4][8];
#pragma unroll
                for (int jj = 0; jj < 4; ++jj) { const f32x4 a = *(const LAS f32x4*)(lds + CWT + (jj * 256 + which * 128 + c8 * 8) * 4), bq = *(const LAS f32x4*)(lds + CWT + (jj * 256 + which * 128 + c8 * 8 + 4) * 4);
                    cw[jj][0] = a[0]; cw[jj][1] = a[1]; cw[jj][2] = a[2]; cw[jj][3] = a[3]; cw[jj][4] = bq[0]; cw[jj][5] = bq[1]; cw[jj][6] = bq[2]; cw[jj][7] = bq[3]; }
                float o[4][8];
#pragma unroll
                for (int tt = 0; tt < 4; ++tt) {
#pragma unroll
                    for (int e2 = 0; e2 < 4; ++e2) { float a0 = 0.f, a1 = 0.f;
#pragma unroll
                        for (int jj = 0; jj < 4; ++jj) { const unsigned x = rq[tt + jj][e2]; a0 += cw[jj][2 * e2] * bf_lo(x); a1 += cw[jj][2 * e2 + 1] * bf_hi(x); }
                        o[tt][2 * e2] = fsilu(a0) * qscale; o[tt][2 * e2 + 1] = fsilu(a1) * qscale; }
                    u32x4 pk; pk.x = cvt_pk_bf16(o[tt][0], o[tt][1]); pk.y = cvt_pk_bf16(o[tt][2], o[tt][3]); pk.z = cvt_pk_bf16(o[tt][4], o[tt][5]); pk.w = cvt_pk_bf16(o[tt][6], o[tt][7]);
                    *(LAS u32x4*)(lds + (which ? KS : QS) + (4 * tq + tt) * QP + c8 * 16) = pk;
                }
                if (which) {
#pragma unroll
                    for (int e = 0; e < 8; ++e) { u32x2 pk; pk.x = cvt_pk_bf16(o[0][e] * kws[0], o[1][e] * kws[1]); pk.y = cvt_pk_bf16(o[2][e] * kws[2], o[3][e] * kws[3]);
                        *(LAS u32x2*)(lds + KWT + (c8 * 8 + e) * SP + (4 * tq) * 2) = pk; }
                }
                u32x2 v0, v1;
                v0.x = (rv[0] & 0xffffu) | (rv[1] << 16); v0.y = (rv[2] & 0xffffu) | (rv[3] << 16);
                v1.x = (rv[0] >> 16) | (rv[1] & 0xffff0000u); v1.y = (rv[2] >> 16) | (rv[3] & 0xffff0000u);
                *(LAS u32x2*)(lds + VT + (2 * vp) * SP + (4 * tqv) * 2) = v0; *(LAS u32x2*)(lds + VT + (2 * vp + 1) * SP + (4 * tqv) * 2) = v1;
            }
            WG_BAR();
            if (c + 1 < SEQ / 64) prefetch(c + 1);
            {
                const int tt = w >> 1, st0 = 2 * (w & 1);
                f32x4 s0 = {0.f, 0.f, 0.f, 0.f}, s1 = {0.f, 0.f, 0.f, 0.f};
#pragma unroll
                for (int kk = 0; kk < 4; ++kk) {
                    const bf16x8 yq = *(const LAS bf16x8*)(lds + QS + (16 * tt + fr) * QP + (32 * kk + 8 * fq) * 2);
                    const bf16x8 x0 = *(const LAS bf16x8*)(lds + KS + (16 * st0 + fr) * QP + (32 * kk + 8 * fq) * 2);
                    const bf16x8 x1 = *(const LAS bf16x8*)(lds + KS + (16 * (st0 + 1) + fr) * QP + (32 * kk + 8 * fq) * 2);
                    s0 = mma16(x0, yq, s0); s1 = mma16(x1, yq, s1);
                }
                const int t = 16 * tt + fr; const float Mt = tM[t];
#pragma unroll
                for (int q = 0; q < 2; ++q) { const f32x4 sv = q ? s1 : s0; const int sb = 16 * (st0 + q) + 4 * fq; const f32x4 u4 = *(const LAS f32x4*)(tU + sb);
                    float p[4];
#pragma unroll
                    for (int e = 0; e < 4; ++e) p[e] = (sb + e <= t) ? sv[e] * fexp(u4[e] - Mt) : 0.f;
                    u32x2 pk; pk.x = cvt_pk_bf16(p[0], p[1]); pk.y = cvt_pk_bf16(p[2], p[3]);
                    *(LAS u32x2*)(lds + PS + t * SP + sb * 2) = pk; }
            }
            WG_BAR_L();
            {
                const int tt = w & 3, jb = (w < 4) ? 0 : 3, nj = (w < 4) ? 3 : 2;
                f32x4 a1[3], a2[3];
#pragma unroll
                for (int jj = 0; jj < 3; ++jj) { a1[jj] = (f32x4){0.f, 0.f, 0.f, 0.f}; a2[jj] = (f32x4){0.f, 0.f, 0.f, 0.f}; }
#pragma unroll
                for (int kk = 0; kk < 2; ++kk) { const bf16x8 yp = *(const LAS bf16x8*)(lds + PS + (16 * tt + fr) * SP + (32 * kk + 8 * fq) * 2);
#pragma unroll
                    for (int jj = 0; jj < 3; ++jj) if (jj < nj) { const bf16x8 xv = *(const LAS bf16x8*)(lds + VT + (16 * (jb + jj) + fr) * SP + (32 * kk + 8 * fq) * 2); a1[jj] = mma16(xv, yp, a1[jj]); } }
#pragma unroll
                for (int kk = 0; kk < 4; ++kk) { const bf16x8 yq = *(const LAS bf16x8*)(lds + QS + (16 * tt + fr) * QP + (32 * kk + 8 * fq) * 2);
#pragma unroll
                    for (int jj = 0; jj < 3; ++jj) if (jj < nj) { const bf16x8 xc = *(const LAS bf16x8*)(lds + CT + (16 * (jb + jj) + fr) * QP + (32 * kk + 8 * fq) * 2); a2[jj] = mma16(xc, yq, a2[jj]); } }
                const int t = 16 * tt + fr; const float Mt = tM[t], bt = tB[t]; const float inter = fexp(mst - Mt);
#pragma unroll
                for (int jj = 0; jj < 3; ++jj) a1[jj] = a1[jj] + a2[jj] * inter;
                if (w >= 4 && fq == 0) tD[t] = a1[1][0];
                WG_BAR_L();
                const float dn = fmaxf(fabsf(tD[t]), fexp(-(bt + Mt))); const float rdn = 1.0f / dn;
#pragma unroll
                for (int jj = 0; jj < 3; ++jj) if (jj < nj && jb + jj < 4) { u32x2 pk; pk.x = cvt_pk_bf16(a1[jj][0] * rdn, a1[jj][1] * rdn); pk.y = cvt_pk_bf16(a1[jj][2] * rdn, a1[jj][3] * rdn);
                    *(u32x2*)((char*)(hb + (rowb + 64 * c + 16 * tt) * DM + hh * 256 + vs * 64 + 16 * (jb + jj)) + (unsigned)(fr * DM + 4 * fq) * 2u) = pk; }
            }
            {
                const float decay = fexp(mst - M63);
#pragma unroll
                for (int jj = 0; jj < 5; ++jj) C[jj] = C[jj] * decay;
#pragma unroll
                for (int kk = 0; kk < 2; ++kk) { const bf16x8 xk = *(const LAS bf16x8*)(lds + KWT + (16 * w + fr) * SP + (32 * kk + 8 * fq) * 2);
#pragma unroll
                    for (int jj = 0; jj < 5; ++jj) { const bf16x8 yv = *(const LAS bf16x8*)(lds + VT + (16 * jj + fr) * SP + (32 * kk + 8 * fq) * 2); C[jj] = mma16(xk, yv, C[jj]); } }
                mst = b63 + M63;
            }
            WG_BAR_L();
        }
    }
}

__device__ __forceinline__ void ml_head_phase(const Frame& F, const bf16* hb, const bf16* proj, const float* ng, bf16* hg) {
    PH_IDS;
    const int gw = F.vcu * NWAVES + w, NGW = F.G * NWAVES;
    f32x4 g[4];
#pragma unroll
    for (int j = 0; j < 4; ++j) g[j] = *(const f32x4*)(ng + 4 * lane + 256 * j);
    for (int m = gw; m < M; m += NGW) {
#pragma unroll
        for (int j = 0; j < 4; ++j) {
            const u32x2 r = *(const u32x2*)(hb + (size_t)m * DM + 4 * lane + 256 * j), ro = *(const u32x2*)(proj + (size_t)m * 3072 + 2048 + 4 * lane + 256 * j);
            const f32x4 v = {bf_lo(r.x), bf_hi(r.x), bf_lo(r.y), bf_hi(r.y)}, o = {bf_lo(ro.x), bf_hi(ro.x), bf_lo(ro.y), bf_hi(ro.y)};
            const float s = wave_sum((v[0] * v[0] + v[1] * v[1]) + (v[2] * v[2] + v[3] * v[3]));
            const float rs = __builtin_amdgcn_rsqf(s * (1.0f / 256.0f) + NORM_EPS);
            u32x2 pk; pk.x = cvt_pk_bf16(v[0] * rs * g[j][0] * fsigmoid(o[0]), v[1] * rs * g[j][1] * fsigmoid(o[1])); pk.y = cvt_pk_bf16(v[2] * rs * g[j][2] * fsigmoid(o[2]), v[3] * rs * g[j][3] * fsigmoid(o[3]));
            *(u32x2*)(hg + (size_t)m * DM + 4 * lane + 256 * j) = pk;
        }
    }
}

__device__ __forceinline__ void rt_chunk_phase(const Frame& F, const bf16* proj, bf16* yb) {
    constexpr int QP = 528, SP = 144;
    constexpr int QS = 0, KS = QS + 64 * QP, KWT = KS + 64 * QP, VT = KWT + 256 * SP, PS = VT + 128 * SP, END = PS + 64 * SP;
    static_assert(END <= MISC_OFF, "rt lds");
    LAS unsigned char* lds = F.lds;
    PH_IDS;
    const int fr = lane & 15, fq = lane >> 4;
    for (int item = F.vcu; item < NB * 16; item += F.G) {
        const int b = item >> 4, hh = (item >> 2) & 3, vs = item & 3;
        const size_t rowb = (size_t)b * SEQ;
        const float lg = __builtin_log2f(1.0f - __builtin_amdgcn_exp2f(-5.0f - (float)hh));
        const int tq = tid >> 5, c8 = tid & 31;
        const int qcol = hh * 256, kcol = 1024 + hh * 256 + c8 * 8, vcol = 2048 + hh * 512 + vs * 128 + 4 * c8;
        f32x4 R[16];
#pragma unroll
        for (int i = 0; i < 16; ++i) R[i] = (f32x4){0.f, 0.f, 0.f, 0.f};
        u32x4 rq[4], rk[4]; u32x2 rv[4];
        const unsigned loQ = (unsigned)((tid >> 5) * 6144 + qcol + (tid & 31) * 8) * 2u, loK = (unsigned)((4 * tq) * 6144 + kcol) * 2u, loV = (unsigned)((4 * tq) * 6144 + vcol) * 2u;
        auto prefetch = [&](int c) {
            const char* base = (const char*)proj + (rowb + 64 * c) * (size_t)(6144 * 2);
#pragma unroll
            for (int i = 0; i < 4; ++i) rq[i] = *(const u32x4*)(base + (size_t)i * (16 * 6144 * 2) + loQ);
#pragma unroll
            for (int i = 0; i < 4; ++i) { rk[i] = *(const u32x4*)(base + (size_t)i * (6144 * 2) + loK); rv[i] = *(const u32x2*)(base + (size_t)i * (6144 * 2) + loV); }
        };
        prefetch(0);
        float kws[4];
#pragma unroll
        for (int i = 0; i < 4; ++i) kws[i] = __builtin_amdgcn_exp2f(lg * (float)(63 - (4 * tq + i)));
        const float cdecay = __builtin_amdgcn_exp2f(lg * 64.0f);
        for (int c = 0; c < SEQ / 64; ++c) {
#pragma unroll
            for (int i = 0; i < 4; ++i) { const int idx = tid + 512 * i; *(LAS u32x4*)(lds + QS + (idx >> 5) * QP + (idx & 31) * 16) = rq[i]; }
#pragma unroll
            for (int i = 0; i < 4; ++i) *(LAS u32x4*)(lds + KS + (4 * tq + i) * QP + c8 * 16) = rk[i];
#pragma unroll
            for (int e2 = 0; e2 < 4; ++e2) {
                u32x2 lo, hi;
                lo.x = cvt_pk_bf16(bf_lo(rk[0][e2]) * kws[0], bf_lo(rk[1][e2]) * kws[1]); lo.y = cvt_pk_bf16(bf_lo(rk[2][e2]) * kws[2], bf_lo(rk[3][e2]) * kws[3]);
                hi.x = cvt_pk_bf16(bf_hi(rk[0][e2]) * kws[0], bf_hi(rk[1][e2]) * kws[1]); hi.y = cvt_pk_bf16(bf_hi(rk[2][e2]) * kws[2], bf_hi(rk[3][e2]) * kws[3]);
                *(LAS u32x2*)(lds + KWT + (c8 * 8 + 2 * e2) * SP + (4 * tq) * 2) = lo; *(LAS u32x2*)(lds + KWT + (c8 * 8 + 2 * e2 + 1) * SP + (4 * tq) * 2) = hi;
            }
            {
                u32x2 v0, v1, v2, v3;
                v0.x = (rv[0].x & 0xffffu) | (rv[1].x << 16); v0.y = (rv[2].x & 0xffffu) | (rv[3].x << 16);
                v1.x = (rv[0].x >> 16) | (rv[1].x & 0xffff0000u); v1.y = (rv[2].x >> 16) | (rv[3].x & 0xffff0000u);
                v2.x = (rv[0].y & 0xffffu) | (rv[1].y << 16); v2.y = (rv[2].y & 0xffffu) | (rv[3].y << 16);
                v3.x = (rv[0].y >> 16) | (rv[1].y & 0xffff0000u); v3.y = (rv[2].y >> 16) | (rv[3].y & 0xffff0000u);
                LAS unsigned char* vb = lds + VT + (4 * c8) * SP + (4 * tq) * 2;
                *(LAS u32x2*)(vb) = v0; *(LAS u32x2*)(vb + SP) = v1; *(LAS u32x2*)(vb + 2 * SP) = v2; *(LAS u32x2*)(vb + 3 * SP) = v3;
            }
            WG_BAR();
            {
                const int tt = w >> 1, st0 = 2 * (w & 1);
                f32x4 s0 = {0.f, 0.f, 0.f, 0.f}, s1 = {0.f, 0.f, 0.f, 0.f};
#pragma unroll 2
                for (int kk = 0; kk < 8; ++kk) {
                    const bf16x8 yq = *(const LAS bf16x8*)(lds + QS + (16 * tt + fr) * QP + (32 * kk + 8 * fq) * 2);
                    const bf16x8 x0 = *(const LAS bf16x8*)(lds + KS + (16 * st0 + fr) * QP + (32 * kk + 8 * fq) * 2);
                    const bf16x8 x1 = *(const LAS bf16x8*)(lds + KS + (16 * (st0 + 1) + fr) * QP + (32 * kk + 8 * fq) * 2);
                    s0 = mma16(x0, yq, s0); s1 = mma16(x1, yq, s1);
                }
                const int t = 16 * tt + fr;
#pragma unroll
                for (int q = 0; q < 2; ++q) { const f32x4 sv = q ? s1 : s0; const int sb = 16 * (st0 + q) + 4 * fq;
                    float p[4];
#pragma unroll
                    for (int e = 0; e < 4; ++e) p[e] = (sb + e <= t) ? sv[e] * __builtin_amdgcn_exp2f(lg * (float)(t - sb - e)) : 0.f;
                    u32x2 pk; pk.x = cvt_pk_bf16(p[0], p[1]); pk.y = cvt_pk_bf16(p[2], p[3]);
                    *(LAS u32x2*)(lds + PS + t * SP + sb * 2) = pk; }
            }
            WG_BAR_L();
            if (c + 1 < SEQ / 64) prefetch(c + 1);
            u32x4 xr[8];
#pragma unroll
            for (int kk = 0; kk < 8; ++kk) { xr[kk].x = cvt_pk_bf16(R[2 * kk][0], R[2 * kk][1]); xr[kk].y = cvt_pk_bf16(R[2 * kk][2], R[2 * kk][3]); xr[kk].z = cvt_pk_bf16(R[2 * kk + 1][0], R[2 * kk + 1][1]); xr[kk].w = cvt_pk_bf16(R[2 * kk + 1][2], R[2 * kk + 1][3]); }
#pragma unroll 1
            for (int tt = 0; tt < 4; ++tt) {
                f32x4 aI = {0.f, 0.f, 0.f, 0.f}, aC = {0.f, 0.f, 0.f, 0.f};
#pragma unroll
                for (int kk = 0; kk < 2; ++kk) { const bf16x8 xv = *(const LAS bf16x8*)(lds + VT + (16 * w + fr) * SP + (32 * kk + 8 * fq) * 2);
                    const bf16x8 yp = *(const LAS bf16x8*)(lds + PS + (16 * tt + fr) * SP + (32 * kk + 8 * fq) * 2); aI = mma16(xv, yp, aI); }
#pragma unroll
                for (int kk = 0; kk < 8; ++kk) {
                    const u32x2 qa = *(const LAS u32x2*)(lds + QS + (16 * tt + fr) * QP + (32 * kk + 4 * fq) * 2), qb = *(const LAS u32x2*)(lds + QS + (16 * tt + fr) * QP + (32 * kk + 16 + 4 * fq) * 2);
                    const u32x4 yq = {qa.x, qa.y, qb.x, qb.y};
                    aC = mma16(__builtin_bit_cast(bf16x8, xr[kk]), __builtin_bit_cast(bf16x8, yq), aC);
                }
                const int t = 16 * tt + fr; const float qd = __builtin_amdgcn_exp2f(lg * (float)(t + 1)); const f32x4 val = aI + aC * qd;
                u32x2 pk; pk.x = cvt_pk_bf16(val[0], val[1]); pk.y = cvt_pk_bf16(val[2], val[3]);
                *(u32x2*)((char*)(yb + (rowb + 64 * c + 16 * tt) * 2048 + hh * 512 + vs * 128 + 16 * w) + (unsigned)(fr * 2048 + 4 * fq) * 2u) = pk;
            }
            {
                const bf16x8 yv0 = *(const LAS bf16x8*)(lds + VT + (16 * w + fr) * SP + (8 * fq) * 2), yv1 = *(const LAS bf16x8*)(lds + VT + (16 * w + fr) * SP + (32 + 8 * fq) * 2);
#pragma unroll
                for (int dt = 0; dt < 16; ++dt) {
                    const bf16x8 x0 = *(const LAS bf16x8*)(lds + KWT + (16 * dt + fr) * SP + (8 * fq) * 2), x1 = *(const LAS bf16x8*)(lds + KWT + (16 * dt + fr) * SP + (32 + 8 * fq) * 2);
                    R[dt] = R[dt] * cdecay; R[dt] = mma16(x0, yv0, R[dt]); R[dt] = mma16(x1, yv1, R[dt]);
                    if ((dt & 3) == 3) asm volatile("" ::: "memory");
                }
            }
            WG_BAR_L();
        }
    }
}

__device__ __forceinline__ void rt_head_phase(const Frame& F, bf16* yb, const bf16* proj) {
    PH_IDS;
    const int gw = F.vcu * NWAVES + w, NGW = F.G * NWAVES;
    for (int m = gw; m < M; m += NGW) {
#pragma unroll
        for (int hd = 0; hd < 4; ++hd) {
            f32x4 v[2], g[2]; float s = 0.f;
#pragma unroll
            for (int q = 0; q < 2; ++q) { const int col = hd * 512 + q * 256 + 4 * lane;
                const u32x2 r = *(const u32x2*)(yb + (size_t)m * 2048 + col), rg = *(const u32x2*)(proj + (size_t)m * 6144 + 4096 + col);
                v[q] = (f32x4){bf_lo(r.x), bf_hi(r.x), bf_lo(r.y), bf_hi(r.y)}; g[q] = (f32x4){bf_lo(rg.x), bf_hi(rg.x), bf_lo(rg.y), bf_hi(rg.y)};
                s += (v[q][0] * v[q][0] + v[q][1] * v[q][1]) + (v[q][2] * v[q][2] + v[q][3] * v[q][3]); }
            const float rs = __builtin_amdgcn_rsqf(wave_sum(s) * (1.0f / 512.0f) + NORM_EPS);
#pragma unroll
            for (int q = 0; q < 2; ++q) { const int col = hd * 512 + q * 256 + 4 * lane;
                u32x2 pk; pk.x = cvt_pk_bf16(fsilu(g[q][0]) * v[q][0] * rs, fsilu(g[q][1]) * v[q][1] * rs); pk.y = cvt_pk_bf16(fsilu(g[q][2]) * v[q][2] * rs, fsilu(g[q][3]) * v[q][3] * rs);
                *(u32x2*)(yb + (size_t)m * 2048 + col) = pk; }
        }
    }
}

__device__ __forceinline__ float red16(float v) { v += __shfl_xor(v, 1); v += __shfl_xor(v, 2); v += __shfl_xor(v, 4); v += __shfl_xor(v, 8); return v; }
__device__ __forceinline__ void rw_scan_phase(const Frame& F, const bf16* rkv, const bf16* wag, const float* k_k, const float* k_a, const float* r_k, const float* ln_g, const float* ln_b, bf16* yout) {
    constexpr int TB = 32;
    constexpr int VW = 0, VK = 8192, VV = 16384, VA = 24576, VB = 32768, VR = 40960, VG = 49152, BON = 57344, SA = 57344 + 128, YP = SA + 4096;
    static_assert(YP + 65536 <= MISC_OFF, "rw lds");
    LAS unsigned char* lds = F.lds;
    PH_IDS;
    for (int item = F.vcu; item < NB * 16; item += F.G) {
        const int b = item >> 4, hh = item & 15;
        const size_t rowb = (size_t)b * SEQ;
        const int ts = tid >> 4, c4 = tid & 15, chg = hh * 64 + 4 * c4;
        const f32x4 kk4 = *(const f32x4*)(k_k + chg), ka4 = *(const f32x4*)(k_a + chg), rk4 = *(const f32x4*)(r_k + chg), lg4 = *(const f32x4*)(ln_g + chg), lb4 = *(const f32x4*)(ln_b + chg);
        float S[8];
#pragma unroll
        for (int i = 0; i < 8; ++i) S[i] = 0.f;
        u32x2 pr, pk, pv, pw, pa, pg;
        auto prefetch = [&](int tb) {
            const size_t row = rowb + (size_t)tb * TB + ts;
            pr = *(const u32x2*)(rkv + row * 3072 + chg); pk = *(const u32x2*)(rkv + row * 3072 + 1024 + chg); pv = *(const u32x2*)(rkv + row * 3072 + 2048 + chg);
            pw = *(const u32x2*)(wag + row * 3072 + chg); pa = *(const u32x2*)(wag + row * 3072 + 1024 + chg); pg = *(const u32x2*)(wag + row * 3072 + 2048 + chg);
        };
        prefetch(0);
        for (int tb = 0; tb < SEQ / TB; ++tb) {
            {
                const f32x4 r = {bf_lo(pr.x), bf_hi(pr.x), bf_lo(pr.y), bf_hi(pr.y)}, k = {bf_lo(pk.x), bf_hi(pk.x), bf_lo(pk.y), bf_hi(pk.y)}, v = {bf_lo(pv.x), bf_hi(pv.x), bf_lo(pv.y), bf_hi(pv.y)};
                const f32x4 lw = {bf_lo(pw.x), bf_hi(pw.x), bf_lo(pw.y), bf_hi(pw.y)}, a = {bf_lo(pa.x), bf_hi(pa.x), bf_lo(pa.y), bf_hi(pa.y)}, g = {bf_lo(pg.x), bf_hi(pg.x), bf_lo(pg.y), bf_hi(pg.y)};
                const f32x4 kkv = k * kk4;
                const float ss = red16((kkv[0] * kkv[0] + kkv[1] * kkv[1]) + (kkv[2] * kkv[2] + kkv[3] * kkv[3]));
                const float inv = 1.0f / fmaxf(sqrtf(ss), 1e-12f);
                const f32x4 kkn = kkv * inv;
                const f32x4 kp = k * (1.0f + (a - 1.0f) * ka4);
                const f32x4 rkp = r * kp * rk4;
                const float bd = red16((rkp[0] + rkp[1]) + (rkp[2] + rkp[3]));
                const f32x4 dec = {fexp(lw[0]), fexp(lw[1]), fexp(lw[2]), fexp(lw[3])};
                const int o = (ts * 64 + 4 * c4) * 4;
                *(LAS f32x4*)(lds + VW + o) = dec; *(LAS f32x4*)(lds + VK + o) = kp; *(LAS f32x4*)(lds + VV + o) = v; *(LAS f32x4*)(lds + VA + o) = -kkn; *(LAS f32x4*)(lds + VB + o) = kkn * a;
                *(LAS f32x4*)(lds + VR + o) = r; *(LAS f32x4*)(lds + VG + o) = g;
                if (c4 == 0) *(LAS float*)(lds + BON + ts * 4) = bd;
            }
            WG_BAR();
            if (tb + 1 < SEQ / TB) prefetch(tb + 1);
#pragma unroll 2
            for (int t = 0; t < TB; ++t) {
                const int o = (t * 64 + 8 * w) * 4;
                const f32x4 w0 = *(const LAS f32x4*)(lds + VW + o), w1 = *(const LAS f32x4*)(lds + VW + o + 16);
                const f32x4 a0 = *(const LAS f32x4*)(lds + VA + o), a1 = *(const LAS f32x4*)(lds + VA + o + 16);
                const f32x4 b0 = *(const LAS f32x4*)(lds + VB + o), b1 = *(const LAS f32x4*)(lds + VB + o + 16);
                const f32x4 k0 = *(const LAS f32x4*)(lds + VK + o), k1 = *(const LAS f32x4*)(lds + VK + o + 16);
                const f32x4 r0 = *(const LAS f32x4*)(lds + VR + o), r1 = *(const LAS f32x4*)(lds + VR + o + 16);
                const float vi = *(const LAS float*)(lds + VV + (t * 64 + lane) * 4);
                float p = (S[0] * a0[0] + S[1] * a0[1]) + (S[2] * a0[2] + S[3] * a0[3]) + (S[4] * a1[0] + S[5] * a1[1]) + (S[6] * a1[2] + S[7] * a1[3]);
                LAS float* sa = (LAS float*)(lds + SA + (t & 1) * 2048);
                sa[lane * 8 + w] = p;
                WG_BAR_L();
                const f32x4 q0 = *(const LAS f32x4*)(sa + lane * 8), q1 = *(const LAS f32x4*)(sa + lane * 8 + 4);
                const float sv = ((q0[0] + q0[1]) + (q0[2] + q0[3])) + ((q1[0] + q1[1]) + (q1[2] + q1[3]));
                S[0] = S[0] * w0[0] + sv * b0[0] + vi * k0[0]; S[1] = S[1] * w0[1] + sv * b0[1] + vi * k0[1]; S[2] = S[2] * w0[2] + sv * b0[2] + vi * k0[2]; S[3] = S[3] * w0[3] + sv * b0[3] + vi * k0[3];
                S[4] = S[4] * w1[0] + sv * b1[0] + vi * k1[0]; S[5] = S[5] * w1[1] + sv * b1[1] + vi * k1[1]; S[6] = S[6] * w1[2] + sv * b1[2] + vi * k1[2]; S[7] = S[7] * w1[3] + sv * b1[3] + vi * k1[3];
                const float yp = (S[0] * r0[0] + S[1] * r0[1]) + (S[2] * r0[2] + S[3] * r0[3]) + (S[4] * r1[0] + S[5] * r1[1]) + (S[6] * r1[2] + S[7] * r1[3]);
                *(LAS float*)(lds + YP + ((t * 8 + w) * 64 + lane) * 4) = yp;
            }
            WG_BAR_L();
            {
                const int o = (ts * 64 + 4 * c4) * 4;
                f32x4 y = *(const LAS f32x4*)(lds + YP + ((ts * 8) * 64 + 4 * c4) * 4);
#pragma unroll
                for (int ww = 1; ww < 8; ++ww) y += *(const LAS f32x4*)(lds + YP + ((ts * 8 + ww) * 64 + 4 * c4) * 4);
                const f32x4 v = *(const LAS f32x4*)(lds + VV + o), g = *(const LAS f32x4*)(lds + VG + o);
                const float bd = *(const LAS float*)(lds + BON + ts * 4);
                const float mean = red16((y[0] + y[1]) + (y[2] + y[3])) * (1.0f / 64.0f);
                const f32x4 d = y - mean;
                const float var = red16((d[0] * d[0] + d[1] * d[1]) + (d[2] * d[2] + d[3] * d[3])) * (1.0f / 64.0f);
                const float rs = __builtin_amdgcn_rsqf(var + 64e-5f);
                const f32x4 outv = ((d * rs) * lg4 + lb4 + v * bd) * g;
                u32x2 po; po.x = cvt_pk_bf16(outv[0], outv[1]); po.y = cvt_pk_bf16(outv[2], outv[3]);
                *(u32x2*)(yout + (rowb + (size_t)tb * TB + ts) * DM + chg) = po;
            }
            WG_BAR_L();
        }
    }
}

constexpr int N_PHASES = 1 + DEPTH * 11;

__global__ void __launch_bounds__(NWAVES * 64, 2) mk_fwd(Args args) {
    extern __shared__ __attribute__((aligned(16))) unsigned char lds_raw[];
    Frame F;
    F.lds = (LAS unsigned char*)lds_raw;
    F.G = gridDim.x; { const int bx = blockIdx.x; F.vcu = (F.G % 8 == 0) ? (bx % 8) * (F.G / 8) + bx / 8 : bx; }
    volatile LAS unsigned* MISC = (volatile LAS unsigned*)(F.lds + MISC_OFF);
    for (int u = threadIdx.x; u < (LDS_BYTES - MISC_OFF) / 4; u += NWAVES * 64) ((LAS unsigned*)(F.lds + MISC_OFF))[u] = 0u;
    __syncthreads();
    unsigned char* ws = args.ws;
    unsigned* ctl = (unsigned*)(ws + WS_CTL);
    const int lo = args.p_lo, hi = args.p_hi;
    XcdBarrier bar; bar.bar = ctl + CW_BAR; bar.x = 0; bar.st = nullptr;
    if (hi - lo > 1) bar = xcd_barrier_post(ctl + CW_BAR, MISC + 8);
    const Args& in = args;
    float* xm = args.out;
    bf16* XN = (bf16*)(ws + WS_XN); bf16* MO = (bf16*)(ws + WS_MO);
    bf16* RA = (bf16*)(ws + WS_A); bf16* RB = (bf16*)(ws + WS_B);
    int p = 0;
#define PH_ON (p >= lo && p < hi)
#define PH_END do { if (p >= lo && p + 1 < hi) xcd_barrier(bar); ++p; } while (0)

    if (PH_ON) { prep_layer(F, in, ws, 0); norm_phase(F, kin(in, 0), xm, nullptr, 0.f, nullptr, kin(in, 2), XN, 0); }
    PH_END;

#pragma unroll 1
    for (int s = 0; s < DEPTH * 3; ++s) {
        const int L = s / 3, sp = s % 3, kind = L % 3, jm = L / 3;
        const float* g6 = kin(in, 2) + (size_t)L * 6 * DM;
        if (sp != 1) {
            const int f = sp >> 1;
            if (PH_ON) { pg8::Gemm g{XN, (const bf16*)(ws + (f ? W_GU1 : W_GU0)), M, 2 * DFF, DM}; pg8::StaticOrder S; S.init(M, 2 * DFF, F.G, (int)blockIdx.x);
                pg8::EpiSwiglu E{RA, DFF}; pg8::gemm_phase<pg8::EpiSwiglu, pg8::StaticOrder, true, true>(F.lds, g, S, E); }
            PH_END;
            if (PH_ON) { pg8::Gemm g{RA, (const bf16*)(ws + (f ? W_DN1 : W_DN0)), M, DM, DFF}; pg8::StaticOrder S; S.init(M, DM, F.G, (int)blockIdx.x);
                pg8::EpiPlain E{RB, DM}; pg8::gemm_phase<pg8::EpiPlain, pg8::StaticOrder, true, true>(F.lds, g, S, E); }
            PH_END;
            if (PH_ON) {
                if (f == 0) {
                    norm_phase(F, xm, xm, RB, 0.5f, g6 + 1 * DM, g6 + 2 * DM, XN, kind == 1 ? 2 : 0);
                } else {
                    const bool lastl = (L == DEPTH - 1);
                    if (!lastl) prep_layer(F, in, ws, L + 1);
                    norm_phase(F, xm, xm, RB, 0.5f, g6 + 5 * DM, lastl ? nullptr : g6 + 6 * DM, XN, lastl ? 3 : 0);
                }
            }
            PH_END;
        } else {
            const bf16* WM = (const bf16*)(ws + W_MIX);
            const bf16* a_out; const bf16* w_out; int k_out;
            if (kind == 0) {
                if (PH_ON) { pg8::Gemm g{XN, WM, M, 3072, DM}; pg8::StaticOrder S; S.init(M, 3072, F.G, (int)blockIdx.x);
                    pg8::EpiPlain E{RA, 3072}; pg8::gemm_phase<pg8::EpiPlain, pg8::StaticOrder, true, true>(F.lds, g, S, E);
                    ml_gate_phase(F, XN, kin(in, 5) + (size_t)jm * DM * ML_IN, kin(in, 6) + jm * 8, (float*)(ws + WS_A + 192 * MiB)); }
                PH_END;
                if (PH_ON) ml_chunk_phase(F, RA, (const float*)(ws + WS_A + 192 * MiB), kin(in, 7) + (size_t)jm * 4 * DM, RB);
                PH_END;
                if (PH_ON) ml_head_phase(F, RB, RA, kin(in, 8) + (size_t)jm * DM, RB + (size_t)M * DM);
                PH_END;
                a_out = RB + (size_t)M * DM; w_out = WM + (size_t)3072 * 1024; k_out = DM;
            } else if (kind == 1) {
                bf16* lmid = RB; bf16* wag = RA + (size_t)M * 3072; bf16* yo = RB + (size_t)M * 256;
                if (PH_ON) { pg8::Gemm g{XN, WM, M, 3328, 2048}; pg8::StaticOrder S; S.init(M, 3328, F.G, (int)blockIdx.x);
                    pg8::EpiRw1 E{RA, lmid}; pg8::gemm_phase<pg8::EpiRw1, pg8::StaticOrder, true, true>(F.lds, g, S, E); }
                PH_END;
                if (PH_ON) { int k_rw2 = 256; asm volatile("" : "+s"(k_rw2));
                    pg8::Gemm g{lmid, WM + (size_t)3328 * 2048, M, 3072, k_rw2}; pg8::StaticOrder S; S.init(M, 3072, F.G, (int)blockIdx.x);
                    pg8::EpiRw2 E{wag, kin(in, 12) + (size_t)jm * DM, kin(in, 15) + (size_t)jm * DM}; pg8::gemm_phase<pg8::EpiRw2, pg8::StaticOrder, true, true>(F.lds, g, S, E); }
                PH_END;
                if (PH_ON) rw_scan_phase(F, RA, wag, kin(in, 20) + (size_t)jm * DM, kin(in, 21) + (size_t)jm * DM, kin(in, 22) + (size_t)jm * DM, kin(in, 23) + (size_t)jm * DM, kin(in, 24) + (size_t)jm * DM, yo);
                PH_END;
                a_out = yo; w_out = WM + (size_t)3328 * 2048 + (size_t)3072 * 256; k_out = DM;
            } else {
                if (PH_ON) { pg8::Gemm g{XN, WM, M, 6144, DM}; pg8::StaticOrder S; S.init(M, 6144, F.G, (int)blockIdx.x);
                    pg8::EpiRtIn E{RA, (const int*)kin(in, 1)}; pg8::gemm_phase<pg8::EpiRtIn, pg8::StaticOrder, true, true>(F.lds, g, S, E); }
                PH_END;
                if (PH_ON) rt_chunk_phase(F, RA, RB);
                PH_END;
                if (PH_ON) rt_head_phase(F, RB, RA);
                PH_END;
                a_out = RB; w_out = WM + (size_t)6144 * 1024; k_out = 2048;
            }
            if (PH_ON) { pg8::Gemm g{a_out, w_out, M, DM, k_out}; pg8::StaticOrder S; S.init(M, DM, F.G, (int)blockIdx.x);
                pg8::EpiPlain E{MO, DM}; pg8::gemm_phase<pg8::EpiPlain, pg8::StaticOrder, true, true>(F.lds, g, S, E); }
            PH_END;
            if (PH_ON) norm_phase(F, xm, xm, MO, 1.0f, g6 + 3 * DM, g6 + 4 * DM, XN, 0);
            PH_END;
        }
    }
#undef PH_ON
#undef PH_END
}

extern "C" void kernel_launch(void* const* d_in, const int* in_sizes, int n_in, void* d_out, int out_size, void* d_ws, size_t ws_size, hipStream_t stream) {
    static int grid = 0;
    if (grid == 0) {
        if (n_in != 28 || out_size != M * DM || ws_size < WS_END) { fprintf(stderr, "kernel_launch: unexpected shapes: n_in %d out %d ws %zu (need %zu)\n", n_in, out_size, ws_size, (size_t)WS_END); grid = -1; return; }
        int dev = 0, cus = 0, per_cu = 0;
        if (hipGetDevice(&dev) != hipSuccess || hipDeviceGetAttribute(&cus, hipDeviceAttributeMultiprocessorCount, dev) != hipSuccess) { grid = -1; return; }
        if (hipFuncSetAttribute((const void*)mk_fwd, hipFuncAttributeMaxDynamicSharedMemorySize, LDS_BYTES) != hipSuccess) { fprintf(stderr, "kernel_launch: hipFuncSetAttribute failed\n"); grid = -1; return; }
        if (hipOccupancyMaxActiveBlocksPerMultiprocessor(&per_cu, (const void*)mk_fwd, NWAVES * 64, LDS_BYTES) != hipSuccess || per_cu < 1) { fprintf(stderr, "kernel_launch: occupancy query says %d\n", per_cu); (void)hipGetLastError(); grid = -1; return; }
        grid = cus;
    }
    if (grid < 0) return;
    (void)hipMemsetAsync((char*)d_ws + WS_CTL, 0, CTL_ZERO_BYTES, stream);
    Args a{};
    for (int i = 0; i < 28; ++i) a.in[i] = d_in[i];
    a.out = (float*)d_out; a.ws = (unsigned char*)d_ws;
#if MK_PER_PHASE
    for (int p = 0; p < N_PHASES; ++p) { a.p_lo = p; a.p_hi = p + 1; hipLaunchKernelGGL(mk_fwd, dim3(grid), dim3(NWAVES * 64), LDS_BYTES, stream, a); }
#else
    a.p_lo = 0; a.p_hi = N_PHASES;
    hipLaunchKernelGGL(mk_fwd, dim3(grid), dim3(NWAVES * 64), LDS_BYTES, stream, a);
#endif
}
```

```cpp
#include <hip/hip_runtime.h>
#include <cstdio>
#include <cstdint>

#ifndef MK_PER_PHASE
#define MK_PER_PHASE 0
#endif

#define LAS __attribute__((address_space(3)))
#define GAS __attribute__((address_space(1)))
typedef unsigned short bf16;
typedef short bf16x8 __attribute__((ext_vector_type(8)));
typedef float f32x4 __attribute__((ext_vector_type(4)));
typedef float f32x2 __attribute__((ext_vector_type(2)));
typedef unsigned u32x4 __attribute__((ext_vector_type(4)));
typedef unsigned u32x2 __attribute__((ext_vector_type(2)));

constexpr int DM = 1024, NB = 16, SEQ = 2048, DEPTH = 4, DFF = 2816;
constexpr int M = NB * SEQ;
constexpr float NORM_EPS = 1e-6f;
constexpr int ML_IN = 3080;
constexpr int NWAVES = 8;

constexpr size_t MiB = 1u << 20;
constexpr size_t WS_CTL = 0, CTL_ZERO_BYTES = 1 * MiB;
constexpr size_t WS_W = 1 * MiB;
constexpr size_t W_GU0 = WS_W, W_DN0 = W_GU0 + (size_t)5632 * 1024 * 2, W_GU1 = W_DN0 + (size_t)1024 * 2816 * 2, W_DN1 = W_GU1 + (size_t)5632 * 1024 * 2;
constexpr size_t W_MIX = W_DN1 + (size_t)1024 * 2816 * 2;
constexpr size_t WS_XN = 58 * MiB;
constexpr size_t WS_MO = WS_XN + 64 * MiB;
constexpr size_t WS_A = 186 * MiB;
constexpr size_t WS_B = 570 * MiB;
constexpr size_t WS_END = 698 * MiB;
static_assert(W_MIX + (size_t)17 * MiB <= WS_XN, "weight region");
constexpr int CW_BAR = 4096;

constexpr int RING_BYTES = 131072;
constexpr int LDS_BYTES = 147456;
constexpr int MISC_OFF = 145408;

typedef __bf16 bf16x2_t __attribute__((ext_vector_type(2)));
__device__ __forceinline__ unsigned cvt_pk_bf16(float lo, float hi) { const f32x2 v = {lo, hi}; return __builtin_bit_cast(unsigned, __builtin_convertvector(v, bf16x2_t)); }
__device__ __forceinline__ float bf_lo(unsigned u) { return __uint_as_float(u << 16); }
__device__ __forceinline__ float bf_hi(unsigned u) { return __uint_as_float(u & 0xffff0000u); }
__device__ __forceinline__ float fexp(float x) { return __builtin_amdgcn_exp2f(x * 1.4426950408889634f); }
__device__ __forceinline__ float fsigmoid(float x) { return __builtin_amdgcn_rcpf(1.0f + fexp(-x)); }
__device__ __forceinline__ float ftanh(float x) { return 2.0f * fsigmoid(2.0f * x) - 1.0f; }
__device__ __forceinline__ float fsilu(float x) { return x * fsigmoid(x); }
__device__ __forceinline__ float wave_sum(float v) {
#pragma unroll
    for (int o = 1; o < 64; o <<= 1) v += __shfl_xor(v, o);
    return v;
}
__device__ __forceinline__ f32x4 mma16(bf16x8 x, bf16x8 y, f32x4 c) { return __builtin_amdgcn_mfma_f32_16x16x32_bf16(x, y, c, 0, 0, 0); }
#define LDS_WAIT() asm volatile("s_waitcnt lgkmcnt(0)" ::: "memory")
#define WG_BAR() do { asm volatile("s_waitcnt vmcnt(0) lgkmcnt(0)" ::: "memory"); __builtin_amdgcn_s_barrier(); asm volatile("" ::: "memory"); } while (0)
#define WG_BAR_L() do { asm volatile("s_waitcnt lgkmcnt(0)" ::: "memory"); __builtin_amdgcn_s_barrier(); asm volatile("" ::: "memory"); } while (0)

namespace pg8 {
#define PG8_LAS __attribute__((address_space(3)))
typedef unsigned short bf16_t;
constexpr int BM = 256, BK = 64, HALF = 128, HTB = HALF * BK * 2, STAGE_BYTES = 8 * HTB, NXCD = 8, WGM = 8;
__host__ __device__ __forceinline__ int lds_byte(int r, int c) { const int st = (r >> 4) * 2 + (c >> 5), rr = r & 15, cc = c & 31, ob = rr * 64 + cc * 2; return st * 1024 + (ob ^ (((ob >> 9) & 1) << 5)); }
__host__ __device__ __forceinline__ void stage_rc(int b, int& R, int& C) { const int st = b / 1024, sb = b % 1024, swz = sb ^ (((sb >> 9) & 1) << 5); R = (st >> 1) * 16 + swz / 64; C = (st & 1) * 32 + (swz % 64) / 2; }
__host__ __device__ __forceinline__ int perm32(int rho) { const int n = rho >> 4, i = rho & 15; return 8 * (i >> 2) + 4 * n + (i & 3); }

struct Unit { int pm, pn; };
struct Gemm { const bf16_t* A; const bf16_t* Bt; int M, N, K; };

struct StaticOrder {
    int nM, nN, nwg, G, c;
    __host__ __device__ void init(int M_, int N_, int G_, int c_) { nM = M_ / BM; nN = N_ / BM; nwg = nM * nN; G = G_; c = c_; }
    __host__ __device__ bool next(int i, Unit& u) const {
        const long L = (long)i * G + c; if (L >= nwg) return false;
        int wgid = (int)L; { const int q = nwg / NXCD, r = nwg % NXCD, xcd = wgid % NXCD, off = wgid / NXCD; wgid = (xcd < r ? xcd * (q + 1) : r * (q + 1) + (xcd - r) * q) + off; }
        const int nig = WGM * nN, gid = wgid / nig, fm = gid * WGM, gsz = (nM - fm) < WGM ? (nM - fm) : WGM;
        u.pm = fm + ((wgid % nig) % gsz); u.pn = (wgid % nig) / gsz; return true;
    }
    __device__ __forceinline__ void a_ready(const Unit&) const {}
    __device__ __forceinline__ void done(const Unit&) const {}
};

__device__ __forceinline__ u32x4 pack8(f32x4 v0, f32x4 v1) { u32x4 w; w.x = cvt_pk_bf16(v0[0], v0[1]); w.y = cvt_pk_bf16(v0[2], v0[3]); w.z = cvt_pk_bf16(v1[0], v1[1]); w.w = cvt_pk_bf16(v1[2], v1[3]); return w; }

struct EpiPlain {
    static constexpr bool PERM = true, AFTER_DRAIN = false;
    bf16_t* O; int ldc;
    __device__ __forceinline__ void operator()(const f32x4 (&acc)[2][2][4][2], const Unit& u, int wr, int wc, int fr, int fq) const {
        const int row0 = u.pm * BM + wr * 64 + fr, col0 = u.pn * BM + wc * 32 + 8 * fq;
#pragma unroll
        for (int ai = 0; ai < 2; ++ai)
#pragma unroll
            for (int m = 0; m < 4; ++m) { bf16_t* rowp = O + (size_t)(row0 + ai * HALF + m * 16) * ldc + col0;
#pragma unroll
                for (int bj = 0; bj < 2; ++bj) *(u32x4*)(rowp + bj * HALF) = pack8(acc[ai][bj][m][0], acc[ai][bj][m][1]); }
    }
};
struct EpiSwiglu {
    static constexpr bool PERM = true, AFTER_DRAIN = false;
    bf16_t* O; int ldc;
    __device__ __forceinline__ void operator()(const f32x4 (&acc)[2][2][4][2], const Unit& u, int wr, int wc, int fr, int fq) const {
        const int row0 = u.pm * BM + wr * 64 + fr, col0 = u.pn * HALF + wc * 32 + 8 * fq;
#pragma unroll
        for (int ai = 0; ai < 2; ++ai)
#pragma unroll
            for (int m = 0; m < 4; ++m) { bf16_t* rowp = O + (size_t)(row0 + ai * HALF + m * 16) * ldc + col0;
                f32x4 o[2];
#pragma unroll
                for (int n = 0; n < 2; ++n)
#pragma unroll
                    for (int e = 0; e < 4; ++e) { const float g = acc[ai][0][m][n][e]; o[n][e] = g * fsigmoid(g) * acc[ai][1][m][n][e]; }
                *(u32x4*)rowp = pack8(o[0], o[1]); }
    }
};
struct EpiRw1 {
    static constexpr bool PERM = true, AFTER_DRAIN = false;
    bf16_t* rkv; bf16_t* lmid;
    __device__ __forceinline__ void operator()(const f32x4 (&acc)[2][2][4][2], const Unit& u, int wr, int wc, int fr, int fq) const {
        const int row0 = u.pm * BM + wr * 64 + fr;
        if (u.pn < 12) {
            const int col0 = u.pn * BM + wc * 32 + 8 * fq;
#pragma unroll
            for (int ai = 0; ai < 2; ++ai)
#pragma unroll
                for (int m = 0; m < 4; ++m) { bf16_t* rowp = rkv + (size_t)(row0 + ai * HALF + m * 16) * 3072 + col0;
#pragma unroll
                    for (int bj = 0; bj < 2; ++bj) *(u32x4*)(rowp + bj * HALF) = pack8(acc[ai][bj][m][0], acc[ai][bj][m][1]); }
        } else {
            const int col0 = wc * 32 + 8 * fq;
#pragma unroll
            for (int ai = 0; ai < 2; ++ai)
#pragma unroll
                for (int m = 0; m < 4; ++m) { bf16_t* rowp = lmid + (size_t)(row0 + ai * HALF + m * 16) * 256 + col0;
#pragma unroll
                    for (int bj = 0; bj < 2; ++bj) { f32x4 o[2];
#pragma unroll
                        for (int n = 0; n < 2; ++n)
#pragma unroll
                            for (int e = 0; e < 4; ++e) { const float v = acc[ai][bj][m][n][e]; o[n][e] = (bj == 1) ? fsigmoid(v) : (wc < 2 ? ftanh(v) : v); }
                        *(u32x4*)(rowp + bj * HALF) = pack8(o[0], o[1]); } }
        }
    }
};
struct EpiRw2 {
    static constexpr bool PERM = true, AFTER_DRAIN = false;
    bf16_t* O; const float* w0; const float* a0;
    __device__ __forceinline__ void operator()(const f32x4 (&acc)[2][2][4][2], const Unit& u, int wr, int wc, int fr, int fq) const {
        const int row0 = u.pm * BM + wr * 64 + fr, col0 = u.pn * BM + wc * 32 + 8 * fq, kind = u.pn >> 2, cc0 = (u.pn & 3) * BM + wc * 32 + 8 * fq;
        if (kind == 2) {
#pragma unroll
            for (int ai = 0; ai < 2; ++ai)
#pragma unroll
                for (int m = 0; m < 4; ++m) { bf16_t* rowp = O + (size_t)(row0 + ai * HALF + m * 16) * 3072 + col0;
#pragma unroll
                    for (int bj = 0; bj < 2; ++bj) *(u32x4*)(rowp + bj * HALF) = pack8(acc[ai][bj][m][0], acc[ai][bj][m][1]); }
        } else {
            const float* bp = (kind == 0 ? w0 : a0) + cc0; const float sc = kind == 0 ? -0.60653065971f : 1.0f;
#pragma unroll
            for (int bj = 0; bj < 2; ++bj) {
                const f32x4 b0 = *(const f32x4*)(bp + bj * HALF), b1 = *(const f32x4*)(bp + bj * HALF + 4);
#pragma unroll
                for (int ai = 0; ai < 2; ++ai)
#pragma unroll
                    for (int m = 0; m < 4; ++m) { bf16_t* rowp = O + (size_t)(row0 + ai * HALF + m * 16) * 3072 + col0; f32x4 o0, o1;
#pragma unroll
                        for (int e = 0; e < 4; ++e) { o0[e] = sc * fsigmoid(acc[ai][bj][m][0][e] + b0[e]); o1[e] = sc * fsigmoid(acc[ai][bj][m][1][e] + b1[e]); }
                        *(u32x4*)(rowp + bj * HALF) = pack8(o0, o1); }
            }
        }
    }
};
struct EpiRtIn {
    static constexpr bool PERM = true, AFTER_DRAIN = false;
    bf16_t* O; const int* pos;
    __device__ __forceinline__ void operator()(const f32x4 (&acc)[2][2][4][2], const Unit& u, int wr, int wc, int fr, int fq) const {
        const int row0 = u.pm * BM + wr * 64 + fr, col0 = u.pn * BM + wc * 32 + 8 * fq;
        if (u.pn >= 8) {
#pragma unroll
            for (int ai = 0; ai < 2; ++ai)
#pragma unroll
                for (int m = 0; m < 4; ++m) { bf16_t* rowp = O + (size_t)(row0 + ai * HALF + m * 16) * 6144 + col0;
#pragma unroll
                    for (int bj = 0; bj < 2; ++bj) *(u32x4*)(rowp + bj * HALF) = pack8(acc[ai][bj][m][0], acc[ai][bj][m][1]); }
        } else {
            const float sc = u.pn >= 4 ? 0.0625f : 1.0f;
            float invf[2][4];
#pragma unroll
            for (int n = 0; n < 2; ++n)
#pragma unroll
                for (int e = 0; e < 4; ++e) { const int i = wc * 32 + 8 * fq + 4 * n + e; invf[n][e] = __builtin_amdgcn_exp2f((float)i * (-13.287712379549449f / 127.0f)) * 0.15915494309189535f; }
#pragma unroll
            for (int ai = 0; ai < 2; ++ai)
#pragma unroll
                for (int m = 0; m < 4; ++m) { const int row = row0 + ai * HALF + m * 16; const float p = (float)pos[row]; bf16_t* rowp = O + (size_t)row * 6144 + col0;
                    f32x4 o1[2], o2[2];
#pragma unroll
                    for (int n = 0; n < 2; ++n)
#pragma unroll
                        for (int e = 0; e < 4; ++e) { float rev = p * invf[n][e]; rev = rev - __builtin_floorf(rev);
                            const float sn = __builtin_amdgcn_sinf(rev), cs = __builtin_amdgcn_cosf(rev);
                            const float u1 = acc[ai][0][m][n][e], u2 = acc[ai][1][m][n][e];
                            o1[n][e] = (u1 * cs - u2 * sn) * sc; o2[n][e] = (u1 * sn + u2 * cs) * sc; }
                    *(u32x4*)rowp = pack8(o1[0], o1[1]); *(u32x4*)(rowp + HALF) = pack8(o2[0], o2[1]); }
        }
    }
};

template <class Epi, class Sched, bool ALIGN_EPI = false, bool SP2 = false>
__device__ __forceinline__ void gemm_phase(PG8_LAS unsigned char* lds, const Gemm g, const Sched& S, const Epi& E) {
    int tid_ = threadIdx.x; asm volatile("" : "+v"(tid_));
    const int tid = tid_, wid = __builtin_amdgcn_readfirstlane(tid >> 6), lane = tid & 63, wr = wid >> 2, wc = wid & 3, fr = lane & 15, fq = lane >> 4;
    const int K = g.K, nt = K / BK;
    unsigned voffA[2], voffB[2];
#pragma unroll
    for (int i = 0; i < 2; ++i) { int R, C; stage_rc(tid * 16 + i * 8192, R, C); const int Rb = Epi::PERM ? ((R & ~31) + perm32(R & 31)) : R;
        voffA[i] = (unsigned)(R * K + C) * 2u; voffB[i] = (unsigned)(Rb * K + C) * 2u; }
    const size_t kstep = (size_t)(BK * 2);
    const size_t hstep = (size_t)HALF * K * 2;
    const size_t tstep = 2 * hstep;
    const unsigned ldsw = (unsigned)wid * 1024u;
    const int aoff = lds_byte(wr * 64 + fr, fq * 8), boff = lds_byte(wc * 32 + fr, fq * 8);
#define PG8_SA(b, h) (((b) * 2 + (h)) * HTB)
#define PG8_SB(b, h) ((4 + (b) * 2 + (h)) * HTB)
#define PG8_STAGE(bufoff, gbase, voff) do { _Pragma("unroll") for (int _i = 0; _i < 2; ++_i) \
        __builtin_amdgcn_global_load_lds((const unsigned*)((const char*)(gbase) + (voff)[_i]), (PG8_LAS unsigned*)(lds + (bufoff) + ldsw + _i * 8192), 16, 0, 0); } while (0)
#define PG8_LDA(dst, b, h) do { _Pragma("unroll") for (int m = 0; m < 4; ++m) _Pragma("unroll") for (int k = 0; k < 2; ++k) dst[m][k] = *(const PG8_LAS bf16x8*)(lds + PG8_SA(b, h) + aoff + m * 2048 + k * 1024); } while (0)
#define PG8_LDB(dst, b, h) do { _Pragma("unroll") for (int n = 0; n < 2; ++n) _Pragma("unroll") for (int k = 0; k < 2; ++k) dst[n][k] = *(const PG8_LAS bf16x8*)(lds + PG8_SB(b, h) + boff + n * 2048 + k * 1024); } while (0)
#define PG8_MMA(ai, bj, At, Bt) do { __builtin_amdgcn_s_setprio(1); _Pragma("unroll") for (int m = 0; m < 4; ++m) _Pragma("unroll") for (int n = 0; n < 2; ++n) _Pragma("unroll") for (int k = 0; k < 2; ++k) \
        acc[ai][bj][m][n] = __builtin_amdgcn_mfma_f32_16x16x32_bf16(Bt[n][k], At[m][k], acc[ai][bj][m][n], 0, 0, 0); __builtin_amdgcn_s_setprio(0); } while (0)
#define PG8_WAIT_V(n) asm volatile("s_waitcnt vmcnt(" #n ")" ::: "memory")
#define PG8_WAIT_L(n) asm volatile("s_waitcnt lgkmcnt(" #n ")" ::: "memory")
#define PG8_BAR __builtin_amdgcn_s_barrier()
#define PG8_SCHED __builtin_amdgcn_sched_barrier(0)
    Unit cur, nxt; int ui = 0;
    if (!S.next(0, cur)) return;
    f32x4 acc[2][2][4][2];
#pragma unroll
    for (int a = 0; a < 2; ++a)
#pragma unroll
        for (int b = 0; b < 2; ++b)
#pragma unroll
            for (int m = 0; m < 4; ++m)
#pragma unroll
                for (int n = 0; n < 2; ++n) acc[a][b][m][n] = (f32x4){0.f, 0.f, 0.f, 0.f};
    bf16x8 At[4][2], B0[2][2], B1[2][2];
    const char* cA = (const char*)g.A + (size_t)cur.pm * tstep; const char* cB = (const char*)g.Bt + (size_t)cur.pn * tstep;
    S.a_ready(cur);
    if constexpr (SP2) {
        PG8_STAGE(PG8_SB(0, 0), cB, voffB); PG8_STAGE(PG8_SB(0, 1), cB + hstep, voffB); PG8_STAGE(PG8_SA(0, 0), cA, voffA); PG8_STAGE(PG8_SA(0, 1), cA + hstep, voffA);
        if (wr == 1) PG8_BAR;
        PG8_WAIT_V(2); PG8_BAR;
        PG8_STAGE(PG8_SB(1, 0), cB + kstep, voffB); PG8_STAGE(PG8_SA(1, 0), cA + kstep, voffA); PG8_STAGE(PG8_SB(1, 1), cB + hstep + kstep, voffB);
        PG8_WAIT_V(6); PG8_BAR;
    } else {
        PG8_STAGE(PG8_SB(0, 0), cB, voffB); PG8_STAGE(PG8_SA(0, 0), cA, voffA); PG8_STAGE(PG8_SB(0, 1), cB + hstep, voffB); PG8_STAGE(PG8_SA(0, 1), cA + hstep, voffA);
        if (wr == 1) PG8_BAR;
        PG8_WAIT_V(4); PG8_BAR;
        PG8_STAGE(PG8_SB(1, 0), cB + kstep, voffB); PG8_STAGE(PG8_SA(1, 0), cA + kstep, voffA); PG8_STAGE(PG8_SB(1, 1), cB + hstep + kstep, voffB);
        PG8_WAIT_V(6); PG8_BAR;
    }
    for (;;) {
        const bool has_next = S.next(ui + 1, nxt);
        const char* nA = has_next ? (const char*)g.A + (size_t)nxt.pm * tstep : cA; const char* nB = has_next ? (const char*)g.Bt + (size_t)nxt.pn * tstep : cB;
        for (int t = 0; t < nt; t += 2) {
            const bool last = (t == nt - 2);
            const char* a1 = cA + (size_t)(t + 1) * kstep;
            const char* a2 = last ? nA : cA + (size_t)(t + 2) * kstep; const char* b2 = last ? nB : cB + (size_t)(t + 2) * kstep;
            const char* a3 = a2 + kstep; const char* b3 = b2 + kstep;
            if (last && has_next) S.a_ready(nxt);
            if constexpr (SP2) {
            PG8_LDB(B0, 0, 0); PG8_LDB(B1, 0, 1); PG8_SCHED; PG8_LDA(At, 0, 0); PG8_STAGE(PG8_SA(1, 1), a1 + hstep, voffA);
            PG8_WAIT_V(8); PG8_WAIT_L(0); PG8_BAR; PG8_MMA(0, 0, At, B0); PG8_MMA(0, 1, At, B1); PG8_BAR; PG8_SCHED;
            PG8_LDA(At, 0, 1); PG8_STAGE(PG8_SB(0, 0), b2, voffB); PG8_STAGE(PG8_SB(0, 1), b2 + hstep, voffB); PG8_STAGE(PG8_SA(0, 0), a2, voffA);
            PG8_WAIT_V(8); PG8_WAIT_L(0); PG8_BAR; PG8_MMA(1, 0, At, B0); PG8_MMA(1, 1, At, B1); PG8_BAR; PG8_SCHED;
            PG8_LDB(B0, 1, 0); PG8_LDB(B1, 1, 1); PG8_SCHED; PG8_LDA(At, 1, 0); PG8_STAGE(PG8_SA(0, 1), a2 + hstep, voffA);
            PG8_WAIT_V(8); PG8_WAIT_L(0); PG8_BAR; PG8_MMA(0, 0, At, B0); PG8_MMA(0, 1, At, B1); PG8_BAR; PG8_SCHED;
            PG8_LDA(At, 1, 1); PG8_STAGE(PG8_SB(1, 0), b3, voffB); PG8_STAGE(PG8_SB(1, 1), b3 + hstep, voffB); PG8_STAGE(PG8_SA(1, 0), a3, voffA);
            PG8_WAIT_V(8); PG8_WAIT_L(0); PG8_BAR; PG8_MMA(1, 0, At, B0); PG8_MMA(1, 1, At, B1); PG8_BAR; PG8_SCHED;
            } else {
            PG8_LDB(B0, 0, 0); PG8_SCHED; PG8_LDA(At, 0, 0); PG8_STAGE(PG8_SA(1, 1), a1 + hstep, voffA);
            PG8_WAIT_L(8); PG8_BAR; PG8_WAIT_L(0); PG8_MMA(0, 0, At, B0); PG8_BAR; PG8_SCHED;
            PG8_LDB(B1, 0, 1); PG8_STAGE(PG8_SB(0, 0), b2, voffB);
            PG8_BAR; PG8_WAIT_L(0); PG8_MMA(0, 1, At, B1); PG8_BAR;
            PG8_LDA(At, 0, 1); PG8_STAGE(PG8_SA(0, 0), a2, voffA);
            PG8_BAR; PG8_WAIT_L(0); PG8_MMA(1, 0, At, B0); PG8_BAR; PG8_SCHED;
            PG8_STAGE(PG8_SB(0, 1), b2 + hstep, voffB);
            PG8_WAIT_V(6); PG8_BAR; PG8_MMA(1, 1, At, B1); PG8_BAR;
            PG8_LDB(B0, 1, 0); PG8_SCHED; PG8_LDA(At, 1, 0); PG8_STAGE(PG8_SA(0, 1), a2 + hstep, voffA);
            PG8_WAIT_L(8); PG8_BAR; PG8_WAIT_L(0); PG8_MMA(0, 0, At, B0); PG8_BAR; PG8_SCHED;
            PG8_LDB(B1, 1, 1); PG8_STAGE(PG8_SB(1, 0), b3, voffB);
            PG8_BAR; PG8_WAIT_L(0); PG8_MMA(0, 1, At, B1); PG8_BAR;
            PG8_LDA(At, 1, 1); PG8_STAGE(PG8_SA(1, 0), a3, voffA);
            PG8_BAR; PG8_WAIT_L(0); PG8_MMA(1, 0, At, B0); PG8_BAR; PG8_SCHED;
            PG8_STAGE(PG8_SB(1, 1), b3 + hstep, voffB);
            PG8_WAIT_V(6); PG8_BAR; PG8_MMA(1, 1, At, B1); PG8_BAR;
            }
        }
        if constexpr (ALIGN_EPI) { if (wr == 0) PG8_BAR; }
        if constexpr (!Epi::AFTER_DRAIN) { E(acc, cur, wr, wc, fr, fq); S.done(cur); }
        if (!has_next) break;
#pragma unroll
        for (int a = 0; a < 2; ++a)
#pragma unroll
            for (int b = 0; b < 2; ++b)
#pragma unroll
                for (int m = 0; m < 4; ++m)
#pragma unroll
                    for (int n = 0; n < 2; ++n) acc[a][b][m][n] = (f32x4){0.f, 0.f, 0.f, 0.f};
        cur = nxt; cA = nA; cB = nB; ++ui;
        if constexpr (ALIGN_EPI) { if (wr == 1) PG8_BAR; }
    }
    PG8_WAIT_V(0);
    if constexpr (!ALIGN_EPI) { if (wr == 0) PG8_BAR; }
    PG8_BAR;
#undef PG8_SA
#undef PG8_SB
#undef PG8_STAGE
#undef PG8_LDA
#undef PG8_LDB
#undef PG8_MMA
#undef PG8_WAIT_V
#undef PG8_WAIT_L
#undef PG8_BAR
#undef PG8_SCHED
}
}

#define XB_TMO      128
#define XB_XCNT(j)  (256  + 64 * (j))
#define XB_XSUB(j)  (1280 + 64 * (j))
#define XB_XGEN(j)  (2304 + 64 * (j))
#define XB_TOP      3328
#define XB_TOPGEN   3392
#define XCD_BAR_WORDS 3456
#define XB_SPIN_CAP (1u << 18)

__device__ __forceinline__ unsigned xb_ld(unsigned* p)              { return __hip_atomic_load(p, __ATOMIC_RELAXED, __HIP_MEMORY_SCOPE_AGENT); }
__device__ __forceinline__ unsigned xb_add(unsigned* p, unsigned v) { return __hip_atomic_fetch_add(p, v, __ATOMIC_RELAXED, __HIP_MEMORY_SCOPE_AGENT); }
__device__ __forceinline__ unsigned xb_xcc_id() { return (unsigned)__builtin_amdgcn_s_getreg((3 << 11) | 20) & 0xFu; }
#define XB_SPIN(cond, bar) do { unsigned _sp = 0; while (cond) { __builtin_amdgcn_s_sleep(1); \
    if ((++_sp & 255u) == 0u) { if (xb_ld(&(bar)[XB_TMO])) break; if (_sp > XB_SPIN_CAP) { atomicAdd(&(bar)[XB_TMO], 1u); break; } } } } while (0)

struct XcdBarrier { unsigned* bar; unsigned x; volatile LAS unsigned* st; };

__device__ __forceinline__ XcdBarrier xcd_barrier_post(unsigned* bar, volatile LAS unsigned* st) {
    XcdBarrier b; b.bar = bar; b.x = xb_xcc_id(); b.st = st;
    if (threadIdx.x == 0) (void)xb_add(&bar[XB_XCNT(b.x)], 1u);
    return b;
}
__device__ __forceinline__ void xcd_barrier_complete(unsigned* bar, unsigned x, unsigned& nloc, unsigned& nx) {
    const unsigned G = gridDim.x * gridDim.y * gridDim.z;
    unsigned sum, cnt, mine, sp = 0u;
    for (;;) {
        sum = 0u; cnt = 0u; mine = 0u;
#pragma unroll
        for (unsigned j = 0; j < 16; ++j) { const unsigned c = xb_ld(&bar[XB_XCNT(j)]); sum += c; cnt += (c > 0u) ? 1u : 0u; mine = (j == x) ? c : mine; }
        if (sum == G) break;
        __builtin_amdgcn_s_sleep(1);
        if ((++sp & 255u) == 0u) { if (xb_ld(&bar[XB_TMO])) break; if (sp > XB_SPIN_CAP) { atomicAdd(&bar[XB_TMO], 1u); break; } }
    }
    nloc = mine > 0u ? mine : 1u; nx = cnt > 0u ? cnt : 1u;
}
__device__ __forceinline__ void xcd_barrier(const XcdBarrier& b) {
    asm volatile("s_waitcnt vmcnt(0)" ::: "memory");
    __syncthreads();
    if (threadIdx.x == 0) {
        unsigned* bar = b.bar;
        __builtin_amdgcn_s_waitcnt(0);
        unsigned nloc = b.st[0], nx = b.st[1];
        if (nloc == 0u) { xcd_barrier_complete(bar, b.x, nloc, nx); b.st[0] = nloc; b.st[1] = nx; }
        const unsigned old = xb_add(&bar[XB_XSUB(b.x)], 1u);
        const unsigned gen = old / nloc;
        if (old + 1u == (gen + 1u) * nloc) {
            __builtin_amdgcn_fence(__ATOMIC_RELEASE, "agent");
            asm volatile("s_waitcnt vmcnt(0)" ::: "memory");
            const unsigned og = xb_add(&bar[XB_TOP], 1u);
            const unsigned tg = og / nx;
            if (og + 1u == (tg + 1u) * nx) xb_add(&bar[XB_TOPGEN], 1u);
            else XB_SPIN(xb_ld(&bar[XB_TOPGEN]) == tg, bar);
            __builtin_amdgcn_fence(__ATOMIC_ACQUIRE, "agent");
            xb_add(&bar[XB_XGEN(b.x)], 1u);
            asm volatile("s_waitcnt vmcnt(0)" ::: "memory");
        } else {
            XB_SPIN(xb_ld(&bar[XB_XGEN(b.x)]) == gen, bar);
            __builtin_amdgcn_fence(__ATOMIC_ACQUIRE, "agent");
            asm volatile("s_waitcnt vmcnt(0)" ::: "memory");
        }
    }
    __syncthreads();
}

struct Frame {
    LAS unsigned char* lds;
    int vcu, G;
};
__device__ __forceinline__ int opaque_tid() { int t = threadIdx.x; asm volatile("" : "+v"(t)); return t; }
#define PH_IDS const int tid = opaque_tid(), lane = tid & 63, w = __builtin_amdgcn_readfirstlane(tid >> 6); (void)tid; (void)lane; (void)w

template <class SrcF>
__device__ __forceinline__ void prep_matrix(const Frame& F, int K, int N, bf16* WT, SrcF src) {
    PH_IDS;
    LAS float* scr = (LAS float*)(F.lds + w * 8448);
    const int gw = F.vcu * NWAVES + w, NGW = F.G * NWAVES;
    const int nblk = N / 32, nitems = (K / 64) * nblk;
    for (int it = gw; it < nitems; it += NGW) {
        const int kb = it / nblk, nb = it % nblk, k0 = 64 * kb, n0 = 32 * nb;
#pragma unroll 8
        for (int i = 0; i < 32; ++i) { const int kk = 2 * i + (lane >> 5); scr[kk * 33 + (lane & 31)] = src(k0 + kk, n0 + (lane & 31)); }
        LDS_WAIT();
        const int c = lane & 7;
#pragma unroll
        for (int j = 0; j < 4; ++j) { const int n = (lane >> 3) + 8 * j; const LAS float* s = scr + (8 * c) * 33 + n;
            u32x4 o; o.x = cvt_pk_bf16(s[0 * 33], s[1 * 33]); o.y = cvt_pk_bf16(s[2 * 33], s[3 * 33]); o.z = cvt_pk_bf16(s[4 * 33], s[5 * 33]); o.w = cvt_pk_bf16(s[6 * 33], s[7 * 33]);
            *(u32x4*)(WT + (size_t)(n0 + n) * K + k0 + 8 * c) = o; }
        LDS_WAIT();
    }
}

struct Args { const void* in[28]; float* out; unsigned char* ws; int p_lo, p_hi; };
__device__ __forceinline__ const float* kin(const Args& a, int i) { asm volatile("" : "+s"(i)); return (const float*)a.in[i]; }

__device__ __forceinline__ void prep_layer(const Frame& F, const Args& in, unsigned char* ws, int L) {
    const int kind = L % 3, j = L / 3;
#pragma unroll 1
    for (int f = 0; f < 2; ++f) {
        const float* wgu = kin(in, 3) + (size_t)(L * 2 + f) * DM * 2 * DFF;
        prep_matrix(F, DM, 2 * DFF, (bf16*)(ws + (f ? W_GU1 : W_GU0)), [=](int k, int n) { const int pn = n >> 8, r = n & 255; const int sc = (r < 128) ? (pn * 128 + r) : (DFF + pn * 128 + (r - 128)); return wgu[(size_t)k * (2 * DFF) + sc]; });
        const float* wdn = kin(in, 4) + (size_t)(L * 2 + f) * DFF * DM;
        prep_matrix(F, DFF, DM, (bf16*)(ws + (f ? W_DN1 : W_DN0)), [=](int k, int n) { return wdn[(size_t)k * DM + n]; });
    }
    if (kind == 0) {
        const float* win = kin(in, 5) + (size_t)j * DM * ML_IN;
        prep_matrix(F, DM, 3072, (bf16*)(ws + W_MIX), [=](int k, int n) { return win[(size_t)k * ML_IN + n]; });
        const float* wo = kin(in, 9) + (size_t)j * DM * DM;
        prep_matrix(F, DM, DM, (bf16*)(ws + W_MIX + (size_t)3072 * 1024 * 2), [=](int k, int n) { return wo[(size_t)k * DM + n]; });
    } else if (kind == 1) {
        const float* mu = kin(in, 10) + (size_t)j * 6 * DM; const float* wrkv = kin(in, 11) + (size_t)j * 3 * DM * DM;
        const float* w1 = kin(in, 13) + (size_t)j * DM * 64; const float* a1 = kin(in, 16) + (size_t)j * DM * 64; const float* g1 = kin(in, 18) + (size_t)j * DM * 128;
        prep_matrix(F, 2048, 3328, (bf16*)(ws + W_MIX), [=](int k, int n) {
            const int kk = k & 1023; const bool hi = k >= 1024; float w; int mi;
            if (n < 3072) { mi = n >> 10; w = wrkv[((size_t)mi * DM + kk) * DM + (n & 1023)]; }
            else { const int c = n - 3072; if (c < 64) { mi = 3; w = w1[kk * 64 + c]; } else if (c < 128) { mi = 4; w = a1[kk * 64 + (c - 64)]; } else { mi = 5; w = g1[kk * 128 + (c - 128)]; } }
            const float m = mu[mi * DM + kk]; return w * (hi ? m : 1.0f - m); });
        const float* w2 = kin(in, 14) + (size_t)j * 64 * DM; const float* a2 = kin(in, 17) + (size_t)j * 64 * DM; const float* g2 = kin(in, 19) + (size_t)j * 128 * DM;
        prep_matrix(F, 256, 3072, (bf16*)(ws + W_MIX + (size_t)3328 * 2048 * 2), [=](int k, int n) {
            const int t = n >> 10, c = n & 1023;
            if (t == 0) return k < 64 ? w2[k * DM + c] : 0.f;
            if (t == 1) return (k >= 64 && k < 128) ? a2[(k - 64) * DM + c] : 0.f;
            return k >= 128 ? g2[(k - 128) * DM + c] : 0.f; });
        const float* wo = kin(in, 25) + (size_t)j * DM * DM;
        prep_matrix(F, DM, DM, (bf16*)(ws + W_MIX + (size_t)3328 * 2048 * 2 + (size_t)3072 * 256 * 2), [=](int k, int n) { return wo[(size_t)k * DM + n]; });
    } else {
        const float* win = kin(in, 26) + (size_t)j * DM * 6144;
        prep_matrix(F, DM, 6144, (bf16*)(ws + W_MIX), [=](int k, int n) { return win[(size_t)k * 6144 + n]; });
        const float* wo = kin(in, 27) + (size_t)j * 2048 * DM;
        prep_matrix(F, 2048, DM, (bf16*)(ws + W_MIX + (size_t)6144 * 1024 * 2), [=](int k, int n) { return wo[(size_t)k * DM + n]; });
    }
}

__device__ __forceinline__ void norm_phase(const Frame& F, const float* xin, float* xout, const bf16* h, float c, const float* gpost, const float* gpre, bf16* xn, int mode) {
    PH_IDS;
    const int gw = F.vcu * NWAVES + w, NGW = F.G * NWAVES;
    f32x4 gp[4], gq[4];
#pragma unroll
    for (int j = 0; j < 4; ++j) { gp[j] = h ? *(const f32x4*)(gpost + 4 * lane + 256 * j) : (f32x4){0.f, 0.f, 0.f, 0.f}; gq[j] = (mode != 3) ? *(const f32x4*)(gpre + 4 * lane + 256 * j) : (f32x4){0.f, 0.f, 0.f, 0.f}; }
    for (int m = gw; m < M; m += NGW) {
        f32x4 v[4];
#pragma unroll
        for (int j = 0; j < 4; ++j) v[j] = *(const f32x4*)(xin + (size_t)m * DM + 4 * lane + 256 * j);
        if (h) {
            f32x4 hv[4]; float s = 0.f;
#pragma unroll
            for (int j = 0; j < 4; ++j) { const u32x2 r = *(const u32x2*)(h + (size_t)m * DM + 4 * lane + 256 * j); hv[j] = (f32x4){bf_lo(r.x), bf_hi(r.x), bf_lo(r.y), bf_hi(r.y)};
                s += (hv[j][0] * hv[j][0] + hv[j][1] * hv[j][1]) + (hv[j][2] * hv[j][2] + hv[j][3] * hv[j][3]); }
            const float rs = __builtin_amdgcn_rsqf(wave_sum(s) * (1.0f / DM) + NORM_EPS) * c;
#pragma unroll
            for (int j = 0; j < 4; ++j) v[j] += hv[j] * rs * gp[j];
        }
#pragma unroll
        for (int j = 0; j < 4; ++j) *(f32x4*)(xout + (size_t)m * DM + 4 * lane + 256 * j) = v[j];
        if (mode != 3) {
            float s = 0.f;
#pragma unroll
            for (int j = 0; j < 4; ++j) s += (v[j][0] * v[j][0] + v[j][1] * v[j][1]) + (v[j][2] * v[j][2] + v[j][3] * v[j][3]);
            const float rs = __builtin_amdgcn_rsqf(wave_sum(s) * (1.0f / DM) + NORM_EPS);
            u32x2 yb[4];
#pragma unroll
            for (int j = 0; j < 4; ++j) { const f32x4 y = v[j] * rs * gq[j]; yb[j].x = cvt_pk_bf16(y[0], y[1]); yb[j].y = cvt_pk_bf16(y[2], y[3]); }
            if (mode == 2) {
                const int t = m & (SEQ - 1);
#pragma unroll
                for (int j = 0; j < 4; ++j) {
                    *(u32x2*)(xn + (size_t)m * 2048 + 4 * lane + 256 * j) = yb[j];
                    if (t != SEQ - 1) *(u32x2*)(xn + (size_t)(m + 1) * 2048 + 1024 + 4 * lane + 256 * j) = yb[j];
                    if (t == 0) { unsigned z = 0u; asm volatile("" : "+v"(z)); *(u32x2*)(xn + (size_t)m * 2048 + 1024 + 4 * lane + 256 * j) = (u32x2){z, z}; }
                }
            } else {
#pragma unroll
                for (int j = 0; j < 4; ++j) *(u32x2*)(xn + (size_t)m * DM + 4 * lane + 256 * j) = yb[j];
            }
        }
    }
}

__device__ __forceinline__ void ml_gate_phase(const Frame& F, const bf16* xn, const float* w_in, const float* b_if, float* ifg) {
    PH_IDS;
    const int gw = F.vcu * NWAVES + w, NGW = F.G * NWAVES;
    f32x4 wif[8][4];
#pragma unroll
    for (int j = 0; j < 4; ++j)
#pragma unroll
        for (int e = 0; e < 4; ++e) { const int k = 4 * lane + 256 * j + e; const f32x4 a = *(const f32x4*)(w_in + (size_t)k * ML_IN + 3072), b = *(const f32x4*)(w_in + (size_t)k * ML_IN + 3076);
            wif[0][j][e] = a[0]; wif[1][j][e] = a[1]; wif[2][j][e] = a[2]; wif[3][j][e] = a[3]; wif[4][j][e] = b[0]; wif[5][j][e] = b[1]; wif[6][j][e] = b[2]; wif[7][j][e] = b[3]; }
    const float bias = lane < 8 ? b_if[lane] : 0.f;
    for (int m = gw; m < M; m += NGW) {
        f32x4 y[4];
#pragma unroll
        for (int j = 0; j < 4; ++j) { const u32x2 r = *(const u32x2*)(xn + (size_t)m * DM + 4 * lane + 256 * j); y[j] = (f32x4){bf_lo(r.x), bf_hi(r.x), bf_lo(r.y), bf_hi(r.y)}; }
        float my = 0.f;
#pragma unroll
        for (int cc = 0; cc < 8; ++cc) { float d = 0.f;
#pragma unroll
            for (int j = 0; j < 4; ++j) d += (y[j][0] * wif[cc][j][0] + y[j][1] * wif[cc][j][1]) + (y[j][2] * wif[cc][j][2] + y[j][3] * wif[cc][j][3]);
            d = wave_sum(d); if (lane == cc) my = d; }
        if (lane < 8) { float val = my + bias; val = 15.0f * tanhf(val * (1.0f / 15.0f));
            if (lane >= 4) val = -log1pf(expf(-val));
            ifg[(size_t)m * 8 + lane] = val; }
    }
}

__device__ __forceinline__ void ml_chunk_phase(const Frame& F, const bf16* proj, const float* ifg, const float* conv_w, bf16* hb) {
    constexpr int QP = 272, SP = 144;
    constexpr int QS = 0, KS = QS + 64 * QP, KWT = KS + 64 * QP, VT = KWT + 128 * SP, PS = VT + 80 * SP, CT = PS + 64 * SP, TAB = CT + 80 * QP, CWT = TAB + 1024;
    static_assert(CWT + 4096 <= RING_BYTES, "ml lds");
    LAS unsigned char* lds = F.lds;
    LAS float* tU = (LAS float*)(lds + TAB); LAS float* tM = tU + 64; LAS float* tB = tU + 128; LAS float* tD = tU + 192;
    PH_IDS;
    const int fr = lane & 15, fq = lane >> 4;
    for (int item = F.vcu; item < NB * 16; item += F.G) {
        const int b = item >> 4, hh = (item >> 2) & 3, vs = item & 3;
        const size_t rowb = (size_t)b * SEQ;
        for (int i = tid; i < 16 * 36; i += 512) { const int r = i / 36, cidx = i % 36; ((LAS unsigned*)(lds + VT + (64 + r) * SP))[cidx] = (r == 0) ? 0x3f803f80u : 0u; }
        const int which = tid >> 8, tq = (tid >> 4) & 15, c8 = tid & 15;
        const int ch = which * 512 + hh * 128 + c8 * 8;
        for (int i = tid; i < 4 * 256; i += 512) { const int jj = i >> 8, cc = i & 255; ((LAS float*)(lds + CWT))[i] = conv_w[jj * 1024 + (cc >> 7) * 512 + hh * 128 + (cc & 127)]; }
        const float qscale = which == 0 ? 0.08838834764831845f : 1.0f;
        const int tqv = tid >> 5, vp = tid & 31;
        const int vcol = 1024 + hh * 256 + vs * 64 + 2 * vp;
        f32x4 C[5];
#pragma unroll
        for (int jj = 0; jj < 5; ++jj) C[jj] = (f32x4){0.f, 0.f, 0.f, 0.f};
        float mst = 0.f;
        u32x4 rq[7]; unsigned rv[4]; float gi, gf;
        const unsigned loQ = (unsigned)((4 * tq) * 3072 + ch) * 2u, loV = (unsigned)((4 * tqv) * 3072 + vcol) * 2u;
        auto prefetch = [&](int c) {
            const char* base = (const char*)proj + (rowb + 64 * c) * (size_t)(3072 * 2);
            const int t0 = 64 * c + 4 * tq - 3;
#pragma unroll
            for (int r = 0; r < 7; ++r) rq[r] = (t0 + r >= 0) ? *(const u32x4*)(base + (ptrdiff_t)(r - 3) * (3072 * 2) + loQ) : (u32x4){0u, 0u, 0u, 0u};
#pragma unroll
            for (int r = 0; r < 4; ++r) rv[r] = *(const unsigned*)(base + (size_t)r * (3072 * 2) + loV);
            const float* gb = ifg + (rowb + 64 * c) * 8 + hh;
            gi = gb[lane * 8]; gf = gb[lane * 8 + 4];
        };
        prefetch(0);
        for (int c = 0; c < SEQ / 64; ++c) {
            float bsum = gf;
#pragma unroll
            for (int o = 1; o < 64; o <<= 1) { const float t = __shfl_up(bsum, o); if (lane >= o) bsum += t; }
            const float uu = gi - bsum; float cm = uu;
#pragma unroll
            for (int o = 1; o < 64; o <<= 1) { const float t = __shfl_up(cm, o); if (lane >= o) cm = fmaxf(cm, t); }
            const float Mx = fmaxf(mst, cm);
            const float M63 = __shfl(Mx, 63), b63 = __shfl(bsum, 63);
            if (w == 0) { tU[lane] = uu; tM[lane] = Mx; tB[lane] = bsum; }
#pragma unroll
            for (int jj = 0; jj < 5; ++jj) { u32x2 o; o.x = cvt_pk_bf16(C[jj][0], C[jj][1]); o.y = cvt_pk_bf16(C[jj][2], C[jj][3]);
                *(LAS u32x2*)(lds + CT + (16 * jj + fr) * QP + (16 * w + 4 * fq) * 2) = o; }
            WG_BAR();
            {
                float kws[4];
#pragma unroll
                for (int tt = 0; tt < 4; ++tt) kws[tt] = fexp(tU[4 * tq + tt] - M63);
                float cw[4][8];
#pragma unroll
                for (int jj = 0; jj < 4; ++jj) { const f32x4 a = *(const LAS f32x4*)(lds + CWT + (jj * 256 + which * 128 + c8 * 8) * 4), bq = *(const LAS f32x4*)(lds + CWT + (jj * 256 + which * 128 + c8 * 8 + 4) * 4);
                    cw[jj][0] = a[0]; cw[jj][1] = a[1]; cw[jj][2] = a[2]; cw[jj][3] = a[3]; cw[jj][4] = bq[0]; cw[jj][5] = bq[1]; cw[jj][6] = bq[2]; cw[jj][7] = bq[3]; }
                float o[4][8];
#pragma unroll
                for (int tt = 0; tt < 4; ++tt) {
#pragma unroll
                    for (int e2 = 0; e2 < 4; ++e2) { float a0 = 0.f, a1 = 0.f;
#pragma unroll
                        for (int jj = 0; jj < 4; ++jj) { const unsigned x = rq[tt + jj][e2]; a0 += cw[jj][2 * e2] * bf_lo(x); a1 += cw[jj][2 * e2 + 1] * bf_hi(x); }
                        o[tt][2 * e2] = fsilu(a0) * qscale; o[tt][2 * e2 + 1] = fsilu(a1) * qscale; }
                    u32x4 pk; pk.x = cvt_pk_bf16(o[tt][0], o[tt][1]); pk.y = cvt_pk_bf16(o[tt][2], o[tt][3]); pk.z = cvt_pk_bf16(o[tt][4], o[tt][5]); pk.w = cvt_pk_bf16(o[tt][6], o[tt][7]);
                    *(LAS u32x4*)(lds + (which ? KS : QS) + (4 * tq + tt) * QP + c8 * 16) = pk;
                }
                if (which) {
#pragma unroll
                    for (int e = 0; e < 8; ++e) { u32x2 pk; pk.x = cvt_pk_bf16(o[0][e] * kws[0], o[1][e] * kws[1]); pk.y = cvt_pk_bf16(o[2][e] * kws[2], o[3][e] * kws[3]);
                        *(LAS u32x2*)(lds + KWT + (c8 * 8 + e) * SP + (4 * tq) * 2) = pk; }
                }
                u32x2 v0, v1;
                v0.x = (rv[0] & 0xffffu) | (rv[1] << 16); v0.y = (rv[2] & 0xffffu) | (rv[3] << 16);
                v1.x = (rv[0] >> 16) | (rv[1] & 0xffff0000u); v1.y = (rv[2] >> 16) | (rv[3] & 0xffff0000u);
                *(LAS u32x2*)(lds + VT + (2 * vp) * SP + (4 * tqv) * 2) = v0; *(LAS u32x2*)(lds + VT + (2 * vp + 1) * SP + (4 * tqv) * 2) = v1;
            }
            WG_BAR();
            if (c + 1 < SEQ / 64) prefetch(c + 1);
            {
                const int tt = w >> 1, st0 = 2 * (w & 1);
                f32x4 s0 = {0.f, 0.f, 0.f, 0.f}, s1 = {0.f, 0.f, 0.f, 0.f};
#pragma unroll
                for (int kk = 0; kk < 4; ++kk) {
                    const bf16x8 yq = *(const LAS bf16x8*)(lds + QS + (16 * tt + fr) * QP + (32 * kk + 8 * fq) * 2);
                    const bf16x8 x0 = *(const LAS bf16x8*)(lds + KS + (16 * st0 + fr) * QP + (32 * kk + 8 * fq) * 2);
                    const bf16x8 x1 = *(const LAS bf16x8*)(lds + KS + (16 * (st0 + 1) + fr) * QP + (32 * kk + 8 * fq) * 2);
                    s0 = mma16(x0, yq, s0); s1 = mma16(x1, yq, s1);
                }
                const int t = 16 * tt + fr; const float Mt = tM[t];
#pragma unroll
                for (int q = 0; q < 2; ++q) { const f32x4 sv = q ? s1 : s0; const int sb = 16 * (st0 + q) + 4 * fq; const f32x4 u4 = *(const LAS f32x4*)(tU + sb);
                    float p[4];
#pragma unroll
                    for (int e = 0; e < 4; ++e) p[e] = (sb + e <= t) ? sv[e] * fexp(u4[e] - Mt) : 0.f;
                    u32x2 pk; pk.x = cvt_pk_bf16(p[0], p[1]); pk.y = cvt_pk_bf16(p[2], p[3]);
                    *(LAS u32x2*)(lds + PS + t * SP + sb * 2) = pk; }
            }
            WG_BAR_L();
            {
                const int tt = w & 3, jb = (w < 4) ? 0 : 3, nj = (w < 4) ? 3 : 2;
                f32x4 a1[3], a2[3];
#pragma unroll
                for (int jj = 0; jj < 3; ++jj) { a1[jj] = (f32x4){0.f, 0.f, 0.f, 0.f}; a2[jj] = (f32x4){0.f, 0.f, 0.f, 0.f}; }
#pragma unroll
                for (int kk = 0; kk < 2; ++kk) { const bf16x8 yp = *(const LAS bf16x8*)(lds + PS + (16 * tt + fr) * SP + (32 * kk + 8 * fq) * 2);
#pragma unroll
                    for (int jj = 0; jj < 3; ++jj) if (jj < nj) { const bf16x8 xv = *(const LAS bf16x8*)(lds + VT + (16 * (jb + jj) + fr) * SP + (32 * kk + 8 * fq) * 2); a1[jj] = mma16(xv, yp, a1[jj]); } }
#pragma unroll
                for (int kk = 0; kk < 4; ++kk) { const bf16x8 yq = *(const LAS bf16x8*)(lds + QS + (16 * tt + fr) * QP + (32 * kk + 8 * fq) * 2);
#pragma unroll
                    for (int jj = 0; jj < 3; ++jj) if (jj < nj) { const bf16x8 xc = *(const LAS bf16x8*)(lds + CT + (16 * (jb + jj) + fr) * QP + (32 * kk + 8 * fq) * 2); a2[jj] = mma16(xc, yq, a2[jj]); } }
                const int t = 16 * tt + fr; const float Mt = tM[t], bt = tB[t]; const float inter = fexp(mst - Mt);
#pragma unroll
                for (int jj = 0; jj < 3; ++jj) a1[jj] = a1[jj] + a2[jj] * inter;
                if (w >= 4 && fq == 0) tD[t] = a1[1][0];
                WG_BAR_L();
                const float dn = fmaxf(fabsf(tD[t]), fexp(-(bt + Mt))); const float rdn = 1.0f / dn;
#pragma unroll
                for (int jj = 0; jj < 3; ++jj) if (jj < nj && jb + jj < 4) { u32x2 pk; pk.x = cvt_pk_bf16(a1[jj][0] * rdn, a1[jj][1] * rdn); pk.y = cvt_pk_bf16(a1[jj][2] * rdn, a1[jj][3] * rdn);
                    *(u32x2*)((char*)(hb + (rowb + 64 * c + 16 * tt) * DM + hh * 256 + vs * 64 + 16 * (jb + jj)) + (unsigned)(fr * DM + 4 * fq) * 2u) = pk; }
            }
            {
                const float decay = fexp(mst - M63);
#pragma unroll
                for (int jj = 0; jj < 5; ++jj) C[jj] = C[jj] * decay;
#pragma unroll
                for (int kk = 0; kk < 2; ++kk) { const bf16x8 xk = *(const LAS bf16x8*)(lds + KWT + (16 * w + fr) * SP + (32 * kk + 8 * fq) * 2);
#pragma unroll
                    for (int jj = 0; jj < 5; ++jj) { const bf16x8 yv = *(const LAS bf16x8*)(lds + VT + (16 * jj + fr) * SP + (32 * kk + 8 * fq) * 2); C[jj] = mma16(xk, yv, C[jj]); } }
                mst = b63 + M63;
            }
            WG_BAR_L();
        }
    }
}

__device__ __forceinline__ void ml_head_phase(const Frame& F, const bf16* hb, const bf16* proj, const float* ng, bf16* hg) {
    PH_IDS;
    const int gw = F.vcu * NWAVES + w, NGW = F.G * NWAVES;
    f32x4 g[4];
#pragma unroll
    for (int j = 0; j < 4; ++j) g[j] = *(const f32x4*)(ng + 4 * lane + 256 * j);
    for (int m = gw; m < M; m += NGW) {
#pragma unroll
        for (int j = 0; j < 4; ++j) {
            const u32x2 r = *(const u32x2*)(hb + (size_t)m * DM + 4 * lane + 256 * j), ro = *(const u32x2*)(proj + (size_t)m * 3072 + 2048 + 4 * lane + 256 * j);
            const f32x4 v = {bf_lo(r.x), bf_hi(r.x), bf_lo(r.y), bf_hi(r.y)}, o = {bf_lo(ro.x), bf_hi(ro.x), bf_lo(ro.y), bf_hi(ro.y)};
            const float s = wave_sum((v[0] * v[0] + v[1] * v[1]) + (v[2] * v[2] + v[3] * v[3]));
            const float rs = __builtin_amdgcn_rsqf(s * (1.0f / 256.0f) + NORM_EPS);
            u32x2 pk; pk.x = cvt_pk_bf16(v[0] * rs * g[j][0] * fsigmoid(o[0]), v[1] * rs * g[j][1] * fsigmoid(o[1])); pk.y = cvt_pk_bf16(v[2] * rs * g[j][2] * fsigmoid(o[2]), v[3] * rs * g[j][3] * fsigmoid(o[3]));
            *(u32x2*)(hg + (size_t)m * DM + 4 * lane + 256 * j) = pk;
        }
    }
}

__device__ __forceinline__ void rt_chunk_phase(const Frame& F, const bf16* proj, bf16* yb) {
    constexpr int QP = 528, SP = 144;
    constexpr int QS = 0, KS = QS + 64 * QP, KWT = KS + 64 * QP, VT = KWT + 256 * SP, PS = VT + 128 * SP, END = PS + 64 * SP;
    static_assert(END <= MISC_OFF, "rt lds");
    LAS unsigned char* lds = F.lds;
    PH_IDS;
    const int fr = lane & 15, fq = lane >> 4;
    for (int item = F.vcu; item < NB * 16; item += F.G) {
        const int b = item >> 4, hh = (item >> 2) & 3, vs = item & 3;
        const size_t rowb = (size_t)b * SEQ;
        const float lg = __builtin_log2f(1.0f - __builtin_amdgcn_exp2f(-5.0f - (float)hh));
        const int tq = tid >> 5, c8 = tid & 31;
        const int qcol = hh * 256, kcol = 1024 + hh * 256 + c8 * 8, vcol = 2048 + hh * 512 + vs * 128 + 4 * c8;
        f32x4 R[16];
#pragma unroll
        for (int i = 0; i < 16; ++i) R[i] = (f32x4){0.f, 0.f, 0.f, 0.f};
        u32x4 rq[4], rk[4]; u32x2 rv[4];
        const unsigned loQ = (unsigned)((tid >> 5) * 6144 + qcol + (tid & 31) * 8) * 2u, loK = (unsigned)((4 * tq) * 6144 + kcol) * 2u, loV = (unsigned)((4 * tq) * 6144 + vcol) * 2u;
        auto prefetch = [&](int c) {
            const char* base = (const char*)proj + (rowb + 64 * c) * (size_t)(6144 * 2);
#pragma unroll
            for (int i = 0; i < 4; ++i) rq[i] = *(const u32x4*)(base + (size_t)i * (16 * 6144 * 2) + loQ);
#pragma unroll
            for (int i = 0; i < 4; ++i) { rk[i] = *(const u32x4*)(base + (size_t)i * (6144 * 2) + loK); rv[i] = *(const u32x2*)(base + (size_t)i * (6144 * 2) + loV); }
        };
        prefetch(0);
        float kws[4];
#pragma unroll
        for (int i = 0; i < 4; ++i) kws[i] = __builtin_amdgcn_exp2f(lg * (float)(63 - (4 * tq + i)));
        const float cdecay = __builtin_amdgcn_exp2f(lg * 64.0f);
        for (int c = 0; c < SEQ / 64; ++c) {
#pragma unroll
            for (int i = 0; i < 4; ++i) { const int idx = tid + 512 * i; *(LAS u32x4*)(lds + QS + (idx >> 5) * QP + (idx & 31) * 16) = rq[i]; }
#pragma unroll
            for (int i = 0; i < 4; ++i) *(LAS u32x4*)(lds + KS + (4 * tq + i) * QP + c8 * 16) = rk[i];
#pragma unroll
            for (int e2 = 0; e2 < 4; ++e2) {
                u32x2 lo, hi;
                lo.x = cvt_pk_bf16(bf_lo(rk[0][e2]) * kws[0], bf_lo(rk[1][e2]) * kws[1]); lo.y = cvt_pk_bf16(bf_lo(rk[2][e2]) * kws[2], bf_lo(rk[3][e2]) * kws[3]);
                hi.x = cvt_pk_bf16(bf_hi(rk[0][e2]) * kws[0], bf_hi(rk[1][e2]) * kws[1]); hi.y = cvt_pk_bf16(bf_hi(rk[2][e2]) * kws[2], bf_hi(rk[3][e2]) * kws[3]);
                *(LAS u32x2*)(lds + KWT + (c8 * 8 + 2 * e2) * SP + (4 * tq) * 2) = lo; *(LAS u32x2*)(lds + KWT + (c8 * 8 + 2 * e2 + 1) * SP + (4 * tq) * 2) = hi;
            }
            {
                u32x2 v0, v1, v2, v3;
                v0.x = (rv[0].x & 0xffffu) | (rv[1].x << 16); v0.y = (rv[2].x & 0xffffu) | (rv[3].x << 16);
                v1.x = (rv[0].x >> 16) | (rv[1].x & 0xffff0000u); v1.y = (rv[2].x >> 16) | (rv[3].x & 0xffff0000u);
                v2.x = (rv[0].y & 0xffffu) | (rv[1].y << 16); v2.y = (rv[2].y & 0xffffu) | (rv[3].y << 16);
                v3.x = (rv[0].y >> 16) | (rv[1].y & 0xffff0000u); v3.y = (rv[2].y >> 16) | (rv[3].y & 0xffff0000u);
                LAS unsigned char* vb = lds + VT + (4 * c8) * SP + (4 * tq) * 2;
                *(LAS u32x2*)(vb) = v0; *(LAS u32x2*)(vb + SP) = v1; *(LAS u32x2*)(vb + 2 * SP) = v2; *(LAS u32x2*)(vb + 3 * SP) = v3;
            }
            WG_BAR();
            {
                const int tt = w >> 1, st0 = 2 * (w & 1);
                f32x4 s0 = {0.f, 0.f, 0.f, 0.f}, s1 = {0.f, 0.f, 0.f, 0.f};
#pragma unroll 2
                for (int kk = 0; kk < 8; ++kk) {
                    const bf16x8 yq = *(const LAS bf16x8*)(lds + QS + (16 * tt + fr) * QP + (32 * kk + 8 * fq) * 2);
                    const bf16x8 x0 = *(const LAS bf16x8*)(lds + KS + (16 * st0 + fr) * QP + (32 * kk + 8 * fq) * 2);
                    const bf16x8 x1 = *(const LAS bf16x8*)(lds + KS + (16 * (st0 + 1) + fr) * QP + (32 * kk + 8 * fq) * 2);
                    s0 = mma16(x0, yq, s0); s1 = mma16(x1, yq, s1);
                }
                const int t = 16 * tt + fr;
#pragma unroll
                for (int q = 0; q < 2; ++q) { const f32x4 sv = q ? s1 : s0; const int sb = 16 * (st0 + q) + 4 * fq;
                    float p[4];
#pragma unroll
                    for (int e = 0; e < 4; ++e) p[e] = (sb + e <= t) ? sv[e] * __builtin_amdgcn_exp2f(lg * (float)(t - sb - e)) : 0.f;
                    u32x2 pk; pk.x = cvt_pk_bf16(p[0], p[1]); pk.y = cvt_pk_bf16(p[2], p[3]);
                    *(LAS u32x2*)(lds + PS + t * SP + sb * 2) = pk; }
            }
            WG_BAR_L();
            if (c + 1 < SEQ / 64) prefetch(c + 1);
            u32x4 xr[8];
#pragma unroll
            for (int kk = 0; kk < 8; ++kk) { xr[kk].x = cvt_pk_bf16(R[2 * kk][0], R[2 * kk][1]); xr[kk].y = cvt_pk_bf16(R[2 * kk][2], R[2 * kk][3]); xr[kk].z = cvt_pk_bf16(R[2 * kk + 1][0], R[2 * kk + 1][1]); xr[kk].w = cvt_pk_bf16(R[2 * kk + 1][2], R[2 * kk + 1][3]); }
#pragma unroll 1
            for (int tt = 0; tt < 4; ++tt) {
                f32x4 aI = {0.f, 0.f, 0.f, 0.f}, aC = {0.f, 0.f, 0.f, 0.f};
#pragma unroll
                for (int kk = 0; kk < 2; ++kk) { const bf16x8 xv = *(const LAS bf16x8*)(lds + VT + (16 * w + fr) * SP + (32 * kk + 8 * fq) * 2);
                    const bf16x8 yp = *(const LAS bf16x8*)(lds + PS + (16 * tt + fr) * SP + (32 * kk + 8 * fq) * 2); aI = mma16(xv, yp, aI); }
#pragma unroll
                for (int kk = 0; kk < 8; ++kk) {
                    const u32x2 qa = *(const LAS u32x2*)(lds + QS + (16 * tt + fr) * QP + (32 * kk + 4 * fq) * 2), qb = *(const LAS u32x2*)(lds + QS + (16 * tt + fr) * QP + (32 * kk + 16 + 4 * fq) * 2);
                    const u32x4 yq = {qa.x, qa.y, qb.x, qb.y};
                    aC = mma16(__builtin_bit_cast(bf16x8, xr[kk]), __builtin_bit_cast(bf16x8, yq), aC);
                }
                const int t = 16 * tt + fr; const float qd = __builtin_amdgcn_exp2f(lg * (float)(t + 1)); const f32x4 val = aI + aC * qd;
                u32x2 pk; pk.x = cvt_pk_bf16(val[0], val[1]); pk.y = cvt_pk_bf16(val[2], val[3]);
                *(u32x2*)((char*)(yb + (rowb + 64 * c + 16 * tt) * 2048 + hh * 512 + vs * 128 + 16 * w) + (unsigned)(fr * 2048 + 4 * fq) * 2u) = pk;
            }
            {
                const bf16x8 yv0 = *(const LAS bf16x8*)(lds + VT + (16 * w + fr) * SP + (8 * fq) * 2), yv1 = *(const LAS bf16x8*)(lds + VT + (16 * w + fr) * SP + (32 + 8 * fq) * 2);
#pragma unroll
                for (int dt = 0; dt < 16; ++dt) {
                    const bf16x8 x0 = *(const LAS bf16x8*)(lds + KWT + (16 * dt + fr) * SP + (8 * fq) * 2), x1 = *(const LAS bf16x8*)(lds + KWT + (16 * dt + fr) * SP + (32 + 8 * fq) * 2);
                    R[dt] = R[dt] * cdecay; R[dt] = mma16(x0, yv0, R[dt]); R[dt] = mma16(x1, yv1, R[dt]);
                    if ((dt & 3) == 3) asm volatile("" ::: "memory");
                }
            }
            WG_BAR_L();
        }
    }
}

__device__ __forceinline__ void rt_head_phase(const Frame& F, bf16* yb, const bf16* proj) {
    PH_IDS;
    const int gw = F.vcu * NWAVES + w, NGW = F.G * NWAVES;
    for (int m = gw; m < M; m += NGW) {
#pragma unroll
        for (int hd = 0; hd < 4; ++hd) {
            f32x4 v[2], g[2]; float s = 0.f;
#pragma unroll
            for (int q = 0; q < 2; ++q) { const int col = hd * 512 + q * 256 + 4 * lane;
                const u32x2 r = *(const u32x2*)(yb + (size_t)m * 2048 + col), rg = *(const u32x2*)(proj + (size_t)m * 6144 + 4096 + col);
                v[q] = (f32x4){bf_lo(r.x), bf_hi(r.x), bf_lo(r.y), bf_hi(r.y)}; g[q] = (f32x4){bf_lo(rg.x), bf_hi(rg.x), bf_lo(rg.y), bf_hi(rg.y)};
                s += (v[q][0] * v[q][0] + v[q][1] * v[q][1]) + (v[q][2] * v[q][2] + v[q][3] * v[q][3]); }
            const float rs = __builtin_amdgcn_rsqf(wave_sum(s) * (1.0f / 512.0f) + NORM_EPS);
#pragma unroll
            for (int q = 0; q < 2; ++q) { const int col = hd * 512 + q * 256 + 4 * lane;
                u32x2 pk; pk.x = cvt_pk_bf16(fsilu(g[q][0]) * v[q][0] * rs, fsilu(g[q][1]) * v[q][1] * rs); pk.y = cvt_pk_bf16(fsilu(g[q][2]) * v[q][2] * rs, fsilu(g[q][3]) * v[q][3] * rs);
                *(u32x2*)(yb + (size_t)m * 2048 + col) = pk; }
        }
    }
}

__device__ __forceinline__ float red16(float v) { v += __shfl_xor(v, 1); v += __shfl_xor(v, 2); v += __shfl_xor(v, 4); v += __shfl_xor(v, 8); return v; }
__device__ __forceinline__ void rw_scan_phase(const Frame& F, const bf16* rkv, const bf16* wag, const float* k_k, const float* k_a, const float* r_k, const float* ln_g, const float* ln_b, bf16* yout) {
    constexpr int TB = 32;
    constexpr int VW = 0, VK = 8192, VV = 16384, VA = 24576, VB = 32768, VR = 40960, VG = 49152, BON = 57344, SA = 57344 + 128, YP = SA + 4096;
    static_assert(YP + 65536 <= MISC_OFF, "rw lds");
    LAS unsigned char* lds = F.lds;
    PH_IDS;
    for (int item = F.vcu; item < NB * 16; item += F.G) {
        const int b = item >> 4, hh = item & 15;
        const size_t rowb = (size_t)b * SEQ;
        const int ts = tid >> 4, c4 = tid & 15, chg = hh * 64 + 4 * c4;
        const f32x4 kk4 = *(const f32x4*)(k_k + chg), ka4 = *(const f32x4*)(k_a + chg), rk4 = *(const f32x4*)(r_k + chg), lg4 = *(const f32x4*)(ln_g + chg), lb4 = *(const f32x4*)(ln_b + chg);
        float S[8];
#pragma unroll
        for (int i = 0; i < 8; ++i) S[i] = 0.f;
        u32x2 pr, pk, pv, pw, pa, pg;
        auto prefetch = [&](int tb) {
            const size_t row = rowb + (size_t)tb * TB + ts;
            pr = *(const u32x2*)(rkv + row * 3072 + chg); pk = *(const u32x2*)(rkv + row * 3072 + 1024 + chg); pv = *(const u32x2*)(rkv + row * 3072 + 2048 + chg);
            pw = *(const u32x2*)(wag + row * 3072 + chg); pa = *(const u32x2*)(wag + row * 3072 + 1024 + chg); pg = *(const u32x2*)(wag + row * 3072 + 2048 + chg);
        };
        prefetch(0);
        for (int tb = 0; tb < SEQ / TB; ++tb) {
            {
                const f32x4 r = {bf_lo(pr.x), bf_hi(pr.x), bf_lo(pr.y), bf_hi(pr.y)}, k = {bf_lo(pk.x), bf_hi(pk.x), bf_lo(pk.y), bf_hi(pk.y)}, v = {bf_lo(pv.x), bf_hi(pv.x), bf_lo(pv.y), bf_hi(pv.y)};
                const f32x4 lw = {bf_lo(pw.x), bf_hi(pw.x), bf_lo(pw.y), bf_hi(pw.y)}, a = {bf_lo(pa.x), bf_hi(pa.x), bf_lo(pa.y), bf_hi(pa.y)}, g = {bf_lo(pg.x), bf_hi(pg.x), bf_lo(pg.y), bf_hi(pg.y)};
                const f32x4 kkv = k * kk4;
                const float ss = red16((kkv[0] * kkv[0] + kkv[1] * kkv[1]) + (kkv[2] * kkv[2] + kkv[3] * kkv[3]));
                const float inv = 1.0f / fmaxf(sqrtf(ss), 1e-12f);
                const f32x4 kkn = kkv * inv;
                const f32x4 kp = k * (1.0f + (a - 1.0f) * ka4);
                const f32x4 rkp = r * kp * rk4;
                const float bd = red16((rkp[0] + rkp[1]) + (rkp[2] + rkp[3]));
                const f32x4 dec = {fexp(lw[0]), fexp(lw[1]), fexp(lw[2]), fexp(lw[3])};
                const int o = (ts * 64 + 4 * c4) * 4;
                *(LAS f32x4*)(lds + VW + o) = dec; *(LAS f32x4*)(lds + VK + o) = kp; *(LAS f32x4*)(lds + VV + o) = v; *(LAS f32x4*)(lds + VA + o) = -kkn; *(LAS f32x4*)(lds + VB + o) = kkn * a;
                *(LAS f32x4*)(lds + VR + o) = r; *(LAS f32x4*)(lds + VG + o) = g;
                if (c4 == 0) *(LAS float*)(lds + BON + ts * 4) = bd;
            }
            WG_BAR();
            if (tb + 1 < SEQ / TB) prefetch(tb + 1);
#pragma unroll 2
            for (int t = 0; t < TB; ++t) {
                const int o = (t * 64 + 8 * w) * 4;
                const f32x4 w0 = *(const LAS f32x4*)(lds + VW + o), w1 = *(const LAS f32x4*)(lds + VW + o + 16);
                const f32x4 a0 = *(const LAS f32x4*)(lds + VA + o), a1 = *(const LAS f32x4*)(lds + VA + o + 16);
                const f32x4 b0 = *(const LAS f32x4*)(lds + VB + o), b1 = *(const LAS f32x4*)(lds + VB + o + 16);
                const f32x4 k0 = *(const LAS f32x4*)(lds + VK + o), k1 = *(const LAS f32x4*)(lds + VK + o + 16);
                const f32x4 r0 = *(const LAS f32x4*)(lds + VR + o), r1 = *(const LAS f32x4*)(lds + VR + o + 16);
                const float vi = *(const LAS float*)(lds + VV + (t * 64 + lane) * 4);
                float p = (S[0] * a0[0] + S[1] * a0[1]) + (S[2] * a0[2] + S[3] * a0[3]) + (S[4] * a1[0] + S[5] * a1[1]) + (S[6] * a1[2] + S[7] * a1[3]);
                LAS float* sa = (LAS float*)(lds + SA + (t & 1) * 2048);
                sa[lane * 8 + w] = p;
                WG_BAR_L();
                const f32x4 q0 = *(const LAS f32x4*)(sa + lane * 8), q1 = *(const LAS f32x4*)(sa + lane * 8 + 4);
                const float sv = ((q0[0] + q0[1]) + (q0[2] + q0[3])) + ((q1[0] + q1[1]) + (q1[2] + q1[3]));
                S[0] = S[0] * w0[0] + sv * b0[0] + vi * k0[0]; S[1] = S[1] * w0[1] + sv * b0[1] + vi * k0[1]; S[2] = S[2] * w0[2] + sv * b0[2] + vi * k0[2]; S[3] = S[3] * w0[3] + sv * b0[3] + vi * k0[3];
                S[4] = S[4] * w1[0] + sv * b1[0] + vi * k1[0]; S[5] = S[5] * w1[1] + sv * b1[1] + vi * k1[1]; S[6] = S[6] * w1[2] + sv * b1[2] + vi * k1[2]; S[7] = S[7] * w1[3] + sv * b1[3] + vi * k1[3];
                const float yp = (S[0] * r0[0] + S[1] * r0[1]) + (S[2] * r0[2] + S[3] * r0[3]) + (S[4] * r1[0] + S[5] * r1[1]) + (S[6] * r1[2] + S[7] * r1[3]);
                *(LAS float*)(lds + YP + ((t * 8 + w) * 64 + lane) * 4) = yp;
            }
            WG_BAR_L();
            {
                const int o = (ts * 64 + 4 * c4) * 4;
                f32x4 y = *(const LAS f32x4*)(lds + YP + ((ts * 8) * 64 + 4 * c4) * 4);
#pragma unroll
                for (int ww = 1; ww < 8; ++ww) y += *(const LAS f32x4*)(lds + YP + ((ts * 8 + ww) * 64 + 4 * c4) * 4);
                const f32x4 v = *(const LAS f32x4*)(lds + VV + o), g = *(const LAS f32x4*)(lds + VG + o);
                const float bd = *(const LAS float*)(lds + BON + ts * 4);
                const float mean = red16((y[0] + y[1]) + (y[2] + y[3])) * (1.0f / 64.0f);
                const f32x4 d = y - mean;
                const float var = red16((d[0] * d[0] + d[1] * d[1]) + (d[2] * d[2] + d[3] * d[3])) * (1.0f / 64.0f);
                const float rs = __builtin_amdgcn_rsqf(var + 64e-5f);
                const f32x4 outv = ((d * rs) * lg4 + lb4 + v * bd) * g;
                u32x2 po; po.x = cvt_pk_bf16(outv[0], outv[1]); po.y = cvt_pk_bf16(outv[2], outv[3]);
                *(u32x2*)(yout + (rowb + (size_t)tb * TB + ts) * DM + chg) = po;
            }
            WG_BAR_L();
        }
    }
}

constexpr int N_PHASES = 1 + DEPTH * 11;

__global__ void __launch_bounds__(NWAVES * 64, 2) mk_fwd(Args args) {
    extern __shared__ __attribute__((aligned(16))) unsigned char lds_raw[];
    Frame F;
    F.lds = (LAS unsigned char*)lds_raw;
    F.G = gridDim.x; { const int bx = blockIdx.x; F.vcu = (F.G % 8 == 0) ? (bx % 8) * (F.G / 8) + bx / 8 : bx; }
    volatile LAS unsigned* MISC = (volatile LAS unsigned*)(F.lds + MISC_OFF);
    for (int u = threadIdx.x; u < (LDS_BYTES - MISC_OFF) / 4; u += NWAVES * 64) ((LAS unsigned*)(F.lds + MISC_OFF))[u] = 0u;
    __syncthreads();
    unsigned char* ws = args.ws;
    unsigned* ctl = (unsigned*)(ws + WS_CTL);
    const int lo = args.p_lo, hi = args.p_hi;
    XcdBarrier bar; bar.bar = ctl + CW_BAR; bar.x = 0; bar.st = nullptr;
    if (hi - lo > 1) bar = xcd_barrier_post(ctl + CW_BAR, MISC + 8);
    const Args& in = args;
    float* xm = args.out;
    bf16* XN = (bf16*)(ws + WS_XN); bf16* MO = (bf16*)(ws + WS_MO);
    bf16* RA = (bf16*)(ws + WS_A); bf16* RB = (bf16*)(ws + WS_B);
    int p = 0;
#define PH_ON (p >= lo && p < hi)
#define PH_END do { if (p >= lo && p + 1 < hi) xcd_barrier(bar); ++p; } while (0)

    if (PH_ON) { prep_layer(F, in, ws, 0); norm_phase(F, kin(in, 0), xm, nullptr, 0.f, nullptr, kin(in, 2), XN, 0); }
    PH_END;

#pragma unroll 1
    for (int s = 0; s < DEPTH * 3; ++s) {
        const int L = s / 3, sp = s % 3, kind = L % 3, jm = L / 3;
        const float* g6 = kin(in, 2) + (size_t)L * 6 * DM;
        if (sp != 1) {
            const int f = sp >> 1;
            if (PH_ON) { pg8::Gemm g{XN, (const bf16*)(ws + (f ? W_GU1 : W_GU0)), M, 2 * DFF, DM}; pg8::StaticOrder S; S.init(M, 2 * DFF, F.G, (int)blockIdx.x);
                pg8::EpiSwiglu E{RA, DFF}; pg8::gemm_phase<pg8::EpiSwiglu, pg8::StaticOrder, true, true>(F.lds, g, S, E); }
            PH_END;
            if (PH_ON) { pg8::Gemm g{RA, (const bf16*)(ws + (f ? W_DN1 : W_DN0)), M, DM, DFF}; pg8::StaticOrder S; S.init(M, DM, F.G, (int)blockIdx.x);
                pg8::EpiPlain E{RB, DM}; pg8::gemm_phase<pg8::EpiPlain, pg8::StaticOrder, true, true>(F.lds, g, S, E); }
            PH_END;
            if (PH_ON) {
                if (f == 0) {
                    norm_phase(F, xm, xm, RB, 0.5f, g6 + 1 * DM, g6 + 2 * DM, XN, kind == 1 ? 2 : 0);
                } else {
                    const bool lastl = (L == DEPTH - 1);
                    if (!lastl) prep_layer(F, in, ws, L + 1);
                    norm_phase(F, xm, xm, RB, 0.5f, g6 + 5 * DM, lastl ? nullptr : g6 + 6 * DM, XN, lastl ? 3 : 0);
                }
            }
            PH_END;
        } else {
            const bf16* WM = (const bf16*)(ws + W_MIX);
            const bf16* a_out; const bf16* w_out; int k_out;
            if (kind == 0) {
                if (PH_ON) { pg8::Gemm g{XN, WM, M, 3072, DM}; pg8::StaticOrder S; S.init(M, 3072, F.G, (int)blockIdx.x);
                    pg8::EpiPlain E{RA, 3072}; pg8::gemm_phase<pg8::EpiPlain, pg8::StaticOrder, true, true>(F.lds, g, S, E);
                    ml_gate_phase(F, XN, kin(in, 5) + (size_t)jm * DM * ML_IN, kin(in, 6) + jm * 8, (float*)(ws + WS_A + 192 * MiB)); }
                PH_END;
                if (PH_ON) ml_chunk_phase(F, RA, (const float*)(ws + WS_A + 192 * MiB), kin(in, 7) + (size_t)jm * 4 * DM, RB);
                PH_END;
                if (PH_ON) ml_head_phase(F, RB, RA, kin(in, 8) + (size_t)jm * DM, RB + (size_t)M * DM);
                PH_END;
                a_out = RB + (size_t)M * DM; w_out = WM + (size_t)3072 * 1024; k_out = DM;
            } else if (kind == 1) {
                bf16* lmid = RB; bf16* wag = RA + (size_t)M * 3072; bf16* yo = RB + (size_t)M * 256;
                if (PH_ON) { pg8::Gemm g{XN, WM, M, 3328, 2048}; pg8::StaticOrder S; S.init(M, 3328, F.G, (int)blockIdx.x);
                    pg8::EpiRw1 E{RA, lmid}; pg8::gemm_phase<pg8::EpiRw1, pg8::StaticOrder, true, true>(F.lds, g, S, E); }
                PH_END;
                if (PH_ON) { int k_rw2 = 256; asm volatile("" : "+s"(k_rw2));
                    pg8::Gemm g{lmid, WM + (size_t)3328 * 2048, M, 3072, k_rw2}; pg8::StaticOrder S; S.init(M, 3072, F.G, (int)blockIdx.x);
                    pg8::EpiRw2 E{wag, kin(in, 12) + (size_t)jm * DM, kin(in, 15) + (size_t)jm * DM}; pg8::gemm_phase<pg8::EpiRw2, pg8::StaticOrder, true, true>(F.lds, g, S, E); }
                PH_END;
                if (PH_ON) rw_scan_phase(F, RA, wag, kin(in, 20) + (size_t)jm * DM, kin(in, 21) + (size_t)jm * DM, kin(in, 22) + (size_t)jm * DM, kin(in, 23) + (size_t)jm * DM, kin(in, 24) + (size_t)jm * DM, yo);
                PH_END;
                a_out = yo; w_out = WM + (size_t)3328 * 2048 + (size_t)3072 * 256; k_out = DM;
            } else {
                if (PH_ON) { pg8::Gemm g{XN, WM, M, 6144, DM}; pg8::StaticOrder S; S.init(M, 6144, F.G, (int)blockIdx.x);
                    pg8::EpiRtIn E{RA, (const int*)kin(in, 1)}; pg8::gemm_phase<pg8::EpiRtIn, pg8::StaticOrder, true, true>(F.lds, g, S, E); }
                PH_END;
                if (PH_ON) rt_chunk_phase(F, RA, RB);
                PH_END;
                if (PH_ON) rt_head_phase(F, RB, RA);
                PH_END;
                a_out = RB; w_out = WM + (size_t)6144 * 1024; k_out = 2048;
            }
            if (PH_ON) { pg8::Gemm g{a_out, w_out, M, DM, k_out}; pg8::StaticOrder S; S.init(M, DM, F.G, (int)blockIdx.x);
                pg8::EpiPlain E{MO, DM}; pg8::gemm_phase<pg8::EpiPlain, pg8::StaticOrder, true, true>(F.lds, g, S, E); }
            PH_END;
            if (PH_ON) norm_phase(F, xm, xm, MO, 1.0f, g6 + 3 * DM, g6 + 4 * DM, XN, 0);
            PH_END;
        }
    }
#undef PH_ON
#undef PH_END
}

extern "C" void kernel_launch(void* const* d_in, const int* in_sizes, int n_in, void* d_out, int out_size, void* d_ws, size_t ws_size, hipStream_t stream) {
    static int grid = 0;
    if (grid == 0) {
        if (n_in != 28 || out_size != M * DM || ws_size < WS_END) { fprintf(stderr, "kernel_launch: unexpected shapes: n_in %d out %d ws %zu (need %zu)\n", n_in, out_size, ws_size, (size_t)WS_END); grid = -1; return; }
        int dev = 0, cus = 0, per_cu = 0;
        if (hipGetDevice(&dev) != hipSuccess || hipDeviceGetAttribute(&cus, hipDeviceAttributeMultiprocessorCount, dev) != hipSuccess) { grid = -1; return; }
        if (hipFuncSetAttribute((const void*)mk_fwd, hipFuncAttributeMaxDynamicSharedMemorySize, LDS_BYTES) != hipSuccess) { fprintf(stderr, "kernel_launch: hipFuncSetAttribute failed\n"); grid = -1; return; }
        if (hipOccupancyMaxActiveBlocksPerMultiprocessor(&per_cu, (const void*)mk_fwd, NWAVES * 64, LDS_BYTES) != hipSuccess || per_cu < 1) { fprintf(stderr, "kernel_launch: occupancy query says %d\n", per_cu); (void)hipGetLastError(); grid = -1; return; }
        grid = cus;
    }
    if (grid < 0) return;
    (void)hipMemsetAsync((char*)d_ws + WS_CTL, 0, CTL_ZERO_BYTES, stream);
    Args a{};
    for (int i = 0; i < 28; ++i) a.in[i] = d_in[i];
    a.out = (float*)d_out; a.ws = (unsigned char*)d_ws;
#if MK_PER_PHASE
    for (int p = 0; p < N_PHASES; ++p) { a.p_lo = p; a.p_hi = p + 1; hipLaunchKernelGGL(mk_fwd, dim3(grid), dim3(NWAVES * 64), LDS_BYTES, stream, a); }
#else
    a.p_lo = 0; a.p_hi = N_PHASES;
    hipLaunchKernelGGL(mk_fwd, dim3(grid), dim3(NWAVES * 64), LDS_BYTES, stream, a);
#endif
}
```

```cpp
#include <hip/hip_runtime.h>
#include <cstdio>
#include <cstdint>

#ifndef MK_PER_PHASE
#define MK_PER_PHASE 0
#endif
#ifndef PROBE_DUP
#define PROBE_DUP 0
#endif

#define LAS __attribute__((address_space(3)))
#define GAS __attribute__((address_space(1)))
typedef unsigned short bf16;
typedef short bf16x8 __attribute__((ext_vector_type(8)));
typedef float f32x4 __attribute__((ext_vector_type(4)));
typedef float f32x2 __attribute__((ext_vector_type(2)));
typedef unsigned u32x4 __attribute__((ext_vector_type(4)));
typedef unsigned u32x2 __attribute__((ext_vector_type(2)));

constexpr int DM = 1024, NB = 16, SEQ = 2048, DEPTH = 4, DFF = 2816;
constexpr int M = NB * SEQ;
constexpr float NORM_EPS = 1e-6f;
constexpr int ML_IN = 3080;
constexpr int NWAVES = 8;

constexpr size_t MiB = 1u << 20;
constexpr size_t WS_CTL = 0, CTL_ZERO_BYTES = 1 * MiB;
constexpr size_t WS_W = 1 * MiB;
constexpr size_t W_GU0 = WS_W, W_DN0 = W_GU0 + (size_t)5632 * 1024 * 2, W_GU1 = W_DN0 + (size_t)1024 * 2816 * 2, W_DN1 = W_GU1 + (size_t)5632 * 1024 * 2;
constexpr size_t W_MIX = W_DN1 + (size_t)1024 * 2816 * 2;
constexpr size_t WS_XN = 58 * MiB;
constexpr size_t WS_MO = WS_XN + 64 * MiB;
constexpr size_t WS_A = 186 * MiB;
constexpr size_t WS_B = 570 * MiB;
constexpr size_t WS_END = 698 * MiB;
static_assert(W_MIX + (size_t)17 * MiB <= WS_XN, "weight region");
constexpr int CW_BAR = 4096;

constexpr int RING_BYTES = 131072;
constexpr int LDS_BYTES = 147456;
constexpr int MISC_OFF = 145408;

typedef __bf16 bf16x2_t __attribute__((ext_vector_type(2)));
__device__ __forceinline__ unsigned cvt_pk_bf16(float lo, float hi) { const f32x2 v = {lo, hi}; return __builtin_bit_cast(unsigned, __builtin_convertvector(v, bf16x2_t)); }
__device__ __forceinline__ float bf_lo(unsigned u) { return __uint_as_float(u << 16); }
__device__ __forceinline__ float bf_hi(unsigned u) { return __uint_as_float(u & 0xffff0000u); }
__device__ __forceinline__ float fexp(float x) { return __builtin_amdgcn_exp2f(x * 1.4426950408889634f); }
__device__ __forceinline__ float fsigmoid(float x) { return __builtin_amdgcn_rcpf(1.0f + fexp(-x)); }
__device__ __forceinline__ float ftanh(float x) { return 2.0f * fsigmoid(2.0f * x) - 1.0f; }
__device__ __forceinline__ float fsilu(float x) { return x * fsigmoid(x); }
__device__ __forceinline__ float wave_sum(float v) {
#pragma unroll
    for (int o = 1; o < 64; o <<= 1) v += __shfl_xor(v, o);
    return v;
}
__device__ __forceinline__ f32x4 mma16(bf16x8 x, bf16x8 y, f32x4 c) { return __builtin_amdgcn_mfma_f32_16x16x32_bf16(x, y, c, 0, 0, 0); }
#define LDS_WAIT() asm volatile("s_waitcnt lgkmcnt(0)" ::: "memory")
#define WG_BAR() do { asm volatile("s_waitcnt vmcnt(0) lgkmcnt(0)" ::: "memory"); __builtin_amdgcn_s_barrier(); asm volatile("" ::: "memory"); } while (0)
#define WG_BAR_L() do { asm volatile("s_waitcnt lgkmcnt(0)" ::: "memory"); __builtin_amdgcn_s_barrier(); asm volatile("" ::: "memory"); } while (0)

namespace pg8 {
#define PG8_LAS __attribute__((address_space(3)))
typedef unsigned short bf16_t;
constexpr int BM = 256, BK = 64, HALF = 128, HTB = HALF * BK * 2, STAGE_BYTES = 8 * HTB, NXCD = 8, WGM = 8;
__host__ __device__ __forceinline__ int lds_byte(int r, int c) { const int st = (r >> 4) * 2 + (c >> 5), rr = r & 15, cc = c & 31, ob = rr * 64 + cc * 2; return st * 1024 + (ob ^ (((ob >> 9) & 1) << 5)); }
__host__ __device__ __forceinline__ void stage_rc(int b, int& R, int& C) { const int st = b / 1024, sb = b % 1024, swz = sb ^ (((sb >> 9) & 1) << 5); R = (st >> 1) * 16 + swz / 64; C = (st & 1) * 32 + (swz % 64) / 2; }
__host__ __device__ __forceinline__ int perm32(int rho) { const int n = rho >> 4, i = rho & 15; return 8 * (i >> 2) + 4 * n + (i & 3); }

struct Unit { int pm, pn; };
struct Gemm { const bf16_t* A; const bf16_t* Bt; int M, N, K; };

struct StaticOrder {
    int nM, nN, nwg, G, c;
    __host__ __device__ void init(int M_, int N_, int G_, int c_) { nM = M_ / BM; nN = N_ / BM; nwg = nM * nN; G = G_; c = c_; }
    __host__ __device__ bool next(int i, Unit& u) const {
        const long L = (long)i * G + c; if (L >= nwg) return false;
        int wgid = (int)L; { const int q = nwg / NXCD, r = nwg % NXCD, xcd = wgid % NXCD, off = wgid / NXCD; wgid = (xcd < r ? xcd * (q + 1) : r * (q + 1) + (xcd - r) * q) + off; }
        const int nig = WGM * nN, gid = wgid / nig, fm = gid * WGM, gsz = (nM - fm) < WGM ? (nM - fm) : WGM;
        u.pm = fm + ((wgid % nig) % gsz); u.pn = (wgid % nig) / gsz; return true;
    }
    __device__ __forceinline__ void a_ready(const Unit&) const {}
    __device__ __forceinline__ void done(const Unit&) const {}
};

__device__ __forceinline__ u32x4 pack8(f32x4 v0, f32x4 v1) { u32x4 w; w.x = cvt_pk_bf16(v0[0], v0[1]); w.y = cvt_pk_bf16(v0[2], v0[3]); w.z = cvt_pk_bf16(v1[0], v1[1]); w.w = cvt_pk_bf16(v1[2], v1[3]); return w; }

struct EpiPlain {
    static constexpr bool PERM = true, AFTER_DRAIN = false;
    bf16_t* O; int ldc;
    __device__ __forceinline__ void operator()(const f32x4 (&acc)[2][2][4][2], const Unit& u, int wr, int wc, int fr, int fq) const {
        const int row0 = u.pm * BM + wr * 64 + fr, col0 = u.pn * BM + wc * 32 + 8 * fq;
#pragma unroll
        for (int ai = 0; ai < 2; ++ai)
#pragma unroll
            for (int m = 0; m < 4; ++m) { bf16_t* rowp = O + (size_t)(row0 + ai * HALF + m * 16) * ldc + col0;
#pragma unroll
                for (int bj = 0; bj < 2; ++bj) *(u32x4*)(rowp + bj * HALF) = pack8(acc[ai][bj][m][0], acc[ai][bj][m][1]); }
    }
};
struct EpiSwiglu {
    static constexpr bool PERM = true, AFTER_DRAIN = false;
    bf16_t* O; int ldc;
    __device__ __forceinline__ void operator()(const f32x4 (&acc)[2][2][4][2], const Unit& u, int wr, int wc, int fr, int fq) const {
        const int row0 = u.pm * BM + wr * 64 + fr, col0 = u.pn * HALF + wc * 32 + 8 * fq;
#pragma unroll
        for (int ai = 0; ai < 2; ++ai)
#pragma unroll
            for (int m = 0; m < 4; ++m) { bf16_t* rowp = O + (size_t)(row0 + ai * HALF + m * 16) * ldc + col0;
                f32x4 o[2];
#pragma unroll
                for (int n = 0; n < 2; ++n)
#pragma unroll
                    for (int e = 0; e < 4; ++e) { const float g = acc[ai][0][m][n][e]; o[n][e] = g * fsigmoid(g) * acc[ai][1][m][n][e]; }
                *(u32x4*)rowp = pack8(o[0], o[1]); }
    }
};
struct EpiRw1 {
    static constexpr bool PERM = true, AFTER_DRAIN = false;
    bf16_t* rkv; bf16_t* lmid;
    __device__ __forceinline__ void operator()(const f32x4 (&acc)[2][2][4][2], const Unit& u, int wr, int wc, int fr, int fq) const {
        const int row0 = u.pm * BM + wr * 64 + fr;
        if (u.pn < 12) {
            const int col0 = u.pn * BM + wc * 32 + 8 * fq;
#pragma unroll
            for (int ai = 0; ai < 2; ++ai)
#pragma unroll
                for (int m = 0; m < 4; ++m) { bf16_t* rowp = rkv + (size_t)(row0 + ai * HALF + m * 16) * 3072 + col0;
#pragma unroll
                    for (int bj = 0; bj < 2; ++bj) *(u32x4*)(rowp + bj * HALF) = pack8(acc[ai][bj][m][0], acc[ai][bj][m][1]); }
        } else {
            const int col0 = wc * 32 + 8 * fq;
#pragma unroll
            for (int ai = 0; ai < 2; ++ai)
#pragma unroll
                for (int m = 0; m < 4; ++m) { bf16_t* rowp = lmid + (size_t)(row0 + ai * HALF + m * 16) * 256 + col0;
#pragma unroll
                    for (int bj = 0; bj < 2; ++bj) { f32x4 o[2];
#pragma unroll
                        for (int n = 0; n < 2; ++n)
#pragma unroll
                            for (int e = 0; e < 4; ++e) { const float v = acc[ai][bj][m][n][e]; o[n][e] = (bj == 1) ? fsigmoid(v) : (wc < 2 ? ftanh(v) : v); }
                        *(u32x4*)(rowp + bj * HALF) = pack8(o[0], o[1]); } }
        }
    }
};
struct EpiRw2 {
    static constexpr bool PERM = true, AFTER_DRAIN = false;
    bf16_t* O; const float* w0; const float* a0;
    __device__ __forceinline__ void operator()(const f32x4 (&acc)[2][2][4][2], const Unit& u, int wr, int wc, int fr, int fq) const {
        const int row0 = u.pm * BM + wr * 64 + fr, col0 = u.pn * BM + wc * 32 + 8 * fq, kind = u.pn >> 2, cc0 = (u.pn & 3) * BM + wc * 32 + 8 * fq;
        if (kind == 2) {
#pragma unroll
            for (int ai = 0; ai < 2; ++ai)
#pragma unroll
                for (int m = 0; m < 4; ++m) { bf16_t* rowp = O + (size_t)(row0 + ai * HALF + m * 16) * 3072 + col0;
#pragma unroll
                    for (int bj = 0; bj < 2; ++bj) *(u32x4*)(rowp + bj * HALF) = pack8(acc[ai][bj][m][0], acc[ai][bj][m][1]); }
        } else {
            const float* bp = (kind == 0 ? w0 : a0) + cc0; const float sc = kind == 0 ? -0.60653065971f : 1.0f;
#pragma unroll
            for (int bj = 0; bj < 2; ++bj) {
                const f32x4 b0 = *(const f32x4*)(bp + bj * HALF), b1 = *(const f32x4*)(bp + bj * HALF + 4);
#pragma unroll
                for (int ai = 0; ai < 2; ++ai)
#pragma unroll
                    for (int m = 0; m < 4; ++m) { bf16_t* rowp = O + (size_t)(row0 + ai * HALF + m * 16) * 3072 + col0; f32x4 o0, o1;
#pragma unroll
                        for (int e = 0; e < 4; ++e) { o0[e] = sc * fsigmoid(acc[ai][bj][m][0][e] + b0[e]); o1[e] = sc * fsigmoid(acc[ai][bj][m][1][e] + b1[e]); }
                        *(u32x4*)(rowp + bj * HALF) = pack8(o0, o1); }
            }
        }
    }
};
struct EpiRtIn {
    static constexpr bool PERM = true, AFTER_DRAIN = false;
    bf16_t* O; const int* pos;
    __device__ __forceinline__ void operator()(const f32x4 (&acc)[2][2][4][2], const Unit& u, int wr, int wc, int fr, int fq) const {
        const int row0 = u.pm * BM + wr * 64 + fr, col0 = u.pn * BM + wc * 32 + 8 * fq;
        if (u.pn >= 8) {
#pragma unroll
            for (int ai = 0; ai < 2; ++ai)
#pragma unroll
                for (int m = 0; m < 4; ++m) { bf16_t* rowp = O + (size_t)(row0 + ai * HALF + m * 16) * 6144 + col0;
#pragma unroll
                    for (int bj = 0; bj < 2; ++bj) *(u32x4*)(rowp + bj * HALF) = pack8(acc[ai][bj][m][0], acc[ai][bj][m][1]); }
        } else {
            const float sc = u.pn >= 4 ? 0.0625f : 1.0f;
            float invf[2][4];
#pragma unroll
            for (int n = 0; n < 2; ++n)
#pragma unroll
                for (int e = 0; e < 4; ++e) { const int i = wc * 32 + 8 * fq + 4 * n + e; invf[n][e] = __builtin_amdgcn_exp2f((float)i * (-13.287712379549449f / 127.0f)) * 0.15915494309189535f; }
#pragma unroll
            for (int ai = 0; ai < 2; ++ai)
#pragma unroll
                for (int m = 0; m < 4; ++m) { const int row = row0 + ai * HALF + m * 16; const float p = (float)pos[row]; bf16_t* rowp = O + (size_t)row * 6144 + col0;
                    f32x4 o1[2], o2[2];
#pragma unroll
                    for (int n = 0; n < 2; ++n)
#pragma unroll
                        for (int e = 0; e < 4; ++e) { float rev = p * invf[n][e]; rev = rev - __builtin_floorf(rev);
                            const float sn = __builtin_amdgcn_sinf(rev), cs = __builtin_amdgcn_cosf(rev);
                            const float u1 = acc[ai][0][m][n][e], u2 = acc[ai][1][m][n][e];
                            o1[n][e] = (u1 * cs - u2 * sn) * sc; o2[n][e] = (u1 * sn + u2 * cs) * sc; }
                    *(u32x4*)rowp = pack8(o1[0], o1[1]); *(u32x4*)(rowp + HALF) = pack8(o2[0], o2[1]); }
        }
    }
};

template <class Epi, class Sched, bool ALIGN_EPI = false, bool SP2 = false>
__device__ __forceinline__ void gemm_phase(PG8_LAS unsigned char* lds, const Gemm g, const Sched& S, const Epi& E) {
    int tid_ = threadIdx.x; asm volatile("" : "+v"(tid_));
    const int tid = tid_, wid = __builtin_amdgcn_readfirstlane(tid >> 6), lane = tid & 63, wr = wid >> 2, wc = wid & 3, fr = lane & 15, fq = lane >> 4;
    const int K = g.K, nt = K / BK;
    unsigned voffA[2], voffB[2];
#pragma unroll
    for (int i = 0; i < 2; ++i) { int R, C; stage_rc(tid * 16 + i * 8192, R, C); const int Rb = Epi::PERM ? ((R & ~31) + perm32(R & 31)) : R;
        voffA[i] = (unsigned)(R * K + C) * 2u; voffB[i] = (unsigned)(Rb * K + C) * 2u; }
    const size_t kstep = (size_t)(BK * 2);
    const size_t hstep = (size_t)HALF * K * 2;
    const size_t tstep = 2 * hstep;
    const unsigned ldsw = (unsigned)wid * 1024u;
    const int aoff = lds_byte(wr * 64 + fr, fq * 8), boff = lds_byte(wc * 32 + fr, fq * 8);
#define PG8_SA(b, h) (((b) * 2 + (h)) * HTB)
#define PG8_SB(b, h) ((4 + (b) * 2 + (h)) * HTB)
#define PG8_STAGE(bufoff, gbase, voff) do { _Pragma("unroll") for (int _i = 0; _i < 2; ++_i) \
        __builtin_amdgcn_global_load_lds((const unsigned*)((const char*)(gbase) + (voff)[_i]), (PG8_LAS unsigned*)(lds + (bufoff) + ldsw + _i * 8192), 16, 0, 0); } while (0)
#define PG8_LDA(dst, b, h) do { _Pragma("unroll") for (int m = 0; m < 4; ++m) _Pragma("unroll") for (int k = 0; k < 2; ++k) dst[m][k] = *(const PG8_LAS bf16x8*)(lds + PG8_SA(b, h) + aoff + m * 2048 + k * 1024); } while (0)
#define PG8_LDB(dst, b, h) do { _Pragma("unroll") for (int n = 0; n < 2; ++n) _Pragma("unroll") for (int k = 0; k < 2; ++k) dst[n][k] = *(const PG8_LAS bf16x8*)(lds + PG8_SB(b, h) + boff + n * 2048 + k * 1024); } while (0)
#define PG8_MMA(ai, bj, At, Bt) do { __builtin_amdgcn_s_setprio(1); _Pragma("unroll") for (int m = 0; m < 4; ++m) _Pragma("unroll") for (int n = 0; n < 2; ++n) _Pragma("unroll") for (int k = 0; k < 2; ++k) \
        acc[ai][bj][m][n] = __builtin_amdgcn_mfma_f32_16x16x32_bf16(Bt[n][k], At[m][k], acc[ai][bj][m][n], 0, 0, 0); __builtin_amdgcn_s_setprio(0); } while (0)
#define PG8_WAIT_V(n) asm volatile("s_waitcnt vmcnt(" #n ")" ::: "memory")
#define PG8_WAIT_L(n) asm volatile("s_waitcnt lgkmcnt(" #n ")" ::: "memory")
#define PG8_BAR __builtin_amdgcn_s_barrier()
#define PG8_SCHED __builtin_amdgcn_sched_barrier(0)
    Unit cur, nxt; int ui = 0;
    if (!S.next(0, cur)) return;
    f32x4 acc[2][2][4][2];
#pragma unroll
    for (int a = 0; a < 2; ++a)
#pragma unroll
        for (int b = 0; b < 2; ++b)
#pragma unroll
            for (int m = 0; m < 4; ++m)
#pragma unroll
                for (int n = 0; n < 2; ++n) acc[a][b][m][n] = (f32x4){0.f, 0.f, 0.f, 0.f};
    bf16x8 At[4][2], B0[2][2], B1[2][2];
    const char* cA = (const char*)g.A + (size_t)cur.pm * tstep; const char* cB = (const char*)g.Bt + (size_t)cur.pn * tstep;
    S.a_ready(cur);
    if constexpr (SP2) {
        PG8_STAGE(PG8_SB(0, 0), cB, voffB); PG8_STAGE(PG8_SB(0, 1), cB + hstep, voffB); PG8_STAGE(PG8_SA(0, 0), cA, voffA); PG8_STAGE(PG8_SA(0, 1), cA + hstep, voffA);
        if (wr == 1) PG8_BAR;
        PG8_WAIT_V(2); PG8_BAR;
        PG8_STAGE(PG8_SB(1, 0), cB + kstep, voffB); PG8_STAGE(PG8_SA(1, 0), cA + kstep, voffA); PG8_STAGE(PG8_SB(1, 1), cB + hstep + kstep, voffB);
        PG8_WAIT_V(6); PG8_BAR;
    } else {
        PG8_STAGE(PG8_SB(0, 0), cB, voffB); PG8_STAGE(PG8_SA(0, 0), cA, voffA); PG8_STAGE(PG8_SB(0, 1), cB + hstep, voffB); PG8_STAGE(PG8_SA(0, 1), cA + hstep, voffA);
        if (wr == 1) PG8_BAR;
        PG8_WAIT_V(4); PG8_BAR;
        PG8_STAGE(PG8_SB(1, 0), cB + kstep, voffB); PG8_STAGE(PG8_SA(1, 0), cA + kstep, voffA); PG8_STAGE(PG8_SB(1, 1), cB + hstep + kstep, voffB);
        PG8_WAIT_V(6); PG8_BAR;
    }
    for (;;) {
        const bool has_next = S.next(ui + 1, nxt);
        const char* nA = has_next ? (const char*)g.A + (size_t)nxt.pm * tstep : cA; const char* nB = has_next ? (const char*)g.Bt + (size_t)nxt.pn * tstep : cB;
        for (int t = 0; t < nt; t += 2) {
            const bool last = (t == nt - 2);
            const char* a1 = cA + (size_t)(t + 1) * kstep;
            const char* a2 = last ? nA : cA + (size_t)(t + 2) * kstep; const char* b2 = last ? nB : cB + (size_t)(t + 2) * kstep;
            const char* a3 = a2 + kstep; const char* b3 = b2 + kstep;
            if (last && has_next) S.a_ready(nxt);
            if constexpr (SP2) {
            PG8_LDB(B0, 0, 0); PG8_LDB(B1, 0, 1); PG8_SCHED; PG8_LDA(At, 0, 0); PG8_STAGE(PG8_SA(1, 1), a1 + hstep, voffA);
            PG8_WAIT_V(8); PG8_WAIT_L(0); PG8_BAR; PG8_MMA(0, 0, At, B0); PG8_MMA(0, 1, At, B1); PG8_BAR; PG8_SCHED;
            PG8_LDA(At, 0, 1); PG8_STAGE(PG8_SB(0, 0), b2, voffB); PG8_STAGE(PG8_SB(0, 1), b2 + hstep, voffB); PG8_STAGE(PG8_SA(0, 0), a2, voffA);
            PG8_WAIT_V(8); PG8_WAIT_L(0); PG8_BAR; PG8_MMA(1, 0, At, B0); PG8_MMA(1, 1, At, B1); PG8_BAR; PG8_SCHED;
            PG8_LDB(B0, 1, 0); PG8_LDB(B1, 1, 1); PG8_SCHED; PG8_LDA(At, 1, 0); PG8_STAGE(PG8_SA(0, 1), a2 + hstep, voffA);
            PG8_WAIT_V(8); PG8_WAIT_L(0); PG8_BAR; PG8_MMA(0, 0, At, B0); PG8_MMA(0, 1, At, B1); PG8_BAR; PG8_SCHED;
            PG8_LDA(At, 1, 1); PG8_STAGE(PG8_SB(1, 0), b3, voffB); PG8_STAGE(PG8_SB(1, 1), b3 + hstep, voffB); PG8_STAGE(PG8_SA(1, 0), a3, voffA);
            PG8_WAIT_V(8); PG8_WAIT_L(0); PG8_BAR; PG8_MMA(1, 0, At, B0); PG8_MMA(1, 1, At, B1); PG8_BAR; PG8_SCHED;
            } else {
            PG8_LDB(B0, 0, 0); PG8_SCHED; PG8_LDA(At, 0, 0); PG8_STAGE(PG8_SA(1, 1), a1 + hstep, voffA);
            PG8_WAIT_L(8); PG8_BAR; PG8_WAIT_L(0); PG8_MMA(0, 0, At, B0); PG8_BAR; PG8_SCHED;
            PG8_LDB(B1, 0, 1); PG8_STAGE(PG8_SB(0, 0), b2, voffB);
            PG8_BAR; PG8_WAIT_L(0); PG8_MMA(0, 1, At, B1); PG8_BAR;
            PG8_LDA(At, 0, 1); PG8_STAGE(PG8_SA(0, 0), a2, voffA);
            PG8_BAR; PG8_WAIT_L(0); PG8_MMA(1, 0, At, B0); PG8_BAR; PG8_SCHED;
            PG8_STAGE(PG8_SB(0, 1), b2 + hstep, voffB);
            PG8_WAIT_V(6); PG8_BAR; PG8_MMA(1, 1, At, B1); PG8_BAR;
            PG8_LDB(B0, 1, 0); PG8_SCHED; PG8_LDA(At, 1, 0); PG8_STAGE(PG8_SA(0, 1), a2 + hstep, voffA);
            PG8_WAIT_L(8); PG8_BAR; PG8_WAIT_L(0); PG8_MMA(0, 0, At, B0); PG8_BAR; PG8_SCHED;
            PG8_LDB(B1, 1, 1); PG8_STAGE(PG8_SB(1, 0), b3, voffB);
            PG8_BAR; PG8_WAIT_L(0); PG8_MMA(0, 1, At, B1); PG8_BAR;
            PG8_LDA(At, 1, 1); PG8_STAGE(PG8_SA(1, 0), a3, voffA);
            PG8_BAR; PG8_WAIT_L(0); PG8_MMA(1, 0, At, B0); PG8_BAR; PG8_SCHED;
            PG8_STAGE(PG8_SB(1, 1), b3 + hstep, voffB);
            PG8_WAIT_V(6); PG8_BAR; PG8_MMA(1, 1, At, B1); PG8_BAR;
            }
        }
        if constexpr (ALIGN_EPI) { if (wr == 0) PG8_BAR; }
        if constexpr (!Epi::AFTER_DRAIN) { E(acc, cur, wr, wc, fr, fq); S.done(cur); }
        if (!has_next) break;
#pragma unroll
        for (int a = 0; a < 2; ++a)
#pragma unroll
            for (int b = 0; b < 2; ++b)
#pragma unroll
                for (int m = 0; m < 4; ++m)
#pragma unroll
                    for (int n = 0; n < 2; ++n) acc[a][b][m][n] = (f32x4){0.f, 0.f, 0.f, 0.f};
        cur = nxt; cA = nA; cB = nB; ++ui;
        if constexpr (ALIGN_EPI) { if (wr == 1) PG8_BAR; }
    }
    PG8_WAIT_V(0);
    if constexpr (!ALIGN_EPI) { if (wr == 0) PG8_BAR; }
    PG8_BAR;
#undef PG8_SA
#undef PG8_SB
#undef PG8_STAGE
#undef PG8_LDA
#undef PG8_LDB
#undef PG8_MMA
#undef PG8_WAIT_V
#undef PG8_WAIT_L
#undef PG8_BAR
#undef PG8_SCHED
}
}

#define XB_TMO      128
#define XB_XCNT(j)  (256  + 64 * (j))
#define XB_XSUB(j)  (1280 + 64 * (j))
#define XB_XGEN(j)  (2304 + 64 * (j))
#define XB_TOP      3328
#define XB_TOPGEN   3392
#define XCD_BAR_WORDS 3456
#define XB_SPIN_CAP (1u << 18)

__device__ __forceinline__ unsigned xb_ld(unsigned* p)              { return __hip_atomic_load(p, __ATOMIC_RELAXED, __HIP_MEMORY_SCOPE_AGENT); }
__device__ __forceinline__ unsigned xb_add(unsigned* p, unsigned v) { return __hip_atomic_fetch_add(p, v, __ATOMIC_RELAXED, __HIP_MEMORY_SCOPE_AGENT); }
__device__ __forceinline__ unsigned xb_xcc_id() { return (unsigned)__builtin_amdgcn_s_getreg((3 << 11) | 20) & 0xFu; }
#define XB_SPIN(cond, bar) do { unsigned _sp = 0; while (cond) { __builtin_amdgcn_s_sleep(1); \
    if ((++_sp & 255u) == 0u) { if (xb_ld(&(bar)[XB_TMO])) break; if (_sp > XB_SPIN_CAP) { atomicAdd(&(bar)[XB_TMO], 1u); break; } } } } while (0)

struct XcdBarrier { unsigned* bar; unsigned x; volatile LAS unsigned* st; };

__device__ __forceinline__ XcdBarrier xcd_barrier_post(unsigned* bar, volatile LAS unsigned* st) {
    XcdBarrier b; b.bar = bar; b.x = xb_xcc_id(); b.st = st;
    if (threadIdx.x == 0) (void)xb_add(&bar[XB_XCNT(b.x)], 1u);
    return b;
}
__device__ __forceinline__ void xcd_barrier_complete(unsigned* bar, unsigned x, unsigned& nloc, unsigned& nx) {
    const unsigned G = gridDim.x * gridDim.y * gridDim.z;
    unsigned sum, cnt, mine, sp = 0u;
    for (;;) {
        sum = 0u; cnt = 0u; mine = 0u;
#pragma unroll
        for (unsigned j = 0; j < 16; ++j) { const unsigned c = xb_ld(&bar[XB_XCNT(j)]); sum += c; cnt += (c > 0u) ? 1u : 0u; mine = (j == x) ? c : mine; }
        if (sum == G) break;
        __builtin_amdgcn_s_sleep(1);
        if ((++sp & 255u) == 0u) { if (xb_ld(&bar[XB_TMO])) break; if (sp > XB_SPIN_CAP) { atomicAdd(&bar[XB_TMO], 1u); break; } }
    }
    nloc = mine > 0u ? mine : 1u; nx = cnt > 0u ? cnt : 1u;
}
__device__ __forceinline__ void xcd_barrier(const XcdBarrier& b) {
    asm volatile("s_waitcnt vmcnt(0)" ::: "memory");
    __syncthreads();
    if (threadIdx.x == 0) {
        unsigned* bar = b.bar;
        __builtin_amdgcn_s_waitcnt(0);
        unsigned nloc = b.st[0], nx = b.st[1];
        if (nloc == 0u) { xcd_barrier_complete(bar, b.x, nloc, nx); b.st[0] = nloc; b.st[1] = nx; }
        const unsigned old = xb_add(&bar[XB_XSUB(b.x)], 1u);
        const unsigned gen = old / nloc;
        if (old + 1u == (gen + 1u) * nloc) {
            __builtin_amdgcn_fence(__ATOMIC_RELEASE, "agent");
            asm volatile("s_waitcnt vmcnt(0)" ::: "memory");
            const unsigned og = xb_add(&bar[XB_TOP], 1u);
            const unsigned tg = og / nx;
            if (og + 1u == (tg + 1u) * nx) xb_add(&bar[XB_TOPGEN], 1u);
            else XB_SPIN(xb_ld(&bar[XB_TOPGEN]) == tg, bar);
            __builtin_amdgcn_fence(__ATOMIC_ACQUIRE, "agent");
            xb_add(&bar[XB_XGEN(b.x)], 1u);
            asm volatile("s_waitcnt vmcnt(0)" ::: "memory");
        } else {
            XB_SPIN(xb_ld(&bar[XB_XGEN(b.x)]) == gen, bar);
            __builtin_amdgcn_fence(__ATOMIC_ACQUIRE, "agent");
            asm volatile("s_waitcnt vmcnt(0)" ::: "memory");
        }
    }
    __syncthreads();
}

struct Frame {
    LAS unsigned char* lds;
    int vcu, G;
};
__device__ __forceinline__ int opaque_tid() { int t = threadIdx.x; asm volatile("" : "+v"(t)); return t; }
#define PH_IDS const int tid = opaque_tid(), lane = tid & 63, w = __builtin_amdgcn_readfirstlane(tid >> 6); (void)tid; (void)lane; (void)w

template <class SrcF>
__device__ __forceinline__ void prep_matrix(const Frame& F, int K, int N, bf16* WT, SrcF src) {
    PH_IDS;
    LAS float* scr = (LAS float*)(F.lds + w * 8448);
    const int gw = F.vcu * NWAVES + w, NGW = F.G * NWAVES;
    const int nblk = N / 32, nitems = (K / 64) * nblk;
    for (int it = gw; it < nitems; it += NGW) {
        const int kb = it / nblk, nb = it % nblk, k0 = 64 * kb, n0 = 32 * nb;
#pragma unroll 8
        for (int i = 0; i < 32; ++i) { const int kk = 2 * i + (lane >> 5); scr[kk * 33 + (lane & 31)] = src(k0 + kk, n0 + (lane & 31)); }
        LDS_WAIT();
        const int c = lane & 7;
#pragma unroll
        for (int j = 0; j < 4; ++j) { const int n = (lane >> 3) + 8 * j; const LAS float* s = scr + (8 * c) * 33 + n;
            u32x4 o; o.x = cvt_pk_bf16(s[0 * 33], s[1 * 33]); o.y = cvt_pk_bf16(s[2 * 33], s[3 * 33]); o.z = cvt_pk_bf16(s[4 * 33], s[5 * 33]); o.w = cvt_pk_bf16(s[6 * 33], s[7 * 33]);
            *(u32x4*)(WT + (size_t)(n0 + n) * K + k0 + 8 * c) = o; }
        LDS_WAIT();
    }
}

struct Args { const void* in[28]; float* out; unsigned char* ws; int p_lo, p_hi; };
__device__ __forceinline__ const float* kin(const Args& a, int i) { asm volatile("" : "+s"(i)); return (const float*)a.in[i]; }

__device__ __forceinline__ void prep_layer(const Frame& F, const Args& in, unsigned char* ws, int L) {
    const int kind = L % 3, j = L / 3;
#pragma unroll 1
    for (int f = 0; f < 2; ++f) {
        const float* wgu = kin(in, 3) + (size_t)(L * 2 + f) * DM * 2 * DFF;
        prep_matrix(F, DM, 2 * DFF, (bf16*)(ws + (f ? W_GU1 : W_GU0)), [=](int k, int n) { const int pn = n >> 8, r = n & 255; const int sc = (r < 128) ? (pn * 128 + r) : (DFF + pn * 128 + (r - 128)); return wgu[(size_t)k * (2 * DFF) + sc]; });
        const float* wdn = kin(in, 4) + (size_t)(L * 2 + f) * DFF * DM;
        prep_matrix(F, DFF, DM, (bf16*)(ws + (f ? W_DN1 : W_DN0)), [=](int k, int n) { return wdn[(size_t)k * DM + n]; });
    }
    if (kind == 0) {
        const float* win = kin(in, 5) + (size_t)j * DM * ML_IN;
        prep_matrix(F, DM, 3072, (bf16*)(ws + W_MIX), [=](int k, int n) { return win[(size_t)k * ML_IN + n]; });
        const float* wo = kin(in, 9) + (size_t)j * DM * DM;
        prep_matrix(F, DM, DM, (bf16*)(ws + W_MIX + (size_t)3072 * 1024 * 2), [=](int k, int n) { return wo[(size_t)k * DM + n]; });
    } else if (kind == 1) {
        const float* mu = kin(in, 10) + (size_t)j * 6 * DM; const float* wrkv = kin(in, 11) + (size_t)j * 3 * DM * DM;
        const float* w1 = kin(in, 13) + (size_t)j * DM * 64; const float* a1 = kin(in, 16) + (size_t)j * DM * 64; const float* g1 = kin(in, 18) + (size_t)j * DM * 128;
        prep_matrix(F, 2048, 3328, (bf16*)(ws + W_MIX), [=](int k, int n) {
            const int kk = k & 1023; const bool hi = k >= 1024; float w; int mi;
            if (n < 3072) { mi = n >> 10; w = wrkv[((size_t)mi * DM + kk) * DM + (n & 1023)]; }
            else { const int c = n - 3072; if (c < 64) { mi = 3; w = w1[kk * 64 + c]; } else if (c < 128) { mi = 4; w = a1[kk * 64 + (c - 64)]; } else { mi = 5; w = g1[kk * 128 + (c - 128)]; } }
            const float m = mu[mi * DM + kk]; return w * (hi ? m : 1.0f - m); });
        const float* w2 = kin(in, 14) + (size_t)j * 64 * DM; const float* a2 = kin(in, 17) + (size_t)j * 64 * DM; const float* g2 = kin(in, 19) + (size_t)j * 128 * DM;
        prep_matrix(F, 256, 3072, (bf16*)(ws + W_MIX + (size_t)3328 * 2048 * 2), [=](int k, int n) {
            const int t = n >> 10, c = n & 1023;
            if (t == 0) return k < 64 ? w2[k * DM + c] : 0.f;
            if (t == 1) return (k >= 64 && k < 128) ? a2[(k - 64) * DM + c] : 0.f;
            return k >= 128 ? g2[(k - 128) * DM + c] : 0.f; });
        const float* wo = kin(in, 25) + (size_t)j * DM * DM;
        prep_matrix(F, DM, DM, (bf16*)(ws + W_MIX + (size_t)3328 * 2048 * 2 + (size_t)3072 * 256 * 2), [=](int k, int n) { return wo[(size_t)k * DM + n]; });
    } else {
        const float* win = kin(in, 26) + (size_t)j * DM * 6144;
        prep_matrix(F, DM, 6144, (bf16*)(ws + W_MIX), [=](int k, int n) { return win[(size_t)k * 6144 + n]; });
        const float* wo = kin(in, 27) + (size_t)j * 2048 * DM;
        prep_matrix(F, 2048, DM, (bf16*)(ws + W_MIX + (size_t)6144 * 1024 * 2), [=](int k, int n) { return wo[(size_t)k * DM + n]; });
    }
}

__device__ __forceinline__ void norm_phase(const Frame& F, const float* x0, bf16* xb, const bf16* h, float c, const float* gpost, const float* gpre, bf16* xn, int mode, float* fout, float* ftmp) {
    PH_IDS;
    const int gw = F.vcu * NWAVES + w, NGW = F.G * NWAVES;
    f32x4 gp[4], gq[4];
#pragma unroll
    for (int j = 0; j < 4; ++j) { gp[j] = h ? *(const f32x4*)(gpost + 4 * lane + 256 * j) : (f32x4){0.f, 0.f, 0.f, 0.f}; gq[j] = (mode != 3) ? *(const f32x4*)(gpre + 4 * lane + 256 * j) : (f32x4){0.f, 0.f, 0.f, 0.f}; }
    for (int m = gw; m < M; m += NGW) {
        f32x4 v[4];
        if (x0) {
#pragma unroll
            for (int j = 0; j < 4; ++j) v[j] = *(const f32x4*)(x0 + (size_t)m * DM + 4 * lane + 256 * j);
        } else {
#pragma unroll
            for (int j = 0; j < 4; ++j) { const u32x2 r = *(const u32x2*)(xb + (size_t)m * DM + 4 * lane + 256 * j); v[j] = (f32x4){bf_lo(r.x), bf_hi(r.x), bf_lo(r.y), bf_hi(r.y)}; }
        }
        if (h) {
            f32x4 hv[4]; float s = 0.f;
#pragma unroll
            for (int j = 0; j < 4; ++j) { const u32x2 r = *(const u32x2*)(h + (size_t)m * DM + 4 * lane + 256 * j); hv[j] = (f32x4){bf_lo(r.x), bf_hi(r.x), bf_lo(r.y), bf_hi(r.y)};
                s += (hv[j][0] * hv[j][0] + hv[j][1] * hv[j][1]) + (hv[j][2] * hv[j][2] + hv[j][3] * hv[j][3]); }
            const float rs = __builtin_amdgcn_rsqf(wave_sum(s) * (1.0f / DM) + NORM_EPS) * c;
#pragma unroll
            for (int j = 0; j < 4; ++j) v[j] += hv[j] * rs * gp[j];
        }
        if (mode == 3) {
            float* o = (m >= M / 2 ? fout : ftmp) + (size_t)m * DM;
#pragma unroll
            for (int j = 0; j < 4; ++j) *(f32x4*)(o + 4 * lane + 256 * j) = v[j];
        } else {
#pragma unroll
            for (int j = 0; j < 4; ++j) { u32x2 o; o.x = cvt_pk_bf16(v[j][0], v[j][1]); o.y = cvt_pk_bf16(v[j][2], v[j][3]); *(u32x2*)(xb + (size_t)m * DM + 4 * lane + 256 * j) = o; }
            float s = 0.f;
#pragma unroll
            for (int j = 0; j < 4; ++j) s += (v[j][0] * v[j][0] + v[j][1] * v[j][1]) + (v[j][2] * v[j][2] + v[j][3] * v[j][3]);
            const float rs = __builtin_amdgcn_rsqf(wave_sum(s) * (1.0f / DM) + NORM_EPS);
            u32x2 yb[4];
#pragma unroll
            for (int j = 0; j < 4; ++j) { const f32x4 y = v[j] * rs * gq[j]; yb[j].x = cvt_pk_bf16(y[0], y[1]); yb[j].y = cvt_pk_bf16(y[2], y[3]); }
            if (mode == 2) {
                const int t = m & (SEQ - 1);
#pragma unroll
                for (int j = 0; j < 4; ++j) {
                    *(u32x2*)(xn + (size_t)m * 2048 + 4 * lane + 256 * j) = yb[j];
                    if (t != SEQ - 1) *(u32x2*)(xn + (size_t)(m + 1) * 2048 + 1024 + 4 * lane + 256 * j) = yb[j];
                    if (t == 0) { unsigned z = 0u; asm volatile("" : "+v"(z)); *(u32x2*)(xn + (size_t)m * 2048 + 1024 + 4 * lane + 256 * j) = (u32x2){z, z}; }
                }
            } else {
#pragma unroll
                for (int j = 0; j < 4; ++j) *(u32x2*)(xn + (size_t)m * DM + 4 * lane + 256 * j) = yb[j];
            }
        }
    }
}
__device__ __forceinline__ void copy_half_phase(const Frame& F, const float* ftmp, float* fout) {
    const size_t n4 = (size_t)(M / 2) * DM / 4, stride = (size_t)F.G * 512;
    for (size_t i = (size_t)F.vcu * 512 + threadIdx.x; i < n4; i += stride) ((f32x4*)fout)[i] = ((const f32x4*)ftmp)[i];
}

__device__ __forceinline__ void ml_gate_phase(const Frame& F, const bf16* xn, const float* w_in, const float* b_if, float* ifg) {
    PH_IDS;
    const int gw = F.vcu * NWAVES + w, NGW = F.G * NWAVES;
    f32x4 wif[8][4];
#pragma unroll
    for (int j = 0; j < 4; ++j)
#pragma unroll
        for (int e = 0; e < 4; ++e) { const int k = 4 * lane + 256 * j + e; const f32x4 a = *(const f32x4*)(w_in + (size_t)k * ML_IN + 3072), b = *(const f32x4*)(w_in + (size_t)k * ML_IN + 3076);
            wif[0][j][e] = a[0]; wif[1][j][e] = a[1]; wif[2][j][e] = a[2]; wif[3][j][e] = a[3]; wif[4][j][e] = b[0]; wif[5][j][e] = b[1]; wif[6][j][e] = b[2]; wif[7][j][e] = b[3]; }
    const float bias = lane < 8 ? b_if[lane] : 0.f;
    for (int m = gw; m < M; m += NGW) {
        f32x4 y[4];
#pragma unroll
        for (int j = 0; j < 4; ++j) { const u32x2 r = *(const u32x2*)(xn + (size_t)m * DM + 4 * lane + 256 * j); y[j] = (f32x4){bf_lo(r.x), bf_hi(r.x), bf_lo(r.y), bf_hi(r.y)}; }
        float my = 0.f;
#pragma unroll
        for (int cc = 0; cc < 8; ++cc) { float d = 0.f;
#pragma unroll
            for (int j = 0; j < 4; ++j) d += (y[j][0] * wif[cc][j][0] + y[j][1] * wif[cc][j][1]) + (y[j][2] * wif[cc][j][2] + y[j][3] * wif[cc][j][3]);
            d = wave_sum(d); if (lane == cc) my = d; }
        if (lane < 8) { float val = my + bias; val = 15.0f * tanhf(val * (1.0f / 15.0f));
            if (lane >= 4) val = -log1pf(expf(-val));
            ifg[(size_t)m * 8 + lane] = val; }
    }
}

__device__ __forceinline__ void ml_chunk_phase(const Frame& F, const bf16* proj, const float* ifg, const float* conv_w, bf16* hb) {
    constexpr int QP = 272, SP = 144;
    constexpr int QS = 0, KS = QS + 64 * QP, KWT = KS + 64 * QP, VT = KWT + 128 * SP, PS = VT + 80 * SP, CT = PS + 64 * SP, TAB = CT + 80 * QP, CWT = TAB + 1024;
    static_assert(CWT + 4096 <= RING_BYTES, "ml lds");
    LAS unsigned char* lds = F.lds;
    LAS float* tU = (LAS float*)(lds + TAB); LAS float* tM = tU + 64; LAS float* tB = tU + 128; LAS float* tD = tU + 192;
    PH_IDS;
    const int fr = lane & 15, fq = lane >> 4;
    for (int item = F.vcu; item < NB * 16; item += F.G) {
        const int b = item >> 4, hh = (item >> 2) & 3, vs = item & 3;
        const size_t rowb = (size_t)b * SEQ;
        for (int i = tid; i < 16 * 36; i += 512) { const int r = i / 36, cidx = i % 36; ((LAS unsigned*)(lds + VT + (64 + r) * SP))[cidx] = (r == 0) ? 0x3f803f80u : 0u; }
        const int which = tid >> 8, tq = (tid >> 4) & 15, c8 = tid & 15;
        const int ch = which * 512 + hh * 128 + c8 * 8;
        for (int i = tid; i < 4 * 256; i += 512) { const int jj = i >> 8, cc = i & 255; ((LAS float*)(lds + CWT))[i] = conv_w[jj * 1024 + (cc >> 7) * 512 + hh * 128 + (cc & 127)]; }
        const float qscale = which == 0 ? 0.08838834764831845f : 1.0f;
        const int tqv = tid >> 5, vp = tid & 31;
        const int vcol = 1024 + hh * 256 + vs * 64 + 2 * vp;
        f32x4 C[5];
#pragma unroll
        for (int jj = 0; jj < 5; ++jj) C[jj] = (f32x4){0.f, 0.f, 0.f, 0.f};
        float mst = 0.f;
        u32x4 rq[7]; unsigned rv[4]; float gi, gf;
        const unsigned loQ = (unsigned)((4 * tq) * 3072 + ch) * 2u, loV = (unsigned)((4 * tqv) * 3072 + vcol) * 2u;
        auto prefetch = [&](int c) {
            const char* base = (const char*)proj + (rowb + 64 * c) * (size_t)(3072 * 2);
            const int t0 = 64 * c + 4 * tq - 3;
#pragma unroll
            for (int r = 0; r < 7; ++r) rq[r] = (t0 + r >= 0) ? *(const u32x4*)(base + (ptrdiff_t)(r - 3) * (3072 * 2) + loQ) : (u32x4){0u, 0u, 0u, 0u};
#pragma unroll
            for (int r = 0; r < 4; ++r) rv[r] = *(const unsigned*)(base + (size_t)r * (3072 * 2) + loV);
            const float* gb = ifg + (rowb + 64 * c) * 8 + hh;
            gi = gb[lane * 8]; gf = gb[lane * 8 + 4];
        };
        prefetch(0);
        for (int c = 0; c < SEQ / 64; ++c) {
            float bsum = gf;
#pragma unroll
            for (int o = 1; o < 64; o <<= 1) { const float t = __shfl_up(bsum, o); if (lane >= o) bsum += t; }
            const float uu = gi - bsum; float cm = uu;
#pragma unroll
            for (int o = 1; o < 64; o <<= 1) { const float t = __shfl_up(cm, o); if (lane >= o) cm = fmaxf(cm, t); }
            const float Mx = fmaxf(mst, cm);
            const float M63 = __shfl(Mx, 63), b63 = __shfl(bsum, 63);
            if (w == 0) { tU[lane] = uu; tM[lane] = Mx; tB[lane] = bsum; }
#pragma unroll
            for (int jj = 0; jj < 5; ++jj) { u32x2 o; o.x = cvt_pk_bf16(C[jj][0], C[jj][1]); o.y = cvt_pk_bf16(C[jj][2], C[jj][3]);
                *(LAS u32x2*)(lds + CT + (16 * jj + fr) * QP + (16 * w + 4 * fq) * 2) = o; }
            WG_BAR();
            {
                float kws[4];
#pragma unroll
                for (int tt = 0; tt < 4; ++tt) kws[tt] = fexp(tU[4 * tq + tt] - M63);
                float cw[4][8];
#pragma unroll
                for (int jj = 0; jj < 4; ++jj) { const f32x4 a = *(const LAS f32x4*)(lds + CWT + (jj * 256 + which * 128 + c8 * 8) * 4), bq = *(const LAS f32x4*)(lds + CWT + (jj * 256 + which * 128 + c8 * 8 + 4) * 4);
                    cw[jj][0] = a[0]; cw[jj][1] = a[1]; cw[jj][2] = a[2]; cw[jj][3] = a[3]; cw[jj][4] = bq[0]; cw[jj][5] = bq[1]; cw[jj][6] = bq[2]; cw[jj][7] = bq[3]; }
                float o[4][8];
#pragma unroll
                for (int tt = 0; tt < 4; ++tt) {
#pragma unroll
                    for (int e2 = 0; e2 < 4; ++e2) { float a0 = 0.f, a1 = 0.f;
#pragma unroll
                        for (int jj = 0; jj < 4; ++jj) { const unsigned x = rq[tt + jj][e2]; a0 += cw[jj][2 * e2] * bf_lo(x); a1 += cw[jj][2 * e2 + 1] * bf_hi(x); }
                        o[tt][2 * e2] = fsilu(a0) * qscale; o[tt][2 * e2 + 1] = fsilu(a1) * qscale; }
                    u32x4 pk; pk.x = cvt_pk_bf16(o[tt][0], o[tt][1]); pk.y = cvt_pk_bf16(o[tt][2], o[tt][3]); pk.z = cvt_pk_bf16(o[tt][4], o[tt][5]); pk.w = cvt_pk_bf16(o[tt][6], o[tt][7]);
                    *(LAS u32x4*)(lds + (which ? KS : QS) + (4 * tq + tt) * QP + c8 * 16) = pk;
                }
                if (which) {
#pragma unroll
                    for (int e = 0; e < 8; ++e) { u32x2 pk; pk.x = cvt_pk_bf16(o[0][e] * kws[0], o[1][e] * kws[1]); pk.y = cvt_pk_bf16(o[2][e] * kws[2], o[3][e] * kws[3]);
                        *(LAS u32x2*)(lds + KWT + (c8 * 8 + e) * SP + (4 * tq) * 2) = pk; }
                }
                u32x2 v0, v1;
                v0.x = (rv[0] & 0xffffu) | (rv[1] << 16); v0.y = (rv[2] & 0xffffu) | (rv[3] << 16);
                v1.x = (rv[0] >> 16) | (rv[1] & 0xffff0000u); v1.y = (rv[2] >> 16) | (rv[3] & 0xffff0000u);
                *(LAS u32x2*)(lds + VT + (2 * vp) * SP + (4 * tqv) * 2) = v0; *(LAS u32x2*)(lds + VT + (2 * vp + 1) * SP + (4 * tqv) * 2) = v1;
            }
            WG_BAR();
            if (c + 1 < SEQ / 64) prefetch(c + 1);
            {
                const int tt = w >> 1, st0 = 2 * (w & 1);
                f32x4 s0 = {0.f, 0.f, 0.f, 0.f}, s1 = {0.f, 0.f, 0.f, 0.f};
#pragma unroll
                for (int kk = 0; kk < 4; ++kk) {
                    const bf16x8 yq = *(const LAS bf16x8*)(lds + QS + (16 * tt + fr) * QP + (32 * kk + 8 * fq) * 2);
                    const bf16x8 x0 = *(const LAS bf16x8*)(lds + KS + (16 * st0 + fr) * QP + (32 * kk + 8 * fq) * 2);
                    const bf16x8 x1 = *(const LAS bf16x8*)(lds + KS + (16 * (st0 + 1) + fr) * QP + (32 * kk + 8 * fq) * 2);
                    s0 = mma16(x0, yq, s0); s1 = mma16(x1, yq, s1);
                }
                const int t = 16 * tt + fr; const float Mt = tM[t];
#pragma unroll
                for (int q = 0; q < 2; ++q) { const f32x4 sv = q ? s1 : s0; const int sb = 16 * (st0 + q) + 4 * fq; const f32x4 u4 = *(const LAS f32x4*)(tU + sb);
                    float p[4];
#pragma unroll
                    for (int e = 0; e < 4; ++e) p[e] = (sb + e <= t) ? sv[e] * fexp(u4[e] - Mt) : 0.f;
                    u32x2 pk; pk.x = cvt_pk_bf16(p[0], p[1]); pk.y = cvt_pk_bf16(p[2], p[3]);
                    *(LAS u32x2*)(lds + PS + t * SP + sb * 2) = pk; }
            }
            WG_BAR_L();
            {
                const int tt = w & 3, jb = (w < 4) ? 0 : 3, nj = (w < 4) ? 3 : 2;
                f32x4 a1[3], a2[3];
#pragma unroll
                for (int jj = 0; jj < 3; ++jj) { a1[jj] = (f32x4){0.f, 0.f, 0.f, 0.f}; a2[jj] = (f32x4){0.f, 0.f, 0.f, 0.f}; }
#pragma unroll
                for (int kk = 0; kk < 2; ++kk) { const bf16x8 yp = *(const LAS bf16x8*)(lds + PS + (16 * tt + fr) * SP + (32 * kk + 8 * fq) * 2);
#pragma unroll
                    for (int jj = 0; jj < 3; ++jj) if (jj < nj) { const bf16x8 xv = *(const LAS bf16x8*)(lds + VT + (16 * (jb + jj) + fr) * SP + (32 * kk + 8 * fq) * 2); a1[jj] = mma16(xv, yp, a1[jj]); } }
#pragma unroll
                for (int kk = 0; kk < 4; ++kk) { const bf16x8 yq = *(const LAS bf16x8*)(lds + QS + (16 * tt + fr) * QP + (32 * kk + 8 * fq) * 2);
#pragma unroll
                    for (int jj = 0; jj < 3; ++jj) if (jj < nj) { const bf16x8 xc = *(const LAS bf16x8*)(lds + CT + (16 * (jb + jj) + fr) * QP + (32 * kk + 8 * fq) * 2); a2[jj] = mma16(xc, yq, a2[jj]); } }
                const int t = 16 * tt + fr; const float Mt = tM[t], bt = tB[t]; const float inter = fexp(mst - Mt);
#pragma unroll
                for (int jj = 0; jj < 3; ++jj) a1[jj] = a1[jj] + a2[jj] * inter;
                if (w >= 4 && fq == 0) tD[t] = a1[1][0];
                WG_BAR_L();
                const float dn = fmaxf(fabsf(tD[t]), fexp(-(bt + Mt))); const float rdn = 1.0f / dn;
#pragma unroll
                for (int jj = 0; jj < 3; ++jj) if (jj < nj && jb + jj < 4) { u32x2 pk; pk.x = cvt_pk_bf16(a1[jj][0] * rdn, a1[jj][1] * rdn); pk.y = cvt_pk_bf16(a1[jj][2] * rdn, a1[jj][3] * rdn);
                    *(u32x2*)((char*)(hb + (rowb + 64 * c + 16 * tt) * DM + hh * 256 + vs * 64 + 16 * (jb + jj)) + (unsigned)(fr * DM + 4 * fq) * 2u) = pk; }
            }
            {
                const float decay = fexp(mst - M63);
#pragma unroll
                for (int jj = 0; jj < 5; ++jj) C[jj] = C[jj] * decay;
#pragma unroll
                for (int kk = 0; kk < 2; ++kk) { const bf16x8 xk = *(const LAS bf16x8*)(lds + KWT + (16 * w + fr) * SP + (32 * kk + 8 * fq) * 2);
#pragma unroll
                    for (int jj = 0; jj < 5; ++jj) { const bf16x8 yv = *(const LAS bf16x8*)(lds + VT + (16 * jj + fr) * SP + (32 * kk + 8 * fq) * 2); C[jj] = mma16(xk, yv, C[jj]); } }
                mst = b63 + M63;
            }
            WG_BAR_L();
        }
    }
}

__device__ __forceinline__ void ml_head_phase(const Frame& F, const bf16* hb, const bf16* proj, const float* ng, bf16* hg) {
    PH_IDS;
    const int gw = F.vcu * NWAVES + w, NGW = F.G * NWAVES;
    f32x4 g[4];
#pragma unroll
    for (int j = 0; j < 4; ++j) g[j] = *(const f32x4*)(ng + 4 * lane + 256 * j);
    for (int m = gw; m < M; m += NGW) {
#pragma unroll
        for (int j = 0; j < 4; ++j) {
            const u32x2 r = *(const u32x2*)(hb + (size_t)m * DM + 4 * lane + 256 * j), ro = *(const u32x2*)(proj + (size_t)m * 3072 + 2048 + 4 * lane + 256 * j);
            const f32x4 v = {bf_lo(r.x), bf_hi(r.x), bf_lo(r.y), bf_hi(r.y)}, o = {bf_lo(ro.x), bf_hi(ro.x), bf_lo(ro.y), bf_hi(ro.y)};
            const float s = wave_sum((v[0] * v[0] + v[1] * v[1]) + (v[2] * v[2] + v[3] * v[3]));
            const float rs = __builtin_amdgcn_rsqf(s * (1.0f / 256.0f) + NORM_EPS);
            u32x2 pk; pk.x = cvt_pk_bf16(v[0] * rs * g[j][0] * fsigmoid(o[0]), v[1] * rs * g[j][1] * fsigmoid(o[1])); pk.y = cvt_pk_bf16(v[2] * rs * g[j][2] * fsigmoid(o[2]), v[3] * rs * g[j][3] * fsigmoid(o[3]));
            *(u32x2*)(hg + (size_t)m * DM + 4 * lane + 256 * j) = pk;
        }
    }
}

__device__ __forceinline__ void rt_chunk_phase(const Frame& F, const bf16* proj, bf16* yb) {
    constexpr int QP = 528, SP = 144;
    constexpr int QS = 0, KS = QS + 64 * QP, KWT = KS + 64 * QP, VT = KWT + 256 * SP, PS = VT + 128 * SP, END = PS + 64 * SP;
    static_assert(END <= MISC_OFF, "rt lds");
    LAS unsigned char* lds = F.lds;
    PH_IDS;
    const int fr = lane & 15, fq = lane >> 4;
    for (int item = F.vcu; item < NB * 16; item += F.G) {
        const int b = item >> 4, hh = (item >> 2) & 3, vs = item & 3;
        const size_t rowb = (size_t)b * SEQ;
        const float lg = __builtin_log2f(1.0f - __builtin_amdgcn_exp2f(-5.0f - (float)hh));
        const int tq = tid >> 5, c8 = tid & 31;
        const int qcol = hh * 256, kcol = 1024 + hh * 256 + c8 * 8, vcol = 2048 + hh * 512 + vs * 128 + 4 * c8;
        f32x4 R[16];
#pragma unroll
        for (int i = 0; i < 16; ++i) R[i] = (f32x4){0.f, 0.f, 0.f, 0.f};
        u32x4 rq[4], rk[4]; u32x2 rv[4];
        const unsigned loQ = (unsigned)((tid >> 5) * 6144 + qcol + (tid & 31) * 8) * 2u, loK = (unsigned)((4 * tq) * 6144 + kcol) * 2u, loV = (unsigned)((4 * tq) * 6144 + vcol) * 2u;
        auto prefetch = [&](int c) {
            const char* base = (const char*)proj + (rowb + 64 * c) * (size_t)(6144 * 2);
#pragma unroll
            for (int i = 0; i < 4; ++i) rq[i] = *(const u32x4*)(base + (size_t)i * (16 * 6144 * 2) + loQ);
#pragma unroll
            for (int i = 0; i < 4; ++i) { rk[i] = *(const u32x4*)(base + (size_t)i * (6144 * 2) + loK); rv[i] = *(const u32x2*)(base + (size_t)i * (6144 * 2) + loV); }
        };
        prefetch(0);
        float kws[4];
#pragma unroll
        for (int i = 0; i < 4; ++i) kws[i] = __builtin_amdgcn_exp2f(lg * (float)(63 - (4 * tq + i)));
        const float cdecay = __builtin_amdgcn_exp2f(lg * 64.0f);
        for (int c = 0; c < SEQ / 64; ++c) {
#pragma unroll
            for (int i = 0; i < 4; ++i) { const int idx = tid + 512 * i; *(LAS u32x4*)(lds + QS + (idx >> 5) * QP + (idx & 31) * 16) = rq[i]; }
#pragma unroll
            for (int i = 0; i < 4; ++i) *(LAS u32x4*)(lds + KS + (4 * tq + i) * QP + c8 * 16) = rk[i];
#pragma unroll
            for (int e2 = 0; e2 < 4; ++e2) {
                u32x2 lo, hi;
                lo.x = cvt_pk_bf16(bf_lo(rk[0][e2]) * kws[0], bf_lo(rk[1][e2]) * kws[1]); lo.y = cvt_pk_bf16(bf_lo(rk[2][e2]) * kws[2], bf_lo(rk[3][e2]) * kws[3]);
                hi.x = cvt_pk_bf16(bf_hi(rk[0][e2]) * kws[0], bf_hi(rk[1][e2]) * kws[1]); hi.y = cvt_pk_bf16(bf_hi(rk[2][e2]) * kws[2], bf_hi(rk[3][e2]) * kws[3]);
                *(LAS u32x2*)(lds + KWT + (c8 * 8 + 2 * e2) * SP + (4 * tq) * 2) = lo; *(LAS u32x2*)(lds + KWT + (c8 * 8 + 2 * e2 + 1) * SP + (4 * tq) * 2) = hi;
            }
            {
                u32x2 v0, v1, v2, v3;
                v0.x = (rv[0].x & 0xffffu) | (rv[1].x << 16); v0.y = (rv[2].x & 0xffffu) | (rv[3].x << 16);
                v1.x = (rv[0].x >> 16) | (rv[1].x & 0xffff0000u); v1.y = (rv[2].x >> 16) | (rv[3].x & 0xffff0000u);
                v2.x = (rv[0].y & 0xffffu) | (rv[1].y << 16); v2.y = (rv[2].y & 0xffffu) | (rv[3].y << 16);
                v3.x = (rv[0].y >> 16) | (rv[1].y & 0xffff0000u); v3.y = (rv[2].y >> 16) | (rv[3].y & 0xffff0000u);
                LAS unsigned char* vb = lds + VT + (4 * c8) * SP + (4 * tq) * 2;
                *(LAS u32x2*)(vb) = v0; *(LAS u32x2*)(vb + SP) = v1; *(LAS u32x2*)(vb + 2 * SP) = v2; *(LAS u32x2*)(vb + 3 * SP) = v3;
            }
            WG_BAR();
            {
                const int tt = w >> 1, st0 = 2 * (w & 1);
                f32x4 s0 = {0.f, 0.f, 0.f, 0.f}, s1 = {0.f, 0.f, 0.f, 0.f};
#pragma unroll 2
                for (int kk = 0; kk < 8; ++kk) {
                    const bf16x8 yq = *(const LAS bf16x8*)(lds + QS + (16 * tt + fr) * QP + (32 * kk + 8 * fq) * 2);
                    const bf16x8 x0 = *(const LAS bf16x8*)(lds + KS + (16 * st0 + fr) * QP + (32 * kk + 8 * fq) * 2);
                    const bf16x8 x1 = *(const LAS bf16x8*)(lds + KS + (16 * (st0 + 1) + fr) * QP + (32 * kk + 8 * fq) * 2);
                    s0 = mma16(x0, yq, s0); s1 = mma16(x1, yq, s1);
                }
                const int t = 16 * tt + fr;
#pragma unroll
                for (int q = 0; q < 2; ++q) { const f32x4 sv = q ? s1 : s0; const int sb = 16 * (st0 + q) + 4 * fq;
                    float p[4];
#pragma unroll
                    for (int e = 0; e < 4; ++e) p[e] = (sb + e <= t) ? sv[e] * __builtin_amdgcn_exp2f(lg * (float)(t - sb - e)) : 0.f;
                    u32x2 pk; pk.x = cvt_pk_bf16(p[0], p[1]); pk.y = cvt_pk_bf16(p[2], p[3]);
                    *(LAS u32x2*)(lds + PS + t * SP + sb * 2) = pk; }
            }
            WG_BAR_L();
            if (c + 1 < SEQ / 64) prefetch(c + 1);
            u32x4 xr[8];
#pragma unroll
            for (int kk = 0; kk < 8; ++kk) { xr[kk].x = cvt_pk_bf16(R[2 * kk][0], R[2 * kk][1]); xr[kk].y = cvt_pk_bf16(R[2 * kk][2], R[2 * kk][3]); xr[kk].z = cvt_pk_bf16(R[2 * kk + 1][0], R[2 * kk + 1][1]); xr[kk].w = cvt_pk_bf16(R[2 * kk + 1][2], R[2 * kk + 1][3]); }
#pragma unroll 1
            for (int tt = 0; tt < 4; ++tt) {
                f32x4 aI = {0.f, 0.f, 0.f, 0.f}, aC = {0.f, 0.f, 0.f, 0.f};
#pragma unroll
                for (int kk = 0; kk < 2; ++kk) { const bf16x8 xv = *(const LAS bf16x8*)(lds + VT + (16 * w + fr) * SP + (32 * kk + 8 * fq) * 2);
                    const bf16x8 yp = *(const LAS bf16x8*)(lds + PS + (16 * tt + fr) * SP + (32 * kk + 8 * fq) * 2); aI = mma16(xv, yp, aI); }
#pragma unroll
                for (int kk = 0; kk < 8; ++kk) {
                    const u32x2 qa = *(const LAS u32x2*)(lds + QS + (16 * tt + fr) * QP + (32 * kk + 4 * fq) * 2), qb = *(const LAS u32x2*)(lds + QS + (16 * tt + fr) * QP + (32 * kk + 16 + 4 * fq) * 2);
                    const u32x4 yq = {qa.x, qa.y, qb.x, qb.y};
                    aC = mma16(__builtin_bit_cast(bf16x8, xr[kk]), __builtin_bit_cast(bf16x8, yq), aC);
                }
                const int t = 16 * tt + fr; const float qd = __builtin_amdgcn_exp2f(lg * (float)(t + 1)); const f32x4 val = aI + aC * qd;
                u32x2 pk; pk.x = cvt_pk_bf16(val[0], val[1]); pk.y = cvt_pk_bf16(val[2], val[3]);
                *(u32x2*)((char*)(yb + (rowb + 64 * c + 16 * tt) * 2048 + hh * 512 + vs * 128 + 16 * w) + (unsigned)(fr * 2048 + 4 * fq) * 2u) = pk;
            }
            {
                const bf16x8 yv0 = *(const LAS bf16x8*)(lds + VT + (16 * w + fr) * SP + (8 * fq) * 2), yv1 = *(const LAS bf16x8*)(lds + VT + (16 * w + fr) * SP + (32 + 8 * fq) * 2);
#pragma unroll
                for (int dt = 0; dt < 16; ++dt) {
                    const bf16x8 x0 = *(const LAS bf16x8*)(lds + KWT + (16 * dt + fr) * SP + (8 * fq) * 2), x1 = *(const LAS bf16x8*)(lds + KWT + (16 * dt + fr) * SP + (32 + 8 * fq) * 2);
                    R[dt] = R[dt] * cdecay; R[dt] = mma16(x0, yv0, R[dt]); R[dt] = mma16(x1, yv1, R[dt]);
                    if ((dt & 3) == 3) asm volatile("" ::: "memory");
                }
            }
            WG_BAR_L();
        }
    }
}

__device__ __forceinline__ void rt_head_phase(const Frame& F, bf16* yb, const bf16* proj) {
    PH_IDS;
    const int gw = F.vcu * NWAVES + w, NGW = F.G * NWAVES;
    for (int m = gw; m < M; m += NGW) {
#pragma unroll
        for (int hd = 0; hd < 4; ++hd) {
            f32x4 v[2], g[2]; float s = 0.f;
#pragma unroll
            for (int q = 0; q < 2; ++q) { const int col = hd * 512 + q * 256 + 4 * lane;
                const u32x2 r = *(const u32x2*)(yb + (size_t)m * 2048 + col), rg = *(const u32x2*)(proj + (size_t)m * 6144 + 4096 + col);
                v[q] = (f32x4){bf_lo(r.x), bf_hi(r.x), bf_lo(r.y), bf_hi(r.y)}; g[q] = (f32x4){bf_lo(rg.x), bf_hi(rg.x), bf_lo(rg.y), bf_hi(rg.y)};
                s += (v[q][0] * v[q][0] + v[q][1] * v[q][1]) + (v[q][2] * v[q][2] + v[q][3] * v[q][3]); }
            const float rs = __builtin_amdgcn_rsqf(wave_sum(s) * (1.0f / 512.0f) + NORM_EPS);
#pragma unroll
            for (int q = 0; q < 2; ++q) { const int col = hd * 512 + q * 256 + 4 * lane;
                u32x2 pk; pk.x = cvt_pk_bf16(fsilu(g[q][0]) * v[q][0] * rs, fsilu(g[q][1]) * v[q][1] * rs); pk.y = cvt_pk_bf16(fsilu(g[q][2]) * v[q][2] * rs, fsilu(g[q][3]) * v[q][3] * rs);
                *(u32x2*)(yb + (size_t)m * 2048 + col) = pk; }
        }
    }
}

__device__ __forceinline__ float red16(float v) { v += __shfl_xor(v, 1); v += __shfl_xor(v, 2); v += __shfl_xor(v, 4); v += __shfl_xor(v, 8); return v; }
__device__ __forceinline__ void rw_scan_phase(const Frame& F, const bf16* rkv, const bf16* wag, const float* k_k, const float* k_a, const float* r_k, const float* ln_g, const float* ln_b, bf16* yout) {
    constexpr int TB = 32;
    constexpr int VW = 0, VK = 8192, VV = 16384, VA = 24576, VB = 32768, VR = 40960, VG = 49152, BON = 57344, SA = 57344 + 128, YP = SA + 4096;
    static_assert(YP + 65536 <= MISC_OFF, "rw lds");
    LAS unsigned char* lds = F.lds;
    PH_IDS;
    for (int item = F.vcu; item < NB * 16; item += F.G) {
        const int b = item >> 4, hh = item & 15;
        const size_t rowb = (size_t)b * SEQ;
        const int ts = tid >> 4, c4 = tid & 15, chg = hh * 64 + 4 * c4;
        const f32x4 kk4 = *(const f32x4*)(k_k + chg), ka4 = *(const f32x4*)(k_a + chg), rk4 = *(const f32x4*)(r_k + chg), lg4 = *(const f32x4*)(ln_g + chg), lb4 = *(const f32x4*)(ln_b + chg);
        float S[8];
#pragma unroll
        for (int i = 0; i < 8; ++i) S[i] = 0.f;
        u32x2 pr, pk, pv, pw, pa, pg;
        auto prefetch = [&](int tb) {
            const size_t row = rowb + (size_t)tb * TB + ts;
            pr = *(const u32x2*)(rkv + row * 3072 + chg); pk = *(const u32x2*)(rkv + row * 3072 + 1024 + chg); pv = *(const u32x2*)(rkv + row * 3072 + 2048 + chg);
            pw = *(const u32x2*)(wag + row * 3072 + chg); pa = *(const u32x2*)(wag + row * 3072 + 1024 + chg); pg = *(const u32x2*)(wag + row * 3072 + 2048 + chg);
        };
        prefetch(0);
        for (int tb = 0; tb < SEQ / TB; ++tb) {
            {
                const f32x4 r = {bf_lo(pr.x), bf_hi(pr.x), bf_lo(pr.y), bf_hi(pr.y)}, k = {bf_lo(pk.x), bf_hi(pk.x), bf_lo(pk.y), bf_hi(pk.y)}, v = {bf_lo(pv.x), bf_hi(pv.x), bf_lo(pv.y), bf_hi(pv.y)};
                const f32x4 lw = {bf_lo(pw.x), bf_hi(pw.x), bf_lo(pw.y), bf_hi(pw.y)}, a = {bf_lo(pa.x), bf_hi(pa.x), bf_lo(pa.y), bf_hi(pa.y)}, g = {bf_lo(pg.x), bf_hi(pg.x), bf_lo(pg.y), bf_hi(pg.y)};
                const f32x4 kkv = k * kk4;
                const float ss = red16((kkv[0] * kkv[0] + kkv[1] * kkv[1]) + (kkv[2] * kkv[2] + kkv[3] * kkv[3]));
                const float inv = 1.0f / fmaxf(sqrtf(ss), 1e-12f);
                const f32x4 kkn = kkv * inv;
                const f32x4 kp = k * (1.0f + (a - 1.0f) * ka4);
                const f32x4 rkp = r * kp * rk4;
                const float bd = red16((rkp[0] + rkp[1]) + (rkp[2] + rkp[3]));
                const f32x4 dec = {fexp(lw[0]), fexp(lw[1]), fexp(lw[2]), fexp(lw[3])};
                const int o = (ts * 64 + 4 * c4) * 4;
                *(LAS f32x4*)(lds + VW + o) = dec; *(LAS f32x4*)(lds + VK + o) = kp; *(LAS f32x4*)(lds + VV + o) = v; *(LAS f32x4*)(lds + VA + o) = -kkn; *(LAS f32x4*)(lds + VB + o) = kkn * a;
                *(LAS f32x4*)(lds + VR + o) = r; *(LAS f32x4*)(lds + VG + o) = g;
                if (c4 == 0) *(LAS float*)(lds + BON + ts * 4) = bd;
            }
            WG_BAR();
            if (tb + 1 < SEQ / TB) prefetch(tb + 1);
#pragma unroll 2
            for (int t = 0; t < TB; ++t) {
                const int o = (t * 64 + 8 * w) * 4;
                const f32x4 w0 = *(const LAS f32x4*)(lds + VW + o), w1 = *(const LAS f32x4*)(lds + VW + o + 16);
                const f32x4 a0 = *(const LAS f32x4*)(lds + VA + o), a1 = *(const LAS f32x4*)(lds + VA + o + 16);
                const f32x4 b0 = *(const LAS f32x4*)(lds + VB + o), b1 = *(const LAS f32x4*)(lds + VB + o + 16);
                const f32x4 k0 = *(const LAS f32x4*)(lds + VK + o), k1 = *(const LAS f32x4*)(lds + VK + o + 16);
                const f32x4 r0 = *(const LAS f32x4*)(lds + VR + o), r1 = *(const LAS f32x4*)(lds + VR + o + 16);
                const float vi = *(const LAS float*)(lds + VV + (t * 64 + lane) * 4);
                float p = (S[0] * a0[0] + S[1] * a0[1]) + (S[2] * a0[2] + S[3] * a0[3]) + (S[4] * a1[0] + S[5] * a1[1]) + (S[6] * a1[2] + S[7] * a1[3]);
                LAS float* sa = (LAS float*)(lds + SA + (t & 1) * 2048);
                sa[lane * 8 + w] = p;
                WG_BAR_L();
                const f32x4 q0 = *(const LAS f32x4*)(sa + lane * 8), q1 = *(const LAS f32x4*)(sa + lane * 8 + 4);
                const float sv = ((q0[0] + q0[1]) + (q0[2] + q0[3])) + ((q1[0] + q1[1]) + (q1[2] + q1[3]));
                S[0] = S[0] * w0[0] + sv * b0[0] + vi * k0[0]; S[1] = S[1] * w0[1] + sv * b0[1] + vi * k0[1]; S[2] = S[2] * w0[2] + sv * b0[2] + vi * k0[2]; S[3] = S[3] * w0[3] + sv * b0[3] + vi * k0[3];
                S[4] = S[4] * w1[0] + sv * b1[0] + vi * k1[0]; S[5] = S[5] * w1[1] + sv * b1[1] + vi * k1[1]; S[6] = S[6] * w1[2] + sv * b1[2] + vi * k1[2]; S[7] = S[7] * w1[3] + sv * b1[3] + vi * k1[3];
                const float yp = (S[0] * r0[0] + S[1] * r0[1]) + (S[2] * r0[2] + S[3] * r0[3]) + (S[4] * r1[0] + S[5] * r1[1]) + (S[6] * r1[2] + S[7] * r1[3]);
                *(LAS float*)(lds + YP + ((t * 8 + w) * 64 + lane) * 4) = yp;
            }
            WG_BAR_L();
            {
                const int o = (ts * 64 + 4 * c4) * 4;
                f32x4 y = *(const LAS f32x4*)(lds + YP + ((ts * 8) * 64 + 4 * c4) * 4);
#pragma unroll
                for (int ww = 1; ww < 8; ++ww) y += *(const LAS f32x4*)(lds + YP + ((ts * 8 + ww) * 64 + 4 * c4) * 4);
                const f32x4 v = *(const LAS f32x4*)(lds + VV + o), g = *(const LAS f32x4*)(lds + VG + o);
                const float bd = *(const LAS float*)(lds + BON + ts * 4);
                const float mean = red16((y[0] + y[1]) + (y[2] + y[3])) * (1.0f / 64.0f);
                const f32x4 d = y - mean;
                const float var = red16((d[0] * d[0] + d[1] * d[1]) + (d[2] * d[2] + d[3] * d[3])) * (1.0f / 64.0f);
                const float rs = __builtin_amdgcn_rsqf(var + 64e-5f);
                const f32x4 outv = ((d * rs) * lg4 + lb4 + v * bd) * g;
                u32x2 po; po.x = cvt_pk_bf16(outv[0], outv[1]); po.y = cvt_pk_bf16(outv[2], outv[3]);
                *(u32x2*)(yout + (rowb + (size_t)tb * TB + ts) * DM + chg) = po;
            }
            WG_BAR_L();
        }
    }
}

constexpr int N_PHASES = 2 + DEPTH * 11;

__global__ void __launch_bounds__(NWAVES * 64, 2) mk_fwd(Args args) {
    extern __shared__ __attribute__((aligned(16))) unsigned char lds_raw[];
    Frame F;
    F.lds = (LAS unsigned char*)lds_raw;
    F.G = gridDim.x; { const int bx = blockIdx.x; F.vcu = (F.G % 8 == 0) ? (bx % 8) * (F.G / 8) + bx / 8 : bx; }
    volatile LAS unsigned* MISC = (volatile LAS unsigned*)(F.lds + MISC_OFF);
    for (int u = threadIdx.x; u < (LDS_BYTES - MISC_OFF) / 4; u += NWAVES * 64) ((LAS unsigned*)(F.lds + MISC_OFF))[u] = 0u;
    __syncthreads();
    unsigned char* ws = args.ws;
    unsigned* ctl = (unsigned*)(ws + WS_CTL);
    const int lo = args.p_lo, hi = args.p_hi;
    XcdBarrier bar; bar.bar = ctl + CW_BAR; bar.x = 0; bar.st = nullptr;
    if (hi - lo > 1) bar = xcd_barrier_post(ctl + CW_BAR, MISC + 8);
    const Args& in = args;
    bf16* xb = (bf16*)args.out;
    bf16* XN = (bf16*)(ws + WS_XN); bf16* MO = (bf16*)(ws + WS_MO);
    bf16* RA = (bf16*)(ws + WS_A); bf16* RB = (bf16*)(ws + WS_B);
    int p = 0;
#define PH_ON (p >= lo && p < hi)
#define PH_END do { if (p >= lo && p + 1 < hi) xcd_barrier(bar); ++p; } while (0)
#define DUP(cat, ...) do { __VA_ARGS__; if (PROBE_DUP == (cat)) { xcd_barrier(bar); __VA_ARGS__; } } while (0)


    if (PH_ON) { DUP(4, prep_layer(F, in, ws, 0)); norm_phase(F, kin(in, 0), xb, nullptr, 0.f, nullptr, kin(in, 2), XN, 0, nullptr, nullptr);
    }
    PH_END;

#pragma unroll 1
    for (int s = 0; s < DEPTH * 3; ++s) {
        const int L = s / 3, sp = s % 3, kind = L % 3, jm = L / 3;
        const float* g6 = kin(in, 2) + (size_t)L * 6 * DM;
        if (sp != 1) {
            const int f = sp >> 1;
            if (PH_ON) { pg8::Gemm g{XN, (const bf16*)(ws + (f ? W_GU1 : W_GU0)), M, 2 * DFF, DM}; pg8::StaticOrder S; S.init(M, 2 * DFF, F.G, (int)blockIdx.x);
                pg8::EpiSwiglu E{RA, DFF}; DUP(1, pg8::gemm_phase<pg8::EpiSwiglu, pg8::StaticOrder, true, true>(F.lds, g, S, E)); }
            PH_END;
            if (PH_ON) { pg8::Gemm g{RA, (const bf16*)(ws + (f ? W_DN1 : W_DN0)), M, DM, DFF}; pg8::StaticOrder S; S.init(M, DM, F.G, (int)blockIdx.x);
                pg8::EpiPlain E{RB, DM}; DUP(2, pg8::gemm_phase<pg8::EpiPlain, pg8::StaticOrder, true, true>(F.lds, g, S, E)); }
            PH_END;
            if (PH_ON) {
                if (f == 0) {
                    norm_phase(F, nullptr, xb, RB, 0.5f, g6 + 1 * DM, g6 + 2 * DM, XN, kind == 1 ? 2 : 0, nullptr, nullptr);
                } else {
                    const bool lastl = (L == DEPTH - 1);
                    if (!lastl) DUP(4, prep_layer(F, in, ws, L + 1));
                    norm_phase(F, nullptr, xb, RB, 0.5f, g6 + 5 * DM, lastl ? nullptr : g6 + 6 * DM, XN, lastl ? 3 : 0, args.out, (float*)(ws + WS_A));
                }
            }
            PH_END;
        } else {
            const bf16* WM = (const bf16*)(ws + W_MIX);
            const bf16* a_out; const bf16* w_out; int k_out;
            if (kind == 0) {
                if (PH_ON) { pg8::Gemm g{XN, WM, M, 3072, DM}; pg8::StaticOrder S; S.init(M, 3072, F.G, (int)blockIdx.x);
                    pg8::EpiPlain E{RA, 3072}; DUP(5, pg8::gemm_phase<pg8::EpiPlain, pg8::StaticOrder, true, true>(F.lds, g, S, E));
                    ml_gate_phase(F, XN, kin(in, 5) + (size_t)jm * DM * ML_IN, kin(in, 6) + jm * 8, (float*)(ws + WS_A + 192 * MiB)); }
                PH_END;
                if (PH_ON) DUP(6, ml_chunk_phase(F, RA, (const float*)(ws + WS_A + 192 * MiB), kin(in, 7) + (size_t)jm * 4 * DM, RB));
                PH_END;
                if (PH_ON) DUP(7, ml_head_phase(F, RB, RA, kin(in, 8) + (size_t)jm * DM, RB + (size_t)M * DM));
                PH_END;
                a_out = RB + (size_t)M * DM; w_out = WM + (size_t)3072 * 1024; k_out = DM;
            } else if (kind == 1) {
                bf16* lmid = RB; bf16* wag = RA + (size_t)M * 3072; bf16* yo = RB + (size_t)M * 256;
                if (PH_ON) { pg8::Gemm g{XN, WM, M, 3328, 2048}; pg8::StaticOrder S; S.init(M, 3328, F.G, (int)blockIdx.x);
                    pg8::EpiRw1 E{RA, lmid}; DUP(9, pg8::gemm_phase<pg8::EpiRw1, pg8::StaticOrder, true, true>(F.lds, g, S, E)); }
                PH_END;
                if (PH_ON) { int k_rw2 = 256; asm volatile("" : "+s"(k_rw2));
                    pg8::Gemm g{lmid, WM + (size_t)3328 * 2048, M, 3072, k_rw2}; pg8::StaticOrder S; S.init(M, 3072, F.G, (int)blockIdx.x);
                    pg8::EpiRw2 E{wag, kin(in, 12) + (size_t)jm * DM, kin(in, 15) + (size_t)jm * DM}; DUP(10, pg8::gemm_phase<pg8::EpiRw2, pg8::StaticOrder, true, true>(F.lds, g, S, E)); }
                PH_END;
                if (PH_ON) DUP(11, rw_scan_phase(F, RA, wag, kin(in, 20) + (size_t)jm * DM, kin(in, 21) + (size_t)jm * DM, kin(in, 22) + (size_t)jm * DM, kin(in, 23) + (size_t)jm * DM, kin(in, 24) + (size_t)jm * DM, yo));
                PH_END;
                a_out = yo; w_out = WM + (size_t)3328 * 2048 + (size_t)3072 * 256; k_out = DM;
            } else {
                if (PH_ON) { pg8::Gemm g{XN, WM, M, 6144, DM}; pg8::StaticOrder S; S.init(M, 6144, F.G, (int)blockIdx.x);
                    pg8::EpiRtIn E{RA, (const int*)kin(in, 1)}; DUP(12, pg8::gemm_phase<pg8::EpiRtIn, pg8::StaticOrder, true, true>(F.lds, g, S, E)); }
                PH_END;
                if (PH_ON) DUP(13, rt_chunk_phase(F, RA, RB));
                PH_END;
                if (PH_ON) rt_head_phase(F, RB, RA);
                PH_END;
                a_out = RB; w_out = WM + (size_t)6144 * 1024; k_out = 2048;
            }
            if (PH_ON) { pg8::Gemm g{a_out, w_out, M, DM, k_out}; pg8::StaticOrder S; S.init(M, DM, F.G, (int)blockIdx.x);
                pg8::EpiPlain E{MO, DM}; DUP(8, pg8::gemm_phase<pg8::EpiPlain, pg8::StaticOrder, true, true>(F.lds, g, S, E)); }
            PH_END;
            if (PH_ON) norm_phase(F, nullptr, xb, MO, 1.0f, g6 + 3 * DM, g6 + 4 * DM, XN, 0, nullptr, nullptr);
            PH_END;
        }
    }
    if (PH_ON) copy_half_phase(F, (const float*)(ws + WS_A), args.out);
    PH_END;
#undef PH_ON
#undef PH_END
}

extern "C" void kernel_launch(void* const* d_in, const int* in_sizes, int n_in, void* d_out, int out_size, void* d_ws, size_t ws_size, hipStream_t stream) {
    static int grid = 0;
    if (grid == 0) {
        if (n_in != 28 || out_size != M * DM || ws_size < WS_END) { fprintf(stderr, "kernel_launch: unexpected shapes: n_in %d out %d ws %zu (need %zu)\n", n_in, out_size, ws_size, (size_t)WS_END); grid = -1; return; }
        int dev = 0, cus = 0, per_cu = 0;
        if (hipGetDevice(&dev) != hipSuccess || hipDeviceGetAttribute(&cus, hipDeviceAttributeMultiprocessorCount, dev) != hipSuccess) { grid = -1; return; }
        if (hipFuncSetAttribute((const void*)mk_fwd, hipFuncAttributeMaxDynamicSharedMemorySize, LDS_BYTES) != hipSuccess) { fprintf(stderr, "kernel_launch: hipFuncSetAttribute failed\n"); grid = -1; return; }
        if (hipOccupancyMaxActiveBlocksPerMultiprocessor(&per_cu, (const void*)mk_fwd, NWAVES * 64, LDS_BYTES) != hipSuccess || per_cu < 1) { fprintf(stderr, "kernel_launch: occupancy query says %d\n", per_cu); (void)hipGetLastError(); grid = -1; return; }
        grid = cus;
    }
    if (grid < 0) return;
    (void)hipMemsetAsync((char*)d_ws + WS_CTL, 0, CTL_ZERO_BYTES, stream);
    Args a{};
    for (int i = 0; i < 28; ++i) a.in[i] = d_in[i];
    a.out = (float*)d_out; a.ws = (unsigned char*)d_ws;
#if MK_PER_PHASE
    for (int p = 0; p < N_PHASES; ++p) { a.p_lo = p; a.p_hi = p + 1; hipLaunchKernelGGL(mk_fwd, dim3(grid), dim3(NWAVES * 64), LDS_BYTES, stream, a); }
#else
    a.p_lo = 0; a.p_hi = N_PHASES;
    hipLaunchKernelGGL(mk_fwd, dim3(grid), dim3(NWAVES * 64), LDS_BYTES, stream, a);
#endif
}
```

```cpp
#include <hip/hip_runtime.h>
#include <cstdio>
#include <cstdint>

#ifndef MK_PER_PHASE
#define MK_PER_PHASE 0
#endif
#ifndef PROBE_DUP
#define PROBE_DUP 0
#endif

#define LAS __attribute__((address_space(3)))
#define GAS __attribute__((address_space(1)))
typedef unsigned short bf16;
typedef short bf16x8 __attribute__((ext_vector_type(8)));
typedef float f32x4 __attribute__((ext_vector_type(4)));
typedef float f32x2 __attribute__((ext_vector_type(2)));
typedef unsigned u32x4 __attribute__((ext_vector_type(4)));
typedef unsigned u32x2 __attribute__((ext_vector_type(2)));

constexpr int DM = 1024, NB = 16, SEQ = 2048, DEPTH = 4, DFF = 2816;
constexpr int M = NB * SEQ;
constexpr float NORM_EPS = 1e-6f;
constexpr int ML_IN = 3080;
constexpr int NWAVES = 8;

constexpr size_t MiB = 1u << 20;
constexpr size_t WS_CTL = 0, CTL_ZERO_BYTES = 1 * MiB;
constexpr size_t WS_W = 1 * MiB;
constexpr size_t W_GU0 = WS_W, W_DN0 = W_GU0 + (size_t)5632 * 1024 * 2, W_GU1 = W_DN0 + (size_t)1024 * 2816 * 2, W_DN1 = W_GU1 + (size_t)5632 * 1024 * 2;
constexpr size_t W_MIX = W_DN1 + (size_t)1024 * 2816 * 2;
constexpr size_t WS_XN = 58 * MiB;
constexpr size_t WS_MO = WS_XN + 64 * MiB;
constexpr size_t WS_A = 186 * MiB;
constexpr size_t WS_B = 570 * MiB;
constexpr size_t WS_END = 698 * MiB;
static_assert(W_MIX + (size_t)17 * MiB <= WS_XN, "weight region");
constexpr int CW_BAR = 4096;

constexpr int RING_BYTES = 131072;
constexpr int LDS_BYTES = 147456;
constexpr int MISC_OFF = 145408;

typedef __bf16 bf16x2_t __attribute__((ext_vector_type(2)));
__device__ __forceinline__ unsigned cvt_pk_bf16(float lo, float hi) { const f32x2 v = {lo, hi}; return __builtin_bit_cast(unsigned, __builtin_convertvector(v, bf16x2_t)); }
__device__ __forceinline__ float bf_lo(unsigned u) { return __uint_as_float(u << 16); }
__device__ __forceinline__ float bf_hi(unsigned u) { return __uint_as_float(u & 0xffff0000u); }
__device__ __forceinline__ float fexp(float x) { return __builtin_amdgcn_exp2f(x * 1.4426950408889634f); }
__device__ __forceinline__ float fsigmoid(float x) { return __builtin_amdgcn_rcpf(1.0f + fexp(-x)); }
__device__ __forceinline__ float ftanh(float x) { return 2.0f * fsigmoid(2.0f * x) - 1.0f; }
__device__ __forceinline__ float fsilu(float x) { return x * fsigmoid(x); }
__device__ __forceinline__ float wave_sum(float v) {
#pragma unroll
    for (int o = 1; o < 64; o <<= 1) v += __shfl_xor(v, o);
    return v;
}
__device__ __forceinline__ f32x4 mma16(bf16x8 x, bf16x8 y, f32x4 c) { return __builtin_amdgcn_mfma_f32_16x16x32_bf16(x, y, c, 0, 0, 0); }
#define LDS_WAIT() asm volatile("s_waitcnt lgkmcnt(0)" ::: "memory")
#define WG_BAR() do { asm volatile("s_waitcnt vmcnt(0) lgkmcnt(0)" ::: "memory"); __builtin_amdgcn_s_barrier(); asm volatile("" ::: "memory"); } while (0)
#define WG_BAR_L() do { asm volatile("s_waitcnt lgkmcnt(0)" ::: "memory"); __builtin_amdgcn_s_barrier(); asm volatile("" ::: "memory"); } while (0)

namespace pg8 {
#define PG8_LAS __attribute__((address_space(3)))
typedef unsigned short bf16_t;
constexpr int BM = 256, BK = 64, HALF = 128, HTB = HALF * BK * 2, STAGE_BYTES = 8 * HTB, NXCD = 8, WGM = 8;
__host__ __device__ __forceinline__ int lds_byte(int r, int c) { const int st = (r >> 4) * 2 + (c >> 5), rr = r & 15, cc = c & 31, ob = rr * 64 + cc * 2; return st * 1024 + (ob ^ (((ob >> 9) & 1) << 5)); }
__host__ __device__ __forceinline__ void stage_rc(int b, int& R, int& C) { const int st = b / 1024, sb = b % 1024, swz = sb ^ (((sb >> 9) & 1) << 5); R = (st >> 1) * 16 + swz / 64; C = (st & 1) * 32 + (swz % 64) / 2; }
__host__ __device__ __forceinline__ int perm32(int rho) { const int n = rho >> 4, i = rho & 15; return 8 * (i >> 2) + 4 * n + (i & 3); }

struct Unit { int pm, pn; };
struct Gemm { const bf16_t* A; const bf16_t* Bt; int M, N, K; };

struct StaticOrder {
    int nM, nN, nwg, G, c;
    __host__ __device__ void init(int M_, int N_, int G_, int c_) { nM = M_ / BM; nN = N_ / BM; nwg = nM * nN; G = G_; c = c_; }
    __host__ __device__ bool next(int i, Unit& u) const {
        const long L = (long)i * G + c; if (L >= nwg) return false;
        int wgid = (int)L; { const int q = nwg / NXCD, r = nwg % NXCD, xcd = wgid % NXCD, off = wgid / NXCD; wgid = (xcd < r ? xcd * (q + 1) : r * (q + 1) + (xcd - r) * q) + off; }
        const int nig = WGM * nN, gid = wgid / nig, fm = gid * WGM, gsz = (nM - fm) < WGM ? (nM - fm) : WGM;
        u.pm = fm + ((wgid % nig) % gsz); u.pn = (wgid % nig) / gsz; return true;
    }
    __device__ __forceinline__ void a_ready(const Unit&) const {}
    __device__ __forceinline__ void done(const Unit&) const {}
};

__device__ __forceinline__ u32x4 pack8(f32x4 v0, f32x4 v1) { u32x4 w; w.x = cvt_pk_bf16(v0[0], v0[1]); w.y = cvt_pk_bf16(v0[2], v0[3]); w.z = cvt_pk_bf16(v1[0], v1[1]); w.w = cvt_pk_bf16(v1[2], v1[3]); return w; }

struct EpiPlain {
    static constexpr bool PERM = true, AFTER_DRAIN = false;
    bf16_t* O; int ldc;
    __device__ __forceinline__ void operator()(const f32x4 (&acc)[2][2][4][2], const Unit& u, int wr, int wc, int fr, int fq) const {
        const int row0 = u.pm * BM + wr * 64 + fr, col0 = u.pn * BM + wc * 32 + 8 * fq;
#pragma unroll
        for (int ai = 0; ai < 2; ++ai)
#pragma unroll
            for (int m = 0; m < 4; ++m) { bf16_t* rowp = O + (size_t)(row0 + ai * HALF + m * 16) * ldc + col0;
#pragma unroll
                for (int bj = 0; bj < 2; ++bj) *(u32x4*)(rowp + bj * HALF) = pack8(acc[ai][bj][m][0], acc[ai][bj][m][1]); }
    }
};
struct EpiSwiglu {
    static constexpr bool PERM = true, AFTER_DRAIN = false;
    bf16_t* O; int ldc;
    __device__ __forceinline__ void operator()(const f32x4 (&acc)[2][2][4][2], const Unit& u, int wr, int wc, int fr, int fq) const {
        const int row0 = u.pm * BM + wr * 64 + fr, col0 = u.pn * HALF + wc * 32 + 8 * fq;
#pragma unroll
        for (int ai = 0; ai < 2; ++ai)
#pragma unroll
            for (int m = 0; m < 4; ++m) { bf16_t* rowp = O + (size_t)(row0 + ai * HALF + m * 16) * ldc + col0;
                f32x4 o[2];
#pragma unroll
                for (int n = 0; n < 2; ++n)
#pragma unroll
                    for (int e = 0; e < 4; ++e) { const float g = acc[ai][0][m][n][e]; o[n][e] = g * fsigmoid(g) * acc[ai][1][m][n][e]; }
                *(u32x4*)rowp = pack8(o[0], o[1]); }
    }
};
struct EpiRw1 {
    static constexpr bool PERM = true, AFTER_DRAIN = false;
    bf16_t* rkv; bf16_t* lmid;
    __device__ __forceinline__ void operator()(const f32x4 (&acc)[2][2][4][2], const Unit& u, int wr, int wc, int fr, int fq) const {
        const int row0 = u.pm * BM + wr * 64 + fr;
        if (u.pn < 12) {
            const int col0 = u.pn * BM + wc * 32 + 8 * fq;
#pragma unroll
            for (int ai = 0; ai < 2; ++ai)
#pragma unroll
                for (int m = 0; m < 4; ++m) { bf16_t* rowp = rkv + (size_t)(row0 + ai * HALF + m * 16) * 3072 + col0;
#pragma unroll
                    for (int bj = 0; bj < 2; ++bj) *(u32x4*)(rowp + bj * HALF) = pack8(acc[ai][bj][m][0], acc[ai][bj][m][1]); }
        } else {
            const int col0 = wc * 32 + 8 * fq;
#pragma unroll
            for (int ai = 0; ai < 2; ++ai)
#pragma unroll
                for (int m = 0; m < 4; ++m) { bf16_t* rowp = lmid + (size_t)(row0 + ai * HALF + m * 16) * 256 + col0;
#pragma unroll
                    for (int bj = 0; bj < 2; ++bj) { f32x4 o[2];
#pragma unroll
                        for (int n = 0; n < 2; ++n)
#pragma unroll
                            for (int e = 0; e < 4; ++e) { const float v = acc[ai][bj][m][n][e]; o[n][e] = (bj == 1) ? fsigmoid(v) : (wc < 2 ? ftanh(v) : v); }
                        *(u32x4*)(rowp + bj * HALF) = pack8(o[0], o[1]); } }
        }
    }
};
struct EpiRw2 {
    static constexpr bool PERM = true, AFTER_DRAIN = false;
    bf16_t* O; const float* w0; const float* a0;
    __device__ __forceinline__ void operator()(const f32x4 (&acc)[2][2][4][2], const Unit& u, int wr, int wc, int fr, int fq) const {
        const int row0 = u.pm * BM + wr * 64 + fr, col0 = u.pn * BM + wc * 32 + 8 * fq, kind = u.pn >> 2, cc0 = (u.pn & 3) * BM + wc * 32 + 8 * fq;
        if (kind == 2) {
#pragma unroll
            for (int ai = 0; ai < 2; ++ai)
#pragma unroll
                for (int m = 0; m < 4; ++m) { bf16_t* rowp = O + (size_t)(row0 + ai * HALF + m * 16) * 3072 + col0;
#pragma unroll
                    for (int bj = 0; bj < 2; ++bj) *(u32x4*)(rowp + bj * HALF) = pack8(acc[ai][bj][m][0], acc[ai][bj][m][1]); }
        } else {
            const float* bp = (kind == 0 ? w0 : a0) + cc0; const float sc = kind == 0 ? -0.60653065971f : 1.0f;
#pragma unroll
            for (int bj = 0; bj < 2; ++bj) {
                const f32x4 b0 = *(const f32x4*)(bp + bj * HALF), b1 = *(const f32x4*)(bp + bj * HALF + 4);
#pragma unroll
                for (int ai = 0; ai < 2; ++ai)
#pragma unroll
                    for (int m = 0; m < 4; ++m) { bf16_t* rowp = O + (size_t)(row0 + ai * HALF + m * 16) * 3072 + col0; f32x4 o0, o1;
#pragma unroll
                        for (int e = 0; e < 4; ++e) { o0[e] = sc * fsigmoid(acc[ai][bj][m][0][e] + b0[e]); o1[e] = sc * fsigmoid(acc[ai][bj][m][1][e] + b1[e]); }
                        *(u32x4*)(rowp + bj * HALF) = pack8(o0, o1); }
            }
        }
    }
};
struct EpiRtIn {
    static constexpr bool PERM = true, AFTER_DRAIN = false;
    bf16_t* O; const int* pos;
    __device__ __forceinline__ void operator()(const f32x4 (&acc)[2][2][4][2], const Unit& u, int wr, int wc, int fr, int fq) const {
        const int row0 = u.pm * BM + wr * 64 + fr, col0 = u.pn * BM + wc * 32 + 8 * fq;
        if (u.pn >= 8) {
#pragma unroll
            for (int ai = 0; ai < 2; ++ai)
#pragma unroll
                for (int m = 0; m < 4; ++m) { bf16_t* rowp = O + (size_t)(row0 + ai * HALF + m * 16) * 6144 + col0;
#pragma unroll
                    for (int bj = 0; bj < 2; ++bj) *(u32x4*)(rowp + bj * HALF) = pack8(acc[ai][bj][m][0], acc[ai][bj][m][1]); }
        } else {
            const float sc = u.pn >= 4 ? 0.0625f : 1.0f;
            float invf[2][4];
#pragma unroll
            for (int n = 0; n < 2; ++n)
#pragma unroll
                for (int e = 0; e < 4; ++e) { const int i = wc * 32 + 8 * fq + 4 * n + e; invf[n][e] = __builtin_amdgcn_exp2f((float)i * (-13.287712379549449f / 127.0f)) * 0.15915494309189535f; }
#pragma unroll
            for (int ai = 0; ai < 2; ++ai)
#pragma unroll
                for (int m = 0; m < 4; ++m) { const int row = row0 + ai * HALF + m * 16; const float p = (float)pos[row]; bf16_t* rowp = O + (size_t)row * 6144 + col0;
                    f32x4 o1[2], o2[2];
#pragma unroll
                    for (int n = 0; n < 2; ++n)
#pragma unroll
                        for (int e = 0; e < 4; ++e) { float rev = p * invf[n][e]; rev = rev - __builtin_floorf(rev);
                            const float sn = __builtin_amdgcn_sinf(rev), cs = __builtin_amdgcn_cosf(rev);
                            const float u1 = acc[ai][0][m][n][e], u2 = acc[ai][1][m][n][e];
                            o1[n][e] = (u1 * cs - u2 * sn) * sc; o2[n][e] = (u1 * sn + u2 * cs) * sc; }
                    *(u32x4*)rowp = pack8(o1[0], o1[1]); *(u32x4*)(rowp + HALF) = pack8(o2[0], o2[1]); }
        }
    }
};

template <class Epi, class Sched, bool ALIGN_EPI = false, bool SP2 = false>
__device__ __forceinline__ void gemm_phase(PG8_LAS unsigned char* lds, const Gemm g, const Sched& S, const Epi& E) {
    int tid_ = threadIdx.x; asm volatile("" : "+v"(tid_));
    const int tid = tid_, wid = __builtin_amdgcn_readfirstlane(tid >> 6), lane = tid & 63, wr = wid >> 2, wc = wid & 3, fr = lane & 15, fq = lane >> 4;
    const int K = g.K, nt = K / BK;
    unsigned voffA[2], voffB[2];
#pragma unroll
    for (int i = 0; i < 2; ++i) { int R, C; stage_rc(tid * 16 + i * 8192, R, C); const int Rb = Epi::PERM ? ((R & ~31) + perm32(R & 31)) : R;
        voffA[i] = (unsigned)(R * K + C) * 2u; voffB[i] = (unsigned)(Rb * K + C) * 2u; }
    const size_t kstep = (size_t)(BK * 2);
    const size_t hstep = (size_t)HALF * K * 2;
    const size_t tstep = 2 * hstep;
    const unsigned ldsw = (unsigned)wid * 1024u;
    const int aoff = lds_byte(wr * 64 + fr, fq * 8), boff = lds_byte(wc * 32 + fr, fq * 8);
#define PG8_SA(b, h) (((b) * 2 + (h)) * HTB)
#define PG8_SB(b, h) ((4 + (b) * 2 + (h)) * HTB)
#define PG8_STAGE(bufoff, gbase, voff) do { _Pragma("unroll") for (int _i = 0; _i < 2; ++_i) \
        __builtin_amdgcn_global_load_lds((const unsigned*)((const char*)(gbase) + (voff)[_i]), (PG8_LAS unsigned*)(lds + (bufoff) + ldsw + _i * 8192), 16, 0, 0); } while (0)
#define PG8_LDA(dst, b, h) do { _Pragma("unroll") for (int m = 0; m < 4; ++m) _Pragma("unroll") for (int k = 0; k < 2; ++k) dst[m][k] = *(const PG8_LAS bf16x8*)(lds + PG8_SA(b, h) + aoff + m * 2048 + k * 1024); } while (0)
#define PG8_LDB(dst, b, h) do { _Pragma("unroll") for (int n = 0; n < 2; ++n) _Pragma("unroll") for (int k = 0; k < 2; ++k) dst[n][k] = *(const PG8_LAS bf16x8*)(lds + PG8_SB(b, h) + boff + n * 2048 + k * 1024); } while (0)
#define PG8_MMA(ai, bj, At, Bt) do { __builtin_amdgcn_s_setprio(1); _Pragma("unroll") for (int m = 0; m < 4; ++m) _Pragma("unroll") for (int n = 0; n < 2; ++n) _Pragma("unroll") for (int k = 0; k < 2; ++k) \
        acc[ai][bj][m][n] = __builtin_amdgcn_mfma_f32_16x16x32_bf16(Bt[n][k], At[m][k], acc[ai][bj][m][n], 0, 0, 0); __builtin_amdgcn_s_setprio(0); } while (0)
#define PG8_WAIT_V(n) asm volatile("s_waitcnt vmcnt(" #n ")" ::: "memory")
#define PG8_WAIT_L(n) asm volatile("s_waitcnt lgkmcnt(" #n ")" ::: "memory")
#define PG8_BAR __builtin_amdgcn_s_barrier()
#define PG8_SCHED __builtin_amdgcn_sched_barrier(0)
    Unit cur, nxt; int ui = 0;
    if (!S.next(0, cur)) return;
    f32x4 acc[2][2][4][2];
#pragma unroll
    for (int a = 0; a < 2; ++a)
#pragma unroll
        for (int b = 0; b < 2; ++b)
#pragma unroll
            for (int m = 0; m < 4; ++m)
#pragma unroll
                for (int n = 0; n < 2; ++n) acc[a][b][m][n] = (f32x4){0.f, 0.f, 0.f, 0.f};
    bf16x8 At[4][2], B0[2][2], B1[2][2];
    const char* cA = (const char*)g.A + (size_t)cur.pm * tstep; const char* cB = (const char*)g.Bt + (size_t)cur.pn * tstep;
    S.a_ready(cur);
    if constexpr (SP2) {
        PG8_STAGE(PG8_SB(0, 0), cB, voffB); PG8_STAGE(PG8_SB(0, 1), cB + hstep, voffB); PG8_STAGE(PG8_SA(0, 0), cA, voffA); PG8_STAGE(PG8_SA(0, 1), cA + hstep, voffA);
        if (wr == 1) PG8_BAR;
        PG8_WAIT_V(2); PG8_BAR;
        PG8_STAGE(PG8_SB(1, 0), cB + kstep, voffB); PG8_STAGE(PG8_SA(1, 0), cA + kstep, voffA); PG8_STAGE(PG8_SB(1, 1), cB + hstep + kstep, voffB);
        PG8_WAIT_V(6); PG8_BAR;
    } else {
        PG8_STAGE(PG8_SB(0, 0), cB, voffB); PG8_STAGE(PG8_SA(0, 0), cA, voffA); PG8_STAGE(PG8_SB(0, 1), cB + hstep, voffB); PG8_STAGE(PG8_SA(0, 1), cA + hstep, voffA);
        if (wr == 1) PG8_BAR;
        PG8_WAIT_V(4); PG8_BAR;
        PG8_STAGE(PG8_SB(1, 0), cB + kstep, voffB); PG8_STAGE(PG8_SA(1, 0), cA + kstep, voffA); PG8_STAGE(PG8_SB(1, 1), cB + hstep + kstep, voffB);
        PG8_WAIT_V(6); PG8_BAR;
    }
    for (;;) {
        const bool has_next = S.next(ui + 1, nxt);
        const char* nA = has_next ? (const char*)g.A + (size_t)nxt.pm * tstep : cA; const char* nB = has_next ? (const char*)g.Bt + (size_t)nxt.pn * tstep : cB;
        for (int t = 0; t < nt; t += 2) {
            const bool last = (t == nt - 2);
            const char* a1 = cA + (size_t)(t + 1) * kstep;
            const char* a2 = last ? nA : cA + (size_t)(t + 2) * kstep; const char* b2 = last ? nB : cB + (size_t)(t + 2) * kstep;
            const char* a3 = a2 + kstep; const char* b3 = b2 + kstep;
            if (last && has_next) S.a_ready(nxt);
            if constexpr (SP2) {
            PG8_LDB(B0, 0, 0); PG8_LDB(B1, 0, 1); PG8_SCHED; PG8_LDA(At, 0, 0); PG8_STAGE(PG8_SA(1, 1), a1 + hstep, voffA);
            PG8_WAIT_V(8); PG8_WAIT_L(0); PG8_BAR; PG8_MMA(0, 0, At, B0); PG8_MMA(0, 1, At, B1); PG8_BAR; PG8_SCHED;
            PG8_LDA(At, 0, 1); PG8_STAGE(PG8_SB(0, 0), b2, voffB); PG8_STAGE(PG8_SB(0, 1), b2 + hstep, voffB); PG8_STAGE(PG8_SA(0, 0), a2, voffA);
            PG8_WAIT_V(8); PG8_WAIT_L(0); PG8_BAR; PG8_MMA(1, 0, At, B0); PG8_MMA(1, 1, At, B1); PG8_BAR; PG8_SCHED;
            PG8_LDB(B0, 1, 0); PG8_LDB(B1, 1, 1); PG8_SCHED; PG8_LDA(At, 1, 0); PG8_STAGE(PG8_SA(0, 1), a2 + hstep, voffA);
            PG8_WAIT_V(8); PG8_WAIT_L(0); PG8_BAR; PG8_MMA(0, 0, At, B0); PG8_MMA(0, 1, At, B1); PG8_BAR; PG8_SCHED;
            PG8_LDA(At, 1, 1); PG8_STAGE(PG8_SB(1, 0), b3, voffB); PG8_STAGE(PG8_SB(1, 1), b3 + hstep, voffB); PG8_STAGE(PG8_SA(1, 0), a3, voffA);
            PG8_WAIT_V(8); PG8_WAIT_L(0); PG8_BAR; PG8_MMA(1, 0, At, B0); PG8_MMA(1, 1, At, B1); PG8_BAR; PG8_SCHED;
            } else {
            PG8_LDB(B0, 0, 0); PG8_SCHED; PG8_LDA(At, 0, 0); PG8_STAGE(PG8_SA(1, 1), a1 + hstep, voffA);
            PG8_WAIT_L(8); PG8_BAR; PG8_WAIT_L(0); PG8_MMA(0, 0, At, B0); PG8_BAR; PG8_SCHED;
            PG8_LDB(B1, 0, 1); PG8_STAGE(PG8_SB(0, 0), b2, voffB);
            PG8_BAR; PG8_WAIT_L(0); PG8_MMA(0, 1, At, B1); PG8_BAR;
            PG8_LDA(At, 0, 1); PG8_STAGE(PG8_SA(0, 0), a2, voffA);
            PG8_BAR; PG8_WAIT_L(0); PG8_MMA(1, 0, At, B0); PG8_BAR; PG8_SCHED;
            PG8_STAGE(PG8_SB(0, 1), b2 + hstep, voffB);
            PG8_WAIT_V(6); PG8_BAR; PG8_MMA(1, 1, At, B1); PG8_BAR;
            PG8_LDB(B0, 1, 0); PG8_SCHED; PG8_LDA(At, 1, 0); PG8_STAGE(PG8_SA(0, 1), a2 + hstep, voffA);
            PG8_WAIT_L(8); PG8_BAR; PG8_WAIT_L(0); PG8_MMA(0, 0, At, B0); PG8_BAR; PG8_SCHED;
            PG8_LDB(B1, 1, 1); PG8_STAGE(PG8_SB(1, 0), b3, voffB);
            PG8_BAR; PG8_WAIT_L(0); PG8_MMA(0, 1, At, B1); PG8_BAR;
            PG8_LDA(At, 1, 1); PG8_STAGE(PG8_SA(1, 0), a3, voffA);
            PG8_BAR; PG8_WAIT_L(0); PG8_MMA(1, 0, At, B0); PG8_BAR; PG8_SCHED;
            PG8_STAGE(PG8_SB(1, 1), b3 + hstep, voffB);
            PG8_WAIT_V(6); PG8_BAR; PG8_MMA(1, 1, At, B1); PG8_BAR;
            }
        }
        if constexpr (ALIGN_EPI) { if (wr == 0) PG8_BAR; }
        if constexpr (!Epi::AFTER_DRAIN) { E(acc, cur, wr, wc, fr, fq); S.done(cur); }
        if (!has_next) break;
#pragma unroll
        for (int a = 0; a < 2; ++a)
#pragma unroll
            for (int b = 0; b < 2; ++b)
#pragma unroll
                for (int m = 0; m < 4; ++m)
#pragma unroll
                    for (int n = 0; n < 2; ++n) acc[a][b][m][n] = (f32x4){0.f, 0.f, 0.f, 0.f};
        cur = nxt; cA = nA; cB = nB; ++ui;
        if constexpr (ALIGN_EPI) { if (wr == 1) PG8_BAR; }
    }
    PG8_WAIT_V(0);
    if constexpr (!ALIGN_EPI) { if (wr == 0) PG8_BAR; }
    PG8_BAR;
#undef PG8_SA
#undef PG8_SB
#undef PG8_STAGE
#undef PG8_LDA
#undef PG8_LDB
#undef PG8_MMA
#undef PG8_WAIT_V
#undef PG8_WAIT_L
#undef PG8_BAR
#undef PG8_SCHED
}
}

#define XB_TMO      128
#define XB_XCNT(j)  (256  + 64 * (j))
#define XB_XSUB(j)  (1280 + 64 * (j))
#define XB_XGEN(j)  (2304 + 64 * (j))
#define XB_TOP      3328
#define XB_TOPGEN   3392
#define XCD_BAR_WORDS 3456
#define XB_SPIN_CAP (1u << 18)

__device__ __forceinline__ unsigned xb_ld(unsigned* p)              { return __hip_atomic_load(p, __ATOMIC_RELAXED, __HIP_MEMORY_SCOPE_AGENT); }
__device__ __forceinline__ unsigned xb_add(unsigned* p, unsigned v) { return __hip_atomic_fetch_add(p, v, __ATOMIC_RELAXED, __HIP_MEMORY_SCOPE_AGENT); }
__device__ __forceinline__ unsigned xb_xcc_id() { return (unsigned)__builtin_amdgcn_s_getreg((3 << 11) | 20) & 0xFu; }
#define XB_SPIN(cond, bar) do { unsigned _sp = 0; while (cond) { __builtin_amdgcn_s_sleep(1); \
    if ((++_sp & 255u) == 0u) { if (xb_ld(&(bar)[XB_TMO])) break; if (_sp > XB_SPIN_CAP) { atomicAdd(&(bar)[XB_TMO], 1u); break; } } } } while (0)

struct XcdBarrier { unsigned* bar; unsigned x; volatile LAS unsigned* st; };

__device__ __forceinline__ XcdBarrier xcd_barrier_post(unsigned* bar, volatile LAS unsigned* st) {
    XcdBarrier b; b.bar = bar; b.x = xb_xcc_id(); b.st = st;
    if (threadIdx.x == 0) (void)xb_add(&bar[XB_XCNT(b.x)], 1u);
    return b;
}
__device__ __forceinline__ void xcd_barrier_complete(unsigned* bar, unsigned x, unsigned& nloc, unsigned& nx) {
    const unsigned G = gridDim.x * gridDim.y * gridDim.z;
    unsigned sum, cnt, mine, sp = 0u;
    for (;;) {
        sum = 0u; cnt = 0u; mine = 0u;
#pragma unroll
        for (unsigned j = 0; j < 16; ++j) { const unsigned c = xb_ld(&bar[XB_XCNT(j)]); sum += c; cnt += (c > 0u) ? 1u : 0u; mine = (j == x) ? c : mine; }
        if (sum == G) break;
        __builtin_amdgcn_s_sleep(1);
        if ((++sp & 255u) == 0u) { if (xb_ld(&bar[XB_TMO])) break; if (sp > XB_SPIN_CAP) { atomicAdd(&bar[XB_TMO], 1u); break; } }
    }
    nloc = mine > 0u ? mine : 1u; nx = cnt > 0u ? cnt : 1u;
}
__device__ __forceinline__ void xcd_barrier(const XcdBarrier& b) {
    asm volatile("s_waitcnt vmcnt(0)" ::: "memory");
    __syncthreads();
    if (threadIdx.x == 0) {
        unsigned* bar = b.bar;
        __builtin_amdgcn_s_waitcnt(0);
        unsigned nloc = b.st[0], nx = b.st[1];
        if (nloc == 0u) { xcd_barrier_complete(bar, b.x, nloc, nx); b.st[0] = nloc; b.st[1] = nx; }
        const unsigned old = xb_add(&bar[XB_XSUB(b.x)], 1u);
        const unsigned gen = old / nloc;
        if (old + 1u == (gen + 1u) * nloc) {
            __builtin_amdgcn_fence(__ATOMIC_RELEASE, "agent");
            asm volatile("s_waitcnt vmcnt(0)" ::: "memory");
            const unsigned og = xb_add(&bar[XB_TOP], 1u);
            const unsigned tg = og / nx;
            if (og + 1u == (tg + 1u) * nx) xb_add(&bar[XB_TOPGEN], 1u);
            else XB_SPIN(xb_ld(&bar[XB_TOPGEN]) == tg, bar);
            __builtin_amdgcn_fence(__ATOMIC_ACQUIRE, "agent");
            xb_add(&bar[XB_XGEN(b.x)], 1u);
            asm volatile("s_waitcnt vmcnt(0)" ::: "memory");
        } else {
            XB_SPIN(xb_ld(&bar[XB_XGEN(b.x)]) == gen, bar);
            __builtin_amdgcn_fence(__ATOMIC_ACQUIRE, "agent");
            asm volatile("s_waitcnt vmcnt(0)" ::: "memory");
        }
    }
    __syncthreads();
}

struct Frame {
    LAS unsigned char* lds;
    int vcu, G;
};
__device__ __forceinline__ int opaque_tid() { int t = threadIdx.x; asm volatile("" : "+v"(t)); return t; }
#define PH_IDS const int tid = opaque_tid(), lane = tid & 63, w = __builtin_amdgcn_readfirstlane(tid >> 6); (void)tid; (void)lane; (void)w

template <class SrcF>
__device__ __forceinline__ void prep_matrix(const Frame& F, int K, int N, bf16* WT, SrcF src) {
    PH_IDS;
    LAS float* scr = (LAS float*)(F.lds + w * 8448);
    const int gw = F.vcu * NWAVES + w, NGW = F.G * NWAVES;
    const int nblk = N / 32, nitems = (K / 64) * nblk;
    for (int it = gw; it < nitems; it += NGW) {
        const int kb = it / nblk, nb = it % nblk, k0 = 64 * kb, n0 = 32 * nb;
#pragma unroll 8
        for (int i = 0; i < 32; ++i) { const int kk = 2 * i + (lane >> 5); scr[kk * 33 + (lane & 31)] = src(k0 + kk, n0 + (lane & 31)); }
        LDS_WAIT();
        const int c = lane & 7;
#pragma unroll
        for (int j = 0; j < 4; ++j) { const int n = (lane >> 3) + 8 * j; const LAS float* s = scr + (8 * c) * 33 + n;
            u32x4 o; o.x = cvt_pk_bf16(s[0 * 33], s[1 * 33]); o.y = cvt_pk_bf16(s[2 * 33], s[3 * 33]); o.z = cvt_pk_bf16(s[4 * 33], s[5 * 33]); o.w = cvt_pk_bf16(s[6 * 33], s[7 * 33]);
            *(u32x4*)(WT + (size_t)(n0 + n) * K + k0 + 8 * c) = o; }
        LDS_WAIT();
    }
}

struct Args { const void* in[28]; float* out; unsigned char* ws; int p_lo, p_hi; };
__device__ __forceinline__ const float* kin(const Args& a, int i) { asm volatile("" : "+s"(i)); return (const float*)a.in[i]; }

__device__ __forceinline__ void prep_layer(const Frame& F, const Args& in, unsigned char* ws, int L) {
    const int kind = L % 3, j = L / 3;
#pragma unroll 1
    for (int f = 0; f < 2; ++f) {
        const float* wgu = kin(in, 3) + (size_t)(L * 2 + f) * DM * 2 * DFF;
        prep_matrix(F, DM, 2 * DFF, (bf16*)(ws + (f ? W_GU1 : W_GU0)), [=](int k, int n) { const int pn = n >> 8, r = n & 255; const int sc = (r < 128) ? (pn * 128 + r) : (DFF + pn * 128 + (r - 128)); return wgu[(size_t)k * (2 * DFF) + sc]; });
        const float* wdn = kin(in, 4) + (size_t)(L * 2 + f) * DFF * DM;
        prep_matrix(F, DFF, DM, (bf16*)(ws + (f ? W_DN1 : W_DN0)), [=](int k, int n) { return wdn[(size_t)k * DM + n]; });
    }
    if (kind == 0) {
        const float* win = kin(in, 5) + (size_t)j * DM * ML_IN;
        prep_matrix(F, DM, 3072, (bf16*)(ws + W_MIX), [=](int k, int n) { return win[(size_t)k * ML_IN + n]; });
        const float* wo = kin(in, 9) + (size_t)j * DM * DM;
        prep_matrix(F, DM, DM, (bf16*)(ws + W_MIX + (size_t)3072 * 1024 * 2), [=](int k, int n) { return wo[(size_t)k * DM + n]; });
    } else if (kind == 1) {
        const float* mu = kin(in, 10) + (size_t)j * 6 * DM; const float* wrkv = kin(in, 11) + (size_t)j * 3 * DM * DM;
        const float* w1 = kin(in, 13) + (size_t)j * DM * 64; const float* a1 = kin(in, 16) + (size_t)j * DM * 64; const float* g1 = kin(in, 18) + (size_t)j * DM * 128;
        prep_matrix(F, 2048, 3328, (bf16*)(ws + W_MIX), [=](int k, int n) {
            const int kk = k & 1023; const bool hi = k >= 1024; float w; int mi;
            if (n < 3072) { mi = n >> 10; w = wrkv[((size_t)mi * DM + kk) * DM + (n & 1023)]; }
            else { const int c = n - 3072; if (c < 64) { mi = 3; w = w1[kk * 64 + c]; } else if (c < 128) { mi = 4; w = a1[kk * 64 + (c - 64)]; } else { mi = 5; w = g1[kk * 128 + (c - 128)]; } }
            const float m = mu[mi * DM + kk]; return w * (hi ? m : 1.0f - m); });
        const float* w2 = kin(in, 14) + (size_t)j * 64 * DM; const float* a2 = kin(in, 17) + (size_t)j * 64 * DM; const float* g2 = kin(in, 19) + (size_t)j * 128 * DM;
        prep_matrix(F, 256, 3072, (bf16*)(ws + W_MIX + (size_t)3328 * 2048 * 2), [=](int k, int n) {
            const int t = n >> 10, c = n & 1023;
            if (t == 0) return k < 64 ? w2[k * DM + c] : 0.f;
            if (t == 1) return (k >= 64 && k < 128) ? a2[(k - 64) * DM + c] : 0.f;
            return k >= 128 ? g2[(k - 128) * DM + c] : 0.f; });
        const float* wo = kin(in, 25) + (size_t)j * DM * DM;
        prep_matrix(F, DM, DM, (bf16*)(ws + W_MIX + (size_t)3328 * 2048 * 2 + (size_t)3072 * 256 * 2), [=](int k, int n) { return wo[(size_t)k * DM + n]; });
    } else {
        const float* win = kin(in, 26) + (size_t)j * DM * 6144;
        prep_matrix(F, DM, 6144, (bf16*)(ws + W_MIX), [=](int k, int n) { return win[(size_t)k * 6144 + n]; });
        const float* wo = kin(in, 27) + (size_t)j * 2048 * DM;
        prep_matrix(F, 2048, DM, (bf16*)(ws + W_MIX + (size_t)6144 * 1024 * 2), [=](int k, int n) { return wo[(size_t)k * DM + n]; });
    }
}

__device__ __forceinline__ void norm_phase(const Frame& F, const float* x0, bf16* xb, const bf16* h, float c, const float* gpost, const float* gpre, bf16* xn, int mode, float* fout, float* ftmp) {
    PH_IDS;
    const int gw = F.vcu * NWAVES + w, NGW = F.G * NWAVES;
    f32x4 gp[4], gq[4];
#pragma unroll
    for (int j = 0; j < 4; ++j) { gp[j] = h ? *(const f32x4*)(gpost + 4 * lane + 256 * j) : (f32x4){0.f, 0.f, 0.f, 0.f}; gq[j] = (mode != 3) ? *(const f32x4*)(gpre + 4 * lane + 256 * j) : (f32x4){0.f, 0.f, 0.f, 0.f}; }
    for (int m = gw; m < M; m += NGW) {
        f32x4 v[4];
        if (x0) {
#pragma unroll
            for (int j = 0; j < 4; ++j) v[j] = *(const f32x4*)(x0 + (size_t)m * DM + 4 * lane + 256 * j);
        } else {
#pragma unroll
            for (int j = 0; j < 4; ++j) { const u32x2 r = *(const u32x2*)(xb + (size_t)m * DM + 4 * lane + 256 * j); v[j] = (f32x4){bf_lo(r.x), bf_hi(r.x), bf_lo(r.y), bf_hi(r.y)}; }
        }
        if (h) {
            f32x4 hv[4]; float s = 0.f;
#pragma unroll
            for (int j = 0; j < 4; ++j) { const u32x2 r = *(const u32x2*)(h + (size_t)m * DM + 4 * lane + 256 * j); hv[j] = (f32x4){bf_lo(r.x), bf_hi(r.x), bf_lo(r.y), bf_hi(r.y)};
                s += (hv[j][0] * hv[j][0] + hv[j][1] * hv[j][1]) + (hv[j][2] * hv[j][2] + hv[j][3] * hv[j][3]); }
            const float rs = __builtin_amdgcn_rsqf(wave_sum(s) * (1.0f / DM) + NORM_EPS) * c;
#pragma unroll
            for (int j = 0; j < 4; ++j) v[j] += hv[j] * rs * gp[j];
        }
        if (mode == 3) {
            float* o = (m >= M / 2 ? fout : ftmp) + (size_t)m * DM;
#pragma unroll
            for (int j = 0; j < 4; ++j) *(f32x4*)(o + 4 * lane + 256 * j) = v[j];
        } else {
#pragma unroll
            for (int j = 0; j < 4; ++j) { u32x2 o; o.x = cvt_pk_bf16(v[j][0], v[j][1]); o.y = cvt_pk_bf16(v[j][2], v[j][3]); *(u32x2*)(xb + (size_t)m * DM + 4 * lane + 256 * j) = o; }
            float s = 0.f;
#pragma unroll
            for (int j = 0; j < 4; ++j) s += (v[j][0] * v[j][0] + v[j][1] * v[j][1]) + (v[j][2] * v[j][2] + v[j][3] * v[j][3]);
            const float rs = __builtin_amdgcn_rsqf(wave_sum(s) * (1.0f / DM) + NORM_EPS);
            u32x2 yb[4];
#pragma unroll
            for (int j = 0; j < 4; ++j) { const f32x4 y = v[j] * rs * gq[j]; yb[j].x = cvt_pk_bf16(y[0], y[1]); yb[j].y = cvt_pk_bf16(y[2], y[3]); }
            if (mode == 2) {
                const int t = m & (SEQ - 1);
#pragma unroll
                for (int j = 0; j < 4; ++j) {
                    *(u32x2*)(xn + (size_t)m * 2048 + 4 * lane + 256 * j) = yb[j];
                    if (t != SEQ - 1) *(u32x2*)(xn + (size_t)(m + 1) * 2048 + 1024 + 4 * lane + 256 * j) = yb[j];
                    if (t == 0) { unsigned z = 0u; asm volatile("" : "+v"(z)); *(u32x2*)(xn + (size_t)m * 2048 + 1024 + 4 * lane + 256 * j) = (u32x2){z, z}; }
                }
            } else {
#pragma unroll
                for (int j = 0; j < 4; ++j) *(u32x2*)(xn + (size_t)m * DM + 4 * lane + 256 * j) = yb[j];
            }
        }
    }
}
__device__ __forceinline__ void copy_half_phase(const Frame& F, const float* ftmp, float* fout) {
    const size_t n4 = (size_t)(M / 2) * DM / 4, stride = (size_t)F.G * 512;
    for (size_t i = (size_t)F.vcu * 512 + threadIdx.x; i < n4; i += stride) ((f32x4*)fout)[i] = ((const f32x4*)ftmp)[i];
}

__device__ __forceinline__ void ml_gate_phase(const Frame& F, const bf16* xn, const float* w_in, const float* b_if, float* ifg) {
    PH_IDS;
    const int gw = F.vcu * NWAVES + w, NGW = F.G * NWAVES;
    f32x4 wif[8][4];
#pragma unroll
    for (int j = 0; j < 4; ++j)
#pragma unroll
        for (int e = 0; e < 4; ++e) { const int k = 4 * lane + 256 * j + e; const f32x4 a = *(const f32x4*)(w_in + (size_t)k * ML_IN + 3072), b = *(const f32x4*)(w_in + (size_t)k * ML_IN + 3076);
            wif[0][j][e] = a[0]; wif[1][j][e] = a[1]; wif[2][j][e] = a[2]; wif[3][j][e] = a[3]; wif[4][j][e] = b[0]; wif[5][j][e] = b[1]; wif[6][j][e] = b[2]; wif[7][j][e] = b[3]; }
    const float bias = lane < 8 ? b_if[lane] : 0.f;
    for (int m = gw; m < M; m += NGW) {
        f32x4 y[4];
#pragma unroll
        for (int j = 0; j < 4; ++j) { const u32x2 r = *(const u32x2*)(xn + (size_t)m * DM + 4 * lane + 256 * j); y[j] = (f32x4){bf_lo(r.x), bf_hi(r.x), bf_lo(r.y), bf_hi(r.y)}; }
        float my = 0.f;
#pragma unroll
        for (int cc = 0; cc < 8; ++cc) { float d = 0.f;
#pragma unroll
            for (int j = 0; j < 4; ++j) d += (y[j][0] * wif[cc][j][0] + y[j][1] * wif[cc][j][1]) + (y[j][2] * wif[cc][j][2] + y[j][3] * wif[cc][j][3]);
            d = wave_sum(d); if (lane == cc) my = d; }
        if (lane < 8) { float val = my + bias; val = 15.0f * tanhf(val * (1.0f / 15.0f));
            if (lane >= 4) val = -log1pf(expf(-val));
            ifg[(size_t)m * 8 + lane] = val; }
    }
}

__device__ __forceinline__ void ml_chunk_phase(const Frame& F, const bf16* proj, const float* ifg, const float* conv_w, bf16* hb) {
    constexpr int QP = 272, SP = 144;
    constexpr int QS = 0, KS = QS + 64 * QP, KWT = KS + 64 * QP, VT = KWT + 128 * SP, PS = VT + 80 * SP, CT = PS + 64 * SP, TAB = CT + 80 * QP, CWT = TAB + 1024;
    static_assert(CWT + 4096 <= RING_BYTES, "ml lds");
    LAS unsigned char* lds = F.lds;
    LAS float* tU = (LAS float*)(lds + TAB); LAS float* tM = tU + 64; LAS float* tB = tU + 128; LAS float* tD = tU + 192;
    PH_IDS;
    const int fr = lane & 15, fq = lane >> 4;
    for (int item = F.vcu; item < NB * 16; item += F.G) {
        const int b = item >> 4, hh = (item >> 2) & 3, vs = item & 3;
        const size_t rowb = (size_t)b * SEQ;
        for (int i = tid; i < 16 * 36; i += 512) { const int r = i / 36, cidx = i % 36; ((LAS unsigned*)(lds + VT + (64 + r) * SP))[cidx] = (r == 0) ? 0x3f803f80u : 0u; }
        const int which = tid >> 8, tq = (tid >> 4) & 15, c8 = tid & 15;
        const int ch = which * 512 + hh * 128 + c8 * 8;
        for (int i = tid; i < 4 * 256; i += 512) { const int jj = i >> 8, cc = i & 255; ((LAS float*)(lds + CWT))[i] = conv_w[jj * 1024 + (cc >> 7) * 512 + hh * 128 + (cc & 127)]; }
        const float qscale = which == 0 ? 0.08838834764831845f : 1.0f;
        const int tqv = tid >> 5, vp = tid & 31;
        const int vcol = 1024 + hh * 256 + vs * 64 + 2 * vp;
        f32x4 C[5];
#pragma unroll
        for (int jj = 0; jj < 5; ++jj) C[jj] = (f32x4){0.f, 0.f, 0.f, 0.f};
        float mst = 0.f;
        u32x4 rq[7]; unsigned rv[4]; float gi, gf;
        const unsigned loQ = (unsigned)((4 * tq) * 3072 + ch) * 2u, loV = (unsigned)((4 * tqv) * 3072 + vcol) * 2u;
        auto prefetch = [&](int c) {
            const char* base = (const char*)proj + (rowb + 64 * c) * (size_t)(3072 * 2);
            const int t0 = 64 * c + 4 * tq - 3;
#pragma unroll
            for (int r = 0; r < 7; ++r) rq[r] = (t0 + r >= 0) ? *(const u32x4*)(base + (ptrdiff_t)(r - 3) * (3072 * 2) + loQ) : (u32x4){0u, 0u, 0u, 0u};
#pragma unroll
            for (int r = 0; r < 4; ++r) rv[r] = *(const unsigned*)(base + (size_t)r * (3072 * 2) + loV);
            const float* gb = ifg + (rowb + 64 * c) * 8 + hh;
            gi = gb[lane * 8]; gf = gb[lane * 8 + 4];
        };
        prefetch(0);
        for (int c = 0; c < SEQ / 64; ++c) {
            float bsum = gf;
#pragma unroll
            for (int o = 1; o < 64; o <<= 1) { const float t = __shfl_up(bsum, o); if (lane >= o) bsum += t; }
            const float uu = gi - bsum; float cm = uu;
#pragma unroll
            for (int o = 1; o < 64; o <<= 1) { const float t = __shfl_up(cm, o); if (lane >= o) cm = fmaxf(cm, t); }
            const float Mx = fmaxf(mst, cm);
            const float M63 = __shfl(Mx, 63), b63 = __shfl(bsum, 63);
            if (w == 0) { tU[lane] = uu; tM[lane] = Mx; tB[lane] = bsum; }
#pragma unroll
            for (int jj = 0; jj < 5; ++jj) { u32x2 o; o.x = cvt_pk_bf16(C[jj][0], C[jj][1]); o.y = cvt_pk_bf16(C[jj][2], C[jj][3]);
                *(LAS u32x2*)(lds + CT + (16 * jj + fr) * QP + (16 * w + 4 * fq) * 2) = o; }
            WG_BAR();
            {
                float kws[4];
#pragma unroll
                for (int tt = 0; tt < 4; ++tt) kws[tt] = fexp(tU[4 * tq + tt] - M63);
                float cw[4][8];
#pragma unroll
                for (int jj = 0; jj < 4; ++jj) { const f32x4 a = *(const LAS f32x4*)(lds + CWT + (jj * 256 + which * 128 + c8 * 8) * 4), bq = *(const LAS f32x4*)(lds + CWT + (jj * 256 + which * 128 + c8 * 8 + 4) * 4);
                    cw[jj][0] = a[0]; cw[jj][1] = a[1]; cw[jj][2] = a[2]; cw[jj][3] = a[3]; cw[jj][4] = bq[0]; cw[jj][5] = bq[1]; cw[jj][6] = bq[2]; cw[jj][7] = bq[3]; }
                float o[4][8];
#pragma unroll
                for (int tt = 0; tt < 4; ++tt) {
#pragma unroll
                    for (int e2 = 0; e2 < 4; ++e2) { float a0 = 0.f, a1 = 0.f;
#pragma unroll
                        for (int jj = 0; jj < 4; ++jj) { const unsigned x = rq[tt + jj][e2]; a0 += cw[jj][2 * e2] * bf_lo(x); a1 += cw[jj][2 * e2 + 1] * bf_hi(x); }
                        o[tt][2 * e2] = fsilu(a0) * qscale; o[tt][2 * e2 + 1] = fsilu(a1) * qscale; }
                    u32x4 pk; pk.x = cvt_pk_bf16(o[tt][0], o[tt][1]); pk.y = cvt_pk_bf16(o[tt][2], o[tt][3]); pk.z = cvt_pk_bf16(o[tt][4], o[tt][5]); pk.w = cvt_pk_bf16(o[tt][6], o[tt][7]);
                    *(LAS u32x4*)(lds + (which ? KS : QS) + (4 * tq + tt) * QP + c8 * 16) = pk;
                }
                if (which) {
#pragma unroll
                    for (int e = 0; e < 8; ++e) { u32x2 pk; pk.x = cvt_pk_bf16(o[0][e] * kws[0], o[1][e] * kws[1]); pk.y = cvt_pk_bf16(o[2][e] * kws[2], o[3][e] * kws[3]);
                        *(LAS u32x2*)(lds + KWT + (c8 * 8 + e) * SP + (4 * tq) * 2) = pk; }
                }
                u32x2 v0, v1;
                v0.x = (rv[0] & 0xffffu) | (rv[1] << 16); v0.y = (rv[2] & 0xffffu) | (rv[3] << 16);
                v1.x = (rv[0] >> 16) | (rv[1] & 0xffff0000u); v1.y = (rv[2] >> 16) | (rv[3] & 0xffff0000u);
                *(LAS u32x2*)(lds + VT + (2 * vp) * SP + (4 * tqv) * 2) = v0; *(LAS u32x2*)(lds + VT + (2 * vp + 1) * SP + (4 * tqv) * 2) = v1;
            }
            WG_BAR();
            if (c + 1 < SEQ / 64) prefetch(c + 1);
            {
                const int tt = w >> 1, st0 = 2 * (w & 1);
                f32x4 s0 = {0.f, 0.f, 0.f, 0.f}, s1 = {0.f, 0.f, 0.f, 0.f};
#pragma unroll
                for (int kk = 0; kk < 4; ++kk) {
                    const bf16x8 yq = *(const LAS bf16x8*)(lds + QS + (16 * tt + fr) * QP + (32 * kk + 8 * fq) * 2);
                    const bf16x8 x0 = *(const LAS bf16x8*)(lds + KS + (16 * st0 + fr) * QP + (32 * kk + 8 * fq) * 2);
                    const bf16x8 x1 = *(const LAS bf16x8*)(lds + KS + (16 * (st0 + 1) + fr) * QP + (32 * kk + 8 * fq) * 2);
                    s0 = mma16(x0, yq, s0); s1 = mma16(x1, yq, s1);
                }
                const int t = 16 * tt + fr; const float Mt = tM[t];
#pragma unroll
                for (int q = 0; q < 2; ++q) { const f32x4 sv = q ? s1 : s0; const int sb = 16 * (st0 + q) + 4 * fq; const f32x4 u4 = *(const LAS f32x4*)(tU + sb);
                    float p[4];
#pragma unroll
                    for (int e = 0; e < 4; ++e) p[e] = (sb + e <= t) ? sv[e] * fexp(u4[e] - Mt) : 0.f;
                    u32x2 pk; pk.x = cvt_pk_bf16(p[0], p[1]); pk.y = cvt_pk_bf16(p[2], p[3]);
                    *(LAS u32x2*)(lds + PS + t * SP + sb * 2) = pk; }
            }
            WG_BAR_L();
            {
                const int tt = w & 3, jb = (w < 4) ? 0 : 3, nj = (w < 4) ? 3 : 2;
                f32x4 a1[3], a2[3];
#pragma unroll
                for (int jj = 0; jj < 3; ++jj) { a1[jj] = (f32x4){0.f, 0.f, 0.f, 0.f}; a2[jj] = (f32x4){0.f, 0.f, 0.f, 0.f}; }
#pragma unroll
                for (int kk = 0; kk < 2; ++kk) { const bf16x8 yp = *(const LAS bf16x8*)(lds + PS + (16 * tt + fr) * SP + (32 * kk + 8 * fq) * 2);
#pragma unroll
                    for (int jj = 0; jj < 3; ++jj) if (jj < nj) { const bf16x8 xv = *(const LAS bf16x8*)(lds + VT + (16 * (jb + jj) + fr) * SP + (32 * kk + 8 * fq) * 2); a1[jj] = mma16(xv, yp, a1[jj]); } }
#pragma unroll
                for (int kk = 0; kk < 4; ++kk) { const bf16x8 yq = *(const LAS bf16x8*)(lds + QS + (16 * tt + fr) * QP + (32 * kk + 8 * fq) * 2);
#pragma unroll
                    for (int jj = 0; jj < 3; ++jj) if (jj < nj) { const bf16x8 xc = *(const LAS bf16x8*)(lds + CT + (16 * (jb + jj) + fr) * QP + (32 * kk + 8 * fq) * 2); a2[jj] = mma16(xc, yq, a2[jj]); } }
                const int t = 16 * tt + fr; const float Mt = tM[t], bt = tB[t]; const float inter = fexp(mst - Mt);
#pragma unroll
                for (int jj = 0; jj < 3; ++jj) a1[jj] = a1[jj] + a2[jj] * inter;
                if (w >= 4 && fq == 0) tD[t] = a1[1][0];
                WG_BAR_L();
                const float dn = fmaxf(fabsf(tD[t]), fexp(-(bt + Mt))); const float rdn = 1.0f / dn;
#pragma unroll
                for (int jj = 0; jj < 3; ++jj) if (jj < nj && jb + jj < 4) { u32x2 pk; pk.x = cvt_pk_bf16(a1[jj][0] * rdn, a1[jj][1] * rdn); pk.y = cvt_pk_bf16(a1[jj][2] * rdn, a1[jj][3] * rdn);
                    *(u32x2*)((char*)(hb + (rowb + 64 * c + 16 * tt) * DM + hh * 256 + vs * 64 + 16 * (jb + jj)) + (unsigned)(fr * DM + 4 * fq) * 2u) = pk; }
            }
            {
                const float decay = fexp(mst - M63);
#pragma unroll
                for (int jj = 0; jj < 5; ++jj) C[jj] = C[jj] * decay;
#pragma unroll
                for (int kk = 0; kk < 2; ++kk) { const bf16x8 xk = *(const LAS bf16x8*)(lds + KWT + (16 * w + fr) * SP + (32 * kk + 8 * fq) * 2);
#pragma unroll
                    for (int jj = 0; jj < 5; ++jj) { const bf16x8 yv = *(const LAS bf16x8*)(lds + VT + (16 * jj + fr) * SP + (32 * kk + 8 * fq) * 2); C[jj] = mma16(xk, yv, C[jj]); } }
                mst = b63 + M63;
            }
            WG_BAR_L();
        }
    }
}

__device__ __forceinline__ void ml_head_phase(const Frame& F, const bf16* hb, const bf16* proj, const float* ng, bf16* hg) {
    PH_IDS;
    const int gw = F.vcu * NWAVES + w, NGW = F.G * NWAVES;
    f32x4 g[4];
#pragma unroll
    for (int j = 0; j < 4; ++j) g[j] = *(const f32x4*)(ng + 4 * lane + 256 * j);
    for (int m = gw; m < M; m += NGW) {
#pragma unroll
        for (int j = 0; j < 4; ++j) {
            const u32x2 r = *(const u32x2*)(hb + (size_t)m * DM + 4 * lane + 256 * j), ro = *(const u32x2*)(proj + (size_t)m * 3072 + 2048 + 4 * lane + 256 * j);
            const f32x4 v = {bf_lo(r.x), bf_hi(r.x), bf_lo(r.y), bf_hi(r.y)}, o = {bf_lo(ro.x), bf_hi(ro.x), bf_lo(ro.y), bf_hi(ro.y)};
            const float s = wave_sum((v[0] * v[0] + v[1] * v[1]) + (v[2] * v[2] + v[3] * v[3]));
            const float rs = __builtin_amdgcn_rsqf(s * (1.0f / 256.0f) + NORM_EPS);
            u32x2 pk; pk.x = cvt_pk_bf16(v[0] * rs * g[j][0] * fsigmoid(o[0]), v[1] * rs * g[j][1] * fsigmoid(o[1])); pk.y = cvt_pk_bf16(v[2] * rs * g[j][2] * fsigmoid(o[2]), v[3] * rs * g[j][3] * fsigmoid(o[3]));
            *(u32x2*)(hg + (size_t)m * DM + 4 * lane + 256 * j) = pk;
        }
    }
}

__device__ __forceinline__ void rt_chunk_phase(const Frame& F, const bf16* proj, bf16* yb) {
    constexpr int QP = 528, SP = 144;
    constexpr int QS = 0, KS = QS + 64 * QP, KWT = KS + 64 * QP, VT = KWT + 256 * SP, PS = VT + 128 * SP, END = PS + 64 * SP;
    static_assert(END <= MISC_OFF, "rt lds");
    LAS unsigned char* lds = F.lds;
    PH_IDS;
    const int fr = lane & 15, fq = lane >> 4;
    for (int item = F.vcu; item < NB * 16; item += F.G) {
        const int b = item >> 4, hh = (item >> 2) & 3, vs = item & 3;
        const size_t rowb = (size_t)b * SEQ;
        const float lg = __builtin_log2f(1.0f - __builtin_amdgcn_exp2f(-5.0f - (float)hh));
        const int tq = tid >> 5, c8 = tid & 31;
        const int qcol = hh * 256, kcol = 1024 + hh * 256 + c8 * 8, vcol = 2048 + hh * 512 + vs * 128 + 4 * c8;
        f32x4 R[16];
#pragma unroll
        for (int i = 0; i < 16; ++i) R[i] = (f32x4){0.f, 0.f, 0.f, 0.f};
        u32x4 rq[4], rk[4]; u32x2 rv[4];
        const unsigned loQ = (unsigned)((tid >> 5) * 6144 + qcol + (tid & 31) * 8) * 2u, loK = (unsigned)((4 * tq) * 6144 + kcol) * 2u, loV = (unsigned)((4 * tq) * 6144 + vcol) * 2u;
        auto prefetch = [&](int c) {
            const char* base = (const char*)proj + (rowb + 64 * c) * (size_t)(6144 * 2);
#pragma unroll
            for (int i = 0; i < 4; ++i) rq[i] = *(const u32x4*)(base + (size_t)i * (16 * 6144 * 2) + loQ);
#pragma unroll
            for (int i = 0; i < 4; ++i) { rk[i] = *(const u32x4*)(base + (size_t)i * (6144 * 2) + loK); rv[i] = *(const u32x2*)(base + (size_t)i * (6144 * 2) + loV); }
        };
        prefetch(0);
        float kws[4];
#pragma unroll
        for (int i = 0; i < 4; ++i) kws[i] = __builtin_amdgcn_exp2f(lg * (float)(63 - (4 * tq + i)));
        const float cdecay = __builtin_amdgcn_exp2f(lg * 64.0f);
        for (int c = 0; c < SEQ / 64; ++c) {
#pragma unroll
            for (int i = 0; i < 4; ++i) { const int idx = tid + 512 * i; *(LAS u32x4*)(lds + QS + (idx >> 5) * QP + (idx & 31) * 16) = rq[i]; }
#pragma unroll
            for (int i = 0; i < 4; ++i) *(LAS u32x4*)(lds + KS + (4 * tq + i) * QP + c8 * 16) = rk[i];
#pragma unroll
            for (int e2 = 0; e2 < 4; ++e2) {
                u32x2 lo, hi;
                lo.x = cvt_pk_bf16(bf_lo(rk[0][e2]) * kws[0], bf_lo(rk[1][e2]) * kws[1]); lo.y = cvt_pk_bf16(bf_lo(rk[2][e2]) * kws[2], bf_lo(rk[3][e2]) * kws[3]);
                hi.x = cvt_pk_bf16(bf_hi(rk[0][e2]) * kws[0], bf_hi(rk[1][e2]) * kws[1]); hi.y = cvt_pk_bf16(bf_hi(rk[2][e2]) * kws[2], bf_hi(rk[3][e2]) * kws[3]);
                *(LAS u32x2*)(lds + KWT + (c8 * 8 + 2 * e2) * SP + (4 * tq) * 2) = lo; *(LAS u32x2*)(lds + KWT + (c8 * 8 + 2 * e2 + 1) * SP + (4 * tq) * 2) = hi;
            }
            {
                u32x2 v0, v1, v2, v3;
                v0.x = (rv[0].x & 0xffffu) | (rv[1].x << 16); v0.y = (rv[2].x & 0xffffu) | (rv[3].x << 16);
                v1.x = (rv[0].x >> 16) | (rv[1].x & 0xffff0000u); v1.y = (rv[2].x >> 16) | (rv[3].x & 0xffff0000u);
                v2.x = (rv[0].y & 0xffffu) | (rv[1].y << 16); v2.y = (rv[2].y & 0xffffu) | (rv[3].y << 16);
                v3.x = (rv[0].y >> 16) | (rv[1].y & 0xffff0000u); v3.y = (rv[2].y >> 16) | (rv[3].y & 0xffff0000u);
                LAS unsigned char* vb = lds + VT + (4 * c8) * SP + (4 * tq) * 2;
                *(LAS u32x2*)(vb) = v0; *(LAS u32x2*)(vb + SP) = v1; *(LAS u32x2*)(vb + 2 * SP) = v2; *(LAS u32x2*)(vb + 3 * SP) = v3;
            }
            WG_BAR();
            {
                const int tt = w >> 1, st0 = 2 * (w & 1);
                f32x4 s0 = {0.f, 0.f, 0.f, 0.f}, s1 = {0.f, 0.f, 0.f, 0.f};
#pragma unroll 2
                for (int kk = 0; kk < 8; ++kk) {
                    const bf16x8 yq = *(const LAS bf16x8*)(lds + QS + (16 * tt + fr) * QP + (32 * kk + 8 * fq) * 2);
                    const bf16x8 x0 = *(const LAS bf16x8*)(lds + KS + (16 * st0 + fr) * QP + (32 * kk + 8 * fq) * 2);
                    const bf16x8 x1 = *(const LAS bf16x8*)(lds + KS + (16 * (st0 + 1) + fr) * QP + (32 * kk + 8 * fq) * 2);
                    s0 = mma16(x0, yq, s0); s1 = mma16(x1, yq, s1);
                }
                const int t = 16 * tt + fr;
#pragma unroll
                for (int q = 0; q < 2; ++q) { const f32x4 sv = q ? s1 : s0; const int sb = 16 * (st0 + q) + 4 * fq;
                    float p[4];
#pragma unroll
                    for (int e = 0; e < 4; ++e) p[e] = (sb + e <= t) ? sv[e] * __builtin_amdgcn_exp2f(lg * (float)(t - sb - e)) : 0.f;
                    u32x2 pk; pk.x = cvt_pk_bf16(p[0], p[1]); pk.y = cvt_pk_bf16(p[2], p[3]);
                    *(LAS u32x2*)(lds + PS + t * SP + sb * 2) = pk; }
            }
            WG_BAR_L();
            if (c + 1 < SEQ / 64) prefetch(c + 1);
            u32x4 xr[8];
#pragma unroll
            for (int kk = 0; kk < 8; ++kk) { xr[kk].x = cvt_pk_bf16(R[2 * kk][0], R[2 * kk][1]); xr[kk].y = cvt_pk_bf16(R[2 * kk][2], R[2 * kk][3]); xr[kk].z = cvt_pk_bf16(R[2 * kk + 1][0], R[2 * kk + 1][1]); xr[kk].w = cvt_pk_bf16(R[2 * kk + 1][2], R[2 * kk + 1][3]); }
#pragma unroll 1
            for (int tt = 0; tt < 4; ++tt) {
                f32x4 aI = {0.f, 0.f, 0.f, 0.f}, aC = {0.f, 0.f, 0.f, 0.f};
#pragma unroll
                for (int kk = 0; kk < 2; ++kk) { const bf16x8 xv = *(const LAS bf16x8*)(lds + VT + (16 * w + fr) * SP + (32 * kk + 8 * fq) * 2);
                    const bf16x8 yp = *(const LAS bf16x8*)(lds + PS + (16 * tt + fr) * SP + (32 * kk + 8 * fq) * 2); aI = mma16(xv, yp, aI); }
#pragma unroll
                for (int kk = 0; kk < 8; ++kk) {
                    const u32x2 qa = *(const LAS u32x2*)(lds + QS + (16 * tt + fr) * QP + (32 * kk + 4 * fq) * 2), qb = *(const LAS u32x2*)(lds + QS + (16 * tt + fr) * QP + (32 * kk + 16 + 4 * fq) * 2);
                    const u32x4 yq = {qa.x, qa.y, qb.x, qb.y};
                    aC = mma16(__builtin_bit_cast(bf16x8, xr[kk]), __builtin_bit_cast(bf16x8, yq), aC);
                }
                const int t = 16 * tt + fr; const float qd = __builtin_amdgcn_exp2f(lg * (float)(t + 1)); const f32x4 val = aI + aC * qd;
                u32x2 pk; pk.x = cvt_pk_bf16(val[0], val[1]); pk.y = cvt_pk_bf16(val[2], val[3]);
                *(u32x2*)((char*)(yb + (rowb + 64 * c + 16 * tt) * 2048 + hh * 512 + vs * 128 + 16 * w) + (unsigned)(fr * 2048 + 4 * fq) * 2u) = pk;
            }
            {
                const bf16x8 yv0 = *(const LAS bf16x8*)(lds + VT + (16 * w + fr) * SP + (8 * fq) * 2), yv1 = *(const LAS bf16x8*)(lds + VT + (16 * w + fr) * SP + (32 + 8 * fq) * 2);
#pragma unroll
                for (int dt = 0; dt < 16; ++dt) {
                    const bf16x8 x0 = *(const LAS bf16x8*)(lds + KWT + (16 * dt + fr) * SP + (8 * fq) * 2), x1 = *(const LAS bf16x8*)(lds + KWT + (16 * dt + fr) * SP + (32 + 8 * fq) * 2);
                    R[dt] = R[dt] * cdecay; R[dt] = mma16(x0, yv0, R[dt]); R[dt] = mma16(x1, yv1, R[dt]);
                    if ((dt & 3) == 3) asm volatile("" ::: "memory");
                }
            }
            WG_BAR_L();
        }
    }
}

__device__ __forceinline__ void rt_head_phase(const Frame& F, bf16* yb, const bf16* proj) {
    PH_IDS;
    const int gw = F.vcu * NWAVES + w, NGW = F.G * NWAVES;
    for (int m = gw; m < M; m += NGW) {
#pragma unroll
        for (int hd = 0; hd < 4; ++hd) {
            f32x4 v[2], g[2]; float s = 0.f;
#pragma unroll
            for (int q = 0; q < 2; ++q) { const int col = hd * 512 + q * 256 + 4 * lane;
                const u32x2 r = *(const u32x2*)(yb + (size_t)m * 2048 + col), rg = *(const u32x2*)(proj + (size_t)m * 6144 + 4096 + col);
                v[q] = (f32x4){bf_lo(r.x), bf_hi(r.x), bf_lo(r.y), bf_hi(r.y)}; g[q] = (f32x4){bf_lo(rg.x), bf_hi(rg.x), bf_lo(rg.y), bf_hi(rg.y)};
                s += (v[q][0] * v[q][0] + v[q][1] * v[q][1]) + (v[q][2] * v[q][2] + v[q][3] * v[q][3]); }
            const float rs = __builtin_amdgcn_rsqf(wave_sum(s) * (1.0f / 512.0f) + NORM_EPS);
#pragma unroll
            for (int q = 0; q < 2; ++q) { const int col = hd * 512 + q * 256 + 4 * lane;
                u32x2 pk; pk.x = cvt_pk_bf16(fsilu(g[q][0]) * v[q][0] * rs, fsilu(g[q][1]) * v[q][1] * rs); pk.y = cvt_pk_bf16(fsilu(g[q][2]) * v[q][2] * rs, fsilu(g[q][3]) * v[q][3] * rs);
                *(u32x2*)(yb + (size_t)m * 2048 + col) = pk; }
        }
    }
}

__device__ __forceinline__ float red16(float v) { v += __shfl_xor(v, 1); v += __shfl_xor(v, 2); v += __shfl_xor(v, 4); v += __shfl_xor(v, 8); return v; }
__device__ __forceinline__ float bf1(unsigned short u) { return __uint_as_float((unsigned)u << 16); }
__device__ __forceinline__ unsigned short f2bf1(float f) { return (unsigned short)(cvt_pk_bf16(f, 0.f) & 0xffffu); }
__device__ __forceinline__ void rw_scan_phase(const Frame& F, const bf16* rkv, const bf16* wag, const float* k_k, const float* k_a, const float* r_k, const float* ln_g, const float* ln_b, bf16* yout) {
    constexpr int TB = 64;
    constexpr int PLW = 0, PK = 8192, PV = 16384, PA = 24576, PB = 32768, PR = 40960, PG = 49152, BON = 57344, IMG = 57600;
    constexpr int I_AH = 0, I_RT = 2048, I_BT = 4096, I_KT = 6144, I_VT = 8192, I_NKH = 10240, I_NBR = 10752, I_NKR = 11264, I_GL = 11776, I_NBA = 12032, I_NKA = 13056, IMGSZ = 14080;
    constexpr int YB = IMG + 4 * IMGSZ;
    static_assert(YB + 4 * 4096 <= MISC_OFF && (IMG % 16) == 0 && (IMGSZ % 16) == 0, "rw lds");
    LAS unsigned char* lds = F.lds;
    PH_IDS;
    const int fr = lane & 15, fq = lane >> 4;
    for (int item = F.vcu; item < NB * 16; item += F.G) {
        const int b = item >> 4, hh = item & 15;
        const size_t rowb = (size_t)b * SEQ;
        const int c4 = tid & 15, chg = hh * 64 + 4 * c4;
        f32x4 ST[4];
#pragma unroll
        for (int jt = 0; jt < 4; ++jt) ST[jt] = (f32x4){0.f, 0.f, 0.f, 0.f};
        u32x2 pr[2], pk[2], pv[2], pw[2], pa[2], pg[2];
        const unsigned lo0 = (unsigned)((tid >> 4) * 3072 + chg) * 2u;
        auto prefetch = [&](int tb) {
            const char* br = (const char*)rkv + (rowb + (size_t)tb * TB) * (3072 * 2); const char* bw = (const char*)wag + (rowb + (size_t)tb * TB) * (3072 * 2);
#pragma unroll
            for (int q = 0; q < 2; ++q) { const size_t o = (size_t)q * (32 * 3072 * 2) + lo0;
                pr[q] = *(const u32x2*)(br + o); pk[q] = *(const u32x2*)(br + o + 2048); pv[q] = *(const u32x2*)(br + o + 4096);
                pw[q] = *(const u32x2*)(bw + o); pa[q] = *(const u32x2*)(bw + o + 2048); pg[q] = *(const u32x2*)(bw + o + 4096); }
        };
        prefetch(0);
        for (int tb = 0; tb < SEQ / TB; ++tb) {
            {
            const f32x4 kk4 = *(const f32x4*)(k_k + chg), ka4 = *(const f32x4*)(k_a + chg), rk4 = *(const f32x4*)(r_k + chg);
#pragma unroll
            for (int q = 0; q < 2; ++q) {
                const int tk = (tid >> 4) + 32 * q;
                const f32x4 r = {bf_lo(pr[q].x), bf_hi(pr[q].x), bf_lo(pr[q].y), bf_hi(pr[q].y)}, k = {bf_lo(pk[q].x), bf_hi(pk[q].x), bf_lo(pk[q].y), bf_hi(pk[q].y)};
                const f32x4 av = {bf_lo(pa[q].x), bf_hi(pa[q].x), bf_lo(pa[q].y), bf_hi(pa[q].y)};
                const f32x4 kkv = k * kk4;
                const float ss = red16((kkv[0] * kkv[0] + kkv[1] * kkv[1]) + (kkv[2] * kkv[2] + kkv[3] * kkv[3]));
                const float inv = 1.0f / fmaxf(sqrtf(ss), 1e-12f);
                const f32x4 kkn = kkv * inv, kp = k * (1.0f + (av - 1.0f) * ka4), rkp = r * kp * rk4, bb = kkn * av;
                const float bd = red16((rkp[0] + rkp[1]) + (rkp[2] + rkp[3]));
                const int o = (tk * 64 + 4 * c4) * 2;
                *(LAS u32x2*)(lds + PLW + o) = pw[q]; *(LAS u32x2*)(lds + PV + o) = pv[q]; *(LAS u32x2*)(lds + PR + o) = pr[q]; *(LAS u32x2*)(lds + PG + o) = pg[q];
                *(LAS u32x2*)(lds + PK + o) = (u32x2){cvt_pk_bf16(kp[0], kp[1]), cvt_pk_bf16(kp[2], kp[3])};
                *(LAS u32x2*)(lds + PA + o) = (u32x2){cvt_pk_bf16(-kkn[0], -kkn[1]), cvt_pk_bf16(-kkn[2], -kkn[3])};
                *(LAS u32x2*)(lds + PB + o) = (u32x2){cvt_pk_bf16(bb[0], bb[1]), cvt_pk_bf16(bb[2], bb[3])};
                if (c4 == 0) *(LAS float*)(lds + BON + tk * 4) = bd;
            }
            }
            WG_BAR();
            if (tb + 1 < SEQ / TB) prefetch(tb + 1);
            if (w >= 4) {
                const int c = w - 4, j = lane;
                LAS unsigned char* img = lds + IMG + c * IMGSZ;
                LAS unsigned char* scr = lds + YB + c * 4096;
                float At[16]; unsigned Bp[8], Kp[8], Vp[8];
                float cum = 0.f, gprev = 1.0f;
#pragma unroll
                for (int t = 0; t < 16; ++t) {
                    const int o = ((16 * c + t) * 64 + j) * 2;
                    const float lwv = bf1(*(const LAS unsigned short*)(lds + PLW + o)), a = bf1(*(const LAS unsigned short*)(lds + PA + o)), bq = bf1(*(const LAS unsigned short*)(lds + PB + o));
                    const float kq = bf1(*(const LAS unsigned short*)(lds + PK + o)), rq = bf1(*(const LAS unsigned short*)(lds + PR + o));
                    const unsigned vq = *(const LAS unsigned short*)(lds + PV + o);
                    cum += lwv;
                    const float gcur = fexp(cum), ginv = fexp(-cum);
                    At[t] = a * gprev;
                    const unsigned short ab = f2bf1(At[t]), rb = f2bf1(rq * gcur), bt = f2bf1(bq * ginv), kt = f2bf1(kq * ginv);
                    const int ot = (t * 64 + j) * 2;
                    *(LAS unsigned short*)(img + I_AH + ot) = ab; *(LAS unsigned short*)(img + I_RT + ot) = rb;
                    *(LAS unsigned short*)(scr + ot) = bt; *(LAS unsigned short*)(scr + 2048 + ot) = kt;
                    if (t & 1) { Bp[t >> 1] |= (unsigned)bt << 16; Kp[t >> 1] |= (unsigned)kt << 16; Vp[t >> 1] |= vq << 16; }
                    else { Bp[t >> 1] = bt; Kp[t >> 1] = kt; Vp[t >> 1] = vq; }
                    gprev = gcur;
                }
                *(LAS u32x4*)(img + I_BT + j * 32) = (u32x4){Bp[0], Bp[1], Bp[2], Bp[3]}; *(LAS u32x4*)(img + I_BT + j * 32 + 16) = (u32x4){Bp[4], Bp[5], Bp[6], Bp[7]};
                *(LAS u32x4*)(img + I_KT + j * 32) = (u32x4){Kp[0], Kp[1], Kp[2], Kp[3]}; *(LAS u32x4*)(img + I_KT + j * 32 + 16) = (u32x4){Kp[4], Kp[5], Kp[6], Kp[7]};
                *(LAS u32x4*)(img + I_VT + j * 32) = (u32x4){Vp[0], Vp[1], Vp[2], Vp[3]}; *(LAS u32x4*)(img + I_VT + j * 32 + 16) = (u32x4){Vp[4], Vp[5], Vp[6], Vp[7]};
                *(LAS float*)(img + I_GL + j * 4) = gprev;
                LDS_WAIT();
                {
                    f32x4 nba = {0.f, 0.f, 0.f, 0.f}, nbr = nba, nka = nba, nkr = nba;
#pragma unroll
                    for (int m = 0; m < 2; ++m) { const int o = fr * 128 + (32 * m + 8 * fq) * 2;
                        const bf16x8 xb = *(const LAS bf16x8*)(scr + o), xk = *(const LAS bf16x8*)(scr + 2048 + o), ya = *(const LAS bf16x8*)(img + I_AH + o), yr = *(const LAS bf16x8*)(img + I_RT + o);
                        nba = mma16(xb, ya, nba); nbr = mma16(xb, yr, nbr); nka = mma16(xk, ya, nka); nkr = mma16(xk, yr, nkr); }
#pragma unroll
                    for (int e = 0; e < 4; ++e) { const int sidx = 4 * fq + e; if (!(sidx < fr)) { nba[e] = 0.f; nka[e] = 0.f; } if (!(sidx <= fr)) { nbr[e] = 0.f; nkr[e] = 0.f; } }
                    *(LAS f32x4*)(img + I_NBA + (fr * 16 + 4 * fq) * 4) = nba; *(LAS f32x4*)(img + I_NKA + (fr * 16 + 4 * fq) * 4) = nka;
                    *(LAS u32x2*)(img + I_NBR + (fr * 16 + 4 * fq) * 2) = (u32x2){cvt_pk_bf16(nbr[0], nbr[1]), cvt_pk_bf16(nbr[2], nbr[3])};
                    *(LAS u32x2*)(img + I_NKR + (fr * 16 + 4 * fq) * 2) = (u32x2){cvt_pk_bf16(nkr[0], nkr[1]), cvt_pk_bf16(nkr[2], nkr[3])};
                }
                LDS_WAIT();
                {
                    float H[16];
#pragma unroll
                    for (int t = 0; t < 16; ++t) {
                        float h = At[t];
#pragma unroll
                        for (int s4 = 0; s4 < 4; ++s4) if (4 * s4 < t) { const f32x4 cf = *(const LAS f32x4*)(img + I_NBA + (t * 16 + 4 * s4) * 4);
#pragma unroll
                            for (int e = 0; e < 4; ++e) if (4 * s4 + e < t) h += H[4 * s4 + e] * cf[e]; }
                        H[t] = h;
                    }
                    LDS_WAIT();
#pragma unroll
                    for (int t = 0; t < 16; ++t) *(LAS unsigned short*)(img + I_AH + (t * 64 + j) * 2) = f2bf1(H[t]);
                    asm volatile("" ::: "memory");
#pragma unroll
                    for (int t = 0; t < 16; ++t) {
                        float g = *(const LAS float*)(img + I_NKA + (t * 16 + (lane & 15)) * 4);
#pragma unroll
                        for (int s4 = 0; s4 < 4; ++s4) if (4 * s4 < t) { const f32x4 cf = *(const LAS f32x4*)(img + I_NBA + (t * 16 + 4 * s4) * 4);
#pragma unroll
                            for (int e = 0; e < 4; ++e) if (4 * s4 + e < t) g += H[4 * s4 + e] * cf[e]; }
                        H[t] = g;
                        if (lane < 16) *(LAS unsigned short*)(img + I_NKH + (t * 16 + lane) * 2) = f2bf1(g);
                    }
                }
            }
            WG_BAR_L();
            if (w < 4) {
#pragma unroll 1
                for (int c = 0; c < 4; ++c) {
                    const LAS unsigned char* img = lds + IMG + c * IMGSZ;
                    u32x4 sf[2];
#pragma unroll
                    for (int m = 0; m < 2; ++m) { sf[m].x = cvt_pk_bf16(ST[2 * m][0], ST[2 * m][1]); sf[m].y = cvt_pk_bf16(ST[2 * m][2], ST[2 * m][3]); sf[m].z = cvt_pk_bf16(ST[2 * m + 1][0], ST[2 * m + 1][1]); sf[m].w = cvt_pk_bf16(ST[2 * m + 1][2], ST[2 * m + 1][3]); }
                    f32x4 d1 = {0.f, 0.f, 0.f, 0.f}, d2 = {0.f, 0.f, 0.f, 0.f};
#pragma unroll
                    for (int m = 0; m < 2; ++m) {
                        const u32x2 x0 = *(const LAS u32x2*)(img + I_AH + fr * 128 + (32 * m + 4 * fq) * 2), x1 = *(const LAS u32x2*)(img + I_AH + fr * 128 + (32 * m + 16 + 4 * fq) * 2);
                        d1 = mma16(__builtin_bit_cast(bf16x8, (u32x4){x0.x, x0.y, x1.x, x1.y}), __builtin_bit_cast(bf16x8, sf[m]), d1);
                        const u32x2 r0 = *(const LAS u32x2*)(img + I_RT + fr * 128 + (32 * m + 4 * fq) * 2), r1 = *(const LAS u32x2*)(img + I_RT + fr * 128 + (32 * m + 16 + 4 * fq) * 2);
                        d2 = mma16(__builtin_bit_cast(bf16x8, (u32x4){r0.x, r0.y, r1.x, r1.y}), __builtin_bit_cast(bf16x8, sf[m]), d2);
                    }
                    const u32x2 vt = *(const LAS u32x2*)(img + I_VT + (16 * w + fr) * 32 + (4 * fq) * 2), nk = *(const LAS u32x2*)(img + I_NKH + (fr * 16 + 4 * fq) * 2);
                    d1 = mma16(__builtin_bit_cast(bf16x8, (u32x4){nk.x, nk.y, 0u, 0u}), __builtin_bit_cast(bf16x8, (u32x4){vt.x, vt.y, 0u, 0u}), d1);
                    const u32x4 ff = {cvt_pk_bf16(d1[0], d1[1]), cvt_pk_bf16(d1[2], d1[3]), vt.x, vt.y};
                    const u32x2 nb = *(const LAS u32x2*)(img + I_NBR + (fr * 16 + 4 * fq) * 2), nr = *(const LAS u32x2*)(img + I_NKR + (fr * 16 + 4 * fq) * 2);
                    d2 = mma16(__builtin_bit_cast(bf16x8, (u32x4){nb.x, nb.y, nr.x, nr.y}), __builtin_bit_cast(bf16x8, ff), d2);
#pragma unroll
                    for (int e = 0; e < 4; ++e) *(LAS float*)(lds + YB + c * 4096 + ((4 * fq + e) * 64 + 16 * w + fr) * 4) = d2[e];
#pragma unroll
                    for (int jt = 0; jt < 4; ++jt) {
                        const u32x2 xb = *(const LAS u32x2*)(img + I_BT + (16 * jt + fr) * 32 + (4 * fq) * 2), xk = *(const LAS u32x2*)(img + I_KT + (16 * jt + fr) * 32 + (4 * fq) * 2);
                        ST[jt] = mma16(__builtin_bit_cast(bf16x8, (u32x4){xb.x, xb.y, xk.x, xk.y}), __builtin_bit_cast(bf16x8, ff), ST[jt]);
                        ST[jt] = ST[jt] * *(const LAS f32x4*)(img + I_GL + (16 * jt + 4 * fq) * 4);
                    }
                }
            }
            WG_BAR_L();
            {
            const f32x4 lg4 = *(const f32x4*)(ln_g + chg), lb4 = *(const f32x4*)(ln_b + chg);
#pragma unroll
            for (int q = 0; q < 2; ++q) {
                const int tk = (tid >> 4) + 32 * q, o = (tk * 64 + 4 * c4) * 2;
                const f32x4 y = *(const LAS f32x4*)(lds + YB + (tk >> 4) * 4096 + ((tk & 15) * 64 + 4 * c4) * 4);
                const u32x2 vb = *(const LAS u32x2*)(lds + PV + o), gb = *(const LAS u32x2*)(lds + PG + o);
                const f32x4 v = {bf_lo(vb.x), bf_hi(vb.x), bf_lo(vb.y), bf_hi(vb.y)}, g = {bf_lo(gb.x), bf_hi(gb.x), bf_lo(gb.y), bf_hi(gb.y)};
                const float bd = *(const LAS float*)(lds + BON + tk * 4);
                const float mean = red16((y[0] + y[1]) + (y[2] + y[3])) * (1.0f / 64.0f);
                const f32x4 d = y - mean;
                const float var = red16((d[0] * d[0] + d[1] * d[1]) + (d[2] * d[2] + d[3] * d[3])) * (1.0f / 64.0f);
                const float rs = __builtin_amdgcn_rsqf(var + 64e-5f);
                const f32x4 outv = ((d * rs) * lg4 + lb4 + v * bd) * g;
                *(u32x2*)((char*)yout + ((rowb + (size_t)tb * TB + tk) * DM + chg) * 2) = (u32x2){cvt_pk_bf16(outv[0], outv[1]), cvt_pk_bf16(outv[2], outv[3])};
            }
            }
            WG_BAR_L();
        }
    }
}

constexpr int N_PHASES = 2 + DEPTH * 11;

__global__ void __launch_bounds__(NWAVES * 64, 2) mk_fwd(Args args) {
    extern __shared__ __attribute__((aligned(16))) unsigned char lds_raw[];
    Frame F;
    F.lds = (LAS unsigned char*)lds_raw;
    F.G = gridDim.x; { const int bx = blockIdx.x; F.vcu = (F.G % 8 == 0) ? (bx % 8) * (F.G / 8) + bx / 8 : bx; }
    volatile LAS unsigned* MISC = (volatile LAS unsigned*)(F.lds + MISC_OFF);
    for (int u = threadIdx.x; u < (LDS_BYTES - MISC_OFF) / 4; u += NWAVES * 64) ((LAS unsigned*)(F.lds + MISC_OFF))[u] = 0u;
    __syncthreads();
    unsigned char* ws = args.ws;
    unsigned* ctl = (unsigned*)(ws + WS_CTL);
    const int lo = args.p_lo, hi = args.p_hi;
    XcdBarrier bar; bar.bar = ctl + CW_BAR; bar.x = 0; bar.st = nullptr;
    if (hi - lo > 1) bar = xcd_barrier_post(ctl + CW_BAR, MISC + 8);
    const Args& in = args;
    bf16* xb = (bf16*)args.out;
    bf16* XN = (bf16*)(ws + WS_XN); bf16* MO = (bf16*)(ws + WS_MO);
    bf16* RA = (bf16*)(ws + WS_A); bf16* RB = (bf16*)(ws + WS_B);
    int p = 0;
#define PH_ON (p >= lo && p < hi)
#define PH_END do { if (p >= lo && p + 1 < hi) xcd_barrier(bar); ++p; } while (0)
#define DUP(cat, ...) do { __VA_ARGS__; if (PROBE_DUP == (cat)) { xcd_barrier(bar); __VA_ARGS__; } } while (0)


    if (PH_ON) { DUP(4, prep_layer(F, in, ws, 0)); norm_phase(F, kin(in, 0), xb, nullptr, 0.f, nullptr, kin(in, 2), XN, 0, nullptr, nullptr);
    }
    PH_END;

#pragma unroll 1
    for (int s = 0; s < DEPTH * 3; ++s) {
        const int L = s / 3, sp = s % 3, kind = L % 3, jm = L / 3;
        const float* g6 = kin(in, 2) + (size_t)L * 6 * DM;
        if (sp != 1) {
            const int f = sp >> 1;
            if (PH_ON) { pg8::Gemm g{XN, (const bf16*)(ws + (f ? W_GU1 : W_GU0)), M, 2 * DFF, DM}; pg8::StaticOrder S; S.init(M, 2 * DFF, F.G, (int)blockIdx.x);
                pg8::EpiSwiglu E{RA, DFF}; DUP(1, pg8::gemm_phase<pg8::EpiSwiglu, pg8::StaticOrder, true, true>(F.lds, g, S, E)); }
            PH_END;
            if (PH_ON) { pg8::Gemm g{RA, (const bf16*)(ws + (f ? W_DN1 : W_DN0)), M, DM, DFF}; pg8::StaticOrder S; S.init(M, DM, F.G, (int)blockIdx.x);
                pg8::EpiPlain E{RB, DM}; DUP(2, pg8::gemm_phase<pg8::EpiPlain, pg8::StaticOrder, true, true>(F.lds, g, S, E)); }
            PH_END;
            if (PH_ON) {
                if (f == 0) {
                    norm_phase(F, nullptr, xb, RB, 0.5f, g6 + 1 * DM, g6 + 2 * DM, XN, kind == 1 ? 2 : 0, nullptr, nullptr);
                } else {
                    const bool lastl = (L == DEPTH - 1);
                    if (!lastl) DUP(4, prep_layer(F, in, ws, L + 1));
                    norm_phase(F, nullptr, xb, RB, 0.5f, g6 + 5 * DM, lastl ? nullptr : g6 + 6 * DM, XN, lastl ? 3 : 0, args.out, (float*)(ws + WS_A));
                }
            }
            PH_END;
        } else {
            const bf16* WM = (const bf16*)(ws + W_MIX);
            const bf16* a_out; const bf16* w_out; int k_out;
            if (kind == 0) {
                if (PH_ON) { pg8::Gemm g{XN, WM, M, 3072, DM}; pg8::StaticOrder S; S.init(M, 3072, F.G, (int)blockIdx.x);
                    pg8::EpiPlain E{RA, 3072}; DUP(5, pg8::gemm_phase<pg8::EpiPlain, pg8::StaticOrder, true, true>(F.lds, g, S, E));
                    ml_gate_phase(F, XN, kin(in, 5) + (size_t)jm * DM * ML_IN, kin(in, 6) + jm * 8, (float*)(ws + WS_A + 192 * MiB)); }
                PH_END;
                if (PH_ON) DUP(6, ml_chunk_phase(F, RA, (const float*)(ws + WS_A + 192 * MiB), kin(in, 7) + (size_t)jm * 4 * DM, RB));
                PH_END;
                if (PH_ON) DUP(7, ml_head_phase(F, RB, RA, kin(in, 8) + (size_t)jm * DM, RB + (size_t)M * DM));
                PH_END;
                a_out = RB + (size_t)M * DM; w_out = WM + (size_t)3072 * 1024; k_out = DM;
            } else if (kind == 1) {
                bf16* lmid = RB; bf16* wag = RA + (size_t)M * 3072; bf16* yo = RB + (size_t)M * 256;
                if (PH_ON) { pg8::Gemm g{XN, WM, M, 3328, 2048}; pg8::StaticOrder S; S.init(M, 3328, F.G, (int)blockIdx.x);
                    pg8::EpiRw1 E{RA, lmid}; DUP(9, pg8::gemm_phase<pg8::EpiRw1, pg8::StaticOrder, true, true>(F.lds, g, S, E)); }
                PH_END;
                if (PH_ON) { int k_rw2 = 256; asm volatile("" : "+s"(k_rw2));
                    pg8::Gemm g{lmid, WM + (size_t)3328 * 2048, M, 3072, k_rw2}; pg8::StaticOrder S; S.init(M, 3072, F.G, (int)blockIdx.x);
                    pg8::EpiRw2 E{wag, kin(in, 12) + (size_t)jm * DM, kin(in, 15) + (size_t)jm * DM}; DUP(10, pg8::gemm_phase<pg8::EpiRw2, pg8::StaticOrder, true, true>(F.lds, g, S, E)); }
                PH_END;
                if (PH_ON) DUP(11, rw_scan_phase(F, RA, wag, kin(in, 20) + (size_t)jm * DM, kin(in, 21) + (size_t)jm * DM, kin(in, 22) + (size_t)jm * DM, kin(in, 23) + (size_t)jm * DM, kin(in, 24) + (size_t)jm * DM, yo));
                PH_END;
                a_out = yo; w_out = WM + (size_t)3328 * 2048 + (size_t)3072 * 256; k_out = DM;
            } else {
                if (PH_ON) { pg8::Gemm g{XN, WM, M, 6144, DM}; pg8::StaticOrder S; S.init(M, 6144, F.G, (int)blockIdx.x);
                    pg8::EpiRtIn E{RA, (const int*)kin(in, 1)}; DUP(12, pg8::gemm_phase<pg8::EpiRtIn, pg8::StaticOrder, true, true>(F.lds, g, S, E)); }
                PH_END;
                if (PH_ON) DUP(13, rt_chunk_phase(F, RA, RB));
                PH_END;
                if (PH_ON) rt_head_phase(F, RB, RA);
                PH_END;
                a_out = RB; w_out = WM + (size_t)6144 * 1024; k_out = 2048;
            }
            if (PH_ON) { pg8::Gemm g{a_out, w_out, M, DM, k_out}; pg8::StaticOrder S; S.init(M, DM, F.G, (int)blockIdx.x);
                pg8::EpiPlain E{MO, DM}; DUP(8, pg8::gemm_phase<pg8::EpiPlain, pg8::StaticOrder, true, true>(F.lds, g, S, E)); }
            PH_END;
            if (PH_ON) norm_phase(F, nullptr, xb, MO, 1.0f, g6 + 3 * DM, g6 + 4 * DM, XN, 0, nullptr, nullptr);
            PH_END;
        }
    }
    if (PH_ON) copy_half_phase(F, (const float*)(ws + WS_A), args.out);
    PH_END;
#undef PH_ON
#undef PH_END
}

extern "C" void kernel_launch(void* const* d_in, const int* in_sizes, int n_in, void* d_out, int out_size, void* d_ws, size_t ws_size, hipStream_t stream) {
    static int grid = 0;
    if (grid == 0) {
        if (n_in != 28 || out_size != M * DM || ws_size < WS_END) { fprintf(stderr, "kernel_launch: unexpected shapes: n_in %d out %d ws %zu (need %zu)\n", n_in, out_size, ws_size, (size_t)WS_END); grid = -1; return; }
        int dev = 0, cus = 0, per_cu = 0;
        if (hipGetDevice(&dev) != hipSuccess || hipDeviceGetAttribute(&cus, hipDeviceAttributeMultiprocessorCount, dev) != hipSuccess) { grid = -1; return; }
        if (hipFuncSetAttribute((const void*)mk_fwd, hipFuncAttributeMaxDynamicSharedMemorySize, LDS_BYTES) != hipSuccess) { fprintf(stderr, "kernel_launch: hipFuncSetAttribute failed\n"); grid = -1; return; }
        if (hipOccupancyMaxActiveBlocksPerMultiprocessor(&per_cu, (const void*)mk_fwd, NWAVES * 64, LDS_BYTES) != hipSuccess || per_cu < 1) { fprintf(stderr, "kernel_launch: occupancy query says %d\n", per_cu); (void)hipGetLastError(); grid = -1; return; }
        grid = cus;
    }
    if (grid < 0) return;
    (void)hipMemsetAsync((char*)d_ws + WS_CTL, 0, CTL_ZERO_BYTES, stream);
    Args a{};
    for (int i = 0; i < 28; ++i) a.in[i] = d_in[i];
    a.out = (float*)d_out; a.ws = (unsigned char*)d_ws;
#if MK_PER_PHASE
    for (int p = 0; p < N_PHASES; ++p) { a.p_lo = p; a.p_hi = p + 1; hipLaunchKernelGGL(mk_fwd, dim3(grid), dim3(NWAVES * 64), LDS_BYTES, stream, a); }
#else
    a.p_lo = 0; a.p_hi = N_PHASES;
    hipLaunchKernelGGL(mk_fwd, dim3(grid), dim3(NWAVES * 64), LDS_BYTES, stream, a);
#endif
}
```

```cpp
#include <hip/hip_runtime.h>
#include <cstdio>
#include <cstdint>

#ifndef MK_PER_PHASE
#define MK_PER_PHASE 0
#endif
#ifndef PROBE_DUP
#define PROBE_DUP 0
#endif

#define LAS __attribute__((address_space(3)))
#define GAS __attribute__((address_space(1)))
typedef unsigned short bf16;
typedef short bf16x8 __attribute__((ext_vector_type(8)));
typedef float f32x4 __attribute__((ext_vector_type(4)));
typedef float f32x2 __attribute__((ext_vector_type(2)));
typedef unsigned u32x4 __attribute__((ext_vector_type(4)));
typedef unsigned u32x2 __attribute__((ext_vector_type(2)));

constexpr int DM = 1024, NB = 16, SEQ = 2048, DEPTH = 4, DFF = 2816;
constexpr int M = NB * SEQ;
constexpr float NORM_EPS = 1e-6f;
constexpr int ML_IN = 3080;
constexpr int NWAVES = 8;

constexpr size_t MiB = 1u << 20;
constexpr size_t WS_CTL = 0, CTL_ZERO_BYTES = 1 * MiB;
constexpr size_t WS_W = 1 * MiB;
constexpr size_t W_GU0 = WS_W, W_DN0 = W_GU0 + (size_t)5632 * 1024 * 2, W_GU1 = W_DN0 + (size_t)1024 * 2816 * 2, W_DN1 = W_GU1 + (size_t)5632 * 1024 * 2;
constexpr size_t W_MIX = W_DN1 + (size_t)1024 * 2816 * 2;
constexpr size_t WS_XN = 58 * MiB;
constexpr size_t WS_MO = WS_XN + 64 * MiB;
constexpr size_t WS_A = 186 * MiB;
constexpr size_t WS_B = 570 * MiB;
constexpr size_t WS_END = 698 * MiB;
static_assert(W_MIX + (size_t)17 * MiB <= WS_XN, "weight region");
constexpr int CW_BAR = 4096;

constexpr int RING_BYTES = 131072;
constexpr int LDS_BYTES = 147456;
constexpr int MISC_OFF = 145408;

typedef __bf16 bf16x2_t __attribute__((ext_vector_type(2)));
__device__ __forceinline__ unsigned cvt_pk_bf16(float lo, float hi) { const f32x2 v = {lo, hi}; return __builtin_bit_cast(unsigned, __builtin_convertvector(v, bf16x2_t)); }
__device__ __forceinline__ float bf_lo(unsigned u) { return __uint_as_float(u << 16); }
__device__ __forceinline__ float bf_hi(unsigned u) { return __uint_as_float(u & 0xffff0000u); }
__device__ __forceinline__ float fexp(float x) { return __builtin_amdgcn_exp2f(x * 1.4426950408889634f); }
__device__ __forceinline__ float fsigmoid(float x) { return __builtin_amdgcn_rcpf(1.0f + fexp(-x)); }
__device__ __forceinline__ float ftanh(float x) { return 2.0f * fsigmoid(2.0f * x) - 1.0f; }
__device__ __forceinline__ float fsilu(float x) { return x * fsigmoid(x); }
template <int CTRL, int ROWMASK> __device__ __forceinline__ float dppmov(float old, float v) {
    return __builtin_bit_cast(float, __builtin_amdgcn_update_dpp(__builtin_bit_cast(int, old), __builtin_bit_cast(int, v), CTRL, ROWMASK, 0xf, false));
}
__device__ __forceinline__ float red16(float v) {
    v += dppmov<0x128, 0xf>(0.f, v); v += dppmov<0x124, 0xf>(0.f, v); v += dppmov<0x122, 0xf>(0.f, v); v += dppmov<0x121, 0xf>(0.f, v); return v; }
__device__ __forceinline__ float wave_sum(float v) {
    v = red16(v);
    const float s0 = __builtin_bit_cast(float, __builtin_amdgcn_readlane(__builtin_bit_cast(int, v), 0)), s1 = __builtin_bit_cast(float, __builtin_amdgcn_readlane(__builtin_bit_cast(int, v), 16));
    const float s2 = __builtin_bit_cast(float, __builtin_amdgcn_readlane(__builtin_bit_cast(int, v), 32)), s3 = __builtin_bit_cast(float, __builtin_amdgcn_readlane(__builtin_bit_cast(int, v), 48));
    return (s0 + s1) + (s2 + s3);
}
__device__ __forceinline__ float scan_sum64(float v) {
    v += dppmov<0x111, 0xf>(0.f, v); v += dppmov<0x112, 0xf>(0.f, v); v += dppmov<0x114, 0xf>(0.f, v); v += dppmov<0x118, 0xf>(0.f, v);
    v += dppmov<0x142, 0xa>(0.f, v); v += dppmov<0x143, 0xc>(0.f, v); return v; }
__device__ __forceinline__ float scan_max64(float v) {
    const float ninf = -__builtin_inff();
    v = fmaxf(v, dppmov<0x111, 0xf>(ninf, v)); v = fmaxf(v, dppmov<0x112, 0xf>(ninf, v)); v = fmaxf(v, dppmov<0x114, 0xf>(ninf, v)); v = fmaxf(v, dppmov<0x118, 0xf>(ninf, v));
    v = fmaxf(v, dppmov<0x142, 0xa>(ninf, v)); v = fmaxf(v, dppmov<0x143, 0xc>(ninf, v)); return v; }
__device__ __forceinline__ float lane63(float v) { return __builtin_bit_cast(float, __builtin_amdgcn_readlane(__builtin_bit_cast(int, v), 63)); }
__device__ __forceinline__ f32x4 mma16(bf16x8 x, bf16x8 y, f32x4 c) { return __builtin_amdgcn_mfma_f32_16x16x32_bf16(x, y, c, 0, 0, 0); }
#define LDS_WAIT() asm volatile("s_waitcnt lgkmcnt(0)" ::: "memory")
#define WG_BAR() do { asm volatile("s_waitcnt vmcnt(0) lgkmcnt(0)" ::: "memory"); __builtin_amdgcn_s_barrier(); asm volatile("" ::: "memory"); } while (0)
#define WG_BAR_L() do { asm volatile("s_waitcnt lgkmcnt(0)" ::: "memory"); __builtin_amdgcn_s_barrier(); asm volatile("" ::: "memory"); } while (0)

namespace pg8 {
#define PG8_LAS __attribute__((address_space(3)))
typedef unsigned short bf16_t;
constexpr int BM = 256, BK = 64, HALF = 128, HTB = HALF * BK * 2, STAGE_BYTES = 8 * HTB, NXCD = 8, WGM = 8;
__host__ __device__ __forceinline__ int lds_byte(int r, int c) { const int st = (r >> 4) * 2 + (c >> 5), rr = r & 15, cc = c & 31, ob = rr * 64 + cc * 2; return st * 1024 + (ob ^ (((ob >> 9) & 1) << 5)); }
__host__ __device__ __forceinline__ void stage_rc(int b, int& R, int& C) { const int st = b / 1024, sb = b % 1024, swz = sb ^ (((sb >> 9) & 1) << 5); R = (st >> 1) * 16 + swz / 64; C = (st & 1) * 32 + (swz % 64) / 2; }
__host__ __device__ __forceinline__ int perm32(int rho) { const int n = rho >> 4, i = rho & 15; return 8 * (i >> 2) + 4 * n + (i & 3); }

struct Unit { int pm, pn; };
struct Gemm { const bf16_t* A; const bf16_t* Bt; int M, N, K; };

struct StaticOrder {
    int nM, nN, nwg, G, c;
    __host__ __device__ void init(int M_, int N_, int G_, int c_) { nM = M_ / BM; nN = N_ / BM; nwg = nM * nN; G = G_; c = c_; }
    __host__ __device__ bool next(int i, Unit& u) const {
        const long L = (long)i * G + c; if (L >= nwg) return false;
        int wgid = (int)L; { const int q = nwg / NXCD, r = nwg % NXCD, xcd = wgid % NXCD, off = wgid / NXCD; wgid = (xcd < r ? xcd * (q + 1) : r * (q + 1) + (xcd - r) * q) + off; }
        const int nig = WGM * nN, gid = wgid / nig, fm = gid * WGM, gsz = (nM - fm) < WGM ? (nM - fm) : WGM;
        u.pm = fm + ((wgid % nig) % gsz); u.pn = (wgid % nig) / gsz; return true;
    }
    __device__ __forceinline__ void a_ready(const Unit&) const {}
    __device__ __forceinline__ void done(const Unit&) const {}
};

__device__ __forceinline__ u32x4 pack8(f32x4 v0, f32x4 v1) { u32x4 w; w.x = cvt_pk_bf16(v0[0], v0[1]); w.y = cvt_pk_bf16(v0[2], v0[3]); w.z = cvt_pk_bf16(v1[0], v1[1]); w.w = cvt_pk_bf16(v1[2], v1[3]); return w; }

struct EpiPlain {
    static constexpr bool PERM = true, AFTER_DRAIN = false;
    bf16_t* O; int ldc;
    __device__ __forceinline__ void operator()(const f32x4 (&acc)[2][2][4][2], const Unit& u, int wr, int wc, int fr, int fq) const {
        const int row0 = u.pm * BM + wr * 64 + fr, col0 = u.pn * BM + wc * 32 + 8 * fq;
#pragma unroll
        for (int ai = 0; ai < 2; ++ai)
#pragma unroll
            for (int m = 0; m < 4; ++m) { bf16_t* rowp = O + (size_t)(row0 + ai * HALF + m * 16) * ldc + col0;
#pragma unroll
                for (int bj = 0; bj < 2; ++bj) *(u32x4*)(rowp + bj * HALF) = pack8(acc[ai][bj][m][0], acc[ai][bj][m][1]); }
    }
};
struct EpiSwiglu {
    static constexpr bool PERM = true, AFTER_DRAIN = false;
    bf16_t* O; int ldc;
    __device__ __forceinline__ void operator()(const f32x4 (&acc)[2][2][4][2], const Unit& u, int wr, int wc, int fr, int fq) const {
        const int row0 = u.pm * BM + wr * 64 + fr, col0 = u.pn * HALF + wc * 32 + 8 * fq;
#pragma unroll
        for (int ai = 0; ai < 2; ++ai)
#pragma unroll
            for (int m = 0; m < 4; ++m) { bf16_t* rowp = O + (size_t)(row0 + ai * HALF + m * 16) * ldc + col0;
                f32x4 o[2];
#pragma unroll
                for (int n = 0; n < 2; ++n)
#pragma unroll
                    for (int e = 0; e < 4; ++e) { const float g = acc[ai][0][m][n][e]; o[n][e] = g * fsigmoid(g) * acc[ai][1][m][n][e]; }
                *(u32x4*)rowp = pack8(o[0], o[1]); }
    }
};
struct EpiRw1 {
    static constexpr bool PERM = true, AFTER_DRAIN = false;
    bf16_t* rkv; bf16_t* lmid;
    __device__ __forceinline__ void operator()(const f32x4 (&acc)[2][2][4][2], const Unit& u, int wr, int wc, int fr, int fq) const {
        const int row0 = u.pm * BM + wr * 64 + fr;
        if (u.pn < 12) {
            const int col0 = u.pn * BM + wc * 32 + 8 * fq;
#pragma unroll
            for (int ai = 0; ai < 2; ++ai)
#pragma unroll
                for (int m = 0; m < 4; ++m) { bf16_t* rowp = rkv + (size_t)(row0 + ai * HALF + m * 16) * 3072 + col0;
#pragma unroll
                    for (int bj = 0; bj < 2; ++bj) *(u32x4*)(rowp + bj * HALF) = pack8(acc[ai][bj][m][0], acc[ai][bj][m][1]); }
        } else {
            const int col0 = wc * 32 + 8 * fq;
#pragma unroll
            for (int ai = 0; ai < 2; ++ai)
#pragma unroll
                for (int m = 0; m < 4; ++m) { bf16_t* rowp = lmid + (size_t)(row0 + ai * HALF + m * 16) * 256 + col0;
#pragma unroll
                    for (int bj = 0; bj < 2; ++bj) { f32x4 o[2];
#pragma unroll
                        for (int n = 0; n < 2; ++n)
#pragma unroll
                            for (int e = 0; e < 4; ++e) { const float v = acc[ai][bj][m][n][e]; o[n][e] = (bj == 1) ? fsigmoid(v) : (wc < 2 ? ftanh(v) : v); }
                        *(u32x4*)(rowp + bj * HALF) = pack8(o[0], o[1]); } }
        }
    }
};
struct EpiRw2 {
    static constexpr bool PERM = true, AFTER_DRAIN = false;
    bf16_t* O; const float* w0; const float* a0;
    __device__ __forceinline__ void operator()(const f32x4 (&acc)[2][2][4][2], const Unit& u, int wr, int wc, int fr, int fq) const {
        const int row0 = u.pm * BM + wr * 64 + fr, col0 = u.pn * BM + wc * 32 + 8 * fq, kind = u.pn >> 2, cc0 = (u.pn & 3) * BM + wc * 32 + 8 * fq;
        if (kind == 2) {
#pragma unroll
            for (int ai = 0; ai < 2; ++ai)
#pragma unroll
                for (int m = 0; m < 4; ++m) { bf16_t* rowp = O + (size_t)(row0 + ai * HALF + m * 16) * 3072 + col0;
#pragma unroll
                    for (int bj = 0; bj < 2; ++bj) *(u32x4*)(rowp + bj * HALF) = pack8(acc[ai][bj][m][0], acc[ai][bj][m][1]); }
        } else {
            const float* bp = (kind == 0 ? w0 : a0) + cc0; const float sc = kind == 0 ? -0.60653065971f : 1.0f;
#pragma unroll
            for (int bj = 0; bj < 2; ++bj) {
                const f32x4 b0 = *(const f32x4*)(bp + bj * HALF), b1 = *(const f32x4*)(bp + bj * HALF + 4);
#pragma unroll
                for (int ai = 0; ai < 2; ++ai)
#pragma unroll
                    for (int m = 0; m < 4; ++m) { bf16_t* rowp = O + (size_t)(row0 + ai * HALF + m * 16) * 3072 + col0; f32x4 o0, o1;
#pragma unroll
                        for (int e = 0; e < 4; ++e) { o0[e] = sc * fsigmoid(acc[ai][bj][m][0][e] + b0[e]); o1[e] = sc * fsigmoid(acc[ai][bj][m][1][e] + b1[e]); }
                        *(u32x4*)(rowp + bj * HALF) = pack8(o0, o1); }
            }
        }
    }
};
struct EpiRtIn {
    static constexpr bool PERM = true, AFTER_DRAIN = false;
    bf16_t* O; const int* pos;
    __device__ __forceinline__ void operator()(const f32x4 (&acc)[2][2][4][2], const Unit& u, int wr, int wc, int fr, int fq) const {
        const int row0 = u.pm * BM + wr * 64 + fr, col0 = u.pn * BM + wc * 32 + 8 * fq;
        if (u.pn >= 8) {
#pragma unroll
            for (int ai = 0; ai < 2; ++ai)
#pragma unroll
                for (int m = 0; m < 4; ++m) { bf16_t* rowp = O + (size_t)(row0 + ai * HALF + m * 16) * 6144 + col0;
#pragma unroll
                    for (int bj = 0; bj < 2; ++bj) *(u32x4*)(rowp + bj * HALF) = pack8(acc[ai][bj][m][0], acc[ai][bj][m][1]); }
        } else {
            const float sc = u.pn >= 4 ? 0.0625f : 1.0f;
            float invf[2][4];
#pragma unroll
            for (int n = 0; n < 2; ++n)
#pragma unroll
                for (int e = 0; e < 4; ++e) { const int i = wc * 32 + 8 * fq + 4 * n + e; invf[n][e] = __builtin_amdgcn_exp2f((float)i * (-13.287712379549449f / 127.0f)) * 0.15915494309189535f; }
#pragma unroll
            for (int ai = 0; ai < 2; ++ai)
#pragma unroll
                for (int m = 0; m < 4; ++m) { const int row = row0 + ai * HALF + m * 16; const float p = (float)pos[row]; bf16_t* rowp = O + (size_t)row * 6144 + col0;
                    f32x4 o1[2], o2[2];
#pragma unroll
                    for (int n = 0; n < 2; ++n)
#pragma unroll
                        for (int e = 0; e < 4; ++e) { float rev = p * invf[n][e]; rev = rev - __builtin_floorf(rev);
                            const float sn = __builtin_amdgcn_sinf(rev), cs = __builtin_amdgcn_cosf(rev);
                            const float u1 = acc[ai][0][m][n][e], u2 = acc[ai][1][m][n][e];
                            o1[n][e] = (u1 * cs - u2 * sn) * sc; o2[n][e] = (u1 * sn + u2 * cs) * sc; }
                    *(u32x4*)rowp = pack8(o1[0], o1[1]); *(u32x4*)(rowp + HALF) = pack8(o2[0], o2[1]); }
        }
    }
};

template <class Epi, class Sched, bool ALIGN_EPI = false, bool SP2 = false>
__device__ __forceinline__ void gemm_phase(PG8_LAS unsigned char* lds, const Gemm g, const Sched& S, const Epi& E) {
    int tid_ = threadIdx.x; asm volatile("" : "+v"(tid_));
    const int tid = tid_, wid = __builtin_amdgcn_readfirstlane(tid >> 6), lane = tid & 63, wr = wid >> 2, wc = wid & 3, fr = lane & 15, fq = lane >> 4;
    const int K = g.K, nt = K / BK;
    unsigned voffA[2], voffB[2];
#pragma unroll
    for (int i = 0; i < 2; ++i) { int R, C; stage_rc(tid * 16 + i * 8192, R, C); const int Rb = Epi::PERM ? ((R & ~31) + perm32(R & 31)) : R;
        voffA[i] = (unsigned)(R * K + C) * 2u; voffB[i] = (unsigned)(Rb * K + C) * 2u; }
    const size_t kstep = (size_t)(BK * 2);
    const size_t hstep = (size_t)HALF * K * 2;
    const size_t tstep = 2 * hstep;
    const unsigned ldsw = (unsigned)wid * 1024u;
    const int aoff = lds_byte(wr * 64 + fr, fq * 8), boff = lds_byte(wc * 32 + fr, fq * 8);
#define PG8_SA(b, h) (((b) * 2 + (h)) * HTB)
#define PG8_SB(b, h) ((4 + (b) * 2 + (h)) * HTB)
#define PG8_STAGE(bufoff, gbase, voff) do { _Pragma("unroll") for (int _i = 0; _i < 2; ++_i) \
        __builtin_amdgcn_global_load_lds((const unsigned*)((const char*)(gbase) + (voff)[_i]), (PG8_LAS unsigned*)(lds + (bufoff) + ldsw + _i * 8192), 16, 0, 0); } while (0)
#define PG8_LDA(dst, b, h) do { _Pragma("unroll") for (int m = 0; m < 4; ++m) _Pragma("unroll") for (int k = 0; k < 2; ++k) dst[m][k] = *(const PG8_LAS bf16x8*)(lds + PG8_SA(b, h) + aoff + m * 2048 + k * 1024); } while (0)
#define PG8_LDB(dst, b, h) do { _Pragma("unroll") for (int n = 0; n < 2; ++n) _Pragma("unroll") for (int k = 0; k < 2; ++k) dst[n][k] = *(const PG8_LAS bf16x8*)(lds + PG8_SB(b, h) + boff + n * 2048 + k * 1024); } while (0)
#define PG8_MMA(ai, bj, At, Bt) do { __builtin_amdgcn_s_setprio(1); _Pragma("unroll") for (int m = 0; m < 4; ++m) _Pragma("unroll") for (int n = 0; n < 2; ++n) _Pragma("unroll") for (int k = 0; k < 2; ++k) \
        acc[ai][bj][m][n] = __builtin_amdgcn_mfma_f32_16x16x32_bf16(Bt[n][k], At[m][k], acc[ai][bj][m][n], 0, 0, 0); __builtin_amdgcn_s_setprio(0); } while (0)
#define PG8_WAIT_V(n) asm volatile("s_waitcnt vmcnt(" #n ")" ::: "memory")
#define PG8_WAIT_L(n) asm volatile("s_waitcnt lgkmcnt(" #n ")" ::: "memory")
#define PG8_BAR __builtin_amdgcn_s_barrier()
#define PG8_SCHED __builtin_amdgcn_sched_barrier(0)
    Unit cur, nxt; int ui = 0;
    if (!S.next(0, cur)) return;
    f32x4 acc[2][2][4][2];
#pragma unroll
    for (int a = 0; a < 2; ++a)
#pragma unroll
        for (int b = 0; b < 2; ++b)
#pragma unroll
            for (int m = 0; m < 4; ++m)
#pragma unroll
                for (int n = 0; n < 2; ++n) acc[a][b][m][n] = (f32x4){0.f, 0.f, 0.f, 0.f};
    bf16x8 At[4][2], B0[2][2], B1[2][2];
    const char* cA = (const char*)g.A + (size_t)cur.pm * tstep; const char* cB = (const char*)g.Bt + (size_t)cur.pn * tstep;
    S.a_ready(cur);
    if constexpr (SP2) {
        PG8_STAGE(PG8_SB(0, 0), cB, voffB); PG8_STAGE(PG8_SB(0, 1), cB + hstep, voffB); PG8_STAGE(PG8_SA(0, 0), cA, voffA); PG8_STAGE(PG8_SA(0, 1), cA + hstep, voffA);
        if (wr == 1) PG8_BAR;
        PG8_WAIT_V(2); PG8_BAR;
        PG8_STAGE(PG8_SB(1, 0), cB + kstep, voffB); PG8_STAGE(PG8_SA(1, 0), cA + kstep, voffA); PG8_STAGE(PG8_SB(1, 1), cB + hstep + kstep, voffB);
        PG8_WAIT_V(6); PG8_BAR;
    } else {
        PG8_STAGE(PG8_SB(0, 0), cB, voffB); PG8_STAGE(PG8_SA(0, 0), cA, voffA); PG8_STAGE(PG8_SB(0, 1), cB + hstep, voffB); PG8_STAGE(PG8_SA(0, 1), cA + hstep, voffA);
        if (wr == 1) PG8_BAR;
        PG8_WAIT_V(4); PG8_BAR;
        PG8_STAGE(PG8_SB(1, 0), cB + kstep, voffB); PG8_STAGE(PG8_SA(1, 0), cA + kstep, voffA); PG8_STAGE(PG8_SB(1, 1), cB + hstep + kstep, voffB);
        PG8_WAIT_V(6); PG8_BAR;
    }
    for (;;) {
        const bool has_next = S.next(ui + 1, nxt);
        const char* nA = has_next ? (const char*)g.A + (size_t)nxt.pm * tstep : cA; const char* nB = has_next ? (const char*)g.Bt + (size_t)nxt.pn * tstep : cB;
        for (int t = 0; t < nt; t += 2) {
            const bool last = (t == nt - 2);
            const char* a1 = cA + (size_t)(t + 1) * kstep;
            const char* a2 = last ? nA : cA + (size_t)(t + 2) * kstep; const char* b2 = last ? nB : cB + (size_t)(t + 2) * kstep;
            const char* a3 = a2 + kstep; const char* b3 = b2 + kstep;
            if (last && has_next) S.a_ready(nxt);
            if constexpr (SP2) {
            PG8_LDB(B0, 0, 0); PG8_LDB(B1, 0, 1); PG8_SCHED; PG8_LDA(At, 0, 0); PG8_STAGE(PG8_SA(1, 1), a1 + hstep, voffA);
            PG8_WAIT_V(8); PG8_WAIT_L(0); PG8_BAR; PG8_MMA(0, 0, At, B0); PG8_MMA(0, 1, At, B1); PG8_BAR; PG8_SCHED;
            PG8_LDA(At, 0, 1); PG8_STAGE(PG8_SB(0, 0), b2, voffB); PG8_STAGE(PG8_SB(0, 1), b2 + hstep, voffB); PG8_STAGE(PG8_SA(0, 0), a2, voffA);
            PG8_WAIT_V(8); PG8_WAIT_L(0); PG8_BAR; PG8_MMA(1, 0, At, B0); PG8_MMA(1, 1, At, B1); PG8_BAR; PG8_SCHED;
            PG8_LDB(B0, 1, 0); PG8_LDB(B1, 1, 1); PG8_SCHED; PG8_LDA(At, 1, 0); PG8_STAGE(PG8_SA(0, 1), a2 + hstep, voffA);
            PG8_WAIT_V(8); PG8_WAIT_L(0); PG8_BAR; PG8_MMA(0, 0, At, B0); PG8_MMA(0, 1, At, B1); PG8_BAR; PG8_SCHED;
            PG8_LDA(At, 1, 1); PG8_STAGE(PG8_SB(1, 0), b3, voffB); PG8_STAGE(PG8_SB(1, 1), b3 + hstep, voffB); PG8_STAGE(PG8_SA(1, 0), a3, voffA);
            PG8_WAIT_V(8); PG8_WAIT_L(0); PG8_BAR; PG8_MMA(1, 0, At, B0); PG8_MMA(1, 1, At, B1); PG8_BAR; PG8_SCHED;
            } else {
            PG8_LDB(B0, 0, 0); PG8_SCHED; PG8_LDA(At, 0, 0); PG8_STAGE(PG8_SA(1, 1), a1 + hstep, voffA);
            PG8_WAIT_L(8); PG8_BAR; PG8_WAIT_L(0); PG8_MMA(0, 0, At, B0); PG8_BAR; PG8_SCHED;
            PG8_LDB(B1, 0, 1); PG8_STAGE(PG8_SB(0, 0), b2, voffB);
            PG8_BAR; PG8_WAIT_L(0); PG8_MMA(0, 1, At, B1); PG8_BAR;
            PG8_LDA(At, 0, 1); PG8_STAGE(PG8_SA(0, 0), a2, voffA);
            PG8_BAR; PG8_WAIT_L(0); PG8_MMA(1, 0, At, B0); PG8_BAR; PG8_SCHED;
            PG8_STAGE(PG8_SB(0, 1), b2 + hstep, voffB);
            PG8_WAIT_V(6); PG8_BAR; PG8_MMA(1, 1, At, B1); PG8_BAR;
            PG8_LDB(B0, 1, 0); PG8_SCHED; PG8_LDA(At, 1, 0); PG8_STAGE(PG8_SA(0, 1), a2 + hstep, voffA);
            PG8_WAIT_L(8); PG8_BAR; PG8_WAIT_L(0); PG8_MMA(0, 0, At, B0); PG8_BAR; PG8_SCHED;
            PG8_LDB(B1, 1, 1); PG8_STAGE(PG8_SB(1, 0), b3, voffB);
            PG8_BAR; PG8_WAIT_L(0); PG8_MMA(0, 1, At, B1); PG8_BAR;
            PG8_LDA(At, 1, 1); PG8_STAGE(PG8_SA(1, 0), a3, voffA);
            PG8_BAR; PG8_WAIT_L(0); PG8_MMA(1, 0, At, B0); PG8_BAR; PG8_SCHED;
            PG8_STAGE(PG8_SB(1, 1), b3 + hstep, voffB);
            PG8_WAIT_V(6); PG8_BAR; PG8_MMA(1, 1, At, B1); PG8_BAR;
            }
        }
        if constexpr (ALIGN_EPI) { if (wr == 0) PG8_BAR; }
        if constexpr (!Epi::AFTER_DRAIN) { E(acc, cur, wr, wc, fr, fq); S.done(cur); }
        if (!has_next) break;
#pragma unroll
        for (int a = 0; a < 2; ++a)
#pragma unroll
            for (int b = 0; b < 2; ++b)
#pragma unroll
                for (int m = 0; m < 4; ++m)
#pragma unroll
                    for (int n = 0; n < 2; ++n) acc[a][b][m][n] = (f32x4){0.f, 0.f, 0.f, 0.f};
        cur = nxt; cA = nA; cB = nB; ++ui;
        if constexpr (ALIGN_EPI) { if (wr == 1) PG8_BAR; }
    }
    PG8_WAIT_V(0);
    if constexpr (!ALIGN_EPI) { if (wr == 0) PG8_BAR; }
    PG8_BAR;
#undef PG8_SA
#undef PG8_SB
#undef PG8_STAGE
#undef PG8_LDA
#undef PG8_LDB
#undef PG8_MMA
#undef PG8_WAIT_V
#undef PG8_WAIT_L
#undef PG8_BAR
#undef PG8_SCHED
}
}

#define XB_TMO      128
#define XB_XCNT(j)  (256  + 64 * (j))
#define XB_XSUB(j)  (1280 + 64 * (j))
#define XB_XGEN(j)  (2304 + 64 * (j))
#define XB_TOP      3328
#define XB_TOPGEN   3392
#define XCD_BAR_WORDS 3456
#define XB_SPIN_CAP (1u << 18)

__device__ __forceinline__ unsigned xb_ld(unsigned* p)              { return __hip_atomic_load(p, __ATOMIC_RELAXED, __HIP_MEMORY_SCOPE_AGENT); }
__device__ __forceinline__ unsigned xb_add(unsigned* p, unsigned v) { return __hip_atomic_fetch_add(p, v, __ATOMIC_RELAXED, __HIP_MEMORY_SCOPE_AGENT); }
__device__ __forceinline__ unsigned xb_xcc_id() { return (unsigned)__builtin_amdgcn_s_getreg((3 << 11) | 20) & 0xFu; }
#define XB_SPIN(cond, bar) do { unsigned _sp = 0; while (cond) { __builtin_amdgcn_s_sleep(1); \
    if ((++_sp & 255u) == 0u) { if (xb_ld(&(bar)[XB_TMO])) break; if (_sp > XB_SPIN_CAP) { atomicAdd(&(bar)[XB_TMO], 1u); break; } } } } while (0)

struct XcdBarrier { unsigned* bar; unsigned x; volatile LAS unsigned* st; };

__device__ __forceinline__ XcdBarrier xcd_barrier_post(unsigned* bar, volatile LAS unsigned* st) {
    XcdBarrier b; b.bar = bar; b.x = xb_xcc_id(); b.st = st;
    if (threadIdx.x == 0) (void)xb_add(&bar[XB_XCNT(b.x)], 1u);
    return b;
}
__device__ __forceinline__ void xcd_barrier_complete(unsigned* bar, unsigned x, unsigned& nloc, unsigned& nx) {
    const unsigned G = gridDim.x * gridDim.y * gridDim.z;
    unsigned sum, cnt, mine, sp = 0u;
    for (;;) {
        sum = 0u; cnt = 0u; mine = 0u;
#pragma unroll
        for (unsigned j = 0; j < 16; ++j) { const unsigned c = xb_ld(&bar[XB_XCNT(j)]); sum += c; cnt += (c > 0u) ? 1u : 0u; mine = (j == x) ? c : mine; }
        if (sum == G) break;
        __builtin_amdgcn_s_sleep(1);
        if ((++sp & 255u) == 0u) { if (xb_ld(&bar[XB_TMO])) break; if (sp > XB_SPIN_CAP) { atomicAdd(&bar[XB_TMO], 1u); break; } }
    }
    nloc = mine > 0u ? mine : 1u; nx = cnt > 0u ? cnt : 1u;
}
__device__ __forceinline__ void xcd_barrier(const XcdBarrier& b) {
    asm volatile("s_waitcnt vmcnt(0)" ::: "memory");
    __syncthreads();
    if (threadIdx.x == 0) {
        unsigned* bar = b.bar;
        __builtin_amdgcn_s_waitcnt(0);
        unsigned nloc = b.st[0], nx = b.st[1];
        if (nloc == 0u) { xcd_barrier_complete(bar, b.x, nloc, nx); b.st[0] = nloc; b.st[1] = nx; }
        const unsigned old = xb_add(&bar[XB_XSUB(b.x)], 1u);
        const unsigned gen = old / nloc;
        if (old + 1u == (gen + 1u) * nloc) {
            __builtin_amdgcn_fence(__ATOMIC_RELEASE, "agent");
            asm volatile("s_waitcnt vmcnt(0)" ::: "memory");
            const unsigned og = xb_add(&bar[XB_TOP], 1u);
            const unsigned tg = og / nx;
            if (og + 1u == (tg + 1u) * nx) xb_add(&bar[XB_TOPGEN], 1u);
            else XB_SPIN(xb_ld(&bar[XB_TOPGEN]) == tg, bar);
            __builtin_amdgcn_fence(__ATOMIC_ACQUIRE, "agent");
            xb_add(&bar[XB_XGEN(b.x)], 1u);
            asm volatile("s_waitcnt vmcnt(0)" ::: "memory");
        } else {
            XB_SPIN(xb_ld(&bar[XB_XGEN(b.x)]) == gen, bar);
            __builtin_amdgcn_fence(__ATOMIC_ACQUIRE, "agent");
            asm volatile("s_waitcnt vmcnt(0)" ::: "memory");
        }
    }
    __syncthreads();
}

struct Frame {
    LAS unsigned char* lds;
    int vcu, G;
};
__device__ __forceinline__ int opaque_tid() { int t = threadIdx.x; asm volatile("" : "+v"(t)); return t; }
#define PH_IDS const int tid = opaque_tid(), lane = tid & 63, w = __builtin_amdgcn_readfirstlane(tid >> 6); (void)tid; (void)lane; (void)w

template <class SrcF>
__device__ __forceinline__ void prep_matrix(const Frame& F, int K, int N, bf16* WT, SrcF src) {
    PH_IDS;
    LAS float* scr = (LAS float*)(F.lds + w * 8448);
    const int gw = F.vcu * NWAVES + w, NGW = F.G * NWAVES;
    const int nblk = N / 32, nitems = (K / 64) * nblk;
    for (int it = gw; it < nitems; it += NGW) {
        const int kb = it / nblk, nb = it % nblk, k0 = 64 * kb, n0 = 32 * nb;
        float tv[32];
#pragma unroll
        for (int i = 0; i < 32; ++i) tv[i] = src(k0 + 2 * i + (lane >> 5), n0 + (lane & 31));
#pragma unroll
        for (int i = 0; i < 32; ++i) scr[(2 * i + (lane >> 5)) * 33 + (lane & 31)] = tv[i];
        LDS_WAIT();
        const int c = lane & 7;
#pragma unroll
        for (int j = 0; j < 4; ++j) { const int n = (lane >> 3) + 8 * j; const LAS float* s = scr + (8 * c) * 33 + n;
            u32x4 o; o.x = cvt_pk_bf16(s[0 * 33], s[1 * 33]); o.y = cvt_pk_bf16(s[2 * 33], s[3 * 33]); o.z = cvt_pk_bf16(s[4 * 33], s[5 * 33]); o.w = cvt_pk_bf16(s[6 * 33], s[7 * 33]);
            *(u32x4*)(WT + (size_t)(n0 + n) * K + k0 + 8 * c) = o; }
        LDS_WAIT();
    }
}

struct Args { const void* in[28]; float* out; unsigned char* ws; int p_lo, p_hi; };
__device__ __forceinline__ const float* kin(const Args& a, int i) { asm volatile("" : "+s"(i)); return (const float*)a.in[i]; }

__device__ __forceinline__ void prep_layer(const Frame& F, const Args& in, unsigned char* ws, int L) {
    const int kind = L % 3, j = L / 3;
#pragma unroll 1
    for (int f = 0; f < 2; ++f) {
        const float* wgu = kin(in, 3) + (size_t)(L * 2 + f) * DM * 2 * DFF;
        prep_matrix(F, DM, 2 * DFF, (bf16*)(ws + (f ? W_GU1 : W_GU0)), [=](int k, int n) { const int pn = n >> 8, r = n & 255; const int sc = (r < 128) ? (pn * 128 + r) : (DFF + pn * 128 + (r - 128)); return wgu[(size_t)k * (2 * DFF) + sc]; });
        const float* wdn = kin(in, 4) + (size_t)(L * 2 + f) * DFF * DM;
        prep_matrix(F, DFF, DM, (bf16*)(ws + (f ? W_DN1 : W_DN0)), [=](int k, int n) { return wdn[(size_t)k * DM + n]; });
    }
    if (kind == 0) {
        const float* win = kin(in, 5) + (size_t)j * DM * ML_IN;
        prep_matrix(F, DM, 3072, (bf16*)(ws + W_MIX), [=](int k, int n) { return win[(size_t)k * ML_IN + n]; });
        const float* wo = kin(in, 9) + (size_t)j * DM * DM;
        prep_matrix(F, DM, DM, (bf16*)(ws + W_MIX + (size_t)3072 * 1024 * 2), [=](int k, int n) { return wo[(size_t)k * DM + n]; });
    } else if (kind == 1) {
        const float* mu = kin(in, 10) + (size_t)j * 6 * DM; const float* wrkv = kin(in, 11) + (size_t)j * 3 * DM * DM;
        const float* w1 = kin(in, 13) + (size_t)j * DM * 64; const float* a1 = kin(in, 16) + (size_t)j * DM * 64; const float* g1 = kin(in, 18) + (size_t)j * DM * 128;
        prep_matrix(F, 2048, 3328, (bf16*)(ws + W_MIX), [=](int k, int n) {
            const int kk = k & 1023; const bool hi = k >= 1024; float w; int mi;
            if (n < 3072) { mi = n >> 10; w = wrkv[((size_t)mi * DM + kk) * DM + (n & 1023)]; }
            else { const int c = n - 3072; if (c < 64) { mi = 3; w = w1[kk * 64 + c]; } else if (c < 128) { mi = 4; w = a1[kk * 64 + (c - 64)]; } else { mi = 5; w = g1[kk * 128 + (c - 128)]; } }
            const float m = mu[mi * DM + kk]; return w * (hi ? m : 1.0f - m); });
        const float* w2 = kin(in, 14) + (size_t)j * 64 * DM; const float* a2 = kin(in, 17) + (size_t)j * 64 * DM; const float* g2 = kin(in, 19) + (size_t)j * 128 * DM;
        prep_matrix(F, 256, 3072, (bf16*)(ws + W_MIX + (size_t)3328 * 2048 * 2), [=](int k, int n) {
            const int t = n >> 10, c = n & 1023;
            if (t == 0) return k < 64 ? w2[k * DM + c] : 0.f;
            if (t == 1) return (k >= 64 && k < 128) ? a2[(k - 64) * DM + c] : 0.f;
            return k >= 128 ? g2[(k - 128) * DM + c] : 0.f; });
        const float* wo = kin(in, 25) + (size_t)j * DM * DM;
        prep_matrix(F, DM, DM, (bf16*)(ws + W_MIX + (size_t)3328 * 2048 * 2 + (size_t)3072 * 256 * 2), [=](int k, int n) { return wo[(size_t)k * DM + n]; });
    } else {
        const float* win = kin(in, 26) + (size_t)j * DM * 6144;
        prep_matrix(F, DM, 6144, (bf16*)(ws + W_MIX), [=](int k, int n) { return win[(size_t)k * 6144 + n]; });
        const float* wo = kin(in, 27) + (size_t)j * 2048 * DM;
        prep_matrix(F, 2048, DM, (bf16*)(ws + W_MIX + (size_t)6144 * 1024 * 2), [=](int k, int n) { return wo[(size_t)k * DM + n]; });
    }
}

__device__ __forceinline__ void norm_phase(const Frame& F, const float* x0, const bf16* xbi, bf16* xb, const bf16* h, float c, const float* gpost, const float* gpre, bf16* xn, int mode, float* fout) {
    PH_IDS;
    const int gw = F.vcu * NWAVES + w, NGW = F.G * NWAVES;
    f32x4 gp[4], gq[4];
#pragma unroll
    for (int j = 0; j < 4; ++j) { gp[j] = h ? *(const f32x4*)(gpost + 4 * lane + 256 * j) : (f32x4){0.f, 0.f, 0.f, 0.f}; gq[j] = (mode != 3) ? *(const f32x4*)(gpre + 4 * lane + 256 * j) : (f32x4){0.f, 0.f, 0.f, 0.f}; }
    for (int m = gw; m < M; m += NGW) {
        f32x4 v[4];
        if (x0) {
#pragma unroll
            for (int j = 0; j < 4; ++j) v[j] = *(const f32x4*)(x0 + (size_t)m * DM + 4 * lane + 256 * j);
        } else {
#pragma unroll
            for (int j = 0; j < 4; ++j) { const u32x2 r = *(const u32x2*)(xbi + (size_t)m * DM + 4 * lane + 256 * j); v[j] = (f32x4){bf_lo(r.x), bf_hi(r.x), bf_lo(r.y), bf_hi(r.y)}; }
        }
        if (h) {
            f32x4 hv[4]; float s = 0.f;
#pragma unroll
            for (int j = 0; j < 4; ++j) { const u32x2 r = *(const u32x2*)(h + (size_t)m * DM + 4 * lane + 256 * j); hv[j] = (f32x4){bf_lo(r.x), bf_hi(r.x), bf_lo(r.y), bf_hi(r.y)};
                s += (hv[j][0] * hv[j][0] + hv[j][1] * hv[j][1]) + (hv[j][2] * hv[j][2] + hv[j][3] * hv[j][3]); }
            const float rs = __builtin_amdgcn_rsqf(wave_sum(s) * (1.0f / DM) + NORM_EPS) * c;
#pragma unroll
            for (int j = 0; j < 4; ++j) v[j] += hv[j] * rs * gp[j];
        }
        if (mode == 3) {
            float* o = fout + (size_t)m * DM;
#pragma unroll
            for (int j = 0; j < 4; ++j) *(f32x4*)(o + 4 * lane + 256 * j) = v[j];
        } else {
#pragma unroll
            for (int j = 0; j < 4; ++j) { u32x2 o; o.x = cvt_pk_bf16(v[j][0], v[j][1]); o.y = cvt_pk_bf16(v[j][2], v[j][3]); *(u32x2*)(xb + (size_t)m * DM + 4 * lane + 256 * j) = o; }
            float s = 0.f;
#pragma unroll
            for (int j = 0; j < 4; ++j) s += (v[j][0] * v[j][0] + v[j][1] * v[j][1]) + (v[j][2] * v[j][2] + v[j][3] * v[j][3]);
            const float rs = __builtin_amdgcn_rsqf(wave_sum(s) * (1.0f / DM) + NORM_EPS);
            u32x2 yb[4];
#pragma unroll
            for (int j = 0; j < 4; ++j) { const f32x4 y = v[j] * rs * gq[j]; yb[j].x = cvt_pk_bf16(y[0], y[1]); yb[j].y = cvt_pk_bf16(y[2], y[3]); }
            if (mode == 2) {
                const int t = m & (SEQ - 1);
#pragma unroll
                for (int j = 0; j < 4; ++j) {
                    *(u32x2*)(xn + (size_t)m * 2048 + 4 * lane + 256 * j) = yb[j];
                    if (t != SEQ - 1) *(u32x2*)(xn + (size_t)(m + 1) * 2048 + 1024 + 4 * lane + 256 * j) = yb[j];
                    if (t == 0) { unsigned z = 0u; asm volatile("" : "+v"(z)); *(u32x2*)(xn + (size_t)m * 2048 + 1024 + 4 * lane + 256 * j) = (u32x2){z, z}; }
                }
            } else {
#pragma unroll
                for (int j = 0; j < 4; ++j) *(u32x2*)(xn + (size_t)m * DM + 4 * lane + 256 * j) = yb[j];
            }
        }
    }
}
__device__ __forceinline__ void ml_gate_phase(const Frame& F, const bf16* xn, const float* w_in, const float* b_if, float* ifg) {
    PH_IDS;
    const int gw = F.vcu * NWAVES + w, NGW = F.G * NWAVES;
    f32x4 wif[8][4];
#pragma unroll
    for (int j = 0; j < 4; ++j)
#pragma unroll
        for (int e = 0; e < 4; ++e) { const int k = 4 * lane + 256 * j + e; const f32x4 a = *(const f32x4*)(w_in + (size_t)k * ML_IN + 3072), b = *(const f32x4*)(w_in + (size_t)k * ML_IN + 3076);
            wif[0][j][e] = a[0]; wif[1][j][e] = a[1]; wif[2][j][e] = a[2]; wif[3][j][e] = a[3]; wif[4][j][e] = b[0]; wif[5][j][e] = b[1]; wif[6][j][e] = b[2]; wif[7][j][e] = b[3]; }
    const float bias = lane < 8 ? b_if[lane] : 0.f;
    for (int m = gw; m < M; m += NGW) {
        f32x4 y[4];
#pragma unroll
        for (int j = 0; j < 4; ++j) { const u32x2 r = *(const u32x2*)(xn + (size_t)m * DM + 4 * lane + 256 * j); y[j] = (f32x4){bf_lo(r.x), bf_hi(r.x), bf_lo(r.y), bf_hi(r.y)}; }
        float my = 0.f;
#pragma unroll
        for (int cc = 0; cc < 8; ++cc) { float d = 0.f;
#pragma unroll
            for (int j = 0; j < 4; ++j) d += (y[j][0] * wif[cc][j][0] + y[j][1] * wif[cc][j][1]) + (y[j][2] * wif[cc][j][2] + y[j][3] * wif[cc][j][3]);
            d = wave_sum(d); if (lane == cc) my = d; }
        if (lane < 8) { float val = my + bias; val = 15.0f * tanhf(val * (1.0f / 15.0f));
            if (lane >= 4) val = -log1pf(expf(-val));
            ifg[(size_t)m * 8 + lane] = val; }
    }
}

__device__ __forceinline__ void ml_chunk_phase(const Frame& F, const bf16* proj, const float* ifg, const float* conv_w, bf16* hb) {
    constexpr int QP = 272, SP = 144;
    constexpr int QS = 0, KS = QS + 64 * QP, KWT = KS + 64 * QP, VT = KWT + 128 * SP, PS = VT + 80 * SP, CT = PS + 64 * SP, TAB = CT + 80 * QP, CWT = TAB + 1024;
    static_assert(CWT + 4096 <= RING_BYTES, "ml lds");
    LAS unsigned char* lds = F.lds;
    LAS float* tU = (LAS float*)(lds + TAB); LAS float* tM = tU + 64; LAS float* tB = tU + 128; LAS float* tD = tU + 192;
    PH_IDS;
    const int fr = lane & 15, fq = lane >> 4;
    for (int item = F.vcu; item < NB * 16; item += F.G) {
        const int b = item >> 4, hh = (item >> 2) & 3, vs = item & 3;
        const size_t rowb = (size_t)b * SEQ;
        for (int i = tid; i < 16 * 36; i += 512) { const int r = i / 36, cidx = i % 36; ((LAS unsigned*)(lds + VT + (64 + r) * SP))[cidx] = (r == 0) ? 0x3f803f80u : 0u; }
        const int which = tid >> 8, tq = (tid >> 4) & 15, c8 = tid & 15;
        const int ch = which * 512 + hh * 128 + c8 * 8;
        for (int i = tid; i < 4 * 256; i += 512) { const int jj = i >> 8, cc = i & 255; ((LAS float*)(lds + CWT))[i] = conv_w[jj * 1024 + (cc >> 7) * 512 + hh * 128 + (cc & 127)]; }
        const float qscale = which == 0 ? 0.08838834764831845f : 1.0f;
        const int tqv = tid >> 5, vp = tid & 31;
        const int vcol = 1024 + hh * 256 + vs * 64 + 2 * vp;
        f32x4 C[5];
#pragma unroll
        for (int jj = 0; jj < 5; ++jj) C[jj] = (f32x4){0.f, 0.f, 0.f, 0.f};
        float mst = 0.f;
        u32x4 rq[7]; unsigned rv[4]; float gi, gf;
        const unsigned loQ = (unsigned)((4 * tq) * 3072 + ch) * 2u, loV = (unsigned)((4 * tqv) * 3072 + vcol) * 2u;
        auto prefetch = [&](int c) {
            const char* base = (const char*)proj + (rowb + 64 * c) * (size_t)(3072 * 2);
            const int t0 = 64 * c + 4 * tq - 3;
#pragma unroll
            for (int r = 0; r < 7; ++r) rq[r] = (t0 + r >= 0) ? *(const u32x4*)(base + (ptrdiff_t)(r - 3) * (3072 * 2) + loQ) : (u32x4){0u, 0u, 0u, 0u};
#pragma unroll
            for (int r = 0; r < 4; ++r) rv[r] = *(const unsigned*)(base + (size_t)r * (3072 * 2) + loV);
            const float* gb = ifg + (rowb + 64 * c) * 8 + hh;
            gi = gb[lane * 8]; gf = gb[lane * 8 + 4];
        };
        prefetch(0);
        for (int c = 0; c < SEQ / 64; ++c) {
            const float bsum = scan_sum64(gf);
            const float uu = gi - bsum;
            const float Mx = fmaxf(mst, scan_max64(uu));
            const float M63 = lane63(Mx), b63 = lane63(bsum);
            if (w == 0) { tU[lane] = uu; tM[lane] = Mx; tB[lane] = bsum; }
#pragma unroll
            for (int jj = 0; jj < 5; ++jj) { u32x2 o; o.x = cvt_pk_bf16(C[jj][0], C[jj][1]); o.y = cvt_pk_bf16(C[jj][2], C[jj][3]);
                *(LAS u32x2*)(lds + CT + (16 * jj + fr) * QP + (16 * w + 4 * fq) * 2) = o; }
            WG_BAR();
            {
                float kws[4];
#pragma unroll
                for (int tt = 0; tt < 4; ++tt) kws[tt] = fexp(tU[4 * tq + tt] - M63);
                float cw[4][8];
#pragma unroll
                for (int jj = 0; jj < 4; ++jj) { const f32x4 a = *(const LAS f32x4*)(lds + CWT + (jj * 256 + which * 128 + c8 * 8) * 4), bq = *(const LAS f32x4*)(lds + CWT + (jj * 256 + which * 128 + c8 * 8 + 4) * 4);
                    cw[jj][0] = a[0]; cw[jj][1] = a[1]; cw[jj][2] = a[2]; cw[jj][3] = a[3]; cw[jj][4] = bq[0]; cw[jj][5] = bq[1]; cw[jj][6] = bq[2]; cw[jj][7] = bq[3]; }
                float o[4][8];
#pragma unroll
                for (int tt = 0; tt < 4; ++tt) {
#pragma unroll
                    for (int e2 = 0; e2 < 4; ++e2) { float a0 = 0.f, a1 = 0.f;
#pragma unroll
                        for (int jj = 0; jj < 4; ++jj) { const unsigned x = rq[tt + jj][e2]; a0 += cw[jj][2 * e2] * bf_lo(x); a1 += cw[jj][2 * e2 + 1] * bf_hi(x); }
                        o[tt][2 * e2] = fsilu(a0) * qscale; o[tt][2 * e2 + 1] = fsilu(a1) * qscale; }
                    u32x4 pk; pk.x = cvt_pk_bf16(o[tt][0], o[tt][1]); pk.y = cvt_pk_bf16(o[tt][2], o[tt][3]); pk.z = cvt_pk_bf16(o[tt][4], o[tt][5]); pk.w = cvt_pk_bf16(o[tt][6], o[tt][7]);
                    *(LAS u32x4*)(lds + (which ? KS : QS) + (4 * tq + tt) * QP + c8 * 16) = pk;
                }
                if (which) {
#pragma unroll
                    for (int e = 0; e < 8; ++e) { u32x2 pk; pk.x = cvt_pk_bf16(o[0][e] * kws[0], o[1][e] * kws[1]); pk.y = cvt_pk_bf16(o[2][e] * kws[2], o[3][e] * kws[3]);
                        *(LAS u32x2*)(lds + KWT + (c8 * 8 + e) * SP + (4 * tq) * 2) = pk; }
                }
                u32x2 v0, v1;
                v0.x = (rv[0] & 0xffffu) | (rv[1] << 16); v0.y = (rv[2] & 0xffffu) | (rv[3] << 16);
                v1.x = (rv[0] >> 16) | (rv[1] & 0xffff0000u); v1.y = (rv[2] >> 16) | (rv[3] & 0xffff0000u);
                *(LAS u32x2*)(lds + VT + (2 * vp) * SP + (4 * tqv) * 2) = v0; *(LAS u32x2*)(lds + VT + (2 * vp + 1) * SP + (4 * tqv) * 2) = v1;
            }
            WG_BAR();
            if (c + 1 < SEQ / 64) prefetch(c + 1);
            {
                const int tt = w >> 1, st0 = 2 * (w & 1);
                f32x4 s0 = {0.f, 0.f, 0.f, 0.f}, s1 = {0.f, 0.f, 0.f, 0.f};
#pragma unroll
                for (int kk = 0; kk < 4; ++kk) {
                    const bf16x8 yq = *(const LAS bf16x8*)(lds + QS + (16 * tt + fr) * QP + (32 * kk + 8 * fq) * 2);
                    const bf16x8 x0 = *(const LAS bf16x8*)(lds + KS + (16 * st0 + fr) * QP + (32 * kk + 8 * fq) * 2);
                    const bf16x8 x1 = *(const LAS bf16x8*)(lds + KS + (16 * (st0 + 1) + fr) * QP + (32 * kk + 8 * fq) * 2);
                    s0 = mma16(x0, yq, s0); s1 = mma16(x1, yq, s1);
                }
                const int t = 16 * tt + fr; const float Mt = tM[t];
#pragma unroll
                for (int q = 0; q < 2; ++q) { const f32x4 sv = q ? s1 : s0; const int sb = 16 * (st0 + q) + 4 * fq; const f32x4 u4 = *(const LAS f32x4*)(tU + sb);
                    float p[4];
#pragma unroll
                    for (int e = 0; e < 4; ++e) p[e] = (sb + e <= t) ? sv[e] * fexp(u4[e] - Mt) : 0.f;
                    u32x2 pk; pk.x = cvt_pk_bf16(p[0], p[1]); pk.y = cvt_pk_bf16(p[2], p[3]);
                    *(LAS u32x2*)(lds + PS + t * SP + sb * 2) = pk; }
            }
            WG_BAR_L();
            {
                const int tt = w & 3, jb = (w < 4) ? 0 : 3, nj = (w < 4) ? 3 : 2;
                f32x4 a1[3], a2[3];
#pragma unroll
                for (int jj = 0; jj < 3; ++jj) { a1[jj] = (f32x4){0.f, 0.f, 0.f, 0.f}; a2[jj] = (f32x4){0.f, 0.f, 0.f, 0.f}; }
#pragma unroll
                for (int kk = 0; kk < 2; ++kk) { const bf16x8 yp = *(const LAS bf16x8*)(lds + PS + (16 * tt + fr) * SP + (32 * kk + 8 * fq) * 2);
#pragma unroll
                    for (int jj = 0; jj < 3; ++jj) if (jj < nj) { const bf16x8 xv = *(const LAS bf16x8*)(lds + VT + (16 * (jb + jj) + fr) * SP + (32 * kk + 8 * fq) * 2); a1[jj] = mma16(xv, yp, a1[jj]); } }
#pragma unroll
                for (int kk = 0; kk < 4; ++kk) { const bf16x8 yq = *(const LAS bf16x8*)(lds + QS + (16 * tt + fr) * QP + (32 * kk + 8 * fq) * 2);
#pragma unroll
                    for (int jj = 0; jj < 3; ++jj) if (jj < nj) { const bf16x8 xc = *(const LAS bf16x8*)(lds + CT + (16 * (jb + jj) + fr) * QP + (32 * kk + 8 * fq) * 2); a2[jj] = mma16(xc, yq, a2[jj]); } }
                const int t = 16 * tt + fr; const float Mt = tM[t], bt = tB[t]; const float inter = fexp(mst - Mt);
#pragma unroll
                for (int jj = 0; jj < 3; ++jj) a1[jj] = a1[jj] + a2[jj] * inter;
                if (w >= 4 && fq == 0) tD[t] = a1[1][0];
                WG_BAR_L();
                const float dn = fmaxf(fabsf(tD[t]), fexp(-(bt + Mt))); const float rdn = 1.0f / dn;
#pragma unroll
                for (int jj = 0; jj < 3; ++jj) if (jj < nj && jb + jj < 4) { u32x2 pk; pk.x = cvt_pk_bf16(a1[jj][0] * rdn, a1[jj][1] * rdn); pk.y = cvt_pk_bf16(a1[jj][2] * rdn, a1[jj][3] * rdn);
                    *(u32x2*)((char*)(hb + (rowb + 64 * c + 16 * tt) * DM + hh * 256 + vs * 64 + 16 * (jb + jj)) + (unsigned)(fr * DM + 4 * fq) * 2u) = pk; }
            }
            {
                const float decay = fexp(mst - M63);
#pragma unroll
                for (int jj = 0; jj < 5; ++jj) C[jj] = C[jj] * decay;
#pragma unroll
                for (int kk = 0; kk < 2; ++kk) { const bf16x8 xk = *(const LAS bf16x8*)(lds + KWT + (16 * w + fr) * SP + (32 * kk + 8 * fq) * 2);
#pragma unroll
                    for (int jj = 0; jj < 5; ++jj) { const bf16x8 yv = *(const LAS bf16x8*)(lds + VT + (16 * jj + fr) * SP + (32 * kk + 8 * fq) * 2); C[jj] = mma16(xk, yv, C[jj]); } }
                mst = b63 + M63;
            }
            WG_BAR_L();
        }
    }
}

__device__ __forceinline__ void ml_head_phase(const Frame& F, const bf16* hb, const bf16* proj, const float* ng, bf16* hg) {
    PH_IDS;
    const int gw = F.vcu * NWAVES + w, NGW = F.G * NWAVES;
    f32x4 g[4];
#pragma unroll
    for (int j = 0; j < 4; ++j) g[j] = *(const f32x4*)(ng + 4 * lane + 256 * j);
    for (int m = gw; m < M; m += NGW) {
#pragma unroll
        for (int j = 0; j < 4; ++j) {
            const u32x2 r = *(const u32x2*)(hb + (size_t)m * DM + 4 * lane + 256 * j), ro = *(const u32x2*)(proj + (size_t)m * 3072 + 2048 + 4 * lane + 256 * j);
            const f32x4 v = {bf_lo(r.x), bf_hi(r.x), bf_lo(r.y), bf_hi(r.y)}, o = {bf_lo(ro.x), bf_hi(ro.x), bf_lo(ro.y), bf_hi(ro.y)};
            const float s = wave_sum((v[0] * v[0] + v[1] * v[1]) + (v[2] * v[2] + v[3] * v[3]));
            const float rs = __builtin_amdgcn_rsqf(s * (1.0f / 256.0f) + NORM_EPS);
            u32x2 pk; pk.x = cvt_pk_bf16(v[0] * rs * g[j][0] * fsigmoid(o[0]), v[1] * rs * g[j][1] * fsigmoid(o[1])); pk.y = cvt_pk_bf16(v[2] * rs * g[j][2] * fsigmoid(o[2]), v[3] * rs * g[j][3] * fsigmoid(o[3]));
            *(u32x2*)(hg + (size_t)m * DM + 4 * lane + 256 * j) = pk;
        }
    }
}

__device__ __forceinline__ void rt_chunk_phase(const Frame& F, const bf16* proj, bf16* yb) {
    constexpr int QP = 528, SP = 144;
    constexpr int QS = 0, KS = QS + 64 * QP, KWT = KS + 64 * QP, VT = KWT + 256 * SP, PS = VT + 128 * SP, END = PS + 64 * SP;
    static_assert(END <= MISC_OFF, "rt lds");
    LAS unsigned char* lds = F.lds;
    PH_IDS;
    const int fr = lane & 15, fq = lane >> 4;
    for (int item = F.vcu; item < NB * 16; item += F.G) {
        const int b = item >> 4, hh = (item >> 2) & 3, vs = item & 3;
        const size_t rowb = (size_t)b * SEQ;
        const float lg = __builtin_log2f(1.0f - __builtin_amdgcn_exp2f(-5.0f - (float)hh));
        const int tq = tid >> 5, c8 = tid & 31;
        const int qcol = hh * 256, kcol = 1024 + hh * 256 + c8 * 8, vcol = 2048 + hh * 512 + vs * 128 + 4 * c8;
        f32x4 R[16];
#pragma unroll
        for (int i = 0; i < 16; ++i) R[i] = (f32x4){0.f, 0.f, 0.f, 0.f};
        u32x4 rq[4], rk[4]; u32x2 rv[4];
        const unsigned loQ = (unsigned)((tid >> 5) * 6144 + qcol + (tid & 31) * 8) * 2u, loK = (unsigned)((4 * tq) * 6144 + kcol) * 2u, loV = (unsigned)((4 * tq) * 6144 + vcol) * 2u;
        auto prefetch = [&](int c) {
            const char* base = (const char*)proj + (rowb + 64 * c) * (size_t)(6144 * 2);
#pragma unroll
            for (int i = 0; i < 4; ++i) rq[i] = *(const u32x4*)(base + (size_t)i * (16 * 6144 * 2) + loQ);
#pragma unroll
            for (int i = 0; i < 4; ++i) { rk[i] = *(const u32x4*)(base + (size_t)i * (6144 * 2) + loK); rv[i] = *(const u32x2*)(base + (size_t)i * (6144 * 2) + loV); }
        };
        prefetch(0);
        float kws[4];
#pragma unroll
        for (int i = 0; i < 4; ++i) kws[i] = __builtin_amdgcn_exp2f(lg * (float)(63 - (4 * tq + i)));
        const float cdecay = __builtin_amdgcn_exp2f(lg * 64.0f);
        for (int c = 0; c < SEQ / 64; ++c) {
#pragma unroll
            for (int i = 0; i < 4; ++i) { const int idx = tid + 512 * i; *(LAS u32x4*)(lds + QS + (idx >> 5) * QP + (idx & 31) * 16) = rq[i]; }
#pragma unroll
            for (int i = 0; i < 4; ++i) *(LAS u32x4*)(lds + KS + (4 * tq + i) * QP + c8 * 16) = rk[i];
#pragma unroll
            for (int e2 = 0; e2 < 4; ++e2) {
                u32x2 lo, hi;
                lo.x = cvt_pk_bf16(bf_lo(rk[0][e2]) * kws[0], bf_lo(rk[1][e2]) * kws[1]); lo.y = cvt_pk_bf16(bf_lo(rk[2][e2]) * kws[2], bf_lo(rk[3][e2]) * kws[3]);
                hi.x = cvt_pk_bf16(bf_hi(rk[0][e2]) * kws[0], bf_hi(rk[1][e2]) * kws[1]); hi.y = cvt_pk_bf16(bf_hi(rk[2][e2]) * kws[2], bf_hi(rk[3][e2]) * kws[3]);
                *(LAS u32x2*)(lds + KWT + (c8 * 8 + 2 * e2) * SP + (4 * tq) * 2) = lo; *(LAS u32x2*)(lds + KWT + (c8 * 8 + 2 * e2 + 1) * SP + (4 * tq) * 2) = hi;
            }
            {
                u32x2 v0, v1, v2, v3;
                v0.x = (rv[0].x & 0xffffu) | (rv[1].x << 16); v0.y = (rv[2].x & 0xffffu) | (rv[3].x << 16);
                v1.x = (rv[0].x >> 16) | (rv[1].x & 0xffff0000u); v1.y = (rv[2].x >> 16) | (rv[3].x & 0xffff0000u);
                v2.x = (rv[0].y & 0xffffu) | (rv[1].y << 16); v2.y = (rv[2].y & 0xffffu) | (rv[3].y << 16);
                v3.x = (rv[0].y >> 16) | (rv[1].y & 0xffff0000u); v3.y = (rv[2].y >> 16) | (rv[3].y & 0xffff0000u);
                LAS unsigned char* vb = lds + VT + (4 * c8) * SP + (4 * tq) * 2;
                *(LAS u32x2*)(vb) = v0; *(LAS u32x2*)(vb + SP) = v1; *(LAS u32x2*)(vb + 2 * SP) = v2; *(LAS u32x2*)(vb + 3 * SP) = v3;
            }
            WG_BAR();
            {
                const int tt = w >> 1, st0 = 2 * (w & 1);
                f32x4 s0 = {0.f, 0.f, 0.f, 0.f}, s1 = {0.f, 0.f, 0.f, 0.f};
#pragma unroll 2
                for (int kk = 0; kk < 8; ++kk) {
                    const bf16x8 yq = *(const LAS bf16x8*)(lds + QS + (16 * tt + fr) * QP + (32 * kk + 8 * fq) * 2);
                    const bf16x8 x0 = *(const LAS bf16x8*)(lds + KS + (16 * st0 + fr) * QP + (32 * kk + 8 * fq) * 2);
                    const bf16x8 x1 = *(const LAS bf16x8*)(lds + KS + (16 * (st0 + 1) + fr) * QP + (32 * kk + 8 * fq) * 2);
                    s0 = mma16(x0, yq, s0); s1 = mma16(x1, yq, s1);
                }
                const int t = 16 * tt + fr;
#pragma unroll
                for (int q = 0; q < 2; ++q) { const f32x4 sv = q ? s1 : s0; const int sb = 16 * (st0 + q) + 4 * fq;
                    float p[4];
#pragma unroll
                    for (int e = 0; e < 4; ++e) p[e] = (sb + e <= t) ? sv[e] * __builtin_amdgcn_exp2f(lg * (float)(t - sb - e)) : 0.f;
                    u32x2 pk; pk.x = cvt_pk_bf16(p[0], p[1]); pk.y = cvt_pk_bf16(p[2], p[3]);
                    *(LAS u32x2*)(lds + PS + t * SP + sb * 2) = pk; }
            }
            WG_BAR_L();
            if (c + 1 < SEQ / 64) prefetch(c + 1);
            u32x4 xr[8];
#pragma unroll
            for (int kk = 0; kk < 8; ++kk) { xr[kk].x = cvt_pk_bf16(R[2 * kk][0], R[2 * kk][1]); xr[kk].y = cvt_pk_bf16(R[2 * kk][2], R[2 * kk][3]); xr[kk].z = cvt_pk_bf16(R[2 * kk + 1][0], R[2 * kk + 1][1]); xr[kk].w = cvt_pk_bf16(R[2 * kk + 1][2], R[2 * kk + 1][3]); }
#pragma unroll 1
            for (int tt = 0; tt < 4; ++tt) {
                f32x4 aI = {0.f, 0.f, 0.f, 0.f}, aC = {0.f, 0.f, 0.f, 0.f};
#pragma unroll
                for (int kk = 0; kk < 2; ++kk) { const bf16x8 xv = *(const LAS bf16x8*)(lds + VT + (16 * w + fr) * SP + (32 * kk + 8 * fq) * 2);
                    const bf16x8 yp = *(const LAS bf16x8*)(lds + PS + (16 * tt + fr) * SP + (32 * kk + 8 * fq) * 2); aI = mma16(xv, yp, aI); }
#pragma unroll
                for (int kk = 0; kk < 8; ++kk) {
                    const u32x2 qa = *(const LAS u32x2*)(lds + QS + (16 * tt + fr) * QP + (32 * kk + 4 * fq) * 2), qb = *(const LAS u32x2*)(lds + QS + (16 * tt + fr) * QP + (32 * kk + 16 + 4 * fq) * 2);
                    const u32x4 yq = {qa.x, qa.y, qb.x, qb.y};
                    aC = mma16(__builtin_bit_cast(bf16x8, xr[kk]), __builtin_bit_cast(bf16x8, yq), aC);
                }
                const int t = 16 * tt + fr; const float qd = __builtin_amdgcn_exp2f(lg * (float)(t + 1)); const f32x4 val = aI + aC * qd;
                u32x2 pk; pk.x = cvt_pk_bf16(val[0], val[1]); pk.y = cvt_pk_bf16(val[2], val[3]);
                *(u32x2*)((char*)(yb + (rowb + 64 * c + 16 * tt) * 2048 + hh * 512 + vs * 128 + 16 * w) + (unsigned)(fr * 2048 + 4 * fq) * 2u) = pk;
            }
            {
                const bf16x8 yv0 = *(const LAS bf16x8*)(lds + VT + (16 * w + fr) * SP + (8 * fq) * 2), yv1 = *(const LAS bf16x8*)(lds + VT + (16 * w + fr) * SP + (32 + 8 * fq) * 2);
#pragma unroll
                for (int dt = 0; dt < 16; ++dt) {
                    const bf16x8 x0 = *(const LAS bf16x8*)(lds + KWT + (16 * dt + fr) * SP + (8 * fq) * 2), x1 = *(const LAS bf16x8*)(lds + KWT + (16 * dt + fr) * SP + (32 + 8 * fq) * 2);
                    R[dt] = R[dt] * cdecay; R[dt] = mma16(x0, yv0, R[dt]); R[dt] = mma16(x1, yv1, R[dt]);
                    if ((dt & 3) == 3) asm volatile("" ::: "memory");
                }
            }
            WG_BAR_L();
        }
    }
}

__device__ __forceinline__ void rt_head_phase(const Frame& F, bf16* yb, const bf16* proj) {
    PH_IDS;
    const int gw = F.vcu * NWAVES + w, NGW = F.G * NWAVES;
    for (int m = gw; m < M; m += NGW) {
#pragma unroll
        for (int hd = 0; hd < 4; ++hd) {
            f32x4 v[2], g[2]; float s = 0.f;
#pragma unroll
            for (int q = 0; q < 2; ++q) { const int col = hd * 512 + q * 256 + 4 * lane;
                const u32x2 r = *(const u32x2*)(yb + (size_t)m * 2048 + col), rg = *(const u32x2*)(proj + (size_t)m * 6144 + 4096 + col);
                v[q] = (f32x4){bf_lo(r.x), bf_hi(r.x), bf_lo(r.y), bf_hi(r.y)}; g[q] = (f32x4){bf_lo(rg.x), bf_hi(rg.x), bf_lo(rg.y), bf_hi(rg.y)};
                s += (v[q][0] * v[q][0] + v[q][1] * v[q][1]) + (v[q][2] * v[q][2] + v[q][3] * v[q][3]); }
            const float rs = __builtin_amdgcn_rsqf(wave_sum(s) * (1.0f / 512.0f) + NORM_EPS);
#pragma unroll
            for (int q = 0; q < 2; ++q) { const int col = hd * 512 + q * 256 + 4 * lane;
                u32x2 pk; pk.x = cvt_pk_bf16(fsilu(g[q][0]) * v[q][0] * rs, fsilu(g[q][1]) * v[q][1] * rs); pk.y = cvt_pk_bf16(fsilu(g[q][2]) * v[q][2] * rs, fsilu(g[q][3]) * v[q][3] * rs);
                *(u32x2*)(yb + (size_t)m * 2048 + col) = pk; }
        }
    }
}

__device__ __forceinline__ float bf1(unsigned short u) { return __uint_as_float((unsigned)u << 16); }
__device__ __forceinline__ unsigned short f2bf1(float f) { return (unsigned short)(cvt_pk_bf16(f, 0.f) & 0xffffu); }
__device__ __forceinline__ void rw_scan_phase(const Frame& F, const bf16* rkv, const bf16* wag, const float* k_k, const float* k_a, const float* r_k, const float* ln_g, const float* ln_b, bf16* yout) {
    constexpr int TB = 64;
    constexpr int PLW = 0, PK = 8192, PV = 16384, PA = 24576, PB = 32768, PR = 40960, PG = 49152, BON = 57344, IMG = 57600;
    constexpr int I_AH = 0, I_RT = 2048, I_BT = 4096, I_KT = 6144, I_VT = 8192, I_NKH = 10240, I_NBR = 10752, I_NKR = 11264, I_GL = 11776, I_NBA = 12032, I_NKA = 13056, IMGSZ = 14080;
    constexpr int YB = IMG + 4 * IMGSZ;
    static_assert(YB + 4 * 4096 <= MISC_OFF && (IMG % 16) == 0 && (IMGSZ % 16) == 0, "rw lds");
    LAS unsigned char* lds = F.lds;
    PH_IDS;
    const int fr = lane & 15, fq = lane >> 4;
    for (int item = F.vcu; item < NB * 16; item += F.G) {
        const int b = item >> 4, hh = item & 15;
        const size_t rowb = (size_t)b * SEQ;
        const int c4 = tid & 15, chg = hh * 64 + 4 * c4;
        f32x4 ST[4];
#pragma unroll
        for (int jt = 0; jt < 4; ++jt) ST[jt] = (f32x4){0.f, 0.f, 0.f, 0.f};
        u32x2 pr[2], pk[2], pv[2], pw[2], pa[2], pg[2];
        const unsigned lo0 = (unsigned)((tid >> 4) * 3072 + chg) * 2u;
        auto prefetch = [&](int tb) {
            const char* br = (const char*)rkv + (rowb + (size_t)tb * TB) * (3072 * 2); const char* bw = (const char*)wag + (rowb + (size_t)tb * TB) * (3072 * 2);
#pragma unroll
            for (int q = 0; q < 2; ++q) { const size_t o = (size_t)q * (32 * 3072 * 2) + lo0;
                pr[q] = *(const u32x2*)(br + o); pk[q] = *(const u32x2*)(br + o + 2048); pv[q] = *(const u32x2*)(br + o + 4096);
                pw[q] = *(const u32x2*)(bw + o); pa[q] = *(const u32x2*)(bw + o + 2048); pg[q] = *(const u32x2*)(bw + o + 4096); }
        };
        prefetch(0);
        for (int tb = 0; tb < SEQ / TB; ++tb) {
            for (int rep_ = 0; rep_ < (PROBE_DUP == 23 ? 2 : 1); ++rep_) {
            const f32x4 kk4 = *(const f32x4*)(k_k + chg), ka4 = *(const f32x4*)(k_a + chg), rk4 = *(const f32x4*)(r_k + chg);
#pragma unroll
            for (int q = 0; q < 2; ++q) {
                const int tk = (tid >> 4) + 32 * q;
                const f32x4 r = {bf_lo(pr[q].x), bf_hi(pr[q].x), bf_lo(pr[q].y), bf_hi(pr[q].y)}, k = {bf_lo(pk[q].x), bf_hi(pk[q].x), bf_lo(pk[q].y), bf_hi(pk[q].y)};
                const f32x4 av = {bf_lo(pa[q].x), bf_hi(pa[q].x), bf_lo(pa[q].y), bf_hi(pa[q].y)};
                const f32x4 kkv = k * kk4;
                const float ss = red16((kkv[0] * kkv[0] + kkv[1] * kkv[1]) + (kkv[2] * kkv[2] + kkv[3] * kkv[3]));
                const float inv = 1.0f / fmaxf(sqrtf(ss), 1e-12f);
                const f32x4 kkn = kkv * inv, kp = k * (1.0f + (av - 1.0f) * ka4), rkp = r * kp * rk4, bb = kkn * av;
                const float bd = red16((rkp[0] + rkp[1]) + (rkp[2] + rkp[3]));
                const int o = (tk * 64 + 4 * c4) * 2;
                *(LAS u32x2*)(lds + PLW + o) = pw[q]; *(LAS u32x2*)(lds + PV + o) = pv[q]; *(LAS u32x2*)(lds + PR + o) = pr[q]; *(LAS u32x2*)(lds + PG + o) = pg[q];
                *(LAS u32x2*)(lds + PK + o) = (u32x2){cvt_pk_bf16(kp[0], kp[1]), cvt_pk_bf16(kp[2], kp[3])};
                *(LAS u32x2*)(lds + PA + o) = (u32x2){cvt_pk_bf16(-kkn[0], -kkn[1]), cvt_pk_bf16(-kkn[2], -kkn[3])};
                *(LAS u32x2*)(lds + PB + o) = (u32x2){cvt_pk_bf16(bb[0], bb[1]), cvt_pk_bf16(bb[2], bb[3])};
                if (c4 == 0) *(LAS float*)(lds + BON + tk * 4) = bd;
            }
            }
            WG_BAR();
            if (tb + 1 < SEQ / TB) prefetch(tb + 1);
            for (int rep_ = 0; rep_ < (PROBE_DUP == 21 ? 2 : 1); ++rep_) if (w >= 4) {
                const int c = w - 4, j = lane;
                LAS unsigned char* img = lds + IMG + c * IMGSZ;
                LAS unsigned char* scr = lds + YB + c * 4096;
                float At[16]; unsigned Bp[8], Kp[8], Vp[8];
                float cum = 0.f, gprev = 1.0f;
#pragma unroll
                for (int t = 0; t < 16; ++t) {
                    const int o = ((16 * c + t) * 64 + j) * 2;
                    const float lwv = bf1(*(const LAS unsigned short*)(lds + PLW + o)), a = bf1(*(const LAS unsigned short*)(lds + PA + o)), bq = bf1(*(const LAS unsigned short*)(lds + PB + o));
                    const float kq = bf1(*(const LAS unsigned short*)(lds + PK + o)), rq = bf1(*(const LAS unsigned short*)(lds + PR + o));
                    const unsigned vq = *(const LAS unsigned short*)(lds + PV + o);
                    cum += lwv;
                    const float gcur = fexp(cum), ginv = fexp(-cum);
                    At[t] = a * gprev;
                    const unsigned short ab = f2bf1(At[t]), rb = f2bf1(rq * gcur), bt = f2bf1(bq * ginv), kt = f2bf1(kq * ginv);
                    const int ot = (t * 64 + j) * 2;
                    *(LAS unsigned short*)(img + I_AH + ot) = ab; *(LAS unsigned short*)(img + I_RT + ot) = rb;
                    *(LAS unsigned short*)(scr + ot) = bt; *(LAS unsigned short*)(scr + 2048 + ot) = kt;
                    if (t & 1) { Bp[t >> 1] |= (unsigned)bt << 16; Kp[t >> 1] |= (unsigned)kt << 16; Vp[t >> 1] |= vq << 16; }
                    else { Bp[t >> 1] = bt; Kp[t >> 1] = kt; Vp[t >> 1] = vq; }
                    gprev = gcur;
                }
                *(LAS u32x4*)(img + I_BT + j * 32) = (u32x4){Bp[0], Bp[1], Bp[2], Bp[3]}; *(LAS u32x4*)(img + I_BT + j * 32 + 16) = (u32x4){Bp[4], Bp[5], Bp[6], Bp[7]};
                *(LAS u32x4*)(img + I_KT + j * 32) = (u32x4){Kp[0], Kp[1], Kp[2], Kp[3]}; *(LAS u32x4*)(img + I_KT + j * 32 + 16) = (u32x4){Kp[4], Kp[5], Kp[6], Kp[7]};
                *(LAS u32x4*)(img + I_VT + j * 32) = (u32x4){Vp[0], Vp[1], Vp[2], Vp[3]}; *(LAS u32x4*)(img + I_VT + j * 32 + 16) = (u32x4){Vp[4], Vp[5], Vp[6], Vp[7]};
                *(LAS float*)(img + I_GL + j * 4) = gprev;
                LDS_WAIT();
                {
                    f32x4 nba = {0.f, 0.f, 0.f, 0.f}, nbr = nba, nka = nba, nkr = nba;
#pragma unroll
                    for (int m = 0; m < 2; ++m) { const int o = fr * 128 + (32 * m + 8 * fq) * 2;
                        const bf16x8 xb = *(const LAS bf16x8*)(scr + o), xk = *(const LAS bf16x8*)(scr + 2048 + o), ya = *(const LAS bf16x8*)(img + I_AH + o), yr = *(const LAS bf16x8*)(img + I_RT + o);
                        nba = mma16(xb, ya, nba); nbr = mma16(xb, yr, nbr); nka = mma16(xk, ya, nka); nkr = mma16(xk, yr, nkr); }
#pragma unroll
                    for (int e = 0; e < 4; ++e) { const int sidx = 4 * fq + e; if (!(sidx < fr)) { nba[e] = 0.f; nka[e] = 0.f; } if (!(sidx <= fr)) { nbr[e] = 0.f; nkr[e] = 0.f; } }
                    *(LAS f32x4*)(img + I_NBA + (fr * 16 + 4 * fq) * 4) = nba; *(LAS f32x4*)(img + I_NKA + (fr * 16 + 4 * fq) * 4) = nka;
                    *(LAS u32x2*)(img + I_NBR + (fr * 16 + 4 * fq) * 2) = (u32x2){cvt_pk_bf16(nbr[0], nbr[1]), cvt_pk_bf16(nbr[2], nbr[3])};
                    *(LAS u32x2*)(img + I_NKR + (fr * 16 + 4 * fq) * 2) = (u32x2){cvt_pk_bf16(nkr[0], nkr[1]), cvt_pk_bf16(nkr[2], nkr[3])};
                }
                LDS_WAIT();
                {
                    float H[16];
#pragma unroll
                    for (int t = 0; t < 16; ++t) {
                        float h = At[t];
#pragma unroll
                        for (int s4 = 0; s4 < 4; ++s4) if (4 * s4 < t) { const f32x4 cf = *(const LAS f32x4*)(img + I_NBA + (t * 16 + 4 * s4) * 4);
#pragma unroll
                            for (int e = 0; e < 4; ++e) if (4 * s4 + e < t) h += H[4 * s4 + e] * cf[e]; }
                        H[t] = h;
                    }
                    LDS_WAIT();
#pragma unroll
                    for (int t = 0; t < 16; ++t) *(LAS unsigned short*)(img + I_AH + (t * 64 + j) * 2) = f2bf1(H[t]);
                    asm volatile("" ::: "memory");
#pragma unroll
                    for (int t = 0; t < 16; ++t) {
                        float g = *(const LAS float*)(img + I_NKA + (t * 16 + (lane & 15)) * 4);
#pragma unroll
                        for (int s4 = 0; s4 < 4; ++s4) if (4 * s4 < t) { const f32x4 cf = *(const LAS f32x4*)(img + I_NBA + (t * 16 + 4 * s4) * 4);
#pragma unroll
                            for (int e = 0; e < 4; ++e) if (4 * s4 + e < t) g += H[4 * s4 + e] * cf[e]; }
                        H[t] = g;
                        if (lane < 16) *(LAS unsigned short*)(img + I_NKH + (t * 16 + lane) * 2) = f2bf1(g);
                    }
                }
            }
            WG_BAR_L();
            if (w < 4) {
                struct Ops { u32x2 ah[4], rt[4], bt[4], kt[4], vt, nk, nb, nr; f32x4 gl[4]; };
                auto load_ops = [&](int c, Ops& o) {
                    const LAS unsigned char* img = lds + IMG + c * IMGSZ;
#pragma unroll
                    for (int m = 0; m < 2; ++m) {
                        o.ah[2 * m] = *(const LAS u32x2*)(img + I_AH + fr * 128 + (32 * m + 4 * fq) * 2); o.ah[2 * m + 1] = *(const LAS u32x2*)(img + I_AH + fr * 128 + (32 * m + 16 + 4 * fq) * 2);
                        o.rt[2 * m] = *(const LAS u32x2*)(img + I_RT + fr * 128 + (32 * m + 4 * fq) * 2); o.rt[2 * m + 1] = *(const LAS u32x2*)(img + I_RT + fr * 128 + (32 * m + 16 + 4 * fq) * 2);
                    }
                    o.vt = *(const LAS u32x2*)(img + I_VT + (16 * w + fr) * 32 + (4 * fq) * 2); o.nk = *(const LAS u32x2*)(img + I_NKH + (fr * 16 + 4 * fq) * 2);
                    o.nb = *(const LAS u32x2*)(img + I_NBR + (fr * 16 + 4 * fq) * 2); o.nr = *(const LAS u32x2*)(img + I_NKR + (fr * 16 + 4 * fq) * 2);
#pragma unroll
                    for (int jt = 0; jt < 4; ++jt) { o.bt[jt] = *(const LAS u32x2*)(img + I_BT + (16 * jt + fr) * 32 + (4 * fq) * 2); o.kt[jt] = *(const LAS u32x2*)(img + I_KT + (16 * jt + fr) * 32 + (4 * fq) * 2);
                        o.gl[jt] = *(const LAS f32x4*)(img + I_GL + (16 * jt + 4 * fq) * 4); }
                };
                Ops cur, nxt;
                load_ops(0, cur);
#pragma unroll
                for (int c = 0; c < 4; ++c) {
                    if (c < 3) load_ops(c + 1, nxt);
                    u32x4 sf[2];
#pragma unroll
                    for (int m = 0; m < 2; ++m) { sf[m].x = cvt_pk_bf16(ST[2 * m][0], ST[2 * m][1]); sf[m].y = cvt_pk_bf16(ST[2 * m][2], ST[2 * m][3]); sf[m].z = cvt_pk_bf16(ST[2 * m + 1][0], ST[2 * m + 1][1]); sf[m].w = cvt_pk_bf16(ST[2 * m + 1][2], ST[2 * m + 1][3]); }
                    f32x4 d1 = {0.f, 0.f, 0.f, 0.f}, d2 = {0.f, 0.f, 0.f, 0.f};
#pragma unroll
                    for (int m = 0; m < 2; ++m) {
                        d1 = mma16(__builtin_bit_cast(bf16x8, (u32x4){cur.ah[2 * m].x, cur.ah[2 * m].y, cur.ah[2 * m + 1].x, cur.ah[2 * m + 1].y}), __builtin_bit_cast(bf16x8, sf[m]), d1);
                        d2 = mma16(__builtin_bit_cast(bf16x8, (u32x4){cur.rt[2 * m].x, cur.rt[2 * m].y, cur.rt[2 * m + 1].x, cur.rt[2 * m + 1].y}), __builtin_bit_cast(bf16x8, sf[m]), d2);
                    }
                    d1 = mma16(__builtin_bit_cast(bf16x8, (u32x4){cur.nk.x, cur.nk.y, 0u, 0u}), __builtin_bit_cast(bf16x8, (u32x4){cur.vt.x, cur.vt.y, 0u, 0u}), d1);
                    const u32x4 ff = {cvt_pk_bf16(d1[0], d1[1]), cvt_pk_bf16(d1[2], d1[3]), cur.vt.x, cur.vt.y};
                    d2 = mma16(__builtin_bit_cast(bf16x8, (u32x4){cur.nb.x, cur.nb.y, cur.nr.x, cur.nr.y}), __builtin_bit_cast(bf16x8, ff), d2);
#pragma unroll
                    for (int e = 0; e < 4; ++e) *(LAS float*)(lds + YB + c * 4096 + ((4 * fq + e) * 64 + 16 * w + fr) * 4) = d2[e];
#pragma unroll
                    for (int jt = 0; jt < 4; ++jt) {
                        ST[jt] = mma16(__builtin_bit_cast(bf16x8, (u32x4){cur.bt[jt].x, cur.bt[jt].y, cur.kt[jt].x, cur.kt[jt].y}), __builtin_bit_cast(bf16x8, ff), ST[jt]);
                        ST[jt] = ST[jt] * cur.gl[jt];
                    }
                    if (c < 3) cur = nxt;
                }
            }
            WG_BAR_L();
            for (int rep_ = 0; rep_ < (PROBE_DUP == 24 ? 2 : 1); ++rep_) {
            const f32x4 lg4 = *(const f32x4*)(ln_g + chg), lb4 = *(const f32x4*)(ln_b + chg);
#pragma unroll
            for (int q = 0; q < 2; ++q) {
                const int tk = (tid >> 4) + 32 * q, o = (tk * 64 + 4 * c4) * 2;
                const f32x4 y = *(const LAS f32x4*)(lds + YB + (tk >> 4) * 4096 + ((tk & 15) * 64 + 4 * c4) * 4);
                const u32x2 vb = *(const LAS u32x2*)(lds + PV + o), gb = *(const LAS u32x2*)(lds + PG + o);
                const f32x4 v = {bf_lo(vb.x), bf_hi(vb.x), bf_lo(vb.y), bf_hi(vb.y)}, g = {bf_lo(gb.x), bf_hi(gb.x), bf_lo(gb.y), bf_hi(gb.y)};
                const float bd = *(const LAS float*)(lds + BON + tk * 4);
                const float mean = red16((y[0] + y[1]) + (y[2] + y[3])) * (1.0f / 64.0f);
                const f32x4 d = y - mean;
                const float var = red16((d[0] * d[0] + d[1] * d[1]) + (d[2] * d[2] + d[3] * d[3])) * (1.0f / 64.0f);
                const float rs = __builtin_amdgcn_rsqf(var + 64e-5f);
                const f32x4 outv = ((d * rs) * lg4 + lb4 + v * bd) * g;
                *(u32x2*)((char*)yout + ((rowb + (size_t)tb * TB + tk) * DM + chg) * 2) = (u32x2){cvt_pk_bf16(outv[0], outv[1]), cvt_pk_bf16(outv[2], outv[3])};
            }
            }
            WG_BAR_L();
        }
    }
}

constexpr int N_PHASES = 1 + DEPTH * 11;

__global__ void __launch_bounds__(NWAVES * 64, 2) mk_fwd(Args args) {
    extern __shared__ __attribute__((aligned(16))) unsigned char lds_raw[];
    Frame F;
    F.lds = (LAS unsigned char*)lds_raw;
    F.G = gridDim.x; { const int bx = blockIdx.x; F.vcu = (F.G % 8 == 0) ? (bx % 8) * (F.G / 8) + bx / 8 : bx; }
    volatile LAS unsigned* MISC = (volatile LAS unsigned*)(F.lds + MISC_OFF);
    for (int u = threadIdx.x; u < (LDS_BYTES - MISC_OFF) / 4; u += NWAVES * 64) ((LAS unsigned*)(F.lds + MISC_OFF))[u] = 0u;
    __syncthreads();
    unsigned char* ws = args.ws;
    unsigned* ctl = (unsigned*)(ws + WS_CTL);
    const int lo = args.p_lo, hi = args.p_hi;
    XcdBarrier bar; bar.bar = ctl + CW_BAR; bar.x = 0; bar.st = nullptr;
    if (hi - lo > 1) bar = xcd_barrier_post(ctl + CW_BAR, MISC + 8);
    const Args& in = args;
    bf16* xb = (bf16*)args.out;
    bf16* xb2 = (bf16*)(ws + WS_A + 256 * MiB);
    bf16* XN = (bf16*)(ws + WS_XN); bf16* MO = (bf16*)(ws + WS_MO);
    bf16* RA = (bf16*)(ws + WS_A); bf16* RB = (bf16*)(ws + WS_B);
    int p = 0;
#define PH_ON (p >= lo && p < hi)
#define PH_END do { if (p >= lo && p + 1 < hi) xcd_barrier(bar); ++p; } while (0)
#define DUP(cat, ...) do { __VA_ARGS__; if (PROBE_DUP == (cat)) { xcd_barrier(bar); __VA_ARGS__; } } while (0)


    if (PH_ON) { DUP(4, prep_layer(F, in, ws, 0)); norm_phase(F, kin(in, 0), nullptr, xb, nullptr, 0.f, nullptr, kin(in, 2), XN, 0, nullptr);
    }
    PH_END;

#pragma unroll 1
    for (int s = 0; s < DEPTH * 3; ++s) {
        const int L = s / 3, sp = s % 3, kind = L % 3, jm = L / 3;
        const float* g6 = kin(in, 2) + (size_t)L * 6 * DM;
        if (sp != 1) {
            const int f = sp >> 1;
            if (PH_ON) { pg8::Gemm g{XN, (const bf16*)(ws + (f ? W_GU1 : W_GU0)), M, 2 * DFF, DM}; pg8::StaticOrder S; S.init(M, 2 * DFF, F.G, (int)blockIdx.x);
                pg8::EpiSwiglu E{RA, DFF}; DUP(1, pg8::gemm_phase<pg8::EpiSwiglu, pg8::StaticOrder, true, true>(F.lds, g, S, E)); }
            PH_END;
            if (PH_ON) { pg8::Gemm g{RA, (const bf16*)(ws + (f ? W_DN1 : W_DN0)), M, DM, DFF}; pg8::StaticOrder S; S.init(M, DM, F.G, (int)blockIdx.x);
                pg8::EpiPlain E{RB, DM}; DUP(2, pg8::gemm_phase<pg8::EpiPlain, pg8::StaticOrder, true, true>(F.lds, g, S, E)); }
            PH_END;
            if (PH_ON) {
                if (f == 0) {
                    norm_phase(F, nullptr, xb, xb, RB, 0.5f, g6 + 1 * DM, g6 + 2 * DM, XN, kind == 1 ? 2 : 0, nullptr);
                } else {
                    const bool lastl = (L == DEPTH - 1);
                    if (!lastl) DUP(4, prep_layer(F, in, ws, L + 1));
                    norm_phase(F, nullptr, lastl ? xb2 : xb, xb, RB, 0.5f, g6 + 5 * DM, lastl ? nullptr : g6 + 6 * DM, XN, lastl ? 3 : 0, args.out);
                }
            }
            PH_END;
        } else {
            const bf16* WM = (const bf16*)(ws + W_MIX);
            const bf16* a_out; const bf16* w_out; int k_out;
            if (kind == 0) {
                if (PH_ON) { pg8::Gemm g{XN, WM, M, 3072, DM}; pg8::StaticOrder S; S.init(M, 3072, F.G, (int)blockIdx.x);
                    pg8::EpiPlain E{RA, 3072}; DUP(5, pg8::gemm_phase<pg8::EpiPlain, pg8::StaticOrder, true, true>(F.lds, g, S, E));
                    DUP(15, ml_gate_phase(F, XN, kin(in, 5) + (size_t)jm * DM * ML_IN, kin(in, 6) + jm * 8, (float*)(ws + WS_A + 192 * MiB))); }
                PH_END;
                if (PH_ON) DUP(6, ml_chunk_phase(F, RA, (const float*)(ws + WS_A + 192 * MiB), kin(in, 7) + (size_t)jm * 4 * DM, RB));
                PH_END;
                if (PH_ON) DUP(7, ml_head_phase(F, RB, RA, kin(in, 8) + (size_t)jm * DM, RB + (size_t)M * DM));
                PH_END;
                a_out = RB + (size_t)M * DM; w_out = WM + (size_t)3072 * 1024; k_out = DM;
            } else if (kind == 1) {
                bf16* lmid = RB; bf16* wag = RA + (size_t)M * 3072; bf16* yo = RB + (size_t)M * 256;
                if (PH_ON) { pg8::Gemm g{XN, WM, M, 3328, 2048}; pg8::StaticOrder S; S.init(M, 3328, F.G, (int)blockIdx.x);
                    pg8::EpiRw1 E{RA, lmid}; DUP(9, pg8::gemm_phase<pg8::EpiRw1, pg8::StaticOrder, true, true>(F.lds, g, S, E)); }
                PH_END;
                if (PH_ON) { int k_rw2 = 256; asm volatile("" : "+s"(k_rw2));
                    pg8::Gemm g{lmid, WM + (size_t)3328 * 2048, M, 3072, k_rw2}; pg8::StaticOrder S; S.init(M, 3072, F.G, (int)blockIdx.x);
                    pg8::EpiRw2 E{wag, kin(in, 12) + (size_t)jm * DM, kin(in, 15) + (size_t)jm * DM}; DUP(10, pg8::gemm_phase<pg8::EpiRw2, pg8::StaticOrder, true, true>(F.lds, g, S, E)); }
                PH_END;
                if (PH_ON) DUP(11, rw_scan_phase(F, RA, wag, kin(in, 20) + (size_t)jm * DM, kin(in, 21) + (size_t)jm * DM, kin(in, 22) + (size_t)jm * DM, kin(in, 23) + (size_t)jm * DM, kin(in, 24) + (size_t)jm * DM, yo));
                PH_END;
                a_out = yo; w_out = WM + (size_t)3328 * 2048 + (size_t)3072 * 256; k_out = DM;
            } else {
                if (PH_ON) { pg8::Gemm g{XN, WM, M, 6144, DM}; pg8::StaticOrder S; S.init(M, 6144, F.G, (int)blockIdx.x);
                    pg8::EpiRtIn E{RA, (const int*)kin(in, 1)}; DUP(12, pg8::gemm_phase<pg8::EpiRtIn, pg8::StaticOrder, true, true>(F.lds, g, S, E)); }
                PH_END;
                if (PH_ON) DUP(13, rt_chunk_phase(F, RA, RB));
                PH_END;
                if (PH_ON) rt_head_phase(F, RB, RA);
                PH_END;
                a_out = RB; w_out = WM + (size_t)6144 * 1024; k_out = 2048;
            }
            if (PH_ON) { pg8::Gemm g{a_out, w_out, M, DM, k_out}; pg8::StaticOrder S; S.init(M, DM, F.G, (int)blockIdx.x);
                pg8::EpiPlain E{MO, DM}; DUP(8, pg8::gemm_phase<pg8::EpiPlain, pg8::StaticOrder, true, true>(F.lds, g, S, E)); }
            PH_END;
            if (PH_ON) norm_phase(F, nullptr, xb, (L == DEPTH - 1) ? xb2 : xb, MO, 1.0f, g6 + 3 * DM, g6 + 4 * DM, XN, 0, nullptr);
            PH_END;
        }
    }
#undef PH_ON
#undef PH_END
}

extern "C" void kernel_launch(void* const* d_in, const int* in_sizes, int n_in, void* d_out, int out_size, void* d_ws, size_t ws_size, hipStream_t stream) {
    static int grid = 0;
    if (grid == 0) {
        if (n_in != 28 || out_size != M * DM || ws_size < WS_END) { fprintf(stderr, "kernel_launch: unexpected shapes: n_in %d out %d ws %zu (need %zu)\n", n_in, out_size, ws_size, (size_t)WS_END); grid = -1; return; }
        int dev = 0, cus = 0, per_cu = 0;
        if (hipGetDevice(&dev) != hipSuccess || hipDeviceGetAttribute(&cus, hipDeviceAttributeMultiprocessorCount, dev) != hipSuccess) { grid = -1; return; }
        if (hipFuncSetAttribute((const void*)mk_fwd, hipFuncAttributeMaxDynamicSharedMemorySize, LDS_BYTES) != hipSuccess) { fprintf(stderr, "kernel_launch: hipFuncSetAttribute failed\n"); grid = -1; return; }
        if (hipOccupancyMaxActiveBlocksPerMultiprocessor(&per_cu, (const void*)mk_fwd, NWAVES * 64, LDS_BYTES) != hipSuccess || per_cu < 1) { fprintf(stderr, "kernel_launch: occupancy query says %d\n", per_cu); (void)hipGetLastError(); grid = -1; return; }
        grid = cus;
    }
    if (grid < 0) return;
    (void)hipMemsetAsync((char*)d_ws + WS_CTL, 0, CTL_ZERO_BYTES, stream);
    Args a{};
    for (int i = 0; i < 28; ++i) a.in[i] = d_in[i];
    a.out = (float*)d_out; a.ws = (unsigned char*)d_ws;
#if MK_PER_PHASE
    for (int p = 0; p < N_PHASES; ++p) { a.p_lo = p; a.p_hi = p + 1; hipLaunchKernelGGL(mk_fwd, dim3(grid), dim3(NWAVES * 64), LDS_BYTES, stream, a); }
#else
    a.p_lo = 0; a.p_hi = N_PHASES;
    hipLaunchKernelGGL(mk_fwd, dim3(grid), dim3(NWAVES * 64), LDS_BYTES, stream, a);
#endif
}
```

```cpp
#include <hip/hip_runtime.h>
#include <cstdio>
#include <cstdint>

#ifndef MK_PER_PHASE
#define MK_PER_PHASE 0
#endif
#ifndef PROBE_DUP
#define PROBE_DUP 0
#endif

#define LAS __attribute__((address_space(3)))
#define GAS __attribute__((address_space(1)))
typedef unsigned short bf16;
typedef short bf16x8 __attribute__((ext_vector_type(8)));
typedef float f32x4 __attribute__((ext_vector_type(4)));
typedef float f32x2 __attribute__((ext_vector_type(2)));
typedef unsigned u32x4 __attribute__((ext_vector_type(4)));
typedef unsigned u32x2 __attribute__((ext_vector_type(2)));

constexpr int DM = 1024, NB = 16, SEQ = 2048, DEPTH = 4, DFF = 2816;
constexpr int M = NB * SEQ;
constexpr float NORM_EPS = 1e-6f;
constexpr int ML_IN = 3080;
constexpr int NWAVES = 8;

constexpr size_t MiB = 1u << 20;
constexpr size_t WS_CTL = 0, CTL_ZERO_BYTES = 1 * MiB;
constexpr size_t WS_W = 1 * MiB;
constexpr size_t W_GU0 = WS_W, W_DN0 = W_GU0 + (size_t)5632 * 1024 * 2, W_GU1 = W_DN0 + (size_t)1024 * 2816 * 2, W_DN1 = W_GU1 + (size_t)5632 * 1024 * 2;
constexpr size_t W_MIX = W_DN1 + (size_t)1024 * 2816 * 2;
constexpr size_t WS_XN = 58 * MiB;
constexpr size_t WS_MO = WS_XN + 64 * MiB;
constexpr size_t WS_A = 186 * MiB;
constexpr size_t WS_B = 570 * MiB;
constexpr size_t WS_END = 698 * MiB;
static_assert(W_MIX + (size_t)17 * MiB <= WS_XN, "weight region");
constexpr int CW_BAR = 4096;

constexpr int RING_BYTES = 131072;
constexpr int LDS_BYTES = 147456;
constexpr int MISC_OFF = 145408;

typedef __bf16 bf16x2_t __attribute__((ext_vector_type(2)));
__device__ __forceinline__ unsigned cvt_pk_bf16(float lo, float hi) { const f32x2 v = {lo, hi}; return __builtin_bit_cast(unsigned, __builtin_convertvector(v, bf16x2_t)); }
__device__ __forceinline__ float bf_lo(unsigned u) { return __uint_as_float(u << 16); }
__device__ __forceinline__ float bf_hi(unsigned u) { return __uint_as_float(u & 0xffff0000u); }
__device__ __forceinline__ float fexp(float x) { return __builtin_amdgcn_exp2f(x * 1.4426950408889634f); }
__device__ __forceinline__ float fsigmoid(float x) { return __builtin_amdgcn_rcpf(1.0f + fexp(-x)); }
__device__ __forceinline__ float ftanh(float x) { return 2.0f * fsigmoid(2.0f * x) - 1.0f; }
__device__ __forceinline__ float fsilu(float x) { return x * fsigmoid(x); }
template <int CTRL, int ROWMASK> __device__ __forceinline__ float dppmov(float old, float v) {
    return __builtin_bit_cast(float, __builtin_amdgcn_update_dpp(__builtin_bit_cast(int, old), __builtin_bit_cast(int, v), CTRL, ROWMASK, 0xf, false));
}
__device__ __forceinline__ float red16(float v) {
    v += dppmov<0x128, 0xf>(0.f, v); v += dppmov<0x124, 0xf>(0.f, v); v += dppmov<0x122, 0xf>(0.f, v); v += dppmov<0x121, 0xf>(0.f, v); return v; }
__device__ __forceinline__ float wave_sum(float v) {
    v = red16(v);
    const float s0 = __builtin_bit_cast(float, __builtin_amdgcn_readlane(__builtin_bit_cast(int, v), 0)), s1 = __builtin_bit_cast(float, __builtin_amdgcn_readlane(__builtin_bit_cast(int, v), 16));
    const float s2 = __builtin_bit_cast(float, __builtin_amdgcn_readlane(__builtin_bit_cast(int, v), 32)), s3 = __builtin_bit_cast(float, __builtin_amdgcn_readlane(__builtin_bit_cast(int, v), 48));
    return (s0 + s1) + (s2 + s3);
}
__device__ __forceinline__ float scan_sum64(float v) {
    v += dppmov<0x111, 0xf>(0.f, v); v += dppmov<0x112, 0xf>(0.f, v); v += dppmov<0x114, 0xf>(0.f, v); v += dppmov<0x118, 0xf>(0.f, v);
    v += dppmov<0x142, 0xa>(0.f, v); v += dppmov<0x143, 0xc>(0.f, v); return v; }
__device__ __forceinline__ float scan_max64(float v) {
    const float ninf = -__builtin_inff();
    v = fmaxf(v, dppmov<0x111, 0xf>(ninf, v)); v = fmaxf(v, dppmov<0x112, 0xf>(ninf, v)); v = fmaxf(v, dppmov<0x114, 0xf>(ninf, v)); v = fmaxf(v, dppmov<0x118, 0xf>(ninf, v));
    v = fmaxf(v, dppmov<0x142, 0xa>(ninf, v)); v = fmaxf(v, dppmov<0x143, 0xc>(ninf, v)); return v; }
__device__ __forceinline__ float lane63(float v) { return __builtin_bit_cast(float, __builtin_amdgcn_readlane(__builtin_bit_cast(int, v), 63)); }
__device__ __forceinline__ f32x4 mma16(bf16x8 x, bf16x8 y, f32x4 c) { return __builtin_amdgcn_mfma_f32_16x16x32_bf16(x, y, c, 0, 0, 0); }
#define LDS_WAIT() asm volatile("s_waitcnt lgkmcnt(0)" ::: "memory")
#define WG_BAR() do { asm volatile("s_waitcnt vmcnt(0) lgkmcnt(0)" ::: "memory"); __builtin_amdgcn_s_barrier(); asm volatile("" ::: "memory"); } while (0)
#define WG_BAR_L() do { asm volatile("s_waitcnt lgkmcnt(0)" ::: "memory"); __builtin_amdgcn_s_barrier(); asm volatile("" ::: "memory"); } while (0)

namespace pg8 {
#define PG8_LAS __attribute__((address_space(3)))
typedef unsigned short bf16_t;
constexpr int BM = 256, BK = 64, HALF = 128, HTB = HALF * BK * 2, STAGE_BYTES = 8 * HTB, NXCD = 8, WGM = 8;
__host__ __device__ __forceinline__ int lds_byte(int r, int c) { const int st = (r >> 4) * 2 + (c >> 5), rr = r & 15, cc = c & 31, ob = rr * 64 + cc * 2; return st * 1024 + (ob ^ (((ob >> 9) & 1) << 5)); }
__host__ __device__ __forceinline__ void stage_rc(int b, int& R, int& C) { const int st = b / 1024, sb = b % 1024, swz = sb ^ (((sb >> 9) & 1) << 5); R = (st >> 1) * 16 + swz / 64; C = (st & 1) * 32 + (swz % 64) / 2; }
__host__ __device__ __forceinline__ int perm32(int rho) { const int n = rho >> 4, i = rho & 15; return 8 * (i >> 2) + 4 * n + (i & 3); }

struct Unit { int pm, pn; };
struct Gemm { const bf16_t* A; const bf16_t* Bt; int M, N, K; };

struct StaticOrder {
    int nM, nN, nwg, G, c;
    __host__ __device__ void init(int M_, int N_, int G_, int c_) { nM = M_ / BM; nN = N_ / BM; nwg = nM * nN; G = G_; c = c_; }
    __host__ __device__ bool next(int i, Unit& u) const {
        const long L = (long)i * G + c; if (L >= nwg) return false;
        int wgid = (int)L; { const int q = nwg / NXCD, r = nwg % NXCD, xcd = wgid % NXCD, off = wgid / NXCD; wgid = (xcd < r ? xcd * (q + 1) : r * (q + 1) + (xcd - r) * q) + off; }
        const int nig = WGM * nN, gid = wgid / nig, fm = gid * WGM, gsz = (nM - fm) < WGM ? (nM - fm) : WGM;
        u.pm = fm + ((wgid % nig) % gsz); u.pn = (wgid % nig) / gsz; return true;
    }
    __device__ __forceinline__ void a_ready(const Unit&) const {}
    __device__ __forceinline__ void done(const Unit&) const {}
};

__device__ __forceinline__ u32x4 pack8(f32x4 v0, f32x4 v1) { u32x4 w; w.x = cvt_pk_bf16(v0[0], v0[1]); w.y = cvt_pk_bf16(v0[2], v0[3]); w.z = cvt_pk_bf16(v1[0], v1[1]); w.w = cvt_pk_bf16(v1[2], v1[3]); return w; }

struct EpiPlain {
    static constexpr bool PERM = true, AFTER_DRAIN = false;
    bf16_t* O; int ldc;
    __device__ __forceinline__ void operator()(const f32x4 (&acc)[2][2][4][2], const Unit& u, int wr, int wc, int fr, int fq) const {
        const int row0 = u.pm * BM + wr * 64 + fr, col0 = u.pn * BM + wc * 32 + 8 * fq;
#pragma unroll
        for (int ai = 0; ai < 2; ++ai)
#pragma unroll
            for (int m = 0; m < 4; ++m) { bf16_t* rowp = O + (size_t)(row0 + ai * HALF + m * 16) * ldc + col0;
#pragma unroll
                for (int bj = 0; bj < 2; ++bj) *(u32x4*)(rowp + bj * HALF) = pack8(acc[ai][bj][m][0], acc[ai][bj][m][1]); }
    }
};
struct EpiSwiglu {
    static constexpr bool PERM = true, AFTER_DRAIN = false;
    bf16_t* O; int ldc;
    __device__ __forceinline__ void operator()(const f32x4 (&acc)[2][2][4][2], const Unit& u, int wr, int wc, int fr, int fq) const {
        const int row0 = u.pm * BM + wr * 64 + fr, col0 = u.pn * HALF + wc * 32 + 8 * fq;
#pragma unroll
        for (int ai = 0; ai < 2; ++ai)
#pragma unroll
            for (int m = 0; m < 4; ++m) { bf16_t* rowp = O + (size_t)(row0 + ai * HALF + m * 16) * ldc + col0;
                f32x4 o[2];
#pragma unroll
                for (int n = 0; n < 2; ++n)
#pragma unroll
                    for (int e = 0; e < 4; ++e) { const float g = acc[ai][0][m][n][e]; o[n][e] = g * fsigmoid(g) * acc[ai][1][m][n][e]; }
                *(u32x4*)rowp = pack8(o[0], o[1]); }
    }
};
struct EpiRw1 {
    static constexpr bool PERM = true, AFTER_DRAIN = false;
    bf16_t* rkv; bf16_t* lmid;
    __device__ __forceinline__ void operator()(const f32x4 (&acc)[2][2][4][2], const Unit& u, int wr, int wc, int fr, int fq) const {
        const int row0 = u.pm * BM + wr * 64 + fr;
        if (u.pn < 12) {
            const int col0 = u.pn * BM + wc * 32 + 8 * fq;
#pragma unroll
            for (int ai = 0; ai < 2; ++ai)
#pragma unroll
                for (int m = 0; m < 4; ++m) { bf16_t* rowp = rkv + (size_t)(row0 + ai * HALF + m * 16) * 3072 + col0;
#pragma unroll
                    for (int bj = 0; bj < 2; ++bj) *(u32x4*)(rowp + bj * HALF) = pack8(acc[ai][bj][m][0], acc[ai][bj][m][1]); }
        } else {
            const int col0 = wc * 32 + 8 * fq;
#pragma unroll
            for (int ai = 0; ai < 2; ++ai)
#pragma unroll
                for (int m = 0; m < 4; ++m) { bf16_t* rowp = lmid + (size_t)(row0 + ai * HALF + m * 16) * 256 + col0;
#pragma unroll
                    for (int bj = 0; bj < 2; ++bj) { f32x4 o[2];
#pragma unroll
                        for (int n = 0; n < 2; ++n)
#pragma unroll
                            for (int e = 0; e < 4; ++e) { const float v = acc[ai][bj][m][n][e]; o[n][e] = (bj == 1) ? fsigmoid(v) : (wc < 2 ? ftanh(v) : v); }
                        *(u32x4*)(rowp + bj * HALF) = pack8(o[0], o[1]); } }
        }
    }
};
struct EpiRw2 {
    static constexpr bool PERM = true, AFTER_DRAIN = false;
    bf16_t* O; const float* w0; const float* a0;
    __device__ __forceinline__ void operator()(const f32x4 (&acc)[2][2][4][2], const Unit& u, int wr, int wc, int fr, int fq) const {
        const int row0 = u.pm * BM + wr * 64 + fr, col0 = u.pn * BM + wc * 32 + 8 * fq, kind = u.pn >> 2, cc0 = (u.pn & 3) * BM + wc * 32 + 8 * fq;
        if (kind == 2) {
#pragma unroll
            for (int ai = 0; ai < 2; ++ai)
#pragma unroll
                for (int m = 0; m < 4; ++m) { bf16_t* rowp = O + (size_t)(row0 + ai * HALF + m * 16) * 3072 + col0;
#pragma unroll
                    for (int bj = 0; bj < 2; ++bj) *(u32x4*)(rowp + bj * HALF) = pack8(acc[ai][bj][m][0], acc[ai][bj][m][1]); }
        } else {
            const float* bp = (kind == 0 ? w0 : a0) + cc0; const float sc = kind == 0 ? -0.60653065971f : 1.0f;
#pragma unroll
            for (int bj = 0; bj < 2; ++bj) {
                const f32x4 b0 = *(const f32x4*)(bp + bj * HALF), b1 = *(const f32x4*)(bp + bj * HALF + 4);
#pragma unroll
                for (int ai = 0; ai < 2; ++ai)
#pragma unroll
                    for (int m = 0; m < 4; ++m) { bf16_t* rowp = O + (size_t)(row0 + ai * HALF + m * 16) * 3072 + col0; f32x4 o0, o1;
#pragma unroll
                        for (int e = 0; e < 4; ++e) { o0[e] = sc * fsigmoid(acc[ai][bj][m][0][e] + b0[e]); o1[e] = sc * fsigmoid(acc[ai][bj][m][1][e] + b1[e]); }
                        *(u32x4*)(rowp + bj * HALF) = pack8(o0, o1); }
            }
        }
    }
};
struct EpiRtIn {
    static constexpr bool PERM = true, AFTER_DRAIN = false;
    bf16_t* O; const int* pos;
    __device__ __forceinline__ void operator()(const f32x4 (&acc)[2][2][4][2], const Unit& u, int wr, int wc, int fr, int fq) const {
        const int row0 = u.pm * BM + wr * 64 + fr, col0 = u.pn * BM + wc * 32 + 8 * fq;
        if (u.pn >= 8) {
#pragma unroll
            for (int ai = 0; ai < 2; ++ai)
#pragma unroll
                for (int m = 0; m < 4; ++m) { bf16_t* rowp = O + (size_t)(row0 + ai * HALF + m * 16) * 6144 + col0;
#pragma unroll
                    for (int bj = 0; bj < 2; ++bj) *(u32x4*)(rowp + bj * HALF) = pack8(acc[ai][bj][m][0], acc[ai][bj][m][1]); }
        } else {
            const float sc = u.pn >= 4 ? 0.0625f : 1.0f;
            float invf[2][4];
#pragma unroll
            for (int n = 0; n < 2; ++n)
#pragma unroll
                for (int e = 0; e < 4; ++e) { const int i = wc * 32 + 8 * fq + 4 * n + e; invf[n][e] = __builtin_amdgcn_exp2f((float)i * (-13.287712379549449f / 127.0f)) * 0.15915494309189535f; }
#pragma unroll
            for (int ai = 0; ai < 2; ++ai)
#pragma unroll
                for (int m = 0; m < 4; ++m) { const int row = row0 + ai * HALF + m * 16; const float p = (float)pos[row]; bf16_t* rowp = O + (size_t)row * 6144 + col0;
                    f32x4 o1[2], o2[2];
#pragma unroll
                    for (int n = 0; n < 2; ++n)
#pragma unroll
                        for (int e = 0; e < 4; ++e) { float rev = p * invf[n][e]; rev = rev - __builtin_floorf(rev);
                            const float sn = __builtin_amdgcn_sinf(rev), cs = __builtin_amdgcn_cosf(rev);
                            const float u1 = acc[ai][0][m][n][e], u2 = acc[ai][1][m][n][e];
                            o1[n][e] = (u1 * cs - u2 * sn) * sc; o2[n][e] = (u1 * sn + u2 * cs) * sc; }
                    *(u32x4*)rowp = pack8(o1[0], o1[1]); *(u32x4*)(rowp + HALF) = pack8(o2[0], o2[1]); }
        }
    }
};

template <class Epi, class Sched, bool ALIGN_EPI = false, bool SP2 = false>
__device__ __forceinline__ void gemm_phase(PG8_LAS unsigned char* lds, const Gemm g, const Sched& S, const Epi& E) {
    int tid_ = threadIdx.x; asm volatile("" : "+v"(tid_));
    const int tid = tid_, wid = __builtin_amdgcn_readfirstlane(tid >> 6), lane = tid & 63, wr = wid >> 2, wc = wid & 3, fr = lane & 15, fq = lane >> 4;
    const int K = g.K, nt = K / BK;
    unsigned voffA[2], voffB[2];
#pragma unroll
    for (int i = 0; i < 2; ++i) { int R, C; stage_rc(tid * 16 + i * 8192, R, C); const int Rb = Epi::PERM ? ((R & ~31) + perm32(R & 31)) : R;
        voffA[i] = (unsigned)(R * K + C) * 2u; voffB[i] = (unsigned)(Rb * K + C) * 2u; }
    const size_t kstep = (size_t)(BK * 2);
    const size_t hstep = (size_t)HALF * K * 2;
    const size_t tstep = 2 * hstep;
    const unsigned ldsw = (unsigned)wid * 1024u;
    const int aoff = lds_byte(wr * 64 + fr, fq * 8), boff = lds_byte(wc * 32 + fr, fq * 8);
#define PG8_SA(b, h) (((b) * 2 + (h)) * HTB)
#define PG8_SB(b, h) ((4 + (b) * 2 + (h)) * HTB)
#define PG8_STAGE(bufoff, gbase, voff) do { _Pragma("unroll") for (int _i = 0; _i < 2; ++_i) \
        __builtin_amdgcn_global_load_lds((const unsigned*)((const char*)(gbase) + (voff)[_i]), (PG8_LAS unsigned*)(lds + (bufoff) + ldsw + _i * 8192), 16, 0, 0); } while (0)
#define PG8_LDA(dst, b, h) do { _Pragma("unroll") for (int m = 0; m < 4; ++m) _Pragma("unroll") for (int k = 0; k < 2; ++k) dst[m][k] = *(const PG8_LAS bf16x8*)(lds + PG8_SA(b, h) + aoff + m * 2048 + k * 1024); } while (0)
#define PG8_LDB(dst, b, h) do { _Pragma("unroll") for (int n = 0; n < 2; ++n) _Pragma("unroll") for (int k = 0; k < 2; ++k) dst[n][k] = *(const PG8_LAS bf16x8*)(lds + PG8_SB(b, h) + boff + n * 2048 + k * 1024); } while (0)
#define PG8_MMA(ai, bj, At, Bt) do { __builtin_amdgcn_s_setprio(1); _Pragma("unroll") for (int m = 0; m < 4; ++m) _Pragma("unroll") for (int n = 0; n < 2; ++n) _Pragma("unroll") for (int k = 0; k < 2; ++k) \
        acc[ai][bj][m][n] = __builtin_amdgcn_mfma_f32_16x16x32_bf16(Bt[n][k], At[m][k], acc[ai][bj][m][n], 0, 0, 0); __builtin_amdgcn_s_setprio(0); } while (0)
#define PG8_WAIT_V(n) asm volatile("s_waitcnt vmcnt(" #n ")" ::: "memory")
#define PG8_WAIT_L(n) asm volatile("s_waitcnt lgkmcnt(" #n ")" ::: "memory")
#define PG8_BAR __builtin_amdgcn_s_barrier()
#define PG8_SCHED __builtin_amdgcn_sched_barrier(0)
    Unit cur, nxt; int ui = 0;
    if (!S.next(0, cur)) return;
    f32x4 acc[2][2][4][2];
#pragma unroll
    for (int a = 0; a < 2; ++a)
#pragma unroll
        for (int b = 0; b < 2; ++b)
#pragma unroll
            for (int m = 0; m < 4; ++m)
#pragma unroll
                for (int n = 0; n < 2; ++n) acc[a][b][m][n] = (f32x4){0.f, 0.f, 0.f, 0.f};
    bf16x8 At[4][2], B0[2][2], B1[2][2];
    const char* cA = (const char*)g.A + (size_t)cur.pm * tstep; const char* cB = (const char*)g.Bt + (size_t)cur.pn * tstep;
    S.a_ready(cur);
    if constexpr (SP2) {
        PG8_STAGE(PG8_SB(0, 0), cB, voffB); PG8_STAGE(PG8_SB(0, 1), cB + hstep, voffB); PG8_STAGE(PG8_SA(0, 0), cA, voffA); PG8_STAGE(PG8_SA(0, 1), cA + hstep, voffA);
        if (wr == 1) PG8_BAR;
        PG8_WAIT_V(2); PG8_BAR;
        PG8_STAGE(PG8_SB(1, 0), cB + kstep, voffB); PG8_STAGE(PG8_SA(1, 0), cA + kstep, voffA); PG8_STAGE(PG8_SB(1, 1), cB + hstep + kstep, voffB);
        PG8_WAIT_V(6); PG8_BAR;
    } else {
        PG8_STAGE(PG8_SB(0, 0), cB, voffB); PG8_STAGE(PG8_SA(0, 0), cA, voffA); PG8_STAGE(PG8_SB(0, 1), cB + hstep, voffB); PG8_STAGE(PG8_SA(0, 1), cA + hstep, voffA);
        if (wr == 1) PG8_BAR;
        PG8_WAIT_V(4); PG8_BAR;
        PG8_STAGE(PG8_SB(1, 0), cB + kstep, voffB); PG8_STAGE(PG8_SA(1, 0), cA + kstep, voffA); PG8_STAGE(PG8_SB(1, 1), cB + hstep + kstep, voffB);
        PG8_WAIT_V(6); PG8_BAR;
    }
    for (;;) {
        const bool has_next = S.next(ui + 1, nxt);
        const char* nA = has_next ? (const char*)g.A + (size_t)nxt.pm * tstep : cA; const char* nB = has_next ? (const char*)g.Bt + (size_t)nxt.pn * tstep : cB;
        for (int t = 0; t < nt; t += 2) {
            const bool last = (t == nt - 2);
            const char* a1 = cA + (size_t)(t + 1) * kstep;
            const char* a2 = last ? nA : cA + (size_t)(t + 2) * kstep; const char* b2 = last ? nB : cB + (size_t)(t + 2) * kstep;
            const char* a3 = a2 + kstep; const char* b3 = b2 + kstep;
            if (last && has_next) S.a_ready(nxt);
            if constexpr (SP2) {
            PG8_LDB(B0, 0, 0); PG8_LDB(B1, 0, 1); PG8_SCHED; PG8_LDA(At, 0, 0); PG8_STAGE(PG8_SA(1, 1), a1 + hstep, voffA);
            PG8_WAIT_V(8); PG8_WAIT_L(0); PG8_BAR; PG8_MMA(0, 0, At, B0); PG8_MMA(0, 1, At, B1); PG8_BAR; PG8_SCHED;
            PG8_LDA(At, 0, 1); PG8_STAGE(PG8_SB(0, 0), b2, voffB); PG8_STAGE(PG8_SB(0, 1), b2 + hstep, voffB); PG8_STAGE(PG8_SA(0, 0), a2, voffA);
            PG8_WAIT_V(8); PG8_WAIT_L(0); PG8_BAR; PG8_MMA(1, 0, At, B0); PG8_MMA(1, 1, At, B1); PG8_BAR; PG8_SCHED;
            PG8_LDB(B0, 1, 0); PG8_LDB(B1, 1, 1); PG8_SCHED; PG8_LDA(At, 1, 0); PG8_STAGE(PG8_SA(0, 1), a2 + hstep, voffA);
            PG8_WAIT_V(8); PG8_WAIT_L(0); PG8_BAR; PG8_MMA(0, 0, At, B0); PG8_MMA(0, 1, At, B1); PG8_BAR; PG8_SCHED;
            PG8_LDA(At, 1, 1); PG8_STAGE(PG8_SB(1, 0), b3, voffB); PG8_STAGE(PG8_SB(1, 1), b3 + hstep, voffB); PG8_STAGE(PG8_SA(1, 0), a3, voffA);
            PG8_WAIT_V(8); PG8_WAIT_L(0); PG8_BAR; PG8_MMA(1, 0, At, B0); PG8_MMA(1, 1, At, B1); PG8_BAR; PG8_SCHED;
            } else {
            PG8_LDB(B0, 0, 0); PG8_SCHED; PG8_LDA(At, 0, 0); PG8_STAGE(PG8_SA(1, 1), a1 + hstep, voffA);
            PG8_WAIT_L(8); PG8_BAR; PG8_WAIT_L(0); PG8_MMA(0, 0, At, B0); PG8_BAR; PG8_SCHED;
            PG8_LDB(B1, 0, 1); PG8_STAGE(PG8_SB(0, 0), b2, voffB);
            PG8_BAR; PG8_WAIT_L(0); PG8_MMA(0, 1, At, B1); PG8_BAR;
            PG8_LDA(At, 0, 1); PG8_STAGE(PG8_SA(0, 0), a2, voffA);
            PG8_BAR; PG8_WAIT_L(0); PG8_MMA(1, 0, At, B0); PG8_BAR; PG8_SCHED;
            PG8_STAGE(PG8_SB(0, 1), b2 + hstep, voffB);
            PG8_WAIT_V(6); PG8_BAR; PG8_MMA(1, 1, At, B1); PG8_BAR;
            PG8_LDB(B0, 1, 0); PG8_SCHED; PG8_LDA(At, 1, 0); PG8_STAGE(PG8_SA(0, 1), a2 + hstep, voffA);
            PG8_WAIT_L(8); PG8_BAR; PG8_WAIT_L(0); PG8_MMA(0, 0, At, B0); PG8_BAR; PG8_SCHED;
            PG8_LDB(B1, 1, 1); PG8_STAGE(PG8_SB(1, 0), b3, voffB);
            PG8_BAR; PG8_WAIT_L(0); PG8_MMA(0, 1, At, B1); PG8_BAR;
            PG8_LDA(At, 1, 1); PG8_STAGE(PG8_SA(1, 0), a3, voffA);
            PG8_BAR; PG8_WAIT_L(0); PG8_MMA(1, 0, At, B0); PG8_BAR; PG8_SCHED;
            PG8_STAGE(PG8_SB(1, 1), b3 + hstep, voffB);
            PG8_WAIT_V(6); PG8_BAR; PG8_MMA(1, 1, At, B1); PG8_BAR;
            }
        }
        if constexpr (ALIGN_EPI) { if (wr == 0) PG8_BAR; }
        if constexpr (!Epi::AFTER_DRAIN) { E(acc, cur, wr, wc, fr, fq); S.done(cur); }
        if (!has_next) break;
#pragma unroll
        for (int a = 0; a < 2; ++a)
#pragma unroll
            for (int b = 0; b < 2; ++b)
#pragma unroll
                for (int m = 0; m < 4; ++m)
#pragma unroll
                    for (int n = 0; n < 2; ++n) acc[a][b][m][n] = (f32x4){0.f, 0.f, 0.f, 0.f};
        cur = nxt; cA = nA; cB = nB; ++ui;
        if constexpr (ALIGN_EPI) { if (wr == 1) PG8_BAR; }
    }
    PG8_WAIT_V(0);
    if constexpr (!ALIGN_EPI) { if (wr == 0) PG8_BAR; }
    PG8_BAR;
#undef PG8_SA
#undef PG8_SB
#undef PG8_STAGE
#undef PG8_LDA
#undef PG8_LDB
#undef PG8_MMA
#undef PG8_WAIT_V
#undef PG8_WAIT_L
#undef PG8_BAR
#undef PG8_SCHED
}
}

#define XB_TMO      128
#define XB_XCNT(j)  (256  + 64 * (j))
#define XB_XSUB(j)  (1280 + 64 * (j))
#define XB_XGEN(j)  (2304 + 64 * (j))
#define XB_TOP      3328
#define XB_TOPGEN   3392
#define XCD_BAR_WORDS 3456
#define XB_SPIN_CAP (1u << 18)

__device__ __forceinline__ unsigned xb_ld(unsigned* p)              { return __hip_atomic_load(p, __ATOMIC_RELAXED, __HIP_MEMORY_SCOPE_AGENT); }
__device__ __forceinline__ unsigned xb_add(unsigned* p, unsigned v) { return __hip_atomic_fetch_add(p, v, __ATOMIC_RELAXED, __HIP_MEMORY_SCOPE_AGENT); }
__device__ __forceinline__ unsigned xb_xcc_id() { return (unsigned)__builtin_amdgcn_s_getreg((3 << 11) | 20) & 0xFu; }
#define XB_SPIN(cond, bar) do { unsigned _sp = 0; while (cond) { __builtin_amdgcn_s_sleep(1); \
    if ((++_sp & 255u) == 0u) { if (xb_ld(&(bar)[XB_TMO])) break; if (_sp > XB_SPIN_CAP) { atomicAdd(&(bar)[XB_TMO], 1u); break; } } } } while (0)

struct XcdBarrier { unsigned* bar; unsigned x; volatile LAS unsigned* st; };

__device__ __forceinline__ XcdBarrier xcd_barrier_post(unsigned* bar, volatile LAS unsigned* st) {
    XcdBarrier b; b.bar = bar; b.x = xb_xcc_id(); b.st = st;
    if (threadIdx.x == 0) (void)xb_add(&bar[XB_XCNT(b.x)], 1u);
    return b;
}
__device__ __forceinline__ void xcd_barrier_complete(unsigned* bar, unsigned x, unsigned& nloc, unsigned& nx) {
    const unsigned G = gridDim.x * gridDim.y * gridDim.z;
    unsigned sum, cnt, mine, sp = 0u;
    for (;;) {
        sum = 0u; cnt = 0u; mine = 0u;
#pragma unroll
        for (unsigned j = 0; j < 16; ++j) { const unsigned c = xb_ld(&bar[XB_XCNT(j)]); sum += c; cnt += (c > 0u) ? 1u : 0u; mine = (j == x) ? c : mine; }
        if (sum == G) break;
        __builtin_amdgcn_s_sleep(1);
        if ((++sp & 255u) == 0u) { if (xb_ld(&bar[XB_TMO])) break; if (sp > XB_SPIN_CAP) { atomicAdd(&bar[XB_TMO], 1u); break; } }
    }
    nloc = mine > 0u ? mine : 1u; nx = cnt > 0u ? cnt : 1u;
}
__device__ __forceinline__ void xcd_barrier(const XcdBarrier& b) {
    asm volatile("s_waitcnt vmcnt(0)" ::: "memory");
    __syncthreads();
    if (threadIdx.x == 0) {
        unsigned* bar = b.bar;
        __builtin_amdgcn_s_waitcnt(0);
        unsigned nloc = b.st[0], nx = b.st[1];
        if (nloc == 0u) { xcd_barrier_complete(bar, b.x, nloc, nx); b.st[0] = nloc; b.st[1] = nx; }
        const unsigned old = xb_add(&bar[XB_XSUB(b.x)], 1u);
        const unsigned gen = old / nloc;
        if (old + 1u == (gen + 1u) * nloc) {
            __builtin_amdgcn_fence(__ATOMIC_RELEASE, "agent");
            asm volatile("s_waitcnt vmcnt(0)" ::: "memory");
            const unsigned og = xb_add(&bar[XB_TOP], 1u);
            const unsigned tg = og / nx;
            if (og + 1u == (tg + 1u) * nx) xb_add(&bar[XB_TOPGEN], 1u);
            else XB_SPIN(xb_ld(&bar[XB_TOPGEN]) == tg, bar);
            __builtin_amdgcn_fence(__ATOMIC_ACQUIRE, "agent");
            xb_add(&bar[XB_XGEN(b.x)], 1u);
            asm volatile("s_waitcnt vmcnt(0)" ::: "memory");
        } else {
            XB_SPIN(xb_ld(&bar[XB_XGEN(b.x)]) == gen, bar);
            __builtin_amdgcn_fence(__ATOMIC_ACQUIRE, "agent");
            asm volatile("s_waitcnt vmcnt(0)" ::: "memory");
        }
    }
    __syncthreads();
}

struct Frame {
    LAS unsigned char* lds;
    int vcu, G;
};
__device__ __forceinline__ int opaque_tid() { int t = threadIdx.x; asm volatile("" : "+v"(t)); return t; }
#define PH_IDS const int tid = opaque_tid(), lane = tid & 63, w = __builtin_amdgcn_readfirstlane(tid >> 6); (void)tid; (void)lane; (void)w

template <class SrcF>
__device__ __forceinline__ void prep_matrix(const Frame& F, int K, int N, bf16* WT, SrcF src) {
    PH_IDS;
    LAS float* scr = (LAS float*)(F.lds + w * 8448);
    const int gw = F.vcu * NWAVES + w, NGW = F.G * NWAVES;
    const int nblk = N / 32, nitems = (K / 64) * nblk;
    for (int it = gw; it < nitems; it += NGW) {
        const int kb = it / nblk, nb = it % nblk, k0 = 64 * kb, n0 = 32 * nb;
        float tv[32];
#pragma unroll
        for (int i = 0; i < 32; ++i) tv[i] = src(k0 + 2 * i + (lane >> 5), n0 + (lane & 31));
#pragma unroll
        for (int i = 0; i < 32; ++i) scr[(2 * i + (lane >> 5)) * 33 + (lane & 31)] = tv[i];
        LDS_WAIT();
        const int c = lane & 7;
#pragma unroll
        for (int j = 0; j < 4; ++j) { const int n = (lane >> 3) + 8 * j; const LAS float* s = scr + (8 * c) * 33 + n;
            u32x4 o; o.x = cvt_pk_bf16(s[0 * 33], s[1 * 33]); o.y = cvt_pk_bf16(s[2 * 33], s[3 * 33]); o.z = cvt_pk_bf16(s[4 * 33], s[5 * 33]); o.w = cvt_pk_bf16(s[6 * 33], s[7 * 33]);
            *(u32x4*)(WT + (size_t)(n0 + n) * K + k0 + 8 * c) = o; }
        LDS_WAIT();
    }
}

struct Args { const void* in[28]; float* out; unsigned char* ws; int p_lo, p_hi; };
__device__ __forceinline__ const float* kin(const Args& a, int i) { asm volatile("" : "+s"(i)); return (const float*)a.in[i]; }

__device__ __forceinline__ void prep_layer(const Frame& F, const Args& in, unsigned char* ws, int L) {
    const int kind = L % 3, j = L / 3;
#pragma unroll 1
    for (int f = 0; f < 2; ++f) {
        const float* wgu = kin(in, 3) + (size_t)(L * 2 + f) * DM * 2 * DFF;
        const float* gpre = kin(in, 2) + (size_t)(L * 6 + (f ? 4 : 0)) * DM;
        prep_matrix(F, DM, 2 * DFF, (bf16*)(ws + (f ? W_GU1 : W_GU0)), [=](int k, int n) { const int pn = n >> 8, r = n & 255; const int sc = (r < 128) ? (pn * 128 + r) : (DFF + pn * 128 + (r - 128)); return wgu[(size_t)k * (2 * DFF) + sc] * gpre[k]; });
        const float* wdn = kin(in, 4) + (size_t)(L * 2 + f) * DFF * DM;
        prep_matrix(F, DFF, DM, (bf16*)(ws + (f ? W_DN1 : W_DN0)), [=](int k, int n) { return wdn[(size_t)k * DM + n]; });
    }
    if (kind == 0) {
        const float* win = kin(in, 5) + (size_t)j * DM * ML_IN;
        const float* g2 = kin(in, 2) + (size_t)(L * 6 + 2) * DM;
        prep_matrix(F, DM, 3072, (bf16*)(ws + W_MIX), [=](int k, int n) { return win[(size_t)k * ML_IN + n] * g2[k]; });
        const float* wo = kin(in, 9) + (size_t)j * DM * DM;
        prep_matrix(F, DM, DM, (bf16*)(ws + W_MIX + (size_t)3072 * 1024 * 2), [=](int k, int n) { return wo[(size_t)k * DM + n]; });
    } else if (kind == 1) {
        const float* mu = kin(in, 10) + (size_t)j * 6 * DM; const float* wrkv = kin(in, 11) + (size_t)j * 3 * DM * DM;
        const float* w1 = kin(in, 13) + (size_t)j * DM * 64; const float* a1 = kin(in, 16) + (size_t)j * DM * 64; const float* g1 = kin(in, 18) + (size_t)j * DM * 128;
        prep_matrix(F, 2048, 3328, (bf16*)(ws + W_MIX), [=](int k, int n) {
            const int kk = k & 1023; const bool hi = k >= 1024; float w; int mi;
            if (n < 3072) { mi = n >> 10; w = wrkv[((size_t)mi * DM + kk) * DM + (n & 1023)]; }
            else { const int c = n - 3072; if (c < 64) { mi = 3; w = w1[kk * 64 + c]; } else if (c < 128) { mi = 4; w = a1[kk * 64 + (c - 64)]; } else { mi = 5; w = g1[kk * 128 + (c - 128)]; } }
            const float m = mu[mi * DM + kk]; return w * (hi ? m : 1.0f - m); });
        const float* w2 = kin(in, 14) + (size_t)j * 64 * DM; const float* a2 = kin(in, 17) + (size_t)j * 64 * DM; const float* g2 = kin(in, 19) + (size_t)j * 128 * DM;
        prep_matrix(F, 256, 3072, (bf16*)(ws + W_MIX + (size_t)3328 * 2048 * 2), [=](int k, int n) {
            const int t = n >> 10, c = n & 1023;
            if (t == 0) return k < 64 ? w2[k * DM + c] : 0.f;
            if (t == 1) return (k >= 64 && k < 128) ? a2[(k - 64) * DM + c] : 0.f;
            return k >= 128 ? g2[(k - 128) * DM + c] : 0.f; });
        const float* wo = kin(in, 25) + (size_t)j * DM * DM;
        prep_matrix(F, DM, DM, (bf16*)(ws + W_MIX + (size_t)3328 * 2048 * 2 + (size_t)3072 * 256 * 2), [=](int k, int n) { return wo[(size_t)k * DM + n]; });
    } else {
        const float* win = kin(in, 26) + (size_t)j * DM * 6144;
        const float* g2 = kin(in, 2) + (size_t)(L * 6 + 2) * DM;
        prep_matrix(F, DM, 6144, (bf16*)(ws + W_MIX), [=](int k, int n) { return win[(size_t)k * 6144 + n] * g2[k]; });
        const float* wo = kin(in, 27) + (size_t)j * 2048 * DM;
        prep_matrix(F, 2048, DM, (bf16*)(ws + W_MIX + (size_t)6144 * 1024 * 2), [=](int k, int n) { return wo[(size_t)k * DM + n]; });
    }
}

__device__ __forceinline__ void norm_phase(const Frame& F, const float* x0, const bf16* xbi, bf16* xb, float* rho, const bf16* h, float c, const float* gpost, const float* gpre, bf16* xn, int mode, float* fout) {
    PH_IDS;
    const int gw = F.vcu * NWAVES + w, NGW = F.G * NWAVES;
    f32x4 gp[4], gq[4];
#pragma unroll
    for (int j = 0; j < 4; ++j) { gp[j] = h ? *(const f32x4*)(gpost + 4 * lane + 256 * j) : (f32x4){0.f, 0.f, 0.f, 0.f}; gq[j] = (mode == 2) ? *(const f32x4*)(gpre + 4 * lane + 256 * j) : (f32x4){0.f, 0.f, 0.f, 0.f}; }
    for (int m = gw; m < M; m += NGW) {
        f32x4 v[4];
        if (x0) {
#pragma unroll
            for (int j = 0; j < 4; ++j) v[j] = *(const f32x4*)(x0 + (size_t)m * DM + 4 * lane + 256 * j);
        } else {
            const float rh = rho[m];
#pragma unroll
            for (int j = 0; j < 4; ++j) { const u32x2 r = *(const u32x2*)(xbi + (size_t)m * DM + 4 * lane + 256 * j); v[j] = (f32x4){bf_lo(r.x), bf_hi(r.x), bf_lo(r.y), bf_hi(r.y)} * rh; }
        }
        if (h) {
            f32x4 hv[4]; float s = 0.f;
#pragma unroll
            for (int j = 0; j < 4; ++j) { const u32x2 r = *(const u32x2*)(h + (size_t)m * DM + 4 * lane + 256 * j); hv[j] = (f32x4){bf_lo(r.x), bf_hi(r.x), bf_lo(r.y), bf_hi(r.y)};
                s += (hv[j][0] * hv[j][0] + hv[j][1] * hv[j][1]) + (hv[j][2] * hv[j][2] + hv[j][3] * hv[j][3]); }
            const float rs = __builtin_amdgcn_rsqf(wave_sum(s) * (1.0f / DM) + NORM_EPS) * c;
#pragma unroll
            for (int j = 0; j < 4; ++j) v[j] += hv[j] * rs * gp[j];
        }
        if (mode == 3) {
            float* o = fout + (size_t)m * DM;
#pragma unroll
            for (int j = 0; j < 4; ++j) *(f32x4*)(o + 4 * lane + 256 * j) = v[j];
        } else {
            float s = 0.f;
#pragma unroll
            for (int j = 0; j < 4; ++j) s += (v[j][0] * v[j][0] + v[j][1] * v[j][1]) + (v[j][2] * v[j][2] + v[j][3] * v[j][3]);
            const float ms = wave_sum(s) * (1.0f / DM) + NORM_EPS;
            const float rs = __builtin_amdgcn_rsqf(ms);
            if (lane == 0) rho[m] = ms * rs;
#pragma unroll
            for (int j = 0; j < 4; ++j) { v[j] = v[j] * rs; u32x2 o; o.x = cvt_pk_bf16(v[j][0], v[j][1]); o.y = cvt_pk_bf16(v[j][2], v[j][3]); *(u32x2*)(xb + (size_t)m * DM + 4 * lane + 256 * j) = o; }
            if (mode == 2) {
                u32x2 yb[4];
#pragma unroll
                for (int j = 0; j < 4; ++j) { const f32x4 y = v[j] * gq[j]; yb[j].x = cvt_pk_bf16(y[0], y[1]); yb[j].y = cvt_pk_bf16(y[2], y[3]); }
                const int t = m & (SEQ - 1);
#pragma unroll
                for (int j = 0; j < 4; ++j) {
                    *(u32x2*)(xn + (size_t)m * 2048 + 4 * lane + 256 * j) = yb[j];
                    if (t != SEQ - 1) *(u32x2*)(xn + (size_t)(m + 1) * 2048 + 1024 + 4 * lane + 256 * j) = yb[j];
                    if (t == 0) { unsigned z = 0u; asm volatile("" : "+v"(z)); *(u32x2*)(xn + (size_t)m * 2048 + 1024 + 4 * lane + 256 * j) = (u32x2){z, z}; }
                }
            }
        }
    }
}

__device__ __forceinline__ void ml_gate_phase(const Frame& F, const bf16* xn, const float* gpre, const float* w_in, const float* b_if, float* ifg) {
    PH_IDS;
    const int gw = F.vcu * NWAVES + w, NGW = F.G * NWAVES;
    f32x4 wif[8][4];
#pragma unroll
    for (int j = 0; j < 4; ++j)
#pragma unroll
        for (int e = 0; e < 4; ++e) { const int k = 4 * lane + 256 * j + e; const f32x4 a = *(const f32x4*)(w_in + (size_t)k * ML_IN + 3072), b = *(const f32x4*)(w_in + (size_t)k * ML_IN + 3076);
            const float gk = gpre[k];
            wif[0][j][e] = a[0] * gk; wif[1][j][e] = a[1] * gk; wif[2][j][e] = a[2] * gk; wif[3][j][e] = a[3] * gk; wif[4][j][e] = b[0] * gk; wif[5][j][e] = b[1] * gk; wif[6][j][e] = b[2] * gk; wif[7][j][e] = b[3] * gk; }
    const float bias = lane < 8 ? b_if[lane] : 0.f;
    for (int m = gw; m < M; m += NGW) {
        f32x4 y[4];
#pragma unroll
        for (int j = 0; j < 4; ++j) { const u32x2 r = *(const u32x2*)(xn + (size_t)m * DM + 4 * lane + 256 * j); y[j] = (f32x4){bf_lo(r.x), bf_hi(r.x), bf_lo(r.y), bf_hi(r.y)}; }
        float my = 0.f;
#pragma unroll
        for (int cc = 0; cc < 8; ++cc) { float d = 0.f;
#pragma unroll
            for (int j = 0; j < 4; ++j) d += (y[j][0] * wif[cc][j][0] + y[j][1] * wif[cc][j][1]) + (y[j][2] * wif[cc][j][2] + y[j][3] * wif[cc][j][3]);
            d = wave_sum(d); if (lane == cc) my = d; }
        if (lane < 8) { float val = my + bias; val = 15.0f * tanhf(val * (1.0f / 15.0f));
            if (lane >= 4) val = -log1pf(expf(-val));
            ifg[(size_t)m * 8 + lane] = val; }
    }
}

__device__ __forceinline__ void ml_chunk_phase(const Frame& F, const bf16* proj, const float* ifg, const float* conv_w, bf16* hb) {
    constexpr int QP = 272, SP = 144;
    constexpr int QS = 0, KS = QS + 64 * QP, KWT = KS + 64 * QP, VT = KWT + 128 * SP, PS = VT + 80 * SP, CT = PS + 64 * SP, TAB = CT + 80 * QP, CWT = TAB + 1024;
    static_assert(CWT + 4096 <= RING_BYTES, "ml lds");
    LAS unsigned char* lds = F.lds;
    LAS float* tU = (LAS float*)(lds + TAB); LAS float* tM = tU + 64; LAS float* tB = tU + 128; LAS float* tD = tU + 192;
    PH_IDS;
    const int fr = lane & 15, fq = lane >> 4;
    for (int item = F.vcu; item < NB * 16; item += F.G) {
        const int b = item >> 4, hh = (item >> 2) & 3, vs = item & 3;
        const size_t rowb = (size_t)b * SEQ;
        for (int i = tid; i < 16 * 36; i += 512) { const int r = i / 36, cidx = i % 36; ((LAS unsigned*)(lds + VT + (64 + r) * SP))[cidx] = (r == 0) ? 0x3f803f80u : 0u; }
        const int which = tid >> 8, tq = (tid >> 4) & 15, c8 = tid & 15;
        const int ch = which * 512 + hh * 128 + c8 * 8;
        for (int i = tid; i < 4 * 256; i += 512) { const int jj = i >> 8, cc = i & 255; ((LAS float*)(lds + CWT))[i] = conv_w[jj * 1024 + (cc >> 7) * 512 + hh * 128 + (cc & 127)]; }
        const float qscale = which == 0 ? 0.08838834764831845f : 1.0f;
        const int tqv = tid >> 5, vp = tid & 31;
        const int vcol = 1024 + hh * 256 + vs * 64 + 2 * vp;
        f32x4 C[5];
#pragma unroll
        for (int jj = 0; jj < 5; ++jj) C[jj] = (f32x4){0.f, 0.f, 0.f, 0.f};
        float mst = 0.f;
        u32x4 rq[7]; unsigned rv[4]; float gi, gf;
        const unsigned loQ = (unsigned)((4 * tq) * 3072 + ch) * 2u, loV = (unsigned)((4 * tqv) * 3072 + vcol) * 2u;
        auto prefetch = [&](int c) {
            const char* base = (const char*)proj + (rowb + 64 * c) * (size_t)(3072 * 2);
            const int t0 = 64 * c + 4 * tq - 3;
#pragma unroll
            for (int r = 0; r < 7; ++r) rq[r] = (t0 + r >= 0) ? *(const u32x4*)(base + (ptrdiff_t)(r - 3) * (3072 * 2) + loQ) : (u32x4){0u, 0u, 0u, 0u};
#pragma unroll
            for (int r = 0; r < 4; ++r) rv[r] = *(const unsigned*)(base + (size_t)r * (3072 * 2) + loV);
            const float* gb = ifg + (rowb + 64 * c) * 8 + hh;
            gi = gb[lane * 8]; gf = gb[lane * 8 + 4];
        };
        prefetch(0);
        for (int c = 0; c < SEQ / 64; ++c) {
            const float bsum = scan_sum64(gf);
            const float uu = gi - bsum;
            const float Mx = fmaxf(mst, scan_max64(uu));
            const float M63 = lane63(Mx), b63 = lane63(bsum);
            if (w == 0) { tU[lane] = uu; tM[lane] = Mx; tB[lane] = bsum; }
#pragma unroll
            for (int jj = 0; jj < 5; ++jj) { u32x2 o; o.x = cvt_pk_bf16(C[jj][0], C[jj][1]); o.y = cvt_pk_bf16(C[jj][2], C[jj][3]);
                *(LAS u32x2*)(lds + CT + (16 * jj + fr) * QP + (16 * w + 4 * fq) * 2) = o; }
            WG_BAR();
            {
                float kws[4];
#pragma unroll
                for (int tt = 0; tt < 4; ++tt) kws[tt] = fexp(tU[4 * tq + tt] - M63);
                float cw[4][8];
#pragma unroll
                for (int jj = 0; jj < 4; ++jj) { const f32x4 a = *(const LAS f32x4*)(lds + CWT + (jj * 256 + which * 128 + c8 * 8) * 4), bq = *(const LAS f32x4*)(lds + CWT + (jj * 256 + which * 128 + c8 * 8 + 4) * 4);
                    cw[jj][0] = a[0]; cw[jj][1] = a[1]; cw[jj][2] = a[2]; cw[jj][3] = a[3]; cw[jj][4] = bq[0]; cw[jj][5] = bq[1]; cw[jj][6] = bq[2]; cw[jj][7] = bq[3]; }
                float o[4][8];
#pragma unroll
                for (int tt = 0; tt < 4; ++tt) {
#pragma unroll
                    for (int e2 = 0; e2 < 4; ++e2) { float a0 = 0.f, a1 = 0.f;
#pragma unroll
                        for (int jj = 0; jj < 4; ++jj) { const unsigned x = rq[tt + jj][e2]; a0 += cw[jj][2 * e2] * bf_lo(x); a1 += cw[jj][2 * e2 + 1] * bf_hi(x); }
                        o[tt][2 * e2] = fsilu(a0) * qscale; o[tt][2 * e2 + 1] = fsilu(a1) * qscale; }
                    u32x4 pk; pk.x = cvt_pk_bf16(o[tt][0], o[tt][1]); pk.y = cvt_pk_bf16(o[tt][2], o[tt][3]); pk.z = cvt_pk_bf16(o[tt][4], o[tt][5]); pk.w = cvt_pk_bf16(o[tt][6], o[tt][7]);
                    *(LAS u32x4*)(lds + (which ? KS : QS) + (4 * tq + tt) * QP + c8 * 16) = pk;
                }
                if (which) {
#pragma unroll
                    for (int e = 0; e < 8; ++e) { u32x2 pk; pk.x = cvt_pk_bf16(o[0][e] * kws[0], o[1][e] * kws[1]); pk.y = cvt_pk_bf16(o[2][e] * kws[2], o[3][e] * kws[3]);
                        *(LAS u32x2*)(lds + KWT + (c8 * 8 + e) * SP + (4 * tq) * 2) = pk; }
                }
                u32x2 v0, v1;
                v0.x = (rv[0] & 0xffffu) | (rv[1] << 16); v0.y = (rv[2] & 0xffffu) | (rv[3] << 16);
                v1.x = (rv[0] >> 16) | (rv[1] & 0xffff0000u); v1.y = (rv[2] >> 16) | (rv[3] & 0xffff0000u);
                *(LAS u32x2*)(lds + VT + (2 * vp) * SP + (4 * tqv) * 2) = v0; *(LAS u32x2*)(lds + VT + (2 * vp + 1) * SP + (4 * tqv) * 2) = v1;
            }
            WG_BAR();
            if (c + 1 < SEQ / 64) prefetch(c + 1);
            {
                const int tt = w >> 1, st0 = 2 * (w & 1);
                f32x4 s0 = {0.f, 0.f, 0.f, 0.f}, s1 = {0.f, 0.f, 0.f, 0.f};
#pragma unroll
                for (int kk = 0; kk < 4; ++kk) {
                    const bf16x8 yq = *(const LAS bf16x8*)(lds + QS + (16 * tt + fr) * QP + (32 * kk + 8 * fq) * 2);
                    const bf16x8 x0 = *(const LAS bf16x8*)(lds + KS + (16 * st0 + fr) * QP + (32 * kk + 8 * fq) * 2);
                    const bf16x8 x1 = *(const LAS bf16x8*)(lds + KS + (16 * (st0 + 1) + fr) * QP + (32 * kk + 8 * fq) * 2);
                    s0 = mma16(x0, yq, s0); s1 = mma16(x1, yq, s1);
                }
                const int t = 16 * tt + fr; const float Mt = tM[t];
#pragma unroll
                for (int q = 0; q < 2; ++q) { const f32x4 sv = q ? s1 : s0; const int sb = 16 * (st0 + q) + 4 * fq; const f32x4 u4 = *(const LAS f32x4*)(tU + sb);
                    float p[4];
#pragma unroll
                    for (int e = 0; e < 4; ++e) p[e] = (sb + e <= t) ? sv[e] * fexp(u4[e] - Mt) : 0.f;
                    u32x2 pk; pk.x = cvt_pk_bf16(p[0], p[1]); pk.y = cvt_pk_bf16(p[2], p[3]);
                    *(LAS u32x2*)(lds + PS + t * SP + sb * 2) = pk; }
            }
            WG_BAR_L();
            {
                const int tt = w & 3, jb = (w < 4) ? 0 : 3, nj = (w < 4) ? 3 : 2;
                f32x4 a1[3], a2[3];
#pragma unroll
                for (int jj = 0; jj < 3; ++jj) { a1[jj] = (f32x4){0.f, 0.f, 0.f, 0.f}; a2[jj] = (f32x4){0.f, 0.f, 0.f, 0.f}; }
#pragma unroll
                for (int kk = 0; kk < 2; ++kk) { const bf16x8 yp = *(const LAS bf16x8*)(lds + PS + (16 * tt + fr) * SP + (32 * kk + 8 * fq) * 2);
#pragma unroll
                    for (int jj = 0; jj < 3; ++jj) if (jj < nj) { const bf16x8 xv = *(const LAS bf16x8*)(lds + VT + (16 * (jb + jj) + fr) * SP + (32 * kk + 8 * fq) * 2); a1[jj] = mma16(xv, yp, a1[jj]); } }
#pragma unroll
                for (int kk = 0; kk < 4; ++kk) { const bf16x8 yq = *(const LAS bf16x8*)(lds + QS + (16 * tt + fr) * QP + (32 * kk + 8 * fq) * 2);
#pragma unroll
                    for (int jj = 0; jj < 3; ++jj) if (jj < nj) { const bf16x8 xc = *(const LAS bf16x8*)(lds + CT + (16 * (jb + jj) + fr) * QP + (32 * kk + 8 * fq) * 2); a2[jj] = mma16(xc, yq, a2[jj]); } }
                const int t = 16 * tt + fr; const float Mt = tM[t], bt = tB[t]; const float inter = fexp(mst - Mt);
#pragma unroll
                for (int jj = 0; jj < 3; ++jj) a1[jj] = a1[jj] + a2[jj] * inter;
                if (w >= 4 && fq == 0) tD[t] = a1[1][0];
                WG_BAR_L();
                const float dn = fmaxf(fabsf(tD[t]), fexp(-(bt + Mt))); const float rdn = 1.0f / dn;
#pragma unroll
                for (int jj = 0; jj < 3; ++jj) if (jj < nj && jb + jj < 4) { u32x2 pk; pk.x = cvt_pk_bf16(a1[jj][0] * rdn, a1[jj][1] * rdn); pk.y = cvt_pk_bf16(a1[jj][2] * rdn, a1[jj][3] * rdn);
                    *(u32x2*)((char*)(hb + (rowb + 64 * c + 16 * tt) * DM + hh * 256 + vs * 64 + 16 * (jb + jj)) + (unsigned)(fr * DM + 4 * fq) * 2u) = pk; }
            }
            {
                const float decay = fexp(mst - M63);
#pragma unroll
                for (int jj = 0; jj < 5; ++jj) C[jj] = C[jj] * decay;
#pragma unroll
                for (int kk = 0; kk < 2; ++kk) { const bf16x8 xk = *(const LAS bf16x8*)(lds + KWT + (16 * w + fr) * SP + (32 * kk + 8 * fq) * 2);
#pragma unroll
                    for (int jj = 0; jj < 5; ++jj) { const bf16x8 yv = *(const LAS bf16x8*)(lds + VT + (16 * jj + fr) * SP + (32 * kk + 8 * fq) * 2); C[jj] = mma16(xk, yv, C[jj]); } }
                mst = b63 + M63;
            }
            WG_BAR_L();
        }
    }
}

__device__ __forceinline__ void ml_head_phase(const Frame& F, const bf16* hb, const bf16* proj, const float* ng, bf16* hg) {
    PH_IDS;
    const int gw = F.vcu * NWAVES + w, NGW = F.G * NWAVES;
    f32x4 g[4];
#pragma unroll
    for (int j = 0; j < 4; ++j) g[j] = *(const f32x4*)(ng + 4 * lane + 256 * j);
    for (int m = gw; m < M; m += NGW) {
#pragma unroll
        for (int j = 0; j < 4; ++j) {
            const u32x2 r = *(const u32x2*)(hb + (size_t)m * DM + 4 * lane + 256 * j), ro = *(const u32x2*)(proj + (size_t)m * 3072 + 2048 + 4 * lane + 256 * j);
            const f32x4 v = {bf_lo(r.x), bf_hi(r.x), bf_lo(r.y), bf_hi(r.y)}, o = {bf_lo(ro.x), bf_hi(ro.x), bf_lo(ro.y), bf_hi(ro.y)};
            const float s = wave_sum((v[0] * v[0] + v[1] * v[1]) + (v[2] * v[2] + v[3] * v[3]));
            const float rs = __builtin_amdgcn_rsqf(s * (1.0f / 256.0f) + NORM_EPS);
            u32x2 pk; pk.x = cvt_pk_bf16(v[0] * rs * g[j][0] * fsigmoid(o[0]), v[1] * rs * g[j][1] * fsigmoid(o[1])); pk.y = cvt_pk_bf16(v[2] * rs * g[j][2] * fsigmoid(o[2]), v[3] * rs * g[j][3] * fsigmoid(o[3]));
            *(u32x2*)(hg + (size_t)m * DM + 4 * lane + 256 * j) = pk;
        }
    }
}

__device__ __forceinline__ void rt_chunk_phase(const Frame& F, const bf16* proj, bf16* yb) {
    constexpr int QP = 528, SP = 144;
    constexpr int QS = 0, KS = QS + 64 * QP, KWT = KS + 64 * QP, VT = KWT + 256 * SP, PS = VT + 128 * SP, END = PS + 64 * SP;
    static_assert(END <= MISC_OFF, "rt lds");
    LAS unsigned char* lds = F.lds;
    PH_IDS;
    const int fr = lane & 15, fq = lane >> 4;
    for (int item = F.vcu; item < NB * 16; item += F.G) {
        const int b = item >> 4, hh = (item >> 2) & 3, vs = item & 3;
        const size_t rowb = (size_t)b * SEQ;
        const float lg = __builtin_log2f(1.0f - __builtin_amdgcn_exp2f(-5.0f - (float)hh));
        const int tq = tid >> 5, c8 = tid & 31;
        const int qcol = hh * 256, kcol = 1024 + hh * 256 + c8 * 8, vcol = 2048 + hh * 512 + vs * 128 + 4 * c8;
        f32x4 R[16];
#pragma unroll
        for (int i = 0; i < 16; ++i) R[i] = (f32x4){0.f, 0.f, 0.f, 0.f};
        u32x4 rq[4], rk[4]; u32x2 rv[4];
        const unsigned loQ = (unsigned)((tid >> 5) * 6144 + qcol + (tid & 31) * 8) * 2u, loK = (unsigned)((4 * tq) * 6144 + kcol) * 2u, loV = (unsigned)((4 * tq) * 6144 + vcol) * 2u;
        auto prefetch = [&](int c) {
            const char* base = (const char*)proj + (rowb + 64 * c) * (size_t)(6144 * 2);
#pragma unroll
            for (int i = 0; i < 4; ++i) rq[i] = *(const u32x4*)(base + (size_t)i * (16 * 6144 * 2) + loQ);
#pragma unroll
            for (int i = 0; i < 4; ++i) { rk[i] = *(const u32x4*)(base + (size_t)i * (6144 * 2) + loK); rv[i] = *(const u32x2*)(base + (size_t)i * (6144 * 2) + loV); }
        };
        prefetch(0);
        float kws[4];
#pragma unroll
        for (int i = 0; i < 4; ++i) kws[i] = __builtin_amdgcn_exp2f(lg * (float)(63 - (4 * tq + i)));
        const float cdecay = __builtin_amdgcn_exp2f(lg * 64.0f);
        for (int c = 0; c < SEQ / 64; ++c) {
#pragma unroll
            for (int i = 0; i < 4; ++i) { const int idx = tid + 512 * i; *(LAS u32x4*)(lds + QS + (idx >> 5) * QP + (idx & 31) * 16) = rq[i]; }
#pragma unroll
            for (int i = 0; i < 4; ++i) *(LAS u32x4*)(lds + KS + (4 * tq + i) * QP + c8 * 16) = rk[i];
#pragma unroll
            for (int e2 = 0; e2 < 4; ++e2) {
                u32x2 lo, hi;
                lo.x = cvt_pk_bf16(bf_lo(rk[0][e2]) * kws[0], bf_lo(rk[1][e2]) * kws[1]); lo.y = cvt_pk_bf16(bf_lo(rk[2][e2]) * kws[2], bf_lo(rk[3][e2]) * kws[3]);
                hi.x = cvt_pk_bf16(bf_hi(rk[0][e2]) * kws[0], bf_hi(rk[1][e2]) * kws[1]); hi.y = cvt_pk_bf16(bf_hi(rk[2][e2]) * kws[2], bf_hi(rk[3][e2]) * kws[3]);
                *(LAS u32x2*)(lds + KWT + (c8 * 8 + 2 * e2) * SP + (4 * tq) * 2) = lo; *(LAS u32x2*)(lds + KWT + (c8 * 8 + 2 * e2 + 1) * SP + (4 * tq) * 2) = hi;
            }
            {
                u32x2 v0, v1, v2, v3;
                v0.x = (rv[0].x & 0xffffu) | (rv[1].x << 16); v0.y = (rv[2].x & 0xffffu) | (rv[3].x << 16);
                v1.x = (rv[0].x >> 16) | (rv[1].x & 0xffff0000u); v1.y = (rv[2].x >> 16) | (rv[3].x & 0xffff0000u);
                v2.x = (rv[0].y & 0xffffu) | (rv[1].y << 16); v2.y = (rv[2].y & 0xffffu) | (rv[3].y << 16);
                v3.x = (rv[0].y >> 16) | (rv[1].y & 0xffff0000u); v3.y = (rv[2].y >> 16) | (rv[3].y & 0xffff0000u);
                LAS unsigned char* vb = lds + VT + (4 * c8) * SP + (4 * tq) * 2;
                *(LAS u32x2*)(vb) = v0; *(LAS u32x2*)(vb + SP) = v1; *(LAS u32x2*)(vb + 2 * SP) = v2; *(LAS u32x2*)(vb + 3 * SP) = v3;
            }
            WG_BAR();
            {
                const int tt = w >> 1, st0 = 2 * (w & 1);
                f32x4 s0 = {0.f, 0.f, 0.f, 0.f}, s1 = {0.f, 0.f, 0.f, 0.f};
#pragma unroll 2
                for (int kk = 0; kk < 8; ++kk) {
                    const bf16x8 yq = *(const LAS bf16x8*)(lds + QS + (16 * tt + fr) * QP + (32 * kk + 8 * fq) * 2);
                    const bf16x8 x0 = *(const LAS bf16x8*)(lds + KS + (16 * st0 + fr) * QP + (32 * kk + 8 * fq) * 2);
                    const bf16x8 x1 = *(const LAS bf16x8*)(lds + KS + (16 * (st0 + 1) + fr) * QP + (32 * kk + 8 * fq) * 2);
                    s0 = mma16(x0, yq, s0); s1 = mma16(x1, yq, s1);
                }
                const int t = 16 * tt + fr;
#pragma unroll
                for (int q = 0; q < 2; ++q) { const f32x4 sv = q ? s1 : s0; const int sb = 16 * (st0 + q) + 4 * fq;
                    float p[4];
#pragma unroll
                    for (int e = 0; e < 4; ++e) p[e] = (sb + e <= t) ? sv[e] * __builtin_amdgcn_exp2f(lg * (float)(t - sb - e)) : 0.f;
                    u32x2 pk; pk.x = cvt_pk_bf16(p[0], p[1]); pk.y = cvt_pk_bf16(p[2], p[3]);
                    *(LAS u32x2*)(lds + PS + t * SP + sb * 2) = pk; }
            }
            WG_BAR_L();
            if (c + 1 < SEQ / 64) prefetch(c + 1);
            u32x4 xr[8];
#pragma unroll
            for (int kk = 0; kk < 8; ++kk) { xr[kk].x = cvt_pk_bf16(R[2 * kk][0], R[2 * kk][1]); xr[kk].y = cvt_pk_bf16(R[2 * kk][2], R[2 * kk][3]); xr[kk].z = cvt_pk_bf16(R[2 * kk + 1][0], R[2 * kk + 1][1]); xr[kk].w = cvt_pk_bf16(R[2 * kk + 1][2], R[2 * kk + 1][3]); }
#pragma unroll 1
            for (int tt = 0; tt < 4; ++tt) {
                f32x4 aI = {0.f, 0.f, 0.f, 0.f}, aC = {0.f, 0.f, 0.f, 0.f};
#pragma unroll
                for (int kk = 0; kk < 2; ++kk) { const bf16x8 xv = *(const LAS bf16x8*)(lds + VT + (16 * w + fr) * SP + (32 * kk + 8 * fq) * 2);
                    const bf16x8 yp = *(const LAS bf16x8*)(lds + PS + (16 * tt + fr) * SP + (32 * kk + 8 * fq) * 2); aI = mma16(xv, yp, aI); }
#pragma unroll
                for (int kk = 0; kk < 8; ++kk) {
                    const u32x2 qa = *(const LAS u32x2*)(lds + QS + (16 * tt + fr) * QP + (32 * kk + 4 * fq) * 2), qb = *(const LAS u32x2*)(lds + QS + (16 * tt + fr) * QP + (32 * kk + 16 + 4 * fq) * 2);
                    const u32x4 yq = {qa.x, qa.y, qb.x, qb.y};
                    aC = mma16(__builtin_bit_cast(bf16x8, xr[kk]), __builtin_bit_cast(bf16x8, yq), aC);
                }
                const int t = 16 * tt + fr; const float qd = __builtin_amdgcn_exp2f(lg * (float)(t + 1)); const f32x4 val = aI + aC * qd;
                u32x2 pk; pk.x = cvt_pk_bf16(val[0], val[1]); pk.y = cvt_pk_bf16(val[2], val[3]);
                *(u32x2*)((char*)(yb + (rowb + 64 * c + 16 * tt) * 2048 + hh * 512 + vs * 128 + 16 * w) + (unsigned)(fr * 2048 + 4 * fq) * 2u) = pk;
            }
            {
                const bf16x8 yv0 = *(const LAS bf16x8*)(lds + VT + (16 * w + fr) * SP + (8 * fq) * 2), yv1 = *(const LAS bf16x8*)(lds + VT + (16 * w + fr) * SP + (32 + 8 * fq) * 2);
#pragma unroll
                for (int dt = 0; dt < 16; ++dt) {
                    const bf16x8 x0 = *(const LAS bf16x8*)(lds + KWT + (16 * dt + fr) * SP + (8 * fq) * 2), x1 = *(const LAS bf16x8*)(lds + KWT + (16 * dt + fr) * SP + (32 + 8 * fq) * 2);
                    R[dt] = R[dt] * cdecay; R[dt] = mma16(x0, yv0, R[dt]); R[dt] = mma16(x1, yv1, R[dt]);
                    if ((dt & 3) == 3) asm volatile("" ::: "memory");
                }
            }
            WG_BAR_L();
        }
    }
}

__device__ __forceinline__ void rt_head_phase(const Frame& F, bf16* yb, const bf16* proj) {
    PH_IDS;
    const int gw = F.vcu * NWAVES + w, NGW = F.G * NWAVES;
    for (int m = gw; m < M; m += NGW) {
#pragma unroll
        for (int hd = 0; hd < 4; ++hd) {
            f32x4 v[2], g[2]; float s = 0.f;
#pragma unroll
            for (int q = 0; q < 2; ++q) { const int col = hd * 512 + q * 256 + 4 * lane;
                const u32x2 r = *(const u32x2*)(yb + (size_t)m * 2048 + col), rg = *(const u32x2*)(proj + (size_t)m * 6144 + 4096 + col);
                v[q] = (f32x4){bf_lo(r.x), bf_hi(r.x), bf_lo(r.y), bf_hi(r.y)}; g[q] = (f32x4){bf_lo(rg.x), bf_hi(rg.x), bf_lo(rg.y), bf_hi(rg.y)};
                s += (v[q][0] * v[q][0] + v[q][1] * v[q][1]) + (v[q][2] * v[q][2] + v[q][3] * v[q][3]); }
            const float rs = __builtin_amdgcn_rsqf(wave_sum(s) * (1.0f / 512.0f) + NORM_EPS);
#pragma unroll
            for (int q = 0; q < 2; ++q) { const int col = hd * 512 + q * 256 + 4 * lane;
                u32x2 pk; pk.x = cvt_pk_bf16(fsilu(g[q][0]) * v[q][0] * rs, fsilu(g[q][1]) * v[q][1] * rs); pk.y = cvt_pk_bf16(fsilu(g[q][2]) * v[q][2] * rs, fsilu(g[q][3]) * v[q][3] * rs);
                *(u32x2*)(yb + (size_t)m * 2048 + col) = pk; }
        }
    }
}

__device__ __forceinline__ float bf1(unsigned short u) { return __uint_as_float((unsigned)u << 16); }
__device__ __forceinline__ unsigned short f2bf1(float f) { return (unsigned short)(cvt_pk_bf16(f, 0.f) & 0xffffu); }
__device__ __forceinline__ void rw_scan_phase(const Frame& F, const bf16* rkv, const bf16* wag, const float* k_k, const float* k_a, const float* r_k, const float* ln_g, const float* ln_b, bf16* yout) {
    constexpr int TB = 64;
    constexpr int PLW = 0, PK = 8192, PV = 16384, PA = 24576, PB = 32768, PR = 40960, PG = 49152, BON = 57344, IMG = 57600;
    constexpr int I_AH = 0, I_RT = 2048, I_BT = 4096, I_KT = 6144, I_VT = 8192, I_NKH = 10240, I_NBR = 10752, I_NKR = 11264, I_GL = 11776, I_NBA = 12032, I_NKA = 13056, IMGSZ = 14080;
    constexpr int YB = IMG + 4 * IMGSZ;
    static_assert(YB + 4 * 4096 <= MISC_OFF && (IMG % 16) == 0 && (IMGSZ % 16) == 0, "rw lds");
    LAS unsigned char* lds = F.lds;
    PH_IDS;
    const int fr = lane & 15, fq = lane >> 4;
    for (int item = F.vcu; item < NB * 16; item += F.G) {
        const int b = item >> 4, hh = item & 15;
        const size_t rowb = (size_t)b * SEQ;
        const int c4 = tid & 15, chg = hh * 64 + 4 * c4;
        f32x4 ST[4];
#pragma unroll
        for (int jt = 0; jt < 4; ++jt) ST[jt] = (f32x4){0.f, 0.f, 0.f, 0.f};
        u32x2 pr[2], pk[2], pv[2], pw[2], pa[2], pg[2];
        const unsigned lo0 = (unsigned)((tid >> 4) * 3072 + chg) * 2u;
        auto prefetch = [&](int tb) {
            const char* br = (const char*)rkv + (rowb + (size_t)tb * TB) * (3072 * 2); const char* bw = (const char*)wag + (rowb + (size_t)tb * TB) * (3072 * 2);
#pragma unroll
            for (int q = 0; q < 2; ++q) { const size_t o = (size_t)q * (32 * 3072 * 2) + lo0;
                pr[q] = *(const u32x2*)(br + o); pk[q] = *(const u32x2*)(br + o + 2048); pv[q] = *(const u32x2*)(br + o + 4096);
                pw[q] = *(const u32x2*)(bw + o); pa[q] = *(const u32x2*)(bw + o + 2048); pg[q] = *(const u32x2*)(bw + o + 4096); }
        };
        prefetch(0);
        for (int tb = 0; tb < SEQ / TB; ++tb) {
            for (int rep_ = 0; rep_ < (PROBE_DUP == 23 ? 2 : 1); ++rep_) {
            const f32x4 kk4 = *(const f32x4*)(k_k + chg), ka4 = *(const f32x4*)(k_a + chg), rk4 = *(const f32x4*)(r_k + chg);
#pragma unroll
            for (int q = 0; q < 2; ++q) {
                const int tk = (tid >> 4) + 32 * q;
                const f32x4 r = {bf_lo(pr[q].x), bf_hi(pr[q].x), bf_lo(pr[q].y), bf_hi(pr[q].y)}, k = {bf_lo(pk[q].x), bf_hi(pk[q].x), bf_lo(pk[q].y), bf_hi(pk[q].y)};
                const f32x4 av = {bf_lo(pa[q].x), bf_hi(pa[q].x), bf_lo(pa[q].y), bf_hi(pa[q].y)};
                const f32x4 kkv = k * kk4;
                const float ss = red16((kkv[0] * kkv[0] + kkv[1] * kkv[1]) + (kkv[2] * kkv[2] + kkv[3] * kkv[3]));
                const float inv = 1.0f / fmaxf(sqrtf(ss), 1e-12f);
                const f32x4 kkn = kkv * inv, kp = k * (1.0f + (av - 1.0f) * ka4), rkp = r * kp * rk4, bb = kkn * av;
                const float bd = red16((rkp[0] + rkp[1]) + (rkp[2] + rkp[3]));
                const int o = (tk * 64 + 4 * c4) * 2;
                *(LAS u32x2*)(lds + PLW + o) = pw[q]; *(LAS u32x2*)(lds + PV + o) = pv[q]; *(LAS u32x2*)(lds + PR + o) = pr[q]; *(LAS u32x2*)(lds + PG + o) = pg[q];
                *(LAS u32x2*)(lds + PK + o) = (u32x2){cvt_pk_bf16(kp[0], kp[1]), cvt_pk_bf16(kp[2], kp[3])};
                *(LAS u32x2*)(lds + PA + o) = (u32x2){cvt_pk_bf16(-kkn[0], -kkn[1]), cvt_pk_bf16(-kkn[2], -kkn[3])};
                *(LAS u32x2*)(lds + PB + o) = (u32x2){cvt_pk_bf16(bb[0], bb[1]), cvt_pk_bf16(bb[2], bb[3])};
                if (c4 == 0) *(LAS float*)(lds + BON + tk * 4) = bd;
            }
            }
            WG_BAR();
            if (tb + 1 < SEQ / TB) prefetch(tb + 1);
            for (int rep_ = 0; rep_ < (PROBE_DUP == 21 ? 2 : 1); ++rep_) if (w >= 4) {
                const int c = w - 4, j = lane;
                LAS unsigned char* img = lds + IMG + c * IMGSZ;
                LAS unsigned char* scr = lds + YB + c * 4096;
                float At[16]; unsigned Bp[8], Kp[8], Vp[8];
                float cum = 0.f, gprev = 1.0f;
#pragma unroll
                for (int t = 0; t < 16; ++t) {
                    const int o = ((16 * c + t) * 64 + j) * 2;
                    const float lwv = bf1(*(const LAS unsigned short*)(lds + PLW + o)), a = bf1(*(const LAS unsigned short*)(lds + PA + o)), bq = bf1(*(const LAS unsigned short*)(lds + PB + o));
                    const float kq = bf1(*(const LAS unsigned short*)(lds + PK + o)), rq = bf1(*(const LAS unsigned short*)(lds + PR + o));
                    const unsigned vq = *(const LAS unsigned short*)(lds + PV + o);
                    cum += lwv;
                    const float gcur = fexp(cum), ginv = fexp(-cum);
                    At[t] = a * gprev;
                    const unsigned short ab = f2bf1(At[t]), rb = f2bf1(rq * gcur), bt = f2bf1(bq * ginv), kt = f2bf1(kq * ginv);
                    const int ot = (t * 64 + j) * 2;
                    *(LAS unsigned short*)(img + I_AH + ot) = ab; *(LAS unsigned short*)(img + I_RT + ot) = rb;
                    *(LAS unsigned short*)(scr + ot) = bt; *(LAS unsigned short*)(scr + 2048 + ot) = kt;
                    if (t & 1) { Bp[t >> 1] |= (unsigned)bt << 16; Kp[t >> 1] |= (unsigned)kt << 16; Vp[t >> 1] |= vq << 16; }
                    else { Bp[t >> 1] = bt; Kp[t >> 1] = kt; Vp[t >> 1] = vq; }
                    gprev = gcur;
                }
                *(LAS u32x4*)(img + I_BT + j * 32) = (u32x4){Bp[0], Bp[1], Bp[2], Bp[3]}; *(LAS u32x4*)(img + I_BT + j * 32 + 16) = (u32x4){Bp[4], Bp[5], Bp[6], Bp[7]};
                *(LAS u32x4*)(img + I_KT + j * 32) = (u32x4){Kp[0], Kp[1], Kp[2], Kp[3]}; *(LAS u32x4*)(img + I_KT + j * 32 + 16) = (u32x4){Kp[4], Kp[5], Kp[6], Kp[7]};
                *(LAS u32x4*)(img + I_VT + j * 32) = (u32x4){Vp[0], Vp[1], Vp[2], Vp[3]}; *(LAS u32x4*)(img + I_VT + j * 32 + 16) = (u32x4){Vp[4], Vp[5], Vp[6], Vp[7]};
                *(LAS float*)(img + I_GL + j * 4) = gprev;
                LDS_WAIT();
                {
                    f32x4 nba = {0.f, 0.f, 0.f, 0.f}, nbr = nba, nka = nba, nkr = nba;
#pragma unroll
                    for (int m = 0; m < 2; ++m) { const int o = fr * 128 + (32 * m + 8 * fq) * 2;
                        const bf16x8 xb = *(const LAS bf16x8*)(scr + o), xk = *(const LAS bf16x8*)(scr + 2048 + o), ya = *(const LAS bf16x8*)(img + I_AH + o), yr = *(const LAS bf16x8*)(img + I_RT + o);
                        nba = mma16(xb, ya, nba); nbr = mma16(xb, yr, nbr); nka = mma16(xk, ya, nka); nkr = mma16(xk, yr, nkr); }
#pragma unroll
                    for (int e = 0; e < 4; ++e) { const int sidx = 4 * fq + e; if (!(sidx < fr)) { nba[e] = 0.f; nka[e] = 0.f; } if (!(sidx <= fr)) { nbr[e] = 0.f; nkr[e] = 0.f; } }
                    *(LAS f32x4*)(img + I_NBA + (fr * 16 + 4 * fq) * 4) = nba; *(LAS f32x4*)(img + I_NKA + (fr * 16 + 4 * fq) * 4) = nka;
                    *(LAS u32x2*)(img + I_NBR + (fr * 16 + 4 * fq) * 2) = (u32x2){cvt_pk_bf16(nbr[0], nbr[1]), cvt_pk_bf16(nbr[2], nbr[3])};
                    *(LAS u32x2*)(img + I_NKR + (fr * 16 + 4 * fq) * 2) = (u32x2){cvt_pk_bf16(nkr[0], nkr[1]), cvt_pk_bf16(nkr[2], nkr[3])};
                }
                LDS_WAIT();
                {
                    float H[16];
#pragma unroll
                    for (int t = 0; t < 16; ++t) {
                        float h = At[t];
#pragma unroll
                        for (int s4 = 0; s4 < 4; ++s4) if (4 * s4 < t) { const f32x4 cf = *(const LAS f32x4*)(img + I_NBA + (t * 16 + 4 * s4) * 4);
#pragma unroll
                            for (int e = 0; e < 4; ++e) if (4 * s4 + e < t) h += H[4 * s4 + e] * cf[e]; }
                        H[t] = h;
                    }
                    LDS_WAIT();
#pragma unroll
                    for (int t = 0; t < 16; ++t) *(LAS unsigned short*)(img + I_AH + (t * 64 + j) * 2) = f2bf1(H[t]);
                    asm volatile("" ::: "memory");
#pragma unroll
                    for (int t = 0; t < 16; ++t) {
                        float g = *(const LAS float*)(img + I_NKA + (t * 16 + (lane & 15)) * 4);
#pragma unroll
                        for (int s4 = 0; s4 < 4; ++s4) if (4 * s4 < t) { const f32x4 cf = *(const LAS f32x4*)(img + I_NBA + (t * 16 + 4 * s4) * 4);
#pragma unroll
                            for (int e = 0; e < 4; ++e) if (4 * s4 + e < t) g += H[4 * s4 + e] * cf[e]; }
                        H[t] = g;
                        if (lane < 16) *(LAS unsigned short*)(img + I_NKH + (t * 16 + lane) * 2) = f2bf1(g);
                    }
                }
            }
            WG_BAR_L();
            if (w < 4) {
                struct Ops { u32x2 ah[4], rt[4], bt[4], kt[4], vt, nk, nb, nr; f32x4 gl[4]; };
                auto load_ops = [&](int c, Ops& o) {
                    const LAS unsigned char* img = lds + IMG + c * IMGSZ;
#pragma unroll
                    for (int m = 0; m < 2; ++m) {
                        o.ah[2 * m] = *(const LAS u32x2*)(img + I_AH + fr * 128 + (32 * m + 4 * fq) * 2); o.ah[2 * m + 1] = *(const LAS u32x2*)(img + I_AH + fr * 128 + (32 * m + 16 + 4 * fq) * 2);
                        o.rt[2 * m] = *(const LAS u32x2*)(img + I_RT + fr * 128 + (32 * m + 4 * fq) * 2); o.rt[2 * m + 1] = *(const LAS u32x2*)(img + I_RT + fr * 128 + (32 * m + 16 + 4 * fq) * 2);
                    }
                    o.vt = *(const LAS u32x2*)(img + I_VT + (16 * w + fr) * 32 + (4 * fq) * 2); o.nk = *(const LAS u32x2*)(img + I_NKH + (fr * 16 + 4 * fq) * 2);
                    o.nb = *(const LAS u32x2*)(img + I_NBR + (fr * 16 + 4 * fq) * 2); o.nr = *(const LAS u32x2*)(img + I_NKR + (fr * 16 + 4 * fq) * 2);
#pragma unroll
                    for (int jt = 0; jt < 4; ++jt) { o.bt[jt] = *(const LAS u32x2*)(img + I_BT + (16 * jt + fr) * 32 + (4 * fq) * 2); o.kt[jt] = *(const LAS u32x2*)(img + I_KT + (16 * jt + fr) * 32 + (4 * fq) * 2);
                        o.gl[jt] = *(const LAS f32x4*)(img + I_GL + (16 * jt + 4 * fq) * 4); }
                };
                Ops cur, nxt;
                load_ops(0, cur);
#pragma unroll
                for (int c = 0; c < 4; ++c) {
                    if (c < 3) load_ops(c + 1, nxt);
                    u32x4 sf[2];
#pragma unroll
                    for (int m = 0; m < 2; ++m) { sf[m].x = cvt_pk_bf16(ST[2 * m][0], ST[2 * m][1]); sf[m].y = cvt_pk_bf16(ST[2 * m][2], ST[2 * m][3]); sf[m].z = cvt_pk_bf16(ST[2 * m + 1][0], ST[2 * m + 1][1]); sf[m].w = cvt_pk_bf16(ST[2 * m + 1][2], ST[2 * m + 1][3]); }
                    f32x4 d1 = {0.f, 0.f, 0.f, 0.f}, d2 = {0.f, 0.f, 0.f, 0.f};
#pragma unroll
                    for (int m = 0; m < 2; ++m) {
                        d1 = mma16(__builtin_bit_cast(bf16x8, (u32x4){cur.ah[2 * m].x, cur.ah[2 * m].y, cur.ah[2 * m + 1].x, cur.ah[2 * m + 1].y}), __builtin_bit_cast(bf16x8, sf[m]), d1);
                        d2 = mma16(__builtin_bit_cast(bf16x8, (u32x4){cur.rt[2 * m].x, cur.rt[2 * m].y, cur.rt[2 * m + 1].x, cur.rt[2 * m + 1].y}), __builtin_bit_cast(bf16x8, sf[m]), d2);
                    }
                    d1 = mma16(__builtin_bit_cast(bf16x8, (u32x4){cur.nk.x, cur.nk.y, 0u, 0u}), __builtin_bit_cast(bf16x8, (u32x4){cur.vt.x, cur.vt.y, 0u, 0u}), d1);
                    const u32x4 ff = {cvt_pk_bf16(d1[0], d1[1]), cvt_pk_bf16(d1[2], d1[3]), cur.vt.x, cur.vt.y};
                    d2 = mma16(__builtin_bit_cast(bf16x8, (u32x4){cur.nb.x, cur.nb.y, cur.nr.x, cur.nr.y}), __builtin_bit_cast(bf16x8, ff), d2);
#pragma unroll
                    for (int e = 0; e < 4; ++e) *(LAS float*)(lds + YB + c * 4096 + ((4 * fq + e) * 64 + 16 * w + fr) * 4) = d2[e];
#pragma unroll
                    for (int jt = 0; jt < 4; ++jt) {
                        ST[jt] = mma16(__builtin_bit_cast(bf16x8, (u32x4){cur.bt[jt].x, cur.bt[jt].y, cur.kt[jt].x, cur.kt[jt].y}), __builtin_bit_cast(bf16x8, ff), ST[jt]);
                        ST[jt] = ST[jt] * cur.gl[jt];
                    }
                    if (c < 3) cur = nxt;
                }
            }
            WG_BAR_L();
            for (int rep_ = 0; rep_ < (PROBE_DUP == 24 ? 2 : 1); ++rep_) {
            const f32x4 lg4 = *(const f32x4*)(ln_g + chg), lb4 = *(const f32x4*)(ln_b + chg);
#pragma unroll
            for (int q = 0; q < 2; ++q) {
                const int tk = (tid >> 4) + 32 * q, o = (tk * 64 + 4 * c4) * 2;
                const f32x4 y = *(const LAS f32x4*)(lds + YB + (tk >> 4) * 4096 + ((tk & 15) * 64 + 4 * c4) * 4);
                const u32x2 vb = *(const LAS u32x2*)(lds + PV + o), gb = *(const LAS u32x2*)(lds + PG + o);
                const f32x4 v = {bf_lo(vb.x), bf_hi(vb.x), bf_lo(vb.y), bf_hi(vb.y)}, g = {bf_lo(gb.x), bf_hi(gb.x), bf_lo(gb.y), bf_hi(gb.y)};
                const float bd = *(const LAS float*)(lds + BON + tk * 4);
                const float mean = red16((y[0] + y[1]) + (y[2] + y[3])) * (1.0f / 64.0f);
                const f32x4 d = y - mean;
                const float var = red16((d[0] * d[0] + d[1] * d[1]) + (d[2] * d[2] + d[3] * d[3])) * (1.0f / 64.0f);
                const float rs = __builtin_amdgcn_rsqf(var + 64e-5f);
                const f32x4 outv = ((d * rs) * lg4 + lb4 + v * bd) * g;
                *(u32x2*)((char*)yout + ((rowb + (size_t)tb * TB + tk) * DM + chg) * 2) = (u32x2){cvt_pk_bf16(outv[0], outv[1]), cvt_pk_bf16(outv[2], outv[3])};
            }
            }
            WG_BAR_L();
        }
    }
}

constexpr int N_PHASES = 1 + DEPTH * 11;

__global__ void __launch_bounds__(NWAVES * 64, 2) mk_fwd(Args args) {
    extern __shared__ __attribute__((aligned(16))) unsigned char lds_raw[];
    Frame F;
    F.lds = (LAS unsigned char*)lds_raw;
    F.G = gridDim.x; { const int bx = blockIdx.x; F.vcu = (F.G % 8 == 0) ? (bx % 8) * (F.G / 8) + bx / 8 : bx; }
    volatile LAS unsigned* MISC = (volatile LAS unsigned*)(F.lds + MISC_OFF);
    for (int u = threadIdx.x; u < (LDS_BYTES - MISC_OFF) / 4; u += NWAVES * 64) ((LAS unsigned*)(F.lds + MISC_OFF))[u] = 0u;
    __syncthreads();
    unsigned char* ws = args.ws;
    unsigned* ctl = (unsigned*)(ws + WS_CTL);
    const int lo = args.p_lo, hi = args.p_hi;
    XcdBarrier bar; bar.bar = ctl + CW_BAR; bar.x = 0; bar.st = nullptr;
    if (hi - lo > 1) bar = xcd_barrier_post(ctl + CW_BAR, MISC + 8);
    const Args& in = args;
    bf16* xb = (bf16*)args.out;
    float* RHO = (float*)(ws + 57 * MiB);
    bf16* xb2 = (bf16*)(ws + WS_A + 256 * MiB);
    bf16* XN = (bf16*)(ws + WS_XN); bf16* MO = (bf16*)(ws + WS_MO);
    bf16* RA = (bf16*)(ws + WS_A); bf16* RB = (bf16*)(ws + WS_B);
    int p = 0;
#define PH_ON (p >= lo && p < hi)
#define PH_END do { if (p >= lo && p + 1 < hi) xcd_barrier(bar); ++p; } while (0)
#define DUP(cat, ...) do { __VA_ARGS__; if (PROBE_DUP == (cat)) { xcd_barrier(bar); __VA_ARGS__; } } while (0)


    if (PH_ON) { DUP(4, prep_layer(F, in, ws, 0)); norm_phase(F, kin(in, 0), nullptr, xb, RHO, nullptr, 0.f, nullptr, nullptr, XN, 0, nullptr);
    }
    PH_END;

#pragma unroll 1
    for (int s = 0; s < DEPTH * 3; ++s) {
        const int L = s / 3, sp = s % 3, kind = L % 3, jm = L / 3;
        const float* g6 = kin(in, 2) + (size_t)L * 6 * DM;
        if (sp != 1) {
            const int f = sp >> 1;
            if (PH_ON) { pg8::Gemm g{(f == 1 && L == DEPTH - 1) ? xb2 : xb, (const bf16*)(ws + (f ? W_GU1 : W_GU0)), M, 2 * DFF, DM}; pg8::StaticOrder S; S.init(M, 2 * DFF, F.G, (int)blockIdx.x);
                pg8::EpiSwiglu E{RA, DFF}; DUP(1, pg8::gemm_phase<pg8::EpiSwiglu, pg8::StaticOrder, true, true>(F.lds, g, S, E)); }
            PH_END;
            if (PH_ON) { pg8::Gemm g{RA, (const bf16*)(ws + (f ? W_DN1 : W_DN0)), M, DM, DFF}; pg8::StaticOrder S; S.init(M, DM, F.G, (int)blockIdx.x);
                pg8::EpiPlain E{RB, DM}; DUP(2, pg8::gemm_phase<pg8::EpiPlain, pg8::StaticOrder, true, true>(F.lds, g, S, E)); }
            PH_END;
            if (PH_ON) {
                if (f == 0) {
                    norm_phase(F, nullptr, xb, xb, RHO, RB, 0.5f, g6 + 1 * DM, g6 + 2 * DM, XN, kind == 1 ? 2 : 0, nullptr);
                } else {
                    const bool lastl = (L == DEPTH - 1);
                    if (!lastl) DUP(4, prep_layer(F, in, ws, L + 1));
                    norm_phase(F, nullptr, lastl ? xb2 : xb, xb, RHO, RB, 0.5f, g6 + 5 * DM, nullptr, XN, lastl ? 3 : 0, args.out);
                }
            }
            PH_END;
        } else {
            const bf16* WM = (const bf16*)(ws + W_MIX);
            const bf16* a_out; const bf16* w_out; int k_out;
            if (kind == 0) {
                if (PH_ON) { pg8::Gemm g{xb, WM, M, 3072, DM}; pg8::StaticOrder S; S.init(M, 3072, F.G, (int)blockIdx.x);
                    pg8::EpiPlain E{RA, 3072}; DUP(5, pg8::gemm_phase<pg8::EpiPlain, pg8::StaticOrder, true, true>(F.lds, g, S, E));
                    DUP(15, ml_gate_phase(F, xb, g6 + 2 * DM, kin(in, 5) + (size_t)jm * DM * ML_IN, kin(in, 6) + jm * 8, (float*)(ws + WS_A + 192 * MiB))); }
                PH_END;
                if (PH_ON) DUP(6, ml_chunk_phase(F, RA, (const float*)(ws + WS_A + 192 * MiB), kin(in, 7) + (size_t)jm * 4 * DM, RB));
                PH_END;
                if (PH_ON) DUP(7, ml_head_phase(F, RB, RA, kin(in, 8) + (size_t)jm * DM, RB + (size_t)M * DM));
                PH_END;
                a_out = RB + (size_t)M * DM; w_out = WM + (size_t)3072 * 1024; k_out = DM;
            } else if (kind == 1) {
                bf16* lmid = RB; bf16* wag = RA + (size_t)M * 3072; bf16* yo = RB + (size_t)M * 256;
                if (PH_ON) { pg8::Gemm g{XN, WM, M, 3328, 2048}; pg8::StaticOrder S; S.init(M, 3328, F.G, (int)blockIdx.x);
                    pg8::EpiRw1 E{RA, lmid}; DUP(9, pg8::gemm_phase<pg8::EpiRw1, pg8::StaticOrder, true, true>(F.lds, g, S, E)); }
                PH_END;
                if (PH_ON) { int k_rw2 = 256; asm volatile("" : "+s"(k_rw2));
                    pg8::Gemm g{lmid, WM + (size_t)3328 * 2048, M, 3072, k_rw2}; pg8::StaticOrder S; S.init(M, 3072, F.G, (int)blockIdx.x);
                    pg8::EpiRw2 E{wag, kin(in, 12) + (size_t)jm * DM, kin(in, 15) + (size_t)jm * DM}; DUP(10, pg8::gemm_phase<pg8::EpiRw2, pg8::StaticOrder, true, true>(F.lds, g, S, E)); }
                PH_END;
                if (PH_ON) DUP(11, rw_scan_phase(F, RA, wag, kin(in, 20) + (size_t)jm * DM, kin(in, 21) + (size_t)jm * DM, kin(in, 22) + (size_t)jm * DM, kin(in, 23) + (size_t)jm * DM, kin(in, 24) + (size_t)jm * DM, yo));
                PH_END;
                a_out = yo; w_out = WM + (size_t)3328 * 2048 + (size_t)3072 * 256; k_out = DM;
            } else {
                if (PH_ON) { pg8::Gemm g{xb, WM, M, 6144, DM}; pg8::StaticOrder S; S.init(M, 6144, F.G, (int)blockIdx.x);
                    pg8::EpiRtIn E{RA, (const int*)kin(in, 1)}; DUP(12, pg8::gemm_phase<pg8::EpiRtIn, pg8::StaticOrder, true, true>(F.lds, g, S, E)); }
                PH_END;
                if (PH_ON) DUP(13, rt_chunk_phase(F, RA, RB));
                PH_END;
                if (PH_ON) rt_head_phase(F, RB, RA);
                PH_END;
                a_out = RB; w_out = WM + (size_t)6144 * 1024; k_out = 2048;
            }
            if (PH_ON) { pg8::Gemm g{a_out, w_out, M, DM, k_out}; pg8::StaticOrder S; S.init(M, DM, F.G, (int)blockIdx.x);
                pg8::EpiPlain E{MO, DM}; DUP(8, pg8::gemm_phase<pg8::EpiPlain, pg8::StaticOrder, true, true>(F.lds, g, S, E)); }
            PH_END;
            if (PH_ON) norm_phase(F, nullptr, xb, (L == DEPTH - 1) ? xb2 : xb, RHO, MO, 1.0f, g6 + 3 * DM, nullptr, XN, 0, nullptr);
            PH_END;
        }
    }
#undef PH_ON
#undef PH_END
}

extern "C" void kernel_launch(void* const* d_in, const int* in_sizes, int n_in, void* d_out, int out_size, void* d_ws, size_t ws_size, hipStream_t stream) {
    static int grid = 0;
    if (grid == 0) {
        if (n_in != 28 || out_size != M * DM || ws_size < WS_END) { fprintf(stderr, "kernel_launch: unexpected shapes: n_in %d out %d ws %zu (need %zu)\n", n_in, out_size, ws_size, (size_t)WS_END); grid = -1; return; }
        int dev = 0, cus = 0, per_cu = 0;
        if (hipGetDevice(&dev) != hipSuccess || hipDeviceGetAttribute(&cus, hipDeviceAttributeMultiprocessorCount, dev) != hipSuccess) { grid = -1; return; }
        if (hipFuncSetAttribute((const void*)mk_fwd, hipFuncAttributeMaxDynamicSharedMemorySize, LDS_BYTES) != hipSuccess) { fprintf(stderr, "kernel_launch: hipFuncSetAttribute failed\n"); grid = -1; return; }
        if (hipOccupancyMaxActiveBlocksPerMultiprocessor(&per_cu, (const void*)mk_fwd, NWAVES * 64, LDS_BYTES) != hipSuccess || per_cu < 1) { fprintf(stderr, "kernel_launch: occupancy query says %d\n", per_cu); (void)hipGetLastError(); grid = -1; return; }
        grid = cus;
    }
    if (grid < 0) return;
    (void)hipMemsetAsync((char*)d_ws + WS_CTL, 0, CTL_ZERO_BYTES, stream);
    Args a{};
    for (int i = 0; i < 28; ++i) a.in[i] = d_in[i];
    a.out = (float*)d_out; a.ws = (unsigned char*)d_ws;
#if MK_PER_PHASE
    for (int p = 0; p < N_PHASES; ++p) { a.p_lo = p; a.p_hi = p + 1; hipLaunchKernelGGL(mk_fwd, dim3(grid), dim3(NWAVES * 64), LDS_BYTES, stream, a); }
#else
    a.p_lo = 0; a.p_hi = N_PHASES;
    hipLaunchKernelGGL(mk_fwd, dim3(grid), dim3(NWAVES * 64), LDS_BYTES, stream, a);
#endif
}
```

```cpp
#include <hip/hip_runtime.h>
#include <cstdio>
#include <cstdint>

#ifndef MK_PER_PHASE
#define MK_PER_PHASE 0
#endif
#ifndef PROBE_DUP
#define PROBE_DUP 0
#endif

#define LAS __attribute__((address_space(3)))
#define GAS __attribute__((address_space(1)))
typedef unsigned short bf16;
typedef short bf16x8 __attribute__((ext_vector_type(8)));
typedef float f32x4 __attribute__((ext_vector_type(4)));
typedef float f32x2 __attribute__((ext_vector_type(2)));
typedef unsigned u32x4 __attribute__((ext_vector_type(4)));
typedef unsigned u32x2 __attribute__((ext_vector_type(2)));

constexpr int DM = 1024, NB = 16, SEQ = 2048, DEPTH = 4, DFF = 2816;
constexpr int M = NB * SEQ;
constexpr float NORM_EPS = 1e-6f;
constexpr int ML_IN = 3080;
constexpr int NWAVES = 8;

constexpr size_t MiB = 1u << 20;
constexpr size_t WS_CTL = 0, CTL_ZERO_BYTES = 1 * MiB;
constexpr size_t WS_W = 1 * MiB;
constexpr size_t W_GU0 = WS_W, W_DN0 = W_GU0 + (size_t)5632 * 1024 * 2, W_GU1 = W_DN0 + (size_t)1024 * 2816 * 2, W_DN1 = W_GU1 + (size_t)5632 * 1024 * 2;
constexpr size_t W_MIX = W_DN1 + (size_t)1024 * 2816 * 2;
constexpr size_t WS_XN = 58 * MiB;
constexpr size_t WS_MO = WS_XN + 64 * MiB;
constexpr size_t WS_A = 186 * MiB;
constexpr size_t WS_B = 570 * MiB;
constexpr size_t WS_END = 698 * MiB;
static_assert(W_MIX + (size_t)17 * MiB <= WS_XN, "weight region");
constexpr int CW_BAR = 4096;

constexpr int RING_BYTES = 131072;
constexpr int LDS_BYTES = 147456;
constexpr int MISC_OFF = 145408;

typedef __bf16 bf16x2_t __attribute__((ext_vector_type(2)));
__device__ __forceinline__ unsigned cvt_pk_bf16(float lo, float hi) { const f32x2 v = {lo, hi}; return __builtin_bit_cast(unsigned, __builtin_convertvector(v, bf16x2_t)); }
__device__ __forceinline__ float bf_lo(unsigned u) { return __uint_as_float(u << 16); }
__device__ __forceinline__ float bf_hi(unsigned u) { return __uint_as_float(u & 0xffff0000u); }
__device__ __forceinline__ float fexp(float x) { return __builtin_amdgcn_exp2f(x * 1.4426950408889634f); }
__device__ __forceinline__ float fsigmoid(float x) { return __builtin_amdgcn_rcpf(1.0f + fexp(-x)); }
__device__ __forceinline__ float ftanh(float x) { return 2.0f * fsigmoid(2.0f * x) - 1.0f; }
__device__ __forceinline__ float fsilu(float x) { return x * fsigmoid(x); }
template <int CTRL, int ROWMASK> __device__ __forceinline__ float dppmov(float old, float v) {
    return __builtin_bit_cast(float, __builtin_amdgcn_update_dpp(__builtin_bit_cast(int, old), __builtin_bit_cast(int, v), CTRL, ROWMASK, 0xf, false));
}
__device__ __forceinline__ float red16(float v) {
    v += dppmov<0x128, 0xf>(0.f, v); v += dppmov<0x124, 0xf>(0.f, v); v += dppmov<0x122, 0xf>(0.f, v); v += dppmov<0x121, 0xf>(0.f, v); return v; }
__device__ __forceinline__ float wave_sum(float v) {
    v = red16(v);
    const float s0 = __builtin_bit_cast(float, __builtin_amdgcn_readlane(__builtin_bit_cast(int, v), 0)), s1 = __builtin_bit_cast(float, __builtin_amdgcn_readlane(__builtin_bit_cast(int, v), 16));
    const float s2 = __builtin_bit_cast(float, __builtin_amdgcn_readlane(__builtin_bit_cast(int, v), 32)), s3 = __builtin_bit_cast(float, __builtin_amdgcn_readlane(__builtin_bit_cast(int, v), 48));
    return (s0 + s1) + (s2 + s3);
}
__device__ __forceinline__ float scan_sum64(float v) {
    v += dppmov<0x111, 0xf>(0.f, v); v += dppmov<0x112, 0xf>(0.f, v); v += dppmov<0x114, 0xf>(0.f, v); v += dppmov<0x118, 0xf>(0.f, v);
    v += dppmov<0x142, 0xa>(0.f, v); v += dppmov<0x143, 0xc>(0.f, v); return v; }
__device__ __forceinline__ float scan_max64(float v) {
    const float ninf = -__builtin_inff();
    v = fmaxf(v, dppmov<0x111, 0xf>(ninf, v)); v = fmaxf(v, dppmov<0x112, 0xf>(ninf, v)); v = fmaxf(v, dppmov<0x114, 0xf>(ninf, v)); v = fmaxf(v, dppmov<0x118, 0xf>(ninf, v));
    v = fmaxf(v, dppmov<0x142, 0xa>(ninf, v)); v = fmaxf(v, dppmov<0x143, 0xc>(ninf, v)); return v; }
__device__ __forceinline__ float lane63(float v) { return __builtin_bit_cast(float, __builtin_amdgcn_readlane(__builtin_bit_cast(int, v), 63)); }
__device__ __forceinline__ f32x4 mma16(bf16x8 x, bf16x8 y, f32x4 c) { return __builtin_amdgcn_mfma_f32_16x16x32_bf16(x, y, c, 0, 0, 0); }
#define LDS_WAIT() asm volatile("s_waitcnt lgkmcnt(0)" ::: "memory")
#define WG_BAR() do { asm volatile("s_waitcnt vmcnt(0) lgkmcnt(0)" ::: "memory"); __builtin_amdgcn_s_barrier(); asm volatile("" ::: "memory"); } while (0)
#define WG_BAR_L() do { asm volatile("s_waitcnt lgkmcnt(0)" ::: "memory"); __builtin_amdgcn_s_barrier(); asm volatile("" ::: "memory"); } while (0)

namespace pg8 {
#define PG8_LAS __attribute__((address_space(3)))
typedef unsigned short bf16_t;
constexpr int BM = 256, BK = 64, HALF = 128, HTB = HALF * BK * 2, STAGE_BYTES = 8 * HTB, NXCD = 8, WGM = 8;
__host__ __device__ __forceinline__ int lds_byte(int r, int c) { const int st = (r >> 4) * 2 + (c >> 5), rr = r & 15, cc = c & 31, ob = rr * 64 + cc * 2; return st * 1024 + (ob ^ (((ob >> 9) & 1) << 5)); }
__host__ __device__ __forceinline__ void stage_rc(int b, int& R, int& C) { const int st = b / 1024, sb = b % 1024, swz = sb ^ (((sb >> 9) & 1) << 5); R = (st >> 1) * 16 + swz / 64; C = (st & 1) * 32 + (swz % 64) / 2; }
__host__ __device__ __forceinline__ int perm32(int rho) { const int n = rho >> 4, i = rho & 15; return 8 * (i >> 2) + 4 * n + (i & 3); }

struct Unit { int pm, pn; };
struct Gemm { const bf16_t* A; const bf16_t* Bt; int M, N, K; int a_shift; size_t a_stride; };

struct StaticOrder {
    int nM, nN, nwg, G, c;
    __host__ __device__ void init(int M_, int N_, int G_, int c_) { nM = M_ / BM; nN = N_ / BM; nwg = nM * nN; G = G_; c = c_; }
    __host__ __device__ bool next(int i, Unit& u) const {
        const long L = (long)i * G + c; if (L >= nwg) return false;
        int wgid = (int)L; { const int q = nwg / NXCD, r = nwg % NXCD, xcd = wgid % NXCD, off = wgid / NXCD; wgid = (xcd < r ? xcd * (q + 1) : r * (q + 1) + (xcd - r) * q) + off; }
        const int nig = WGM * nN, gid = wgid / nig, fm = gid * WGM, gsz = (nM - fm) < WGM ? (nM - fm) : WGM;
        u.pm = fm + ((wgid % nig) % gsz); u.pn = (wgid % nig) / gsz; return true;
    }
    __device__ __forceinline__ void a_ready(const Unit&) const {}
    __device__ __forceinline__ void done(const Unit&) const {}
};

__device__ __forceinline__ u32x4 pack8(f32x4 v0, f32x4 v1) { u32x4 w; w.x = cvt_pk_bf16(v0[0], v0[1]); w.y = cvt_pk_bf16(v0[2], v0[3]); w.z = cvt_pk_bf16(v1[0], v1[1]); w.w = cvt_pk_bf16(v1[2], v1[3]); return w; }

struct EpiPlain {
    static constexpr bool PERM = true, AFTER_DRAIN = false;
    bf16_t* O; int ldc;
    __device__ __forceinline__ void operator()(const f32x4 (&acc)[2][2][4][2], const Unit& u, int wr, int wc, int fr, int fq) const {
        const int row0 = u.pm * BM + wr * 64 + fr, col0 = u.pn * BM + wc * 32 + 8 * fq;
#pragma unroll
        for (int ai = 0; ai < 2; ++ai)
#pragma unroll
            for (int m = 0; m < 4; ++m) { bf16_t* rowp = O + (size_t)(row0 + ai * HALF + m * 16) * ldc + col0;
#pragma unroll
                for (int bj = 0; bj < 2; ++bj) *(u32x4*)(rowp + bj * HALF) = pack8(acc[ai][bj][m][0], acc[ai][bj][m][1]); }
    }
};
struct EpiSwiglu {
    static constexpr bool PERM = true, AFTER_DRAIN = false;
    bf16_t* O; int ldc;
    __device__ __forceinline__ void operator()(const f32x4 (&acc)[2][2][4][2], const Unit& u, int wr, int wc, int fr, int fq) const {
        const int row0 = u.pm * BM + wr * 64 + fr, col0 = u.pn * HALF + wc * 32 + 8 * fq;
#pragma unroll
        for (int ai = 0; ai < 2; ++ai)
#pragma unroll
            for (int m = 0; m < 4; ++m) { bf16_t* rowp = O + (size_t)(row0 + ai * HALF + m * 16) * ldc + col0;
                f32x4 o[2];
#pragma unroll
                for (int n = 0; n < 2; ++n)
#pragma unroll
                    for (int e = 0; e < 4; ++e) { const float g = acc[ai][0][m][n][e]; o[n][e] = g * fsigmoid(g) * acc[ai][1][m][n][e]; }
                *(u32x4*)rowp = pack8(o[0], o[1]); }
    }
};
struct EpiLora {
    static constexpr bool PERM = true, AFTER_DRAIN = false;
    bf16_t* lmid;
    __device__ __forceinline__ void operator()(const f32x4 (&acc)[2][2][4][2], const Unit& u, int wr, int wc, int fr, int fq) const {
        const int row0 = u.pm * BM + wr * 64 + fr, col0 = wc * 32 + 8 * fq;
#pragma unroll
        for (int ai = 0; ai < 2; ++ai)
#pragma unroll
            for (int m = 0; m < 4; ++m) { bf16_t* rowp = lmid + (size_t)(row0 + ai * HALF + m * 16) * 256 + col0;
#pragma unroll
                for (int bj = 0; bj < 2; ++bj) { f32x4 o[2];
#pragma unroll
                    for (int n = 0; n < 2; ++n)
#pragma unroll
                        for (int e = 0; e < 4; ++e) { const float v = acc[ai][bj][m][n][e]; o[n][e] = (bj == 1) ? fsigmoid(v) : (wc < 2 ? ftanh(v) : v); }
                    *(u32x4*)(rowp + bj * HALF) = pack8(o[0], o[1]); } }
    }
};
struct EpiRw2 {
    static constexpr bool PERM = true, AFTER_DRAIN = false;
    bf16_t* O; const float* w0; const float* a0;
    __device__ __forceinline__ void operator()(const f32x4 (&acc)[2][2][4][2], const Unit& u, int wr, int wc, int fr, int fq) const {
        const int row0 = u.pm * BM + wr * 64 + fr, col0 = u.pn * BM + wc * 32 + 8 * fq, kind = u.pn >> 2, cc0 = (u.pn & 3) * BM + wc * 32 + 8 * fq;
        if (kind == 2) {
#pragma unroll
            for (int ai = 0; ai < 2; ++ai)
#pragma unroll
                for (int m = 0; m < 4; ++m) { bf16_t* rowp = O + (size_t)(row0 + ai * HALF + m * 16) * 3072 + col0;
#pragma unroll
                    for (int bj = 0; bj < 2; ++bj) *(u32x4*)(rowp + bj * HALF) = pack8(acc[ai][bj][m][0], acc[ai][bj][m][1]); }
        } else {
            const float* bp = (kind == 0 ? w0 : a0) + cc0; const float sc = kind == 0 ? -0.60653065971f : 1.0f;
#pragma unroll
            for (int bj = 0; bj < 2; ++bj) {
                const f32x4 b0 = *(const f32x4*)(bp + bj * HALF), b1 = *(const f32x4*)(bp + bj * HALF + 4);
#pragma unroll
                for (int ai = 0; ai < 2; ++ai)
#pragma unroll
                    for (int m = 0; m < 4; ++m) { bf16_t* rowp = O + (size_t)(row0 + ai * HALF + m * 16) * 3072 + col0; f32x4 o0, o1;
#pragma unroll
                        for (int e = 0; e < 4; ++e) { o0[e] = sc * fsigmoid(acc[ai][bj][m][0][e] + b0[e]); o1[e] = sc * fsigmoid(acc[ai][bj][m][1][e] + b1[e]); }
                        *(u32x4*)(rowp + bj * HALF) = pack8(o0, o1); }
            }
        }
    }
};
struct EpiRtIn {
    static constexpr bool PERM = true, AFTER_DRAIN = false;
    bf16_t* O; const int* pos;
    __device__ __forceinline__ void operator()(const f32x4 (&acc)[2][2][4][2], const Unit& u, int wr, int wc, int fr, int fq) const {
        const int row0 = u.pm * BM + wr * 64 + fr, col0 = u.pn * BM + wc * 32 + 8 * fq;
        if (u.pn >= 8) {
#pragma unroll
            for (int ai = 0; ai < 2; ++ai)
#pragma unroll
                for (int m = 0; m < 4; ++m) { bf16_t* rowp = O + (size_t)(row0 + ai * HALF + m * 16) * 6144 + col0;
#pragma unroll
                    for (int bj = 0; bj < 2; ++bj) *(u32x4*)(rowp + bj * HALF) = pack8(acc[ai][bj][m][0], acc[ai][bj][m][1]); }
        } else {
            const float sc = u.pn >= 4 ? 0.0625f : 1.0f;
            float invf[2][4];
#pragma unroll
            for (int n = 0; n < 2; ++n)
#pragma unroll
                for (int e = 0; e < 4; ++e) { const int i = wc * 32 + 8 * fq + 4 * n + e; invf[n][e] = __builtin_amdgcn_exp2f((float)i * (-13.287712379549449f / 127.0f)) * 0.15915494309189535f; }
#pragma unroll
            for (int ai = 0; ai < 2; ++ai)
#pragma unroll
                for (int m = 0; m < 4; ++m) { const int row = row0 + ai * HALF + m * 16; const float p = (float)pos[row]; bf16_t* rowp = O + (size_t)row * 6144 + col0;
                    f32x4 o1[2], o2[2];
#pragma unroll
                    for (int n = 0; n < 2; ++n)
#pragma unroll
                        for (int e = 0; e < 4; ++e) { float rev = p * invf[n][e]; rev = rev - __builtin_floorf(rev);
                            const float sn = __builtin_amdgcn_sinf(rev), cs = __builtin_amdgcn_cosf(rev);
                            const float u1 = acc[ai][0][m][n][e], u2 = acc[ai][1][m][n][e];
                            o1[n][e] = (u1 * cs - u2 * sn) * sc; o2[n][e] = (u1 * sn + u2 * cs) * sc; }
                    *(u32x4*)rowp = pack8(o1[0], o1[1]); *(u32x4*)(rowp + HALF) = pack8(o2[0], o2[1]); }
        }
    }
};

template <class Epi, class Sched, bool ALIGN_EPI = false, bool SP2 = false>
__device__ __forceinline__ void gemm_phase(PG8_LAS unsigned char* lds, const Gemm g, const Sched& S, const Epi& E) {
    int tid_ = threadIdx.x; asm volatile("" : "+v"(tid_));
    const int tid = tid_, wid = __builtin_amdgcn_readfirstlane(tid >> 6), lane = tid & 63, wr = wid >> 2, wc = wid & 3, fr = lane & 15, fq = lane >> 4;
    const int K = g.K, nt = K / BK;
    unsigned voffA[2], voffB[2];
#pragma unroll
    for (int i = 0; i < 2; ++i) { int R, C; stage_rc(tid * 16 + i * 8192, R, C); const int Rb = Epi::PERM ? ((R & ~31) + perm32(R & 31)) : R;
        voffA[i] = (unsigned)(R * K + C) * 2u; voffB[i] = (unsigned)(Rb * K + C) * 2u; }
    const size_t kstep = (size_t)(BK * 2);
    const size_t hstep = (size_t)HALF * K * 2;
    const size_t tstep = 2 * hstep;
    const unsigned ldsw = (unsigned)wid * 1024u;
    const int aoff = lds_byte(wr * 64 + fr, fq * 8), boff = lds_byte(wc * 32 + fr, fq * 8);
#define PG8_SA(b, h) (((b) * 2 + (h)) * HTB)
#define PG8_SB(b, h) ((4 + (b) * 2 + (h)) * HTB)
#define PG8_STAGE(bufoff, gbase, voff) do { _Pragma("unroll") for (int _i = 0; _i < 2; ++_i) \
        __builtin_amdgcn_global_load_lds((const unsigned*)((const char*)(gbase) + (voff)[_i]), (PG8_LAS unsigned*)(lds + (bufoff) + ldsw + _i * 8192), 16, 0, 0); } while (0)
#define PG8_LDA(dst, b, h) do { _Pragma("unroll") for (int m = 0; m < 4; ++m) _Pragma("unroll") for (int k = 0; k < 2; ++k) dst[m][k] = *(const PG8_LAS bf16x8*)(lds + PG8_SA(b, h) + aoff + m * 2048 + k * 1024); } while (0)
#define PG8_LDB(dst, b, h) do { _Pragma("unroll") for (int n = 0; n < 2; ++n) _Pragma("unroll") for (int k = 0; k < 2; ++k) dst[n][k] = *(const PG8_LAS bf16x8*)(lds + PG8_SB(b, h) + boff + n * 2048 + k * 1024); } while (0)
#define PG8_MMA(ai, bj, At, Bt) do { __builtin_amdgcn_s_setprio(1); _Pragma("unroll") for (int m = 0; m < 4; ++m) _Pragma("unroll") for (int n = 0; n < 2; ++n) _Pragma("unroll") for (int k = 0; k < 2; ++k) \
        acc[ai][bj][m][n] = __builtin_amdgcn_mfma_f32_16x16x32_bf16(Bt[n][k], At[m][k], acc[ai][bj][m][n], 0, 0, 0); __builtin_amdgcn_s_setprio(0); } while (0)
#define PG8_WAIT_V(n) asm volatile("s_waitcnt vmcnt(" #n ")" ::: "memory")
#define PG8_WAIT_L(n) asm volatile("s_waitcnt lgkmcnt(" #n ")" ::: "memory")
#define PG8_BAR __builtin_amdgcn_s_barrier()
#define PG8_SCHED __builtin_amdgcn_sched_barrier(0)
    Unit cur, nxt; int ui = 0;
    if (!S.next(0, cur)) return;
    f32x4 acc[2][2][4][2];
#pragma unroll
    for (int a = 0; a < 2; ++a)
#pragma unroll
        for (int b = 0; b < 2; ++b)
#pragma unroll
            for (int m = 0; m < 4; ++m)
#pragma unroll
                for (int n = 0; n < 2; ++n) acc[a][b][m][n] = (f32x4){0.f, 0.f, 0.f, 0.f};
    bf16x8 At[4][2], B0[2][2], B1[2][2];
    const char* cA = (const char*)g.A + (size_t)(cur.pn >> g.a_shift) * g.a_stride + (size_t)cur.pm * tstep; const char* cB = (const char*)g.Bt + (size_t)cur.pn * tstep;
    S.a_ready(cur);
    if constexpr (SP2) {
        PG8_STAGE(PG8_SB(0, 0), cB, voffB); PG8_STAGE(PG8_SB(0, 1), cB + hstep, voffB); PG8_STAGE(PG8_SA(0, 0), cA, voffA); PG8_STAGE(PG8_SA(0, 1), cA + hstep, voffA);
        if (wr == 1) PG8_BAR;
        PG8_WAIT_V(2); PG8_BAR;
        PG8_STAGE(PG8_SB(1, 0), cB + kstep, voffB); PG8_STAGE(PG8_SA(1, 0), cA + kstep, voffA); PG8_STAGE(PG8_SB(1, 1), cB + hstep + kstep, voffB);
        PG8_WAIT_V(6); PG8_BAR;
    } else {
        PG8_STAGE(PG8_SB(0, 0), cB, voffB); PG8_STAGE(PG8_SA(0, 0), cA, voffA); PG8_STAGE(PG8_SB(0, 1), cB + hstep, voffB); PG8_STAGE(PG8_SA(0, 1), cA + hstep, voffA);
        if (wr == 1) PG8_BAR;
        PG8_WAIT_V(4); PG8_BAR;
        PG8_STAGE(PG8_SB(1, 0), cB + kstep, voffB); PG8_STAGE(PG8_SA(1, 0), cA + kstep, voffA); PG8_STAGE(PG8_SB(1, 1), cB + hstep + kstep, voffB);
        PG8_WAIT_V(6); PG8_BAR;
    }
    for (;;) {
        const bool has_next = S.next(ui + 1, nxt);
        const char* nA = has_next ? (const char*)g.A + (size_t)(nxt.pn >> g.a_shift) * g.a_stride + (size_t)nxt.pm * tstep : cA; const char* nB = has_next ? (const char*)g.Bt + (size_t)nxt.pn * tstep : cB;
        for (int t = 0; t < nt; t += 2) {
            const bool last = (t == nt - 2);
            const char* a1 = cA + (size_t)(t + 1) * kstep;
            const char* a2 = last ? nA : cA + (size_t)(t + 2) * kstep; const char* b2 = last ? nB : cB + (size_t)(t + 2) * kstep;
            const char* a3 = a2 + kstep; const char* b3 = b2 + kstep;
            if (last && has_next) S.a_ready(nxt);
            if constexpr (SP2) {
            PG8_LDB(B0, 0, 0); PG8_LDB(B1, 0, 1); PG8_SCHED; PG8_LDA(At, 0, 0); PG8_STAGE(PG8_SA(1, 1), a1 + hstep, voffA);
            PG8_WAIT_V(8); PG8_WAIT_L(0); PG8_BAR; PG8_MMA(0, 0, At, B0); PG8_MMA(0, 1, At, B1); PG8_BAR; PG8_SCHED;
            PG8_LDA(At, 0, 1); PG8_STAGE(PG8_SB(0, 0), b2, voffB); PG8_STAGE(PG8_SB(0, 1), b2 + hstep, voffB); PG8_STAGE(PG8_SA(0, 0), a2, voffA);
            PG8_WAIT_V(8); PG8_WAIT_L(0); PG8_BAR; PG8_MMA(1, 0, At, B0); PG8_MMA(1, 1, At, B1); PG8_BAR; PG8_SCHED;
            PG8_LDB(B0, 1, 0); PG8_LDB(B1, 1, 1); PG8_SCHED; PG8_LDA(At, 1, 0); PG8_STAGE(PG8_SA(0, 1), a2 + hstep, voffA);
            PG8_WAIT_V(8); PG8_WAIT_L(0); PG8_BAR; PG8_MMA(0, 0, At, B0); PG8_MMA(0, 1, At, B1); PG8_BAR; PG8_SCHED;
            PG8_LDA(At, 1, 1); PG8_STAGE(PG8_SB(1, 0), b3, voffB); PG8_STAGE(PG8_SB(1, 1), b3 + hstep, voffB); PG8_STAGE(PG8_SA(1, 0), a3, voffA);
            PG8_WAIT_V(8); PG8_WAIT_L(0); PG8_BAR; PG8_MMA(1, 0, At, B0); PG8_MMA(1, 1, At, B1); PG8_BAR; PG8_SCHED;
            } else {
            PG8_LDB(B0, 0, 0); PG8_SCHED; PG8_LDA(At, 0, 0); PG8_STAGE(PG8_SA(1, 1), a1 + hstep, voffA);
            PG8_WAIT_L(8); PG8_BAR; PG8_WAIT_L(0); PG8_MMA(0, 0, At, B0); PG8_BAR; PG8_SCHED;
            PG8_LDB(B1, 0, 1); PG8_STAGE(PG8_SB(0, 0), b2, voffB);
            PG8_BAR; PG8_WAIT_L(0); PG8_MMA(0, 1, At, B1); PG8_BAR;
            PG8_LDA(At, 0, 1); PG8_STAGE(PG8_SA(0, 0), a2, voffA);
            PG8_BAR; PG8_WAIT_L(0); PG8_MMA(1, 0, At, B0); PG8_BAR; PG8_SCHED;
            PG8_STAGE(PG8_SB(0, 1), b2 + hstep, voffB);
            PG8_WAIT_V(6); PG8_BAR; PG8_MMA(1, 1, At, B1); PG8_BAR;
            PG8_LDB(B0, 1, 0); PG8_SCHED; PG8_LDA(At, 1, 0); PG8_STAGE(PG8_SA(0, 1), a2 + hstep, voffA);
            PG8_WAIT_L(8); PG8_BAR; PG8_WAIT_L(0); PG8_MMA(0, 0, At, B0); PG8_BAR; PG8_SCHED;
            PG8_LDB(B1, 1, 1); PG8_STAGE(PG8_SB(1, 0), b3, voffB);
            PG8_BAR; PG8_WAIT_L(0); PG8_MMA(0, 1, At, B1); PG8_BAR;
            PG8_LDA(At, 1, 1); PG8_STAGE(PG8_SA(1, 0), a3, voffA);
            PG8_BAR; PG8_WAIT_L(0); PG8_MMA(1, 0, At, B0); PG8_BAR; PG8_SCHED;
            PG8_STAGE(PG8_SB(1, 1), b3 + hstep, voffB);
            PG8_WAIT_V(6); PG8_BAR; PG8_MMA(1, 1, At, B1); PG8_BAR;
            }
        }
        if constexpr (ALIGN_EPI) { if (wr == 0) PG8_BAR; }
        if constexpr (!Epi::AFTER_DRAIN) { E(acc, cur, wr, wc, fr, fq); S.done(cur); }
        if (!has_next) break;
#pragma unroll
        for (int a = 0; a < 2; ++a)
#pragma unroll
            for (int b = 0; b < 2; ++b)
#pragma unroll
                for (int m = 0; m < 4; ++m)
#pragma unroll
                    for (int n = 0; n < 2; ++n) acc[a][b][m][n] = (f32x4){0.f, 0.f, 0.f, 0.f};
        cur = nxt; cA = nA; cB = nB; ++ui;
        if constexpr (ALIGN_EPI) { if (wr == 1) PG8_BAR; }
    }
    PG8_WAIT_V(0);
    if constexpr (!ALIGN_EPI) { if (wr == 0) PG8_BAR; }
    PG8_BAR;
#undef PG8_SA
#undef PG8_SB
#undef PG8_STAGE
#undef PG8_LDA
#undef PG8_LDB
#undef PG8_MMA
#undef PG8_WAIT_V
#undef PG8_WAIT_L
#undef PG8_BAR
#undef PG8_SCHED
}
}

#define XB_TMO      128
#define XB_XCNT(j)  (256  + 64 * (j))
#define XB_XSUB(j)  (1280 + 64 * (j))
#define XB_XGEN(j)  (2304 + 64 * (j))
#define XB_TOP      3328
#define XB_TOPGEN   3392
#define XCD_BAR_WORDS 3456
#define XB_SPIN_CAP (1u << 18)

__device__ __forceinline__ unsigned xb_ld(unsigned* p)              { return __hip_atomic_load(p, __ATOMIC_RELAXED, __HIP_MEMORY_SCOPE_AGENT); }
__device__ __forceinline__ unsigned xb_add(unsigned* p, unsigned v) { return __hip_atomic_fetch_add(p, v, __ATOMIC_RELAXED, __HIP_MEMORY_SCOPE_AGENT); }
__device__ __forceinline__ unsigned xb_xcc_id() { return (unsigned)__builtin_amdgcn_s_getreg((3 << 11) | 20) & 0xFu; }
#define XB_SPIN(cond, bar) do { unsigned _sp = 0; while (cond) { __builtin_amdgcn_s_sleep(1); \
    if ((++_sp & 255u) == 0u) { if (xb_ld(&(bar)[XB_TMO])) break; if (_sp > XB_SPIN_CAP) { atomicAdd(&(bar)[XB_TMO], 1u); break; } } } } while (0)

struct XcdBarrier { unsigned* bar; unsigned x; volatile LAS unsigned* st; };

__device__ __forceinline__ XcdBarrier xcd_barrier_post(unsigned* bar, volatile LAS unsigned* st) {
    XcdBarrier b; b.bar = bar; b.x = xb_xcc_id(); b.st = st;
    if (threadIdx.x == 0) (void)xb_add(&bar[XB_XCNT(b.x)], 1u);
    return b;
}
__device__ __forceinline__ void xcd_barrier_complete(unsigned* bar, unsigned x, unsigned& nloc, unsigned& nx) {
    const unsigned G = gridDim.x * gridDim.y * gridDim.z;
    unsigned sum, cnt, mine, sp = 0u;
    for (;;) {
        sum = 0u; cnt = 0u; mine = 0u;
#pragma unroll
        for (unsigned j = 0; j < 16; ++j) { const unsigned c = xb_ld(&bar[XB_XCNT(j)]); sum += c; cnt += (c > 0u) ? 1u : 0u; mine = (j == x) ? c : mine; }
        if (sum == G) break;
        __builtin_amdgcn_s_sleep(1);
        if ((++sp & 255u) == 0u) { if (xb_ld(&bar[XB_TMO])) break; if (sp > XB_SPIN_CAP) { atomicAdd(&bar[XB_TMO], 1u); break; } }
    }
    nloc = mine > 0u ? mine : 1u; nx = cnt > 0u ? cnt : 1u;
}
__device__ __forceinline__ void xcd_barrier(const XcdBarrier& b) {
    asm volatile("s_waitcnt vmcnt(0)" ::: "memory");
    __syncthreads();
    if (threadIdx.x == 0) {
        unsigned* bar = b.bar;
        __builtin_amdgcn_s_waitcnt(0);
        unsigned nloc = b.st[0], nx = b.st[1];
        if (nloc == 0u) { xcd_barrier_complete(bar, b.x, nloc, nx); b.st[0] = nloc; b.st[1] = nx; }
        const unsigned old = xb_add(&bar[XB_XSUB(b.x)], 1u);
        const unsigned gen = old / nloc;
        if (old + 1u == (gen + 1u) * nloc) {
            __builtin_amdgcn_fence(__ATOMIC_RELEASE, "agent");
            asm volatile("s_waitcnt vmcnt(0)" ::: "memory");
            const unsigned og = xb_add(&bar[XB_TOP], 1u);
            const unsigned tg = og / nx;
            if (og + 1u == (tg + 1u) * nx) xb_add(&bar[XB_TOPGEN], 1u);
            else XB_SPIN(xb_ld(&bar[XB_TOPGEN]) == tg, bar);
            __builtin_amdgcn_fence(__ATOMIC_ACQUIRE, "agent");
            xb_add(&bar[XB_XGEN(b.x)], 1u);
            asm volatile("s_waitcnt vmcnt(0)" ::: "memory");
        } else {
            XB_SPIN(xb_ld(&bar[XB_XGEN(b.x)]) == gen, bar);
            __builtin_amdgcn_fence(__ATOMIC_ACQUIRE, "agent");
            asm volatile("s_waitcnt vmcnt(0)" ::: "memory");
        }
    }
    __syncthreads();
}

struct Frame {
    LAS unsigned char* lds;
    int vcu, G;
};
__device__ __forceinline__ int opaque_tid() { int t = threadIdx.x; asm volatile("" : "+v"(t)); return t; }
#define PH_IDS const int tid = opaque_tid(), lane = tid & 63, w = __builtin_amdgcn_readfirstlane(tid >> 6); (void)tid; (void)lane; (void)w

template <class SrcF>
__device__ __forceinline__ void prep_matrix(const Frame& F, int K, int N, bf16* WT, SrcF src) {
    PH_IDS;
    LAS float* scr = (LAS float*)(F.lds + w * 8448);
    const int gw = F.vcu * NWAVES + w, NGW = F.G * NWAVES;
    const int nblk = N / 32, nitems = (K / 64) * nblk;
    for (int it = gw; it < nitems; it += NGW) {
        const int kb = it / nblk, nb = it % nblk, k0 = 64 * kb, n0 = 32 * nb;
        float tv[32];
#pragma unroll
        for (int i = 0; i < 32; ++i) tv[i] = src(k0 + 2 * i + (lane >> 5), n0 + (lane & 31));
#pragma unroll
        for (int i = 0; i < 32; ++i) scr[(2 * i + (lane >> 5)) * 33 + (lane & 31)] = tv[i];
        LDS_WAIT();
        const int c = lane & 7;
#pragma unroll
        for (int j = 0; j < 4; ++j) { const int n = (lane >> 3) + 8 * j; const LAS float* s = scr + (8 * c) * 33 + n;
            u32x4 o; o.x = cvt_pk_bf16(s[0 * 33], s[1 * 33]); o.y = cvt_pk_bf16(s[2 * 33], s[3 * 33]); o.z = cvt_pk_bf16(s[4 * 33], s[5 * 33]); o.w = cvt_pk_bf16(s[6 * 33], s[7 * 33]);
            *(u32x4*)(WT + (size_t)(n0 + n) * K + k0 + 8 * c) = o; }
        LDS_WAIT();
    }
}

struct Args { const void* in[28]; float* out; unsigned char* ws; int p_lo, p_hi; };
__device__ __forceinline__ const float* kin(const Args& a, int i) { asm volatile("" : "+s"(i)); return (const float*)a.in[i]; }

__device__ __forceinline__ void prep_layer(const Frame& F, const Args& in, unsigned char* ws, int L) {
    const int kind = L % 3, j = L / 3;
#pragma unroll 1
    for (int f = 0; f < 2; ++f) {
        const float* wgu = kin(in, 3) + (size_t)(L * 2 + f) * DM * 2 * DFF;
        const float* gpre = kin(in, 2) + (size_t)(L * 6 + (f ? 4 : 0)) * DM;
        prep_matrix(F, DM, 2 * DFF, (bf16*)(ws + (f ? W_GU1 : W_GU0)), [=](int k, int n) { const int pn = n >> 8, r = n & 255; const int sc = (r < 128) ? (pn * 128 + r) : (DFF + pn * 128 + (r - 128)); return wgu[(size_t)k * (2 * DFF) + sc] * gpre[k]; });
        const float* wdn = kin(in, 4) + (size_t)(L * 2 + f) * DFF * DM;
        prep_matrix(F, DFF, DM, (bf16*)(ws + (f ? W_DN1 : W_DN0)), [=](int k, int n) { return wdn[(size_t)k * DM + n]; });
    }
    if (kind == 0) {
        const float* win = kin(in, 5) + (size_t)j * DM * ML_IN;
        const float* g2 = kin(in, 2) + (size_t)(L * 6 + 2) * DM;
        prep_matrix(F, DM, 3072, (bf16*)(ws + W_MIX), [=](int k, int n) { return win[(size_t)k * ML_IN + n] * g2[k]; });
        const float* wo = kin(in, 9) + (size_t)j * DM * DM;
        prep_matrix(F, DM, DM, (bf16*)(ws + W_MIX + (size_t)3072 * 1024 * 2), [=](int k, int n) { return wo[(size_t)k * DM + n]; });
    } else if (kind == 1) {
        const float* mu = kin(in, 10) + (size_t)j * 6 * DM; const float* wrkv = kin(in, 11) + (size_t)j * 3 * DM * DM;
        const float* w1 = kin(in, 13) + (size_t)j * DM * 64; const float* a1 = kin(in, 16) + (size_t)j * DM * 64; const float* g1 = kin(in, 18) + (size_t)j * DM * 128;
        prep_matrix(F, DM, 3072, (bf16*)(ws + W_MIX), [=](int k, int n) { return wrkv[((size_t)(n >> 10) * DM + k) * DM + (n & 1023)]; });
        prep_matrix(F, 2048, 256, (bf16*)(ws + W_MIX + (size_t)3072 * 1024 * 2), [=](int k, int c) {
            const int kk = k & 1023; const bool hi = k >= 1024; float w; int mi;
            if (c < 64) { mi = 3; w = w1[kk * 64 + c]; } else if (c < 128) { mi = 4; w = a1[kk * 64 + (c - 64)]; } else { mi = 5; w = g1[kk * 128 + (c - 128)]; }
            const float m = mu[mi * DM + kk]; return w * (hi ? m : 1.0f - m); });
        const float* w2 = kin(in, 14) + (size_t)j * 64 * DM; const float* a2 = kin(in, 17) + (size_t)j * 64 * DM; const float* g2 = kin(in, 19) + (size_t)j * 128 * DM;
        prep_matrix(F, 256, 3072, (bf16*)(ws + W_MIX + (size_t)3072 * 1024 * 2 + (size_t)256 * 2048 * 2), [=](int k, int n) {
            const int t = n >> 10, c = n & 1023;
            if (t == 0) return k < 64 ? w2[k * DM + c] : 0.f;
            if (t == 1) return (k >= 64 && k < 128) ? a2[(k - 64) * DM + c] : 0.f;
            return k >= 128 ? g2[(k - 128) * DM + c] : 0.f; });
        const float* wo = kin(in, 25) + (size_t)j * DM * DM;
        prep_matrix(F, DM, DM, (bf16*)(ws + W_MIX + (size_t)3072 * 1024 * 2 + (size_t)256 * 2048 * 2 + (size_t)3072 * 256 * 2), [=](int k, int n) { return wo[(size_t)k * DM + n]; });
    } else {
        const float* win = kin(in, 26) + (size_t)j * DM * 6144;
        const float* g2 = kin(in, 2) + (size_t)(L * 6 + 2) * DM;
        prep_matrix(F, DM, 6144, (bf16*)(ws + W_MIX), [=](int k, int n) { return win[(size_t)k * 6144 + n] * g2[k]; });
        const float* wo = kin(in, 27) + (size_t)j * 2048 * DM;
        prep_matrix(F, 2048, DM, (bf16*)(ws + W_MIX + (size_t)6144 * 1024 * 2), [=](int k, int n) { return wo[(size_t)k * DM + n]; });
    }
}

__device__ __forceinline__ void norm_phase(const Frame& F, const float* x0, const bf16* xbi, const float* rhoi, bf16* xb, float* rho, const bf16* h, float c, const float* gpost, int mode, float* fout) {
    PH_IDS;
    const int gw = F.vcu * NWAVES + w, NGW = F.G * NWAVES;
    f32x4 gp[4];
#pragma unroll
    for (int j = 0; j < 4; ++j) gp[j] = h ? *(const f32x4*)(gpost + 4 * lane + 256 * j) : (f32x4){0.f, 0.f, 0.f, 0.f};
    for (int m = gw; m < M; m += NGW) {
        f32x4 v[4];
        if (x0) {
#pragma unroll
            for (int j = 0; j < 4; ++j) v[j] = *(const f32x4*)(x0 + (size_t)m * DM + 4 * lane + 256 * j);
        } else {
            const float rh = rhoi[m];
#pragma unroll
            for (int j = 0; j < 4; ++j) { const u32x2 r = *(const u32x2*)(xbi + (size_t)m * DM + 4 * lane + 256 * j); v[j] = (f32x4){bf_lo(r.x), bf_hi(r.x), bf_lo(r.y), bf_hi(r.y)} * rh; }
        }
        if (h) {
            f32x4 hv[4]; float s = 0.f;
#pragma unroll
            for (int j = 0; j < 4; ++j) { const u32x2 r = *(const u32x2*)(h + (size_t)m * DM + 4 * lane + 256 * j); hv[j] = (f32x4){bf_lo(r.x), bf_hi(r.x), bf_lo(r.y), bf_hi(r.y)};
                s += (hv[j][0] * hv[j][0] + hv[j][1] * hv[j][1]) + (hv[j][2] * hv[j][2] + hv[j][3] * hv[j][3]); }
            const float rs = __builtin_amdgcn_rsqf(wave_sum(s) * (1.0f / DM) + NORM_EPS) * c;
#pragma unroll
            for (int j = 0; j < 4; ++j) v[j] += hv[j] * rs * gp[j];
        }
        if (mode == 3) {
            float* o = fout + (size_t)m * DM;
#pragma unroll
            for (int j = 0; j < 4; ++j) *(f32x4*)(o + 4 * lane + 256 * j) = v[j];
        } else {
            float s = 0.f;
#pragma unroll
            for (int j = 0; j < 4; ++j) s += (v[j][0] * v[j][0] + v[j][1] * v[j][1]) + (v[j][2] * v[j][2] + v[j][3] * v[j][3]);
            const float ms = wave_sum(s) * (1.0f / DM) + NORM_EPS;
            const float rs = __builtin_amdgcn_rsqf(ms);
            if (lane == 0) rho[m] = ms * rs;
#pragma unroll
            for (int j = 0; j < 4; ++j) { v[j] = v[j] * rs; u32x2 o; o.x = cvt_pk_bf16(v[j][0], v[j][1]); o.y = cvt_pk_bf16(v[j][2], v[j][3]); *(u32x2*)(xb + (size_t)m * DM + 4 * lane + 256 * j) = o; }
        }
    }
}

__device__ __forceinline__ void norm_mix_phase(const Frame& F, const bf16* xbi, const float* rhoi, bf16* xbo, float* rhoo, const bf16* h, float c, const float* gpost, const float* gpre, const float* mu, bf16* ap, bf16* mixes) {
    PH_IDS;
    const int gw = F.vcu * NWAVES + w, NGW = F.G * NWAVES, rpw = M / NGW;
    f32x4 gp[4], gq[4], mu0[4], mu1[4], mu2[4];
#pragma unroll
    for (int j = 0; j < 4; ++j) { const int o = 4 * lane + 256 * j; gp[j] = *(const f32x4*)(gpost + o); gq[j] = *(const f32x4*)(gpre + o); mu0[j] = *(const f32x4*)(mu + o); mu1[j] = *(const f32x4*)(mu + DM + o); mu2[j] = *(const f32x4*)(mu + 2 * DM + o); }
    f32x4 prev[4];
    for (int r = -1; r < rpw; ++r) {
        const int m = gw * rpw + r, t = m & (SEQ - 1);
        if (r < 0 && t == SEQ - 1) {
#pragma unroll
            for (int j = 0; j < 4; ++j) prev[j] = (f32x4){0.f, 0.f, 0.f, 0.f};
            continue;
        }
        f32x4 v[4], hv[4]; float s = 0.f;
        const float rh = rhoi[m];
#pragma unroll
        for (int j = 0; j < 4; ++j) { const u32x2 a = *(const u32x2*)(xbi + (size_t)m * DM + 4 * lane + 256 * j), b = *(const u32x2*)(h + (size_t)m * DM + 4 * lane + 256 * j);
            v[j] = (f32x4){bf_lo(a.x), bf_hi(a.x), bf_lo(a.y), bf_hi(a.y)} * rh; hv[j] = (f32x4){bf_lo(b.x), bf_hi(b.x), bf_lo(b.y), bf_hi(b.y)};
            s += (hv[j][0] * hv[j][0] + hv[j][1] * hv[j][1]) + (hv[j][2] * hv[j][2] + hv[j][3] * hv[j][3]); }
        const float rsh = __builtin_amdgcn_rsqf(wave_sum(s) * (1.0f / DM) + NORM_EPS) * c;
        float s2 = 0.f;
#pragma unroll
        for (int j = 0; j < 4; ++j) { v[j] += hv[j] * rsh * gp[j]; s2 += (v[j][0] * v[j][0] + v[j][1] * v[j][1]) + (v[j][2] * v[j][2] + v[j][3] * v[j][3]); }
        const float ms = wave_sum(s2) * (1.0f / DM) + NORM_EPS, rs = __builtin_amdgcn_rsqf(ms);
        f32x4 y[4];
#pragma unroll
        for (int j = 0; j < 4; ++j) { v[j] = v[j] * rs; y[j] = v[j] * gq[j]; }
        if (r >= 0) {
            if (lane == 0) rhoo[m] = ms * rs;
#pragma unroll
            for (int j = 0; j < 4; ++j) {
                const int o = 4 * lane + 256 * j;
                *(u32x2*)(xbo + (size_t)m * DM + o) = (u32x2){cvt_pk_bf16(v[j][0], v[j][1]), cvt_pk_bf16(v[j][2], v[j][3])};
                const f32x4 d = prev[j] - y[j], m0v = y[j] + d * mu0[j], m1v = y[j] + d * mu1[j], m2v = y[j] + d * mu2[j];
                *(u32x2*)(ap + (size_t)m * 2048 + o) = (u32x2){cvt_pk_bf16(y[j][0], y[j][1]), cvt_pk_bf16(y[j][2], y[j][3])};
                *(u32x2*)(ap + (size_t)m * 2048 + 1024 + o) = (u32x2){cvt_pk_bf16(prev[j][0], prev[j][1]), cvt_pk_bf16(prev[j][2], prev[j][3])};
                *(u32x2*)(mixes + (size_t)m * DM + o) = (u32x2){cvt_pk_bf16(m0v[0], m0v[1]), cvt_pk_bf16(m0v[2], m0v[3])};
                *(u32x2*)(mixes + ((size_t)M + m) * DM + o) = (u32x2){cvt_pk_bf16(m1v[0], m1v[1]), cvt_pk_bf16(m1v[2], m1v[3])};
                *(u32x2*)(mixes + ((size_t)2 * M + m) * DM + o) = (u32x2){cvt_pk_bf16(m2v[0], m2v[1]), cvt_pk_bf16(m2v[2], m2v[3])};
            }
        }
        if (t == SEQ - 1) {
#pragma unroll
            for (int j = 0; j < 4; ++j) prev[j] = (f32x4){0.f, 0.f, 0.f, 0.f};
        } else {
#pragma unroll
            for (int j = 0; j < 4; ++j) prev[j] = y[j];
        }
    }
}

__device__ __forceinline__ void ml_gate_phase(const Frame& F, const bf16* xn, const float* gpre, const float* w_in, const float* b_if, float* ifg) {
    PH_IDS;
    const int gw = F.vcu * NWAVES + w, NGW = F.G * NWAVES;
    f32x4 wif[8][4];
#pragma unroll
    for (int j = 0; j < 4; ++j)
#pragma unroll
        for (int e = 0; e < 4; ++e) { const int k = 4 * lane + 256 * j + e; const f32x4 a = *(const f32x4*)(w_in + (size_t)k * ML_IN + 3072), b = *(const f32x4*)(w_in + (size_t)k * ML_IN + 3076);
            const float gk = gpre[k];
            wif[0][j][e] = a[0] * gk; wif[1][j][e] = a[1] * gk; wif[2][j][e] = a[2] * gk; wif[3][j][e] = a[3] * gk; wif[4][j][e] = b[0] * gk; wif[5][j][e] = b[1] * gk; wif[6][j][e] = b[2] * gk; wif[7][j][e] = b[3] * gk; }
    const float bias = lane < 8 ? b_if[lane] : 0.f;
    for (int m = gw; m < M; m += NGW) {
        f32x4 y[4];
#pragma unroll
        for (int j = 0; j < 4; ++j) { const u32x2 r = *(const u32x2*)(xn + (size_t)m * DM + 4 * lane + 256 * j); y[j] = (f32x4){bf_lo(r.x), bf_hi(r.x), bf_lo(r.y), bf_hi(r.y)}; }
        float my = 0.f;
#pragma unroll
        for (int cc = 0; cc < 8; ++cc) { float d = 0.f;
#pragma unroll
            for (int j = 0; j < 4; ++j) d += (y[j][0] * wif[cc][j][0] + y[j][1] * wif[cc][j][1]) + (y[j][2] * wif[cc][j][2] + y[j][3] * wif[cc][j][3]);
            d = wave_sum(d); if (lane == cc) my = d; }
        if (lane < 8) { float val = my + bias; val = 15.0f * tanhf(val * (1.0f / 15.0f));
            if (lane >= 4) val = -log1pf(expf(-val));
            ifg[(size_t)m * 8 + lane] = val; }
    }
}

__device__ __forceinline__ void ml_chunk_phase(const Frame& F, const bf16* proj, const float* ifg, const float* conv_w, bf16* hb) {
    constexpr int QP = 272, SP = 144;
    constexpr int QS = 0, KS = QS + 64 * QP, KWT = KS + 64 * QP, VT = KWT + 128 * SP, PS = VT + 80 * SP, CT = PS + 64 * SP, TAB = CT + 80 * QP, CWT = TAB + 1024;
    static_assert(CWT + 4096 <= RING_BYTES, "ml lds");
    LAS unsigned char* lds = F.lds;
    LAS float* tU = (LAS float*)(lds + TAB); LAS float* tM = tU + 64; LAS float* tB = tU + 128; LAS float* tD = tU + 192;
    PH_IDS;
    const int fr = lane & 15, fq = lane >> 4;
    for (int item = F.vcu; item < NB * 16; item += F.G) {
        const int b = item >> 4, hh = (item >> 2) & 3, vs = item & 3;
        const size_t rowb = (size_t)b * SEQ;
        for (int i = tid; i < 16 * 36; i += 512) { const int r = i / 36, cidx = i % 36; ((LAS unsigned*)(lds + VT + (64 + r) * SP))[cidx] = (r == 0) ? 0x3f803f80u : 0u; }
        const int which = tid >> 8, tq = (tid >> 4) & 15, c8 = tid & 15;
        const int ch = which * 512 + hh * 128 + c8 * 8;
        for (int i = tid; i < 4 * 256; i += 512) { const int jj = i >> 8, cc = i & 255; ((LAS float*)(lds + CWT))[i] = conv_w[jj * 1024 + (cc >> 7) * 512 + hh * 128 + (cc & 127)]; }
        const float qscale = which == 0 ? 0.08838834764831845f : 1.0f;
        const int tqv = tid >> 5, vp = tid & 31;
        const int vcol = 1024 + hh * 256 + vs * 64 + 2 * vp;
        f32x4 C[5];
#pragma unroll
        for (int jj = 0; jj < 5; ++jj) C[jj] = (f32x4){0.f, 0.f, 0.f, 0.f};
        float mst = 0.f;
        u32x4 rq[7]; unsigned rv[4]; float gi, gf;
        const unsigned loQ = (unsigned)((4 * tq) * 3072 + ch) * 2u, loV = (unsigned)((4 * tqv) * 3072 + vcol) * 2u;
        auto prefetch = [&](int c) {
            const char* base = (const char*)proj + (rowb + 64 * c) * (size_t)(3072 * 2);
            const int t0 = 64 * c + 4 * tq - 3;
#pragma unroll
            for (int r = 0; r < 7; ++r) rq[r] = (t0 + r >= 0) ? *(const u32x4*)(base + (ptrdiff_t)(r - 3) * (3072 * 2) + loQ) : (u32x4){0u, 0u, 0u, 0u};
#pragma unroll
            for (int r = 0; r < 4; ++r) rv[r] = *(const unsigned*)(base + (size_t)r * (3072 * 2) + loV);
            const float* gb = ifg + (rowb + 64 * c) * 8 + hh;
            gi = gb[lane * 8]; gf = gb[lane * 8 + 4];
        };
        prefetch(0);
        for (int c = 0; c < SEQ / 64; ++c) {
            const float bsum = scan_sum64(gf);
            const float uu = gi - bsum;
            const float Mx = fmaxf(mst, scan_max64(uu));
            const float M63 = lane63(Mx), b63 = lane63(bsum);
            if (w == 0) { tU[lane] = uu; tM[lane] = Mx; tB[lane] = bsum; }
#pragma unroll
            for (int jj = 0; jj < 5; ++jj) { u32x2 o; o.x = cvt_pk_bf16(C[jj][0], C[jj][1]); o.y = cvt_pk_bf16(C[jj][2], C[jj][3]);
                *(LAS u32x2*)(lds + CT + (16 * jj + fr) * QP + (16 * w + 4 * fq) * 2) = o; }
            WG_BAR();
            {
                float kws[4];
#pragma unroll
                for (int tt = 0; tt < 4; ++tt) kws[tt] = fexp(tU[4 * tq + tt] - M63);
                float cw[4][8];
#pragma unroll
                for (int jj = 0; jj < 4; ++jj) { const f32x4 a = *(const LAS f32x4*)(lds + CWT + (jj * 256 + which * 128 + c8 * 8) * 4), bq = *(const LAS f32x4*)(lds + CWT + (jj * 256 + which * 128 + c8 * 8 + 4) * 4);
                    cw[jj][0] = a[0]; cw[jj][1] = a[1]; cw[jj][2] = a[2]; cw[jj][3] = a[3]; cw[jj][4] = bq[0]; cw[jj][5] = bq[1]; cw[jj][6] = bq[2]; cw[jj][7] = bq[3]; }
                float o[4][8];
#pragma unroll
                for (int tt = 0; tt < 4; ++tt) {
#pragma unroll
                    for (int e2 = 0; e2 < 4; ++e2) { float a0 = 0.f, a1 = 0.f;
#pragma unroll
                        for (int jj = 0; jj < 4; ++jj) { const unsigned x = rq[tt + jj][e2]; a0 += cw[jj][2 * e2] * bf_lo(x); a1 += cw[jj][2 * e2 + 1] * bf_hi(x); }
                        o[tt][2 * e2] = fsilu(a0) * qscale; o[tt][2 * e2 + 1] = fsilu(a1) * qscale; }
                    u32x4 pk; pk.x = cvt_pk_bf16(o[tt][0], o[tt][1]); pk.y = cvt_pk_bf16(o[tt][2], o[tt][3]); pk.z = cvt_pk_bf16(o[tt][4], o[tt][5]); pk.w = cvt_pk_bf16(o[tt][6], o[tt][7]);
                    *(LAS u32x4*)(lds + (which ? KS : QS) + (4 * tq + tt) * QP + c8 * 16) = pk;
                }
                if (which) {
#pragma unroll
                    for (int e = 0; e < 8; ++e) { u32x2 pk; pk.x = cvt_pk_bf16(o[0][e] * kws[0], o[1][e] * kws[1]); pk.y = cvt_pk_bf16(o[2][e] * kws[2], o[3][e] * kws[3]);
                        *(LAS u32x2*)(lds + KWT + (c8 * 8 + e) * SP + (4 * tq) * 2) = pk; }
                }
                u32x2 v0, v1;
                v0.x = (rv[0] & 0xffffu) | (rv[1] << 16); v0.y = (rv[2] & 0xffffu) | (rv[3] << 16);
                v1.x = (rv[0] >> 16) | (rv[1] & 0xffff0000u); v1.y = (rv[2] >> 16) | (rv[3] & 0xffff0000u);
                *(LAS u32x2*)(lds + VT + (2 * vp) * SP + (4 * tqv) * 2) = v0; *(LAS u32x2*)(lds + VT + (2 * vp + 1) * SP + (4 * tqv) * 2) = v1;
            }
            WG_BAR();
            if (c + 1 < SEQ / 64) prefetch(c + 1);
            {
                const int tt = w >> 1, st0 = 2 * (w & 1);
                f32x4 s0 = {0.f, 0.f, 0.f, 0.f}, s1 = {0.f, 0.f, 0.f, 0.f};
#pragma unroll
                for (int kk = 0; kk < 4; ++kk) {
                    const bf16x8 yq = *(const LAS bf16x8*)(lds + QS + (16 * tt + fr) * QP + (32 * kk + 8 * fq) * 2);
                    const bf16x8 x0 = *(const LAS bf16x8*)(lds + KS + (16 * st0 + fr) * QP + (32 * kk + 8 * fq) * 2);
                    const bf16x8 x1 = *(const LAS bf16x8*)(lds + KS + (16 * (st0 + 1) + fr) * QP + (32 * kk + 8 * fq) * 2);
                    s0 = mma16(x0, yq, s0); s1 = mma16(x1, yq, s1);
                }
                const int t = 16 * tt + fr; const float Mt = tM[t];
#pragma unroll
                for (int q = 0; q < 2; ++q) { const f32x4 sv = q ? s1 : s0; const int sb = 16 * (st0 + q) + 4 * fq; const f32x4 u4 = *(const LAS f32x4*)(tU + sb);
                    float p[4];
#pragma unroll
                    for (int e = 0; e < 4; ++e) p[e] = (sb + e <= t) ? sv[e] * fexp(u4[e] - Mt) : 0.f;
                    u32x2 pk; pk.x = cvt_pk_bf16(p[0], p[1]); pk.y = cvt_pk_bf16(p[2], p[3]);
                    *(LAS u32x2*)(lds + PS + t * SP + sb * 2) = pk; }
            }
            WG_BAR_L();
            {
                const int tt = w & 3, jb = (w < 4) ? 0 : 3, nj = (w < 4) ? 3 : 2;
                f32x4 a1[3], a2[3];
#pragma unroll
                for (int jj = 0; jj < 3; ++jj) { a1[jj] = (f32x4){0.f, 0.f, 0.f, 0.f}; a2[jj] = (f32x4){0.f, 0.f, 0.f, 0.f}; }
#pragma unroll
                for (int kk = 0; kk < 2; ++kk) { const bf16x8 yp = *(const LAS bf16x8*)(lds + PS + (16 * tt + fr) * SP + (32 * kk + 8 * fq) * 2);
#pragma unroll
                    for (int jj = 0; jj < 3; ++jj) if (jj < nj) { const bf16x8 xv = *(const LAS bf16x8*)(lds + VT + (16 * (jb + jj) + fr) * SP + (32 * kk + 8 * fq) * 2); a1[jj] = mma16(xv, yp, a1[jj]); } }
#pragma unroll
                for (int kk = 0; kk < 4; ++kk) { const bf16x8 yq = *(const LAS bf16x8*)(lds + QS + (16 * tt + fr) * QP + (32 * kk + 8 * fq) * 2);
#pragma unroll
                    for (int jj = 0; jj < 3; ++jj) if (jj < nj) { const bf16x8 xc = *(const LAS bf16x8*)(lds + CT + (16 * (jb + jj) + fr) * QP + (32 * kk + 8 * fq) * 2); a2[jj] = mma16(xc, yq, a2[jj]); } }
                const int t = 16 * tt + fr; const float Mt = tM[t], bt = tB[t]; const float inter = fexp(mst - Mt);
#pragma unroll
                for (int jj = 0; jj < 3; ++jj) a1[jj] = a1[jj] + a2[jj] * inter;
                if (w >= 4 && fq == 0) tD[t] = a1[1][0];
                WG_BAR_L();
                const float dn = fmaxf(fabsf(tD[t]), fexp(-(bt + Mt))); const float rdn = 1.0f / dn;
#pragma unroll
                for (int jj = 0; jj < 3; ++jj) if (jj < nj && jb + jj < 4) { u32x2 pk; pk.x = cvt_pk_bf16(a1[jj][0] * rdn, a1[jj][1] * rdn); pk.y = cvt_pk_bf16(a1[jj][2] * rdn, a1[jj][3] * rdn);
                    *(u32x2*)((char*)(hb + (rowb + 64 * c + 16 * tt) * DM + hh * 256 + vs * 64 + 16 * (jb + jj)) + (unsigned)(fr * DM + 4 * fq) * 2u) = pk; }
            }
            {
                const float decay = fexp(mst - M63);
#pragma unroll
                for (int jj = 0; jj < 5; ++jj) C[jj] = C[jj] * decay;
#pragma unroll
                for (int kk = 0; kk < 2; ++kk) { const bf16x8 xk = *(const LAS bf16x8*)(lds + KWT + (16 * w + fr) * SP + (32 * kk + 8 * fq) * 2);
#pragma unroll
                    for (int jj = 0; jj < 5; ++jj) { const bf16x8 yv = *(const LAS bf16x8*)(lds + VT + (16 * jj + fr) * SP + (32 * kk + 8 * fq) * 2); C[jj] = mma16(xk, yv, C[jj]); } }
                mst = b63 + M63;
            }
            WG_BAR_L();
        }
    }
}

__device__ __forceinline__ void ml_head_phase(const Frame& F, const bf16* hb, const bf16* proj, const float* ng, bf16* hg) {
    PH_IDS;
    const int gw = F.vcu * NWAVES + w, NGW = F.G * NWAVES;
    f32x4 g[4];
#pragma unroll
    for (int j = 0; j < 4; ++j) g[j] = *(const f32x4*)(ng + 4 * lane + 256 * j);
    for (int m = gw; m < M; m += NGW) {
#pragma unroll
        for (int j = 0; j < 4; ++j) {
            const u32x2 r = *(const u32x2*)(hb + (size_t)m * DM + 4 * lane + 256 * j), ro = *(const u32x2*)(proj + (size_t)m * 3072 + 2048 + 4 * lane + 256 * j);
            const f32x4 v = {bf_lo(r.x), bf_hi(r.x), bf_lo(r.y), bf_hi(r.y)}, o = {bf_lo(ro.x), bf_hi(ro.x), bf_lo(ro.y), bf_hi(ro.y)};
            const float s = wave_sum((v[0] * v[0] + v[1] * v[1]) + (v[2] * v[2] + v[3] * v[3]));
            const float rs = __builtin_amdgcn_rsqf(s * (1.0f / 256.0f) + NORM_EPS);
            u32x2 pk; pk.x = cvt_pk_bf16(v[0] * rs * g[j][0] * fsigmoid(o[0]), v[1] * rs * g[j][1] * fsigmoid(o[1])); pk.y = cvt_pk_bf16(v[2] * rs * g[j][2] * fsigmoid(o[2]), v[3] * rs * g[j][3] * fsigmoid(o[3]));
            *(u32x2*)(hg + (size_t)m * DM + 4 * lane + 256 * j) = pk;
        }
    }
}

__device__ __forceinline__ void rt_chunk_phase(const Frame& F, const bf16* proj, bf16* yb) {
    constexpr int QP = 528, SP = 144;
    constexpr int QS = 0, KS = QS + 64 * QP, KWT = KS + 64 * QP, VT = KWT + 256 * SP, PS = VT + 128 * SP, END = PS + 64 * SP;
    static_assert(END <= MISC_OFF, "rt lds");
    LAS unsigned char* lds = F.lds;
    PH_IDS;
    const int fr = lane & 15, fq = lane >> 4;
    for (int item = F.vcu; item < NB * 16; item += F.G) {
        const int b = item >> 4, hh = (item >> 2) & 3, vs = item & 3;
        const size_t rowb = (size_t)b * SEQ;
        const float lg = __builtin_log2f(1.0f - __builtin_amdgcn_exp2f(-5.0f - (float)hh));
        const int tq = tid >> 5, c8 = tid & 31;
        const int qcol = hh * 256, kcol = 1024 + hh * 256 + c8 * 8, vcol = 2048 + hh * 512 + vs * 128 + 4 * c8;
        f32x4 R[16];
#pragma unroll
        for (int i = 0; i < 16; ++i) R[i] = (f32x4){0.f, 0.f, 0.f, 0.f};
        u32x4 rq[4], rk[4]; u32x2 rv[4];
        const unsigned loQ = (unsigned)((tid >> 5) * 6144 + qcol + (tid & 31) * 8) * 2u, loK = (unsigned)((4 * tq) * 6144 + kcol) * 2u, loV = (unsigned)((4 * tq) * 6144 + vcol) * 2u;
        auto prefetch = [&](int c) {
            const char* base = (const char*)proj + (rowb + 64 * c) * (size_t)(6144 * 2);
#pragma unroll
            for (int i = 0; i < 4; ++i) rq[i] = *(const u32x4*)(base + (size_t)i * (16 * 6144 * 2) + loQ);
#pragma unroll
            for (int i = 0; i < 4; ++i) { rk[i] = *(const u32x4*)(base + (size_t)i * (6144 * 2) + loK); rv[i] = *(const u32x2*)(base + (size_t)i * (6144 * 2) + loV); }
        };
        prefetch(0);
        float kws[4];
#pragma unroll
        for (int i = 0; i < 4; ++i) kws[i] = __builtin_amdgcn_exp2f(lg * (float)(63 - (4 * tq + i)));
        const float cdecay = __builtin_amdgcn_exp2f(lg * 64.0f);
        for (int c = 0; c < SEQ / 64; ++c) {
#pragma unroll
            for (int i = 0; i < 4; ++i) { const int idx = tid + 512 * i; *(LAS u32x4*)(lds + QS + (idx >> 5) * QP + (idx & 31) * 16) = rq[i]; }
#pragma unroll
            for (int i = 0; i < 4; ++i) *(LAS u32x4*)(lds + KS + (4 * tq + i) * QP + c8 * 16) = rk[i];
#pragma unroll
            for (int e2 = 0; e2 < 4; ++e2) {
                u32x2 lo, hi;
                lo.x = cvt_pk_bf16(bf_lo(rk[0][e2]) * kws[0], bf_lo(rk[1][e2]) * kws[1]); lo.y = cvt_pk_bf16(bf_lo(rk[2][e2]) * kws[2], bf_lo(rk[3][e2]) * kws[3]);
                hi.x = cvt_pk_bf16(bf_hi(rk[0][e2]) * kws[0], bf_hi(rk[1][e2]) * kws[1]); hi.y = cvt_pk_bf16(bf_hi(rk[2][e2]) * kws[2], bf_hi(rk[3][e2]) * kws[3]);
                *(LAS u32x2*)(lds + KWT + (c8 * 8 + 2 * e2) * SP + (4 * tq) * 2) = lo; *(LAS u32x2*)(lds + KWT + (c8 * 8 + 2 * e2 + 1) * SP + (4 * tq) * 2) = hi;
            }
            {
                u32x2 v0, v1, v2, v3;
                v0.x = (rv[0].x & 0xffffu) | (rv[1].x << 16); v0.y = (rv[2].x & 0xffffu) | (rv[3].x << 16);
                v1.x = (rv[0].x >> 16) | (rv[1].x & 0xffff0000u); v1.y = (rv[2].x >> 16) | (rv[3].x & 0xffff0000u);
                v2.x = (rv[0].y & 0xffffu) | (rv[1].y << 16); v2.y = (rv[2].y & 0xffffu) | (rv[3].y << 16);
                v3.x = (rv[0].y >> 16) | (rv[1].y & 0xffff0000u); v3.y = (rv[2].y >> 16) | (rv[3].y & 0xffff0000u);
                LAS unsigned char* vb = lds + VT + (4 * c8) * SP + (4 * tq) * 2;
                *(LAS u32x2*)(vb) = v0; *(LAS u32x2*)(vb + SP) = v1; *(LAS u32x2*)(vb + 2 * SP) = v2; *(LAS u32x2*)(vb + 3 * SP) = v3;
            }
            WG_BAR();
            {
                const int tt = w >> 1, st0 = 2 * (w & 1);
                f32x4 s0 = {0.f, 0.f, 0.f, 0.f}, s1 = {0.f, 0.f, 0.f, 0.f};
#pragma unroll 2
                for (int kk = 0; kk < 8; ++kk) {
                    const bf16x8 yq = *(const LAS bf16x8*)(lds + QS + (16 * tt + fr) * QP + (32 * kk + 8 * fq) * 2);
                    const bf16x8 x0 = *(const LAS bf16x8*)(lds + KS + (16 * st0 + fr) * QP + (32 * kk + 8 * fq) * 2);
                    const bf16x8 x1 = *(const LAS bf16x8*)(lds + KS + (16 * (st0 + 1) + fr) * QP + (32 * kk + 8 * fq) * 2);
                    s0 = mma16(x0, yq, s0); s1 = mma16(x1, yq, s1);
                }
                const int t = 16 * tt + fr;
#pragma unroll
                for (int q = 0; q < 2; ++q) { const f32x4 sv = q ? s1 : s0; const int sb = 16 * (st0 + q) + 4 * fq;
                    float p[4];
#pragma unroll
                    for (int e = 0; e < 4; ++e) p[e] = (sb + e <= t) ? sv[e] * __builtin_amdgcn_exp2f(lg * (float)(t - sb - e)) : 0.f;
                    u32x2 pk; pk.x = cvt_pk_bf16(p[0], p[1]); pk.y = cvt_pk_bf16(p[2], p[3]);
                    *(LAS u32x2*)(lds + PS + t * SP + sb * 2) = pk; }
            }
            WG_BAR_L();
            if (c + 1 < SEQ / 64) prefetch(c + 1);
            u32x4 xr[8];
#pragma unroll
            for (int kk = 0; kk < 8; ++kk) { xr[kk].x = cvt_pk_bf16(R[2 * kk][0], R[2 * kk][1]); xr[kk].y = cvt_pk_bf16(R[2 * kk][2], R[2 * kk][3]); xr[kk].z = cvt_pk_bf16(R[2 * kk + 1][0], R[2 * kk + 1][1]); xr[kk].w = cvt_pk_bf16(R[2 * kk + 1][2], R[2 * kk + 1][3]); }
#pragma unroll 1
            for (int tt = 0; tt < 4; ++tt) {
                f32x4 aI = {0.f, 0.f, 0.f, 0.f}, aC = {0.f, 0.f, 0.f, 0.f};
#pragma unroll
                for (int kk = 0; kk < 2; ++kk) { const bf16x8 xv = *(const LAS bf16x8*)(lds + VT + (16 * w + fr) * SP + (32 * kk + 8 * fq) * 2);
                    const bf16x8 yp = *(const LAS bf16x8*)(lds + PS + (16 * tt + fr) * SP + (32 * kk + 8 * fq) * 2); aI = mma16(xv, yp, aI); }
#pragma unroll
                for (int kk = 0; kk < 8; ++kk) {
                    const u32x2 qa = *(const LAS u32x2*)(lds + QS + (16 * tt + fr) * QP + (32 * kk + 4 * fq) * 2), qb = *(const LAS u32x2*)(lds + QS + (16 * tt + fr) * QP + (32 * kk + 16 + 4 * fq) * 2);
                    const u32x4 yq = {qa.x, qa.y, qb.x, qb.y};
                    aC = mma16(__builtin_bit_cast(bf16x8, xr[kk]), __builtin_bit_cast(bf16x8, yq), aC);
                }
                const int t = 16 * tt + fr; const float qd = __builtin_amdgcn_exp2f(lg * (float)(t + 1)); const f32x4 val = aI + aC * qd;
                u32x2 pk; pk.x = cvt_pk_bf16(val[0], val[1]); pk.y = cvt_pk_bf16(val[2], val[3]);
                *(u32x2*)((char*)(yb + (rowb + 64 * c + 16 * tt) * 2048 + hh * 512 + vs * 128 + 16 * w) + (unsigned)(fr * 2048 + 4 * fq) * 2u) = pk;
            }
            {
                const bf16x8 yv0 = *(const LAS bf16x8*)(lds + VT + (16 * w + fr) * SP + (8 * fq) * 2), yv1 = *(const LAS bf16x8*)(lds + VT + (16 * w + fr) * SP + (32 + 8 * fq) * 2);
#pragma unroll
                for (int dt = 0; dt < 16; ++dt) {
                    const bf16x8 x0 = *(const LAS bf16x8*)(lds + KWT + (16 * dt + fr) * SP + (8 * fq) * 2), x1 = *(const LAS bf16x8*)(lds + KWT + (16 * dt + fr) * SP + (32 + 8 * fq) * 2);
                    R[dt] = R[dt] * cdecay; R[dt] = mma16(x0, yv0, R[dt]); R[dt] = mma16(x1, yv1, R[dt]);
                    if ((dt & 3) == 3) asm volatile("" ::: "memory");
                }
            }
            WG_BAR_L();
        }
    }
}

__device__ __forceinline__ void rt_head_phase(const Frame& F, bf16* yb, const bf16* proj) {
    PH_IDS;
    const int gw = F.vcu * NWAVES + w, NGW = F.G * NWAVES;
    for (int m = gw; m < M; m += NGW) {
#pragma unroll
        for (int hd = 0; hd < 4; ++hd) {
            f32x4 v[2], g[2]; float s = 0.f;
#pragma unroll
            for (int q = 0; q < 2; ++q) { const int col = hd * 512 + q * 256 + 4 * lane;
                const u32x2 r = *(const u32x2*)(yb + (size_t)m * 2048 + col), rg = *(const u32x2*)(proj + (size_t)m * 6144 + 4096 + col);
                v[q] = (f32x4){bf_lo(r.x), bf_hi(r.x), bf_lo(r.y), bf_hi(r.y)}; g[q] = (f32x4){bf_lo(rg.x), bf_hi(rg.x), bf_lo(rg.y), bf_hi(rg.y)};
                s += (v[q][0] * v[q][0] + v[q][1] * v[q][1]) + (v[q][2] * v[q][2] + v[q][3] * v[q][3]); }
            const float rs = __builtin_amdgcn_rsqf(wave_sum(s) * (1.0f / 512.0f) + NORM_EPS);
#pragma unroll
            for (int q = 0; q < 2; ++q) { const int col = hd * 512 + q * 256 + 4 * lane;
                u32x2 pk; pk.x = cvt_pk_bf16(fsilu(g[q][0]) * v[q][0] * rs, fsilu(g[q][1]) * v[q][1] * rs); pk.y = cvt_pk_bf16(fsilu(g[q][2]) * v[q][2] * rs, fsilu(g[q][3]) * v[q][3] * rs);
                *(u32x2*)(yb + (size_t)m * 2048 + col) = pk; }
        }
    }
}

__device__ __forceinline__ float bf1(unsigned short u) { return __uint_as_float((unsigned)u << 16); }
__device__ __forceinline__ unsigned short f2bf1(float f) { return (unsigned short)(cvt_pk_bf16(f, 0.f) & 0xffffu); }
__device__ __forceinline__ void rw_scan_phase(const Frame& F, const bf16* rkv, const bf16* wag, const float* k_k, const float* k_a, const float* r_k, const float* ln_g, const float* ln_b, bf16* yout) {
    constexpr int TB = 64;
    constexpr int PLW = 0, PK = 8192, PV = 16384, PA = 24576, PB = 32768, PR = 40960, PG = 49152, BON = 57344, IMG = 57600;
    constexpr int I_AH = 0, I_RT = 2048, I_BT = 4096, I_KT = 6144, I_VT = 8192, I_NKH = 10240, I_NBR = 10752, I_NKR = 11264, I_GL = 11776, I_NBA = 12032, I_NKA = 13056, IMGSZ = 14080;
    constexpr int YB = IMG + 4 * IMGSZ;
    constexpr int CST = YB + 4 * 4096;
    static_assert(CST + 5 * 256 <= MISC_OFF && (IMG % 16) == 0 && (IMGSZ % 16) == 0, "rw lds");
    LAS unsigned char* lds = F.lds;
    PH_IDS;
    const int fr = lane & 15, fq = lane >> 4;
    for (int item = F.vcu; item < NB * 16; item += F.G) {
        const int b = item >> 4, hh = item & 15;
        const size_t rowb = (size_t)b * SEQ;
        const int c4 = tid & 15, chg = hh * 64 + 4 * c4;
        if (tid < 320) { const int a = tid >> 6, cc = tid & 63; const float* src = a == 0 ? k_k : (a == 1 ? k_a : (a == 2 ? r_k : (a == 3 ? ln_g : ln_b))); *(LAS float*)(lds + CST + tid * 4) = src[hh * 64 + cc]; }
        WG_BAR();
        f32x4 ST[4];
#pragma unroll
        for (int jt = 0; jt < 4; ++jt) ST[jt] = (f32x4){0.f, 0.f, 0.f, 0.f};
        u32x2 pr[2], pk[2], pv[2], pw[2], pa[2], pg[2];
        const unsigned lo0 = (unsigned)((tid >> 4) * 3072 + chg) * 2u;
        auto prefetch = [&](int tb) {
            const char* br = (const char*)rkv + (rowb + (size_t)tb * TB) * (3072 * 2); const char* bw = (const char*)wag + (rowb + (size_t)tb * TB) * (3072 * 2);
#pragma unroll
            for (int q = 0; q < 2; ++q) { const size_t o = (size_t)q * (32 * 3072 * 2) + lo0;
                pr[q] = *(const u32x2*)(br + o); pk[q] = *(const u32x2*)(br + o + 2048); pv[q] = *(const u32x2*)(br + o + 4096);
                pw[q] = *(const u32x2*)(bw + o); pa[q] = *(const u32x2*)(bw + o + 2048); pg[q] = *(const u32x2*)(bw + o + 4096); }
        };
        prefetch(0);
        for (int tb = 0; tb < SEQ / TB; ++tb) {
            for (int rep_ = 0; rep_ < (PROBE_DUP == 23 ? 2 : 1); ++rep_) {
            const f32x4 kk4 = *(const LAS f32x4*)(lds + CST + (4 * c4) * 4), ka4 = *(const LAS f32x4*)(lds + CST + (64 + 4 * c4) * 4), rk4 = *(const LAS f32x4*)(lds + CST + (128 + 4 * c4) * 4);
#pragma unroll
            for (int q = 0; q < 2; ++q) {
                const int tk = (tid >> 4) + 32 * q;
                const f32x4 r = {bf_lo(pr[q].x), bf_hi(pr[q].x), bf_lo(pr[q].y), bf_hi(pr[q].y)}, k = {bf_lo(pk[q].x), bf_hi(pk[q].x), bf_lo(pk[q].y), bf_hi(pk[q].y)};
                const f32x4 av = {bf_lo(pa[q].x), bf_hi(pa[q].x), bf_lo(pa[q].y), bf_hi(pa[q].y)};
                const f32x4 kkv = k * kk4;
                const float ss = red16((kkv[0] * kkv[0] + kkv[1] * kkv[1]) + (kkv[2] * kkv[2] + kkv[3] * kkv[3]));
                const float inv = 1.0f / fmaxf(sqrtf(ss), 1e-12f);
                const f32x4 kkn = kkv * inv, kp = k * (1.0f + (av - 1.0f) * ka4), rkp = r * kp * rk4, bb = kkn * av;
                const float bd = red16((rkp[0] + rkp[1]) + (rkp[2] + rkp[3]));
                const int o = (tk * 64 + 4 * c4) * 2;
                *(LAS u32x2*)(lds + PLW + o) = pw[q]; *(LAS u32x2*)(lds + PV + o) = pv[q]; *(LAS u32x2*)(lds + PR + o) = pr[q]; *(LAS u32x2*)(lds + PG + o) = pg[q];
                *(LAS u32x2*)(lds + PK + o) = (u32x2){cvt_pk_bf16(kp[0], kp[1]), cvt_pk_bf16(kp[2], kp[3])};
                *(LAS u32x2*)(lds + PA + o) = (u32x2){cvt_pk_bf16(-kkn[0], -kkn[1]), cvt_pk_bf16(-kkn[2], -kkn[3])};
                *(LAS u32x2*)(lds + PB + o) = (u32x2){cvt_pk_bf16(bb[0], bb[1]), cvt_pk_bf16(bb[2], bb[3])};
                if (c4 == 0) *(LAS float*)(lds + BON + tk * 4) = bd;
            }
            }
            WG_BAR();
            if (tb + 1 < SEQ / TB) prefetch(tb + 1);
            for (int rep_ = 0; rep_ < (PROBE_DUP == 21 ? 2 : 1); ++rep_) if (w >= 4) {
                const int c = w - 4, j = lane;
                LAS unsigned char* img = lds + IMG + c * IMGSZ;
                LAS unsigned char* scr = lds + YB + c * 4096;
                float At[16]; unsigned Bp[8], Kp[8], Vp[8];
                float cum = 0.f, gprev = 1.0f;
#pragma unroll
                for (int t = 0; t < 16; ++t) {
                    const int o = ((16 * c + t) * 64 + j) * 2;
                    const float lwv = bf1(*(const LAS unsigned short*)(lds + PLW + o)), a = bf1(*(const LAS unsigned short*)(lds + PA + o)), bq = bf1(*(const LAS unsigned short*)(lds + PB + o));
                    const float kq = bf1(*(const LAS unsigned short*)(lds + PK + o)), rq = bf1(*(const LAS unsigned short*)(lds + PR + o));
                    const unsigned vq = *(const LAS unsigned short*)(lds + PV + o);
                    cum += lwv;
                    const float gcur = fexp(cum), ginv = fexp(-cum);
                    At[t] = a * gprev;
                    const unsigned short ab = f2bf1(At[t]), rb = f2bf1(rq * gcur), bt = f2bf1(bq * ginv), kt = f2bf1(kq * ginv);
                    const int ot = (t * 64 + j) * 2;
                    *(LAS unsigned short*)(img + I_AH + ot) = ab; *(LAS unsigned short*)(img + I_RT + ot) = rb;
                    *(LAS unsigned short*)(scr + ot) = bt; *(LAS unsigned short*)(scr + 2048 + ot) = kt;
                    if (t & 1) { Bp[t >> 1] |= (unsigned)bt << 16; Kp[t >> 1] |= (unsigned)kt << 16; Vp[t >> 1] |= vq << 16; }
                    else { Bp[t >> 1] = bt; Kp[t >> 1] = kt; Vp[t >> 1] = vq; }
                    gprev = gcur;
                }
                *(LAS u32x4*)(img + I_BT + j * 32) = (u32x4){Bp[0], Bp[1], Bp[2], Bp[3]}; *(LAS u32x4*)(img + I_BT + j * 32 + 16) = (u32x4){Bp[4], Bp[5], Bp[6], Bp[7]};
                *(LAS u32x4*)(img + I_KT + j * 32) = (u32x4){Kp[0], Kp[1], Kp[2], Kp[3]}; *(LAS u32x4*)(img + I_KT + j * 32 + 16) = (u32x4){Kp[4], Kp[5], Kp[6], Kp[7]};
                *(LAS u32x4*)(img + I_VT + j * 32) = (u32x4){Vp[0], Vp[1], Vp[2], Vp[3]}; *(LAS u32x4*)(img + I_VT + j * 32 + 16) = (u32x4){Vp[4], Vp[5], Vp[6], Vp[7]};
                *(LAS float*)(img + I_GL + j * 4) = gprev;
                LDS_WAIT();
                {
                    f32x4 nba = {0.f, 0.f, 0.f, 0.f}, nbr = nba, nka = nba, nkr = nba;
#pragma unroll
                    for (int m = 0; m < 2; ++m) { const int o = fr * 128 + (32 * m + 8 * fq) * 2;
                        const bf16x8 xb = *(const LAS bf16x8*)(scr + o), xk = *(const LAS bf16x8*)(scr + 2048 + o), ya = *(const LAS bf16x8*)(img + I_AH + o), yr = *(const LAS bf16x8*)(img + I_RT + o);
                        nba = mma16(xb, ya, nba); nbr = mma16(xb, yr, nbr); nka = mma16(xk, ya, nka); nkr = mma16(xk, yr, nkr); }
#pragma unroll
                    for (int e = 0; e < 4; ++e) { const int sidx = 4 * fq + e; if (!(sidx < fr)) { nba[e] = 0.f; nka[e] = 0.f; } if (!(sidx <= fr)) { nbr[e] = 0.f; nkr[e] = 0.f; } }
                    *(LAS f32x4*)(img + I_NBA + (fr * 16 + 4 * fq) * 4) = nba; *(LAS f32x4*)(img + I_NKA + (fr * 16 + 4 * fq) * 4) = nka;
                    *(LAS u32x2*)(img + I_NBR + (fr * 16 + 4 * fq) * 2) = (u32x2){cvt_pk_bf16(nbr[0], nbr[1]), cvt_pk_bf16(nbr[2], nbr[3])};
                    *(LAS u32x2*)(img + I_NKR + (fr * 16 + 4 * fq) * 2) = (u32x2){cvt_pk_bf16(nkr[0], nkr[1]), cvt_pk_bf16(nkr[2], nkr[3])};
                }
                LDS_WAIT();
                {
                    float H[16];
#pragma unroll
                    for (int t = 0; t < 16; ++t) {
                        float h = At[t];
#pragma unroll
                        for (int s4 = 0; s4 < 4; ++s4) if (4 * s4 < t) { const f32x4 cf = *(const LAS f32x4*)(img + I_NBA + (t * 16 + 4 * s4) * 4);
#pragma unroll
                            for (int e = 0; e < 4; ++e) if (4 * s4 + e < t) h += H[4 * s4 + e] * cf[e]; }
                        H[t] = h;
                    }
                    LDS_WAIT();
#pragma unroll
                    for (int t = 0; t < 16; ++t) *(LAS unsigned short*)(img + I_AH + (t * 64 + j) * 2) = f2bf1(H[t]);
                    asm volatile("" ::: "memory");
#pragma unroll
                    for (int t = 0; t < 16; ++t) {
                        float g = *(const LAS float*)(img + I_NKA + (t * 16 + (lane & 15)) * 4);
#pragma unroll
                        for (int s4 = 0; s4 < 4; ++s4) if (4 * s4 < t) { const f32x4 cf = *(const LAS f32x4*)(img + I_NBA + (t * 16 + 4 * s4) * 4);
#pragma unroll
                            for (int e = 0; e < 4; ++e) if (4 * s4 + e < t) g += H[4 * s4 + e] * cf[e]; }
                        H[t] = g;
                        if (lane < 16) *(LAS unsigned short*)(img + I_NKH + (t * 16 + lane) * 2) = f2bf1(g);
                    }
                }
            }
            WG_BAR_L();
            if (w < 4) {
                struct Ops { u32x2 ah[4], rt[4], bt[4], kt[4], vt, nk, nb, nr; f32x4 gl[4]; };
                auto load_ops = [&](int c, Ops& o) {
                    const LAS unsigned char* img = lds + IMG + c * IMGSZ;
#pragma unroll
                    for (int m = 0; m < 2; ++m) {
                        o.ah[2 * m] = *(const LAS u32x2*)(img + I_AH + fr * 128 + (32 * m + 4 * fq) * 2); o.ah[2 * m + 1] = *(const LAS u32x2*)(img + I_AH + fr * 128 + (32 * m + 16 + 4 * fq) * 2);
                        o.rt[2 * m] = *(const LAS u32x2*)(img + I_RT + fr * 128 + (32 * m + 4 * fq) * 2); o.rt[2 * m + 1] = *(const LAS u32x2*)(img + I_RT + fr * 128 + (32 * m + 16 + 4 * fq) * 2);
                    }
                    o.vt = *(const LAS u32x2*)(img + I_VT + (16 * w + fr) * 32 + (4 * fq) * 2); o.nk = *(const LAS u32x2*)(img + I_NKH + (fr * 16 + 4 * fq) * 2);
                    o.nb = *(const LAS u32x2*)(img + I_NBR + (fr * 16 + 4 * fq) * 2); o.nr = *(const LAS u32x2*)(img + I_NKR + (fr * 16 + 4 * fq) * 2);
#pragma unroll
                    for (int jt = 0; jt < 4; ++jt) { o.bt[jt] = *(const LAS u32x2*)(img + I_BT + (16 * jt + fr) * 32 + (4 * fq) * 2); o.kt[jt] = *(const LAS u32x2*)(img + I_KT + (16 * jt + fr) * 32 + (4 * fq) * 2);
                        o.gl[jt] = *(const LAS f32x4*)(img + I_GL + (16 * jt + 4 * fq) * 4); }
                };
                Ops cur, nxt;
                load_ops(0, cur);
#pragma unroll
                for (int c = 0; c < 4; ++c) {
                    if (c < 3) load_ops(c + 1, nxt);
                    u32x4 sf[2];
#pragma unroll
                    for (int m = 0; m < 2; ++m) { sf[m].x = cvt_pk_bf16(ST[2 * m][0], ST[2 * m][1]); sf[m].y = cvt_pk_bf16(ST[2 * m][2], ST[2 * m][3]); sf[m].z = cvt_pk_bf16(ST[2 * m + 1][0], ST[2 * m + 1][1]); sf[m].w = cvt_pk_bf16(ST[2 * m + 1][2], ST[2 * m + 1][3]); }
                    f32x4 d1 = {0.f, 0.f, 0.f, 0.f}, d2 = {0.f, 0.f, 0.f, 0.f};
#pragma unroll
                    for (int m = 0; m < 2; ++m) {
                        d1 = mma16(__builtin_bit_cast(bf16x8, (u32x4){cur.ah[2 * m].x, cur.ah[2 * m].y, cur.ah[2 * m + 1].x, cur.ah[2 * m + 1].y}), __builtin_bit_cast(bf16x8, sf[m]), d1);
                        d2 = mma16(__builtin_bit_cast(bf16x8, (u32x4){cur.rt[2 * m].x, cur.rt[2 * m].y, cur.rt[2 * m + 1].x, cur.rt[2 * m + 1].y}), __builtin_bit_cast(bf16x8, sf[m]), d2);
                    }
                    d1 = mma16(__builtin_bit_cast(bf16x8, (u32x4){cur.nk.x, cur.nk.y, 0u, 0u}), __builtin_bit_cast(bf16x8, (u32x4){cur.vt.x, cur.vt.y, 0u, 0u}), d1);
                    const u32x4 ff = {cvt_pk_bf16(d1[0], d1[1]), cvt_pk_bf16(d1[2], d1[3]), cur.vt.x, cur.vt.y};
                    d2 = mma16(__builtin_bit_cast(bf16x8, (u32x4){cur.nb.x, cur.nb.y, cur.nr.x, cur.nr.y}), __builtin_bit_cast(bf16x8, ff), d2);
#pragma unroll
                    for (int e = 0; e < 4; ++e) *(LAS float*)(lds + YB + c * 4096 + ((4 * fq + e) * 64 + 16 * w + fr) * 4) = d2[e];
#pragma unroll
                    for (int jt = 0; jt < 4; ++jt) {
                        ST[jt] = mma16(__builtin_bit_cast(bf16x8, (u32x4){cur.bt[jt].x, cur.bt[jt].y, cur.kt[jt].x, cur.kt[jt].y}), __builtin_bit_cast(bf16x8, ff), ST[jt]);
                        ST[jt] = ST[jt] * cur.gl[jt];
                    }
                    if (c < 3) cur = nxt;
                }
            }
            WG_BAR_L();
            for (int rep_ = 0; rep_ < (PROBE_DUP == 24 ? 2 : 1); ++rep_) {
            const f32x4 lg4 = *(const LAS f32x4*)(lds + CST + (192 + 4 * c4) * 4), lb4 = *(const LAS f32x4*)(lds + CST + (256 + 4 * c4) * 4);
#pragma unroll
            for (int q = 0; q < 2; ++q) {
                const int tk = (tid >> 4) + 32 * q, o = (tk * 64 + 4 * c4) * 2;
                const f32x4 y = *(const LAS f32x4*)(lds + YB + (tk >> 4) * 4096 + ((tk & 15) * 64 + 4 * c4) * 4);
                const u32x2 vb = *(const LAS u32x2*)(lds + PV + o), gb = *(const LAS u32x2*)(lds + PG + o);
                const f32x4 v = {bf_lo(vb.x), bf_hi(vb.x), bf_lo(vb.y), bf_hi(vb.y)}, g = {bf_lo(gb.x), bf_hi(gb.x), bf_lo(gb.y), bf_hi(gb.y)};
                const float bd = *(const LAS float*)(lds + BON + tk * 4);
                const float mean = red16((y[0] + y[1]) + (y[2] + y[3])) * (1.0f / 64.0f);
                const f32x4 d = y - mean;
                const float var = red16((d[0] * d[0] + d[1] * d[1]) + (d[2] * d[2] + d[3] * d[3])) * (1.0f / 64.0f);
                const float rs = __builtin_amdgcn_rsqf(var + 64e-5f);
                const f32x4 outv = ((d * rs) * lg4 + lb4 + v * bd) * g;
                *(u32x2*)((char*)yout + ((rowb + (size_t)tb * TB + tk) * DM + chg) * 2) = (u32x2){cvt_pk_bf16(outv[0], outv[1]), cvt_pk_bf16(outv[2], outv[3])};
            }
            }
            WG_BAR_L();
        }
    }
}

constexpr int N_PHASES = 2 + DEPTH * 11;

__global__ void __launch_bounds__(NWAVES * 64, 2) mk_fwd(Args args) {
    extern __shared__ __attribute__((aligned(16))) unsigned char lds_raw[];
    Frame F;
    F.lds = (LAS unsigned char*)lds_raw;
    F.G = gridDim.x; { const int bx = blockIdx.x; F.vcu = (F.G % 8 == 0) ? (bx % 8) * (F.G / 8) + bx / 8 : bx; }
    volatile LAS unsigned* MISC = (volatile LAS unsigned*)(F.lds + MISC_OFF);
    for (int u = threadIdx.x; u < (LDS_BYTES - MISC_OFF) / 4; u += NWAVES * 64) ((LAS unsigned*)(F.lds + MISC_OFF))[u] = 0u;
    __syncthreads();
    unsigned char* ws = args.ws;
    unsigned* ctl = (unsigned*)(ws + WS_CTL);
    const int lo = args.p_lo, hi = args.p_hi;
    XcdBarrier bar; bar.bar = ctl + CW_BAR; bar.x = 0; bar.st = nullptr;
    if (hi - lo > 1) bar = xcd_barrier_post(ctl + CW_BAR, MISC + 8);
    const Args& in = args;
    bf16* xb = (bf16*)args.out;
    float* RHO = (float*)(ws + 57 * MiB);
    bf16* xb_alt = xb + (size_t)M * DM;
    bf16* xb2 = (bf16*)(ws + WS_A + 256 * MiB);
    bf16* XN = (bf16*)(ws + WS_XN); bf16* MO = (bf16*)(ws + WS_MO);
    bf16* RA = (bf16*)(ws + WS_A); bf16* RB = (bf16*)(ws + WS_B);
    int p = 0;
#define PH_ON (p >= lo && p < hi)
#define PH_END do { if (p >= lo && p + 1 < hi) xcd_barrier(bar); ++p; } while (0)
#define DUP(cat, ...) do { __VA_ARGS__; if (PROBE_DUP == (cat)) { xcd_barrier(bar); __VA_ARGS__; } } while (0)


    if (PH_ON) { DUP(4, prep_layer(F, in, ws, 0)); norm_phase(F, kin(in, 0), nullptr, nullptr, xb, RHO, nullptr, 0.f, nullptr, 0, nullptr);
    }
    PH_END;

#pragma unroll 1
    for (int s = 0; s < DEPTH * 3; ++s) {
        const int L = s / 3, sp = s % 3, kind = L % 3, jm = L / 3;
        const float* g6 = kin(in, 2) + (size_t)L * 6 * DM;
        if (sp != 1) {
            const int f = sp >> 1;
            if (PH_ON) { pg8::Gemm g{(f == 1 && L == DEPTH - 1) ? xb2 : xb, (const bf16*)(ws + (f ? W_GU1 : W_GU0)), M, 2 * DFF, DM}; pg8::StaticOrder S; S.init(M, 2 * DFF, F.G, (int)blockIdx.x);
                pg8::EpiSwiglu E{RA, DFF}; DUP(1, pg8::gemm_phase<pg8::EpiSwiglu, pg8::StaticOrder, true, true>(F.lds, g, S, E)); }
            PH_END;
            if (PH_ON) { pg8::Gemm g{RA, (const bf16*)(ws + (f ? W_DN1 : W_DN0)), M, DM, DFF}; pg8::StaticOrder S; S.init(M, DM, F.G, (int)blockIdx.x);
                pg8::EpiPlain E{RB, DM}; DUP(2, pg8::gemm_phase<pg8::EpiPlain, pg8::StaticOrder, true, true>(F.lds, g, S, E)); }
            PH_END;
            if (PH_ON) {
                if (f == 0) {
                    if (kind == 1) norm_mix_phase(F, xb, RHO, xb_alt, RHO + M, RB, 0.5f, g6 + 1 * DM, g6 + 2 * DM, kin(in, 10) + (size_t)jm * 6 * DM, XN, RA + (size_t)M * 3072);
                    else norm_phase(F, nullptr, xb, RHO, xb, RHO, RB, 0.5f, g6 + 1 * DM, 0, nullptr);
                } else {
                    const bool lastl = (L == DEPTH - 1);
                    if (!lastl) DUP(4, prep_layer(F, in, ws, L + 1));
                    norm_phase(F, nullptr, lastl ? xb2 : xb, RHO, xb, RHO, RB, 0.5f, g6 + 5 * DM, lastl ? 3 : 0, args.out);
                }
            }
            PH_END;
        } else {
            const bf16* WM = (const bf16*)(ws + W_MIX);
            const bf16* a_out; const bf16* w_out; int k_out;
            if (kind == 0) {
                if (PH_ON) { pg8::Gemm g{xb, WM, M, 3072, DM}; pg8::StaticOrder S; S.init(M, 3072, F.G, (int)blockIdx.x);
                    pg8::EpiPlain E{RA, 3072}; DUP(5, pg8::gemm_phase<pg8::EpiPlain, pg8::StaticOrder, true, true>(F.lds, g, S, E));
                    DUP(15, ml_gate_phase(F, xb, g6 + 2 * DM, kin(in, 5) + (size_t)jm * DM * ML_IN, kin(in, 6) + jm * 8, (float*)(ws + WS_A + 192 * MiB))); }
                PH_END;
                if (PH_ON) DUP(6, ml_chunk_phase(F, RA, (const float*)(ws + WS_A + 192 * MiB), kin(in, 7) + (size_t)jm * 4 * DM, RB));
                PH_END;
                if (PH_ON) DUP(7, ml_head_phase(F, RB, RA, kin(in, 8) + (size_t)jm * DM, RB + (size_t)M * DM));
                PH_END;
                a_out = RB + (size_t)M * DM; w_out = WM + (size_t)3072 * 1024; k_out = DM;
            } else if (kind == 1) {
                bf16* lmid = RB; bf16* wag = RA + (size_t)M * 3072; bf16* yo = RB + (size_t)M * 256;
                if (PH_ON) { pg8::Gemm g{RA + (size_t)M * 3072, WM, M, 3072, DM, 2, (size_t)M * DM * 2}; pg8::StaticOrder S; S.init(M, 3072, F.G, (int)blockIdx.x);
                    pg8::EpiPlain E{RA, 3072}; DUP(9, pg8::gemm_phase<pg8::EpiPlain, pg8::StaticOrder, true, true>(F.lds, g, S, E)); }
                PH_END;
                if (PH_ON) { pg8::Gemm g{XN, WM + (size_t)3072 * 1024, M, 256, 2048}; pg8::StaticOrder S; S.init(M, 256, F.G, (int)blockIdx.x);
                    pg8::EpiLora E{lmid}; DUP(16, pg8::gemm_phase<pg8::EpiLora, pg8::StaticOrder, true, true>(F.lds, g, S, E)); }
                PH_END;
                if (PH_ON) { int k_rw2 = 256; asm volatile("" : "+s"(k_rw2));
                    pg8::Gemm g{lmid, WM + (size_t)3072 * 1024 + (size_t)256 * 2048, M, 3072, k_rw2}; pg8::StaticOrder S; S.init(M, 3072, F.G, (int)blockIdx.x);
                    pg8::EpiRw2 E{wag, kin(in, 12) + (size_t)jm * DM, kin(in, 15) + (size_t)jm * DM}; DUP(10, pg8::gemm_phase<pg8::EpiRw2, pg8::StaticOrder, true, true>(F.lds, g, S, E)); }
                PH_END;
                if (PH_ON) DUP(11, rw_scan_phase(F, RA, wag, kin(in, 20) + (size_t)jm * DM, kin(in, 21) + (size_t)jm * DM, kin(in, 22) + (size_t)jm * DM, kin(in, 23) + (size_t)jm * DM, kin(in, 24) + (size_t)jm * DM, yo));
                PH_END;
                a_out = yo; w_out = WM + (size_t)3072 * 1024 + (size_t)256 * 2048 + (size_t)3072 * 256; k_out = DM;
            } else {
                if (PH_ON) { pg8::Gemm g{xb, WM, M, 6144, DM}; pg8::StaticOrder S; S.init(M, 6144, F.G, (int)blockIdx.x);
                    pg8::EpiRtIn E{RA, (const int*)kin(in, 1)}; DUP(12, pg8::gemm_phase<pg8::EpiRtIn, pg8::StaticOrder, true, true>(F.lds, g, S, E)); }
                PH_END;
                if (PH_ON) DUP(13, rt_chunk_phase(F, RA, RB));
                PH_END;
                if (PH_ON) rt_head_phase(F, RB, RA);
                PH_END;
                a_out = RB; w_out = WM + (size_t)6144 * 1024; k_out = 2048;
            }
            if (PH_ON) { pg8::Gemm g{a_out, w_out, M, DM, k_out}; pg8::StaticOrder S; S.init(M, DM, F.G, (int)blockIdx.x);
                pg8::EpiPlain E{MO, DM}; DUP(8, pg8::gemm_phase<pg8::EpiPlain, pg8::StaticOrder, true, true>(F.lds, g, S, E)); }
            PH_END;
            if (PH_ON) norm_phase(F, nullptr, kind == 1 ? xb_alt : xb, kind == 1 ? RHO + M : RHO, (L == DEPTH - 1) ? xb2 : xb, RHO, MO, 1.0f, g6 + 3 * DM, 0, nullptr);
            PH_END;
        }
    }
#undef PH_ON
#undef PH_END
}

extern "C" void kernel_launch(void* const* d_in, const int* in_sizes, int n_in, void* d_out, int out_size, void* d_ws, size_t ws_size, hipStream_t stream) {
    static int grid = 0;
    if (grid == 0) {
        if (n_in != 28 || out_size != M * DM || ws_size < WS_END) { fprintf(stderr, "kernel_launch: unexpected shapes: n_in %d out %d ws %zu (need %zu)\n", n_in, out_size, ws_size, (size_t)WS_END); grid = -1; return; }
        int dev = 0, cus = 0, per_cu = 0;
        if (hipGetDevice(&dev) != hipSuccess || hipDeviceGetAttribute(&cus, hipDeviceAttributeMultiprocessorCount, dev) != hipSuccess) { grid = -1; return; }
        if (hipFuncSetAttribute((const void*)mk_fwd, hipFuncAttributeMaxDynamicSharedMemorySize, LDS_BYTES) != hipSuccess) { fprintf(stderr, "kernel_launch: hipFuncSetAttribute failed\n"); grid = -1; return; }
        if (hipOccupancyMaxActiveBlocksPerMultiprocessor(&per_cu, (const void*)mk_fwd, NWAVES * 64, LDS_BYTES) != hipSuccess || per_cu < 1) { fprintf(stderr, "kernel_launch: occupancy query says %d\n", per_cu); (void)hipGetLastError(); grid = -1; return; }
        grid = cus;
    }
    if (grid < 0) return;
    (void)hipMemsetAsync((char*)d_ws + WS_CTL, 0, CTL_ZERO_BYTES, stream);
    Args a{};
    for (int i = 0; i < 28; ++i) a.in[i] = d_in[i];
    a.out = (float*)d_out; a.ws = (unsigned char*)d_ws;
#if MK_PER_PHASE
    for (int p = 0; p < N_PHASES; ++p) { a.p_lo = p; a.p_hi = p + 1; hipLaunchKernelGGL(mk_fwd, dim3(grid), dim3(NWAVES * 64), LDS_BYTES, stream, a); }
#else
    a.p_lo = 0; a.p_hi = N_PHASES;
    hipLaunchKernelGGL(mk_fwd, dim3(grid), dim3(NWAVES * 64), LDS_BYTES, stream, a);
#endif
}
```

```cpp
#include <hip/hip_runtime.h>
#include <cstdio>
#include <cstdint>

#ifndef MK_PER_PHASE
#define MK_PER_PHASE 0
#endif
#ifndef PROBE_DUP
#define PROBE_DUP 0
#endif

#define LAS __attribute__((address_space(3)))
#define GAS __attribute__((address_space(1)))
typedef unsigned short bf16;
typedef short bf16x8 __attribute__((ext_vector_type(8)));
typedef float f32x4 __attribute__((ext_vector_type(4)));
typedef float f32x2 __attribute__((ext_vector_type(2)));
typedef unsigned u32x4 __attribute__((ext_vector_type(4)));
typedef unsigned u32x2 __attribute__((ext_vector_type(2)));

constexpr int DM = 1024, NB = 16, SEQ = 2048, DEPTH = 4, DFF = 2816;
constexpr int M = NB * SEQ;
constexpr float NORM_EPS = 1e-6f;
constexpr int ML_IN = 3080;
constexpr int NWAVES = 8;

constexpr size_t MiB = 1u << 20;
constexpr size_t WS_CTL = 0, CTL_ZERO_BYTES = 1 * MiB;
constexpr size_t WS_W = 1 * MiB;
constexpr size_t W_GU0 = WS_W, W_DN0 = W_GU0 + (size_t)5632 * 1024 * 2, W_GU1 = W_DN0 + (size_t)1024 * 2816 * 2, W_DN1 = W_GU1 + (size_t)5632 * 1024 * 2;
constexpr size_t W_MIX = W_DN1 + (size_t)1024 * 2816 * 2;
constexpr size_t WS_XN = 58 * MiB;
constexpr size_t WS_MO = WS_XN + 64 * MiB;
constexpr size_t WS_A = 186 * MiB;
constexpr size_t WS_B = 570 * MiB;
constexpr size_t WS_END = 698 * MiB;
static_assert(W_MIX + (size_t)17 * MiB <= WS_XN, "weight region");
constexpr int F8_FROM = 6;
constexpr int G8_FROM = 2;
constexpr float X8_SCALE = 32.0f, WI_SCALE = 1100.0f;
constexpr unsigned I8_MIX = (1u << 7) | (1u << 10);
constexpr size_t X8_OFF = (size_t)84 * MiB;
constexpr float H8_SCALE = 8.0f, W8_SCALE = 256.0f;
constexpr int CW_BAR = 4096;
constexpr size_t STATS_PER_PHASE = (size_t)128 * 4 * 3 * 256;
constexpr int CW_CNT = 8192;

constexpr int RING_BYTES = 131072;
constexpr int LDS_BYTES = 151552;
constexpr int MISC_OFF = 145408;
constexpr int GAIN_OFF = 147456;

typedef __bf16 bf16x2_t __attribute__((ext_vector_type(2)));
__device__ __forceinline__ unsigned cvt_pk_bf16(float lo, float hi) { const f32x2 v = {lo, hi}; return __builtin_bit_cast(unsigned, __builtin_convertvector(v, bf16x2_t)); }
__device__ __forceinline__ float bf_lo(unsigned u) { return __uint_as_float(u << 16); }
__device__ __forceinline__ float bf_hi(unsigned u) { return __uint_as_float(u & 0xffff0000u); }
__device__ __forceinline__ float fexp(float x) { return __builtin_amdgcn_exp2f(x * 1.4426950408889634f); }
__device__ __forceinline__ float fsigmoid(float x) { return __builtin_amdgcn_rcpf(1.0f + fexp(-x)); }
__device__ __forceinline__ float ftanh(float x) { return 2.0f * fsigmoid(2.0f * x) - 1.0f; }
__device__ __forceinline__ float fsilu(float x) { return x * fsigmoid(x); }
template <int CTRL, int ROWMASK> __device__ __forceinline__ float dppmov(float old, float v) {
    return __builtin_bit_cast(float, __builtin_amdgcn_update_dpp(__builtin_bit_cast(int, old), __builtin_bit_cast(int, v), CTRL, ROWMASK, 0xf, false));
}
__device__ __forceinline__ float red16(float v) {
    v += dppmov<0x128, 0xf>(0.f, v); v += dppmov<0x124, 0xf>(0.f, v); v += dppmov<0x122, 0xf>(0.f, v); v += dppmov<0x121, 0xf>(0.f, v); return v; }
__device__ __forceinline__ float wave_sum(float v) {
    v = red16(v);
    const float s0 = __builtin_bit_cast(float, __builtin_amdgcn_readlane(__builtin_bit_cast(int, v), 0)), s1 = __builtin_bit_cast(float, __builtin_amdgcn_readlane(__builtin_bit_cast(int, v), 16));
    const float s2 = __builtin_bit_cast(float, __builtin_amdgcn_readlane(__builtin_bit_cast(int, v), 32)), s3 = __builtin_bit_cast(float, __builtin_amdgcn_readlane(__builtin_bit_cast(int, v), 48));
    return (s0 + s1) + (s2 + s3);
}
__device__ __forceinline__ float scan_sum64(float v) {
    v += dppmov<0x111, 0xf>(0.f, v); v += dppmov<0x112, 0xf>(0.f, v); v += dppmov<0x114, 0xf>(0.f, v); v += dppmov<0x118, 0xf>(0.f, v);
    v += dppmov<0x142, 0xa>(0.f, v); v += dppmov<0x143, 0xc>(0.f, v); return v; }
__device__ __forceinline__ float scan_max64(float v) {
    const float ninf = -__builtin_inff();
    v = fmaxf(v, dppmov<0x111, 0xf>(ninf, v)); v = fmaxf(v, dppmov<0x112, 0xf>(ninf, v)); v = fmaxf(v, dppmov<0x114, 0xf>(ninf, v)); v = fmaxf(v, dppmov<0x118, 0xf>(ninf, v));
    v = fmaxf(v, dppmov<0x142, 0xa>(ninf, v)); v = fmaxf(v, dppmov<0x143, 0xc>(ninf, v)); return v; }
__device__ __forceinline__ float lane63(float v) { return __builtin_bit_cast(float, __builtin_amdgcn_readlane(__builtin_bit_cast(int, v), 63)); }
__device__ __forceinline__ f32x4 mma16(bf16x8 x, bf16x8 y, f32x4 c) { return __builtin_amdgcn_mfma_f32_16x16x32_bf16(x, y, c, 0, 0, 0); }
#define LDS_WAIT() asm volatile("s_waitcnt lgkmcnt(0)" ::: "memory")
#define WG_BAR() do { asm volatile("s_waitcnt vmcnt(0) lgkmcnt(0)" ::: "memory"); __builtin_amdgcn_s_barrier(); asm volatile("" ::: "memory"); } while (0)
#define WG_BAR_L() do { asm volatile("s_waitcnt lgkmcnt(0)" ::: "memory"); __builtin_amdgcn_s_barrier(); asm volatile("" ::: "memory"); } while (0)

namespace pg8 {
#define PG8_LAS __attribute__((address_space(3)))
typedef unsigned short bf16_t;
constexpr int BM = 256, BK = 64, HALF = 128, HTB = HALF * BK * 2, STAGE_BYTES = 8 * HTB, NXCD = 8, WGM = 8;
__host__ __device__ __forceinline__ int lds_byte(int r, int c) { const int st = (r >> 4) * 2 + (c >> 5), rr = r & 15, cc = c & 31, ob = rr * 64 + cc * 2; return st * 1024 + (ob ^ (((ob >> 9) & 1) << 5)); }
__host__ __device__ __forceinline__ void stage_rc(int b, int& R, int& C) { const int st = b / 1024, sb = b % 1024, swz = sb ^ (((sb >> 9) & 1) << 5); R = (st >> 1) * 16 + swz / 64; C = (st & 1) * 32 + (swz % 64) / 2; }
__host__ __device__ __forceinline__ int perm32(int rho) { const int n = rho >> 4, i = rho & 15; return 8 * (i >> 2) + 4 * n + (i & 3); }

typedef int i32x4 __attribute__((ext_vector_type(4)));
typedef int i32x8 __attribute__((ext_vector_type(8)));
__device__ __forceinline__ f32x4 mfma_f8(bf16x8 x0, bf16x8 x1, bf16x8 y0, bf16x8 y1, f32x4 c) {
    const i32x4 a0 = __builtin_bit_cast(i32x4, x0), a1 = __builtin_bit_cast(i32x4, x1), b0 = __builtin_bit_cast(i32x4, y0), b1 = __builtin_bit_cast(i32x4, y1);
    const i32x8 A = {a0.x, a0.y, a0.z, a0.w, a1.x, a1.y, a1.z, a1.w}, B = {b0.x, b0.y, b0.z, b0.w, b1.x, b1.y, b1.z, b1.w};
    asm volatile("v_mfma_f32_16x16x128_f8f6f4 %0, %1, %2, %0" : "+v"(c) : "v"(A), "v"(B));
    return c;
}
__device__ __forceinline__ unsigned pk4_fp8(float a, float b, float c, float d) {
    a = __builtin_fminf(__builtin_fmaxf(a, -448.f), 448.f); b = __builtin_fminf(__builtin_fmaxf(b, -448.f), 448.f); c = __builtin_fminf(__builtin_fmaxf(c, -448.f), 448.f); d = __builtin_fminf(__builtin_fmaxf(d, -448.f), 448.f);
    unsigned w = 0u; w = __builtin_amdgcn_cvt_pk_fp8_f32(a, b, w, false); w = __builtin_amdgcn_cvt_pk_fp8_f32(c, d, w, true); return w;
}

__device__ __forceinline__ f32x4 mfma_i8(bf16x8 x, bf16x8 y, f32x4 c) {
    return __builtin_bit_cast(f32x4, __builtin_amdgcn_mfma_i32_16x16x64_i8(__builtin_bit_cast(i32x4, x), __builtin_bit_cast(i32x4, y), __builtin_bit_cast(i32x4, c), 0, 0, 0));
}
__device__ __forceinline__ unsigned pk4_i8(float a, float b, float c, float d) {
    const float M_ = 12582912.0f;
    const unsigned ua = __float_as_uint(__builtin_fminf(__builtin_fmaxf(a, -127.f), 127.f) + M_), ub = __float_as_uint(__builtin_fminf(__builtin_fmaxf(b, -127.f), 127.f) + M_);
    const unsigned uc = __float_as_uint(__builtin_fminf(__builtin_fmaxf(c, -127.f), 127.f) + M_), ud = __float_as_uint(__builtin_fminf(__builtin_fmaxf(d, -127.f), 127.f) + M_);
    return (ua & 0xffu) | ((ub & 0xffu) << 8) | ((uc & 0xffu) << 16) | (ud << 24);
}

struct Unit { int pm, pn; };
struct Gemm { const bf16_t* A; const bf16_t* Bt; int M, N, K; int a_shift; size_t a_stride; };

struct StaticOrder {
    int nM, nN, nwg, G, c;
    __host__ __device__ void init(int M_, int N_, int G_, int c_) { nM = M_ / BM; nN = N_ / BM; nwg = nM * nN; G = G_; c = c_; }
    __host__ __device__ bool next(int i, Unit& u) const {
        const long L = (long)i * G + c; if (L >= nwg) return false;
        int wgid = (int)L; { const int q = nwg / NXCD, r = nwg % NXCD, xcd = wgid % NXCD, off = wgid / NXCD; wgid = (xcd < r ? xcd * (q + 1) : r * (q + 1) + (xcd - r) * q) + off; }
        const int nig = WGM * nN, gid = wgid / nig, fm = gid * WGM, gsz = (nM - fm) < WGM ? (nM - fm) : WGM;
        u.pm = fm + ((wgid % nig) % gsz); u.pn = (wgid % nig) / gsz; return true;
    }
    __device__ __forceinline__ void a_ready(const Unit&) const {}
    __device__ __forceinline__ void done(const Unit&) const {}
};

struct SplitOrder {
    int nM, nN, nwg, c;
    __host__ __device__ void init(int M_, int N_, int c_) { nM = M_ / BM; nN = N_ / BM; nwg = nM * nN; c = c_; }
    __host__ __device__ bool next(int i, Unit& u) const {
        int L;
        if (i < 5) L = i * 256 + c; else if (c >= 128 && i < 7) L = 1280 + (i - 5) * 128 + (c - 128); else return false;
        int wgid = L; { const int q = nwg / NXCD, xcd = wgid % NXCD, off = wgid / NXCD; wgid = xcd * q + off; }
        const int nig = WGM * nN, gid = wgid / nig, fm = gid * WGM;
        u.pm = fm + ((wgid % nig) % WGM); u.pn = (wgid % nig) / WGM; return true;
    }
    __device__ __forceinline__ void a_ready(const Unit&) const {}
    __device__ __forceinline__ void done(const Unit&) const {}
};

__device__ __forceinline__ u32x4 pack8(f32x4 v0, f32x4 v1) { u32x4 w; w.x = cvt_pk_bf16(v0[0], v0[1]); w.y = cvt_pk_bf16(v0[2], v0[3]); w.z = cvt_pk_bf16(v1[0], v1[1]); w.w = cvt_pk_bf16(v1[2], v1[3]); return w; }

struct EpiPlain {
    static constexpr bool PERM = true, AFTER_DRAIN = false; static constexpr int NST = 16;
    bf16_t* O; int ldc;
    __device__ __forceinline__ void operator()(const f32x4 (&acc)[2][2][4][2], const Unit& u, int wr, int wc, int fr, int fq) const {
        const int row0 = u.pm * BM + wr * 64 + fr, col0 = u.pn * BM + wc * 32 + 8 * fq;
#pragma unroll
        for (int ai = 0; ai < 2; ++ai)
#pragma unroll
            for (int m = 0; m < 4; ++m) { bf16_t* rowp = O + (size_t)(row0 + ai * HALF + m * 16) * ldc + col0;
#pragma unroll
                for (int bj = 0; bj < 2; ++bj) *(u32x4*)(rowp + bj * HALF) = pack8(acc[ai][bj][m][0], acc[ai][bj][m][1]); }
    }
};
template <bool IA> __device__ __forceinline__ float accf(float v) { if constexpr (IA) return (float)__builtin_bit_cast(int, v); else return v; }
template <bool IA>
struct EpiSwigluT {
    static constexpr bool PERM = true, AFTER_DRAIN = false; static constexpr int NST = 8;
    bf16_t* O; int ldc; float is;
    __device__ __forceinline__ void operator()(const f32x4 (&acc)[2][2][4][2], const Unit& u, int wr, int wc, int fr, int fq) const {
        const int row0 = u.pm * BM + wr * 64 + fr, col0 = u.pn * HALF + wc * 32 + 8 * fq;
#pragma unroll
        for (int ai = 0; ai < 2; ++ai)
#pragma unroll
            for (int m = 0; m < 4; ++m) { bf16_t* rowp = O + (size_t)(row0 + ai * HALF + m * 16) * ldc + col0;
                f32x4 o[2];
#pragma unroll
                for (int n = 0; n < 2; ++n)
#pragma unroll
                    for (int e = 0; e < 4; ++e) { const float g = accf<IA>(acc[ai][0][m][n][e]) * is; o[n][e] = g * fsigmoid(g) * (accf<IA>(acc[ai][1][m][n][e]) * is); }
                *(u32x4*)rowp = pack8(o[0], o[1]); }
    }
};
typedef EpiSwigluT<false> EpiSwiglu;
struct EpiPlainI8 {
    static constexpr bool PERM = true, AFTER_DRAIN = false; static constexpr int NST = 16;
    bf16_t* O; int ldc; float is;
    __device__ __forceinline__ void operator()(const f32x4 (&acc)[2][2][4][2], const Unit& u, int wr, int wc, int fr, int fq) const {
        const int row0 = u.pm * BM + wr * 64 + fr, col0 = u.pn * BM + wc * 32 + 8 * fq;
#pragma unroll
        for (int ai = 0; ai < 2; ++ai)
#pragma unroll
            for (int m = 0; m < 4; ++m) { bf16_t* rowp = O + (size_t)(row0 + ai * HALF + m * 16) * ldc + col0;
#pragma unroll
                for (int bj = 0; bj < 2; ++bj) { f32x4 o[2];
#pragma unroll
                    for (int n = 0; n < 2; ++n)
#pragma unroll
                        for (int e = 0; e < 4; ++e) o[n][e] = accf<true>(acc[ai][bj][m][n][e]) * is;
                    *(u32x4*)(rowp + bj * HALF) = pack8(o[0], o[1]); } }
    }
};
template <bool IA>
struct EpiSwiglu8T {
    static constexpr bool PERM = true, AFTER_DRAIN = false; static constexpr int NST = 8;
    unsigned char* O; int ldc; float sc, is;
    __device__ __forceinline__ void operator()(const f32x4 (&acc)[2][2][4][2], const Unit& u, int wr, int wc, int fr, int fq) const {
        const int row0 = u.pm * BM + wr * 64 + fr, col0 = u.pn * HALF + wc * 32 + 8 * fq; const float scu = sc * is;
#pragma unroll
        for (int ai = 0; ai < 2; ++ai)
#pragma unroll
            for (int m = 0; m < 4; ++m) { unsigned char* rowp = O + (size_t)(row0 + ai * HALF + m * 16) * ldc + col0;
                f32x4 o[2];
#pragma unroll
                for (int n = 0; n < 2; ++n)
#pragma unroll
                    for (int e = 0; e < 4; ++e) { const float g = accf<IA>(acc[ai][0][m][n][e]) * is; o[n][e] = g * fsigmoid(g) * accf<IA>(acc[ai][1][m][n][e]) * scu; }
                *(u32x2*)rowp = (u32x2){pk4_fp8(o[0][0], o[0][1], o[0][2], o[0][3]), pk4_fp8(o[1][0], o[1][1], o[1][2], o[1][3])}; }
    }
};
typedef EpiSwiglu8T<false> EpiSwiglu8;
struct EpiLora {
    static constexpr bool PERM = true, AFTER_DRAIN = false; static constexpr int NST = 16;
    bf16_t* lmid;
    __device__ __forceinline__ void operator()(const f32x4 (&acc)[2][2][4][2], const Unit& u, int wr, int wc, int fr, int fq) const {
        const int row0 = u.pm * BM + wr * 64 + fr, col0 = wc * 32 + 8 * fq;
#pragma unroll
        for (int ai = 0; ai < 2; ++ai)
#pragma unroll
            for (int m = 0; m < 4; ++m) { bf16_t* rowp = lmid + (size_t)(row0 + ai * HALF + m * 16) * 256 + col0;
#pragma unroll
                for (int bj = 0; bj < 2; ++bj) { f32x4 o[2];
#pragma unroll
                    for (int n = 0; n < 2; ++n)
#pragma unroll
                        for (int e = 0; e < 4; ++e) { const float v = acc[ai][bj][m][n][e]; o[n][e] = (bj == 1) ? fsigmoid(v) : (wc < 2 ? ftanh(v) : v); }
                    *(u32x4*)(rowp + bj * HALF) = pack8(o[0], o[1]); } }
    }
};
struct EpiRw2 {
    static constexpr bool PERM = true, AFTER_DRAIN = false; static constexpr int NST = 16;
    bf16_t* O; const float* w0; const float* a0;
    __device__ __forceinline__ void operator()(const f32x4 (&acc)[2][2][4][2], const Unit& u, int wr, int wc, int fr, int fq) const {
        const int row0 = u.pm * BM + wr * 64 + fr, col0 = u.pn * BM + wc * 32 + 8 * fq, kind = u.pn >> 2, cc0 = (u.pn & 3) * BM + wc * 32 + 8 * fq;
        if (kind == 2) {
#pragma unroll
            for (int ai = 0; ai < 2; ++ai)
#pragma unroll
                for (int m = 0; m < 4; ++m) { bf16_t* rowp = O + (size_t)(row0 + ai * HALF + m * 16) * 3072 + col0;
#pragma unroll
                    for (int bj = 0; bj < 2; ++bj) *(u32x4*)(rowp + bj * HALF) = pack8(acc[ai][bj][m][0], acc[ai][bj][m][1]); }
        } else {
            const float* bp = (kind == 0 ? w0 : a0) + cc0; const float sc = kind == 0 ? -0.60653065971f : 1.0f;
#pragma unroll
            for (int bj = 0; bj < 2; ++bj) {
                const f32x4 b0 = *(const f32x4*)(bp + bj * HALF), b1 = *(const f32x4*)(bp + bj * HALF + 4);
#pragma unroll
                for (int ai = 0; ai < 2; ++ai)
#pragma unroll
                    for (int m = 0; m < 4; ++m) { bf16_t* rowp = O + (size_t)(row0 + ai * HALF + m * 16) * 3072 + col0; f32x4 o0, o1;
#pragma unroll
                        for (int e = 0; e < 4; ++e) { o0[e] = sc * fsigmoid(acc[ai][bj][m][0][e] + b0[e]); o1[e] = sc * fsigmoid(acc[ai][bj][m][1][e] + b1[e]); }
                        *(u32x4*)(rowp + bj * HALF) = pack8(o0, o1); }
            }
        }
    }
};
template <bool IA> __device__ __forceinline__ float accf_(float v) { if constexpr (IA) return (float)__builtin_bit_cast(int, v); else return v; }
template <bool IA>
struct EpiRtInT {
    static constexpr bool PERM = true, AFTER_DRAIN = false; static constexpr int NST = 16;
    bf16_t* O; const int* pos; float is;
    __device__ __forceinline__ void operator()(const f32x4 (&acc)[2][2][4][2], const Unit& u, int wr, int wc, int fr, int fq) const {
        const int row0 = u.pm * BM + wr * 64 + fr, col0 = u.pn * BM + wc * 32 + 8 * fq;
        if (u.pn >= 8) {
#pragma unroll
            for (int ai = 0; ai < 2; ++ai)
#pragma unroll
                for (int m = 0; m < 4; ++m) { bf16_t* rowp = O + (size_t)(row0 + ai * HALF + m * 16) * 6144 + col0;
#pragma unroll
                    for (int bj = 0; bj < 2; ++bj) {
                        if constexpr (IA) { f32x4 o[2];
#pragma unroll
                            for (int n = 0; n < 2; ++n)
#pragma unroll
                                for (int e = 0; e < 4; ++e) o[n][e] = accf_<true>(acc[ai][bj][m][n][e]) * is;
                            *(u32x4*)(rowp + bj * HALF) = pack8(o[0], o[1]); }
                        else *(u32x4*)(rowp + bj * HALF) = pack8(acc[ai][bj][m][0], acc[ai][bj][m][1]); } }
        } else {
            const float sc = (u.pn >= 4 ? 0.0625f : 1.0f) * (IA ? is : 1.0f);
            float invf[2][4];
#pragma unroll
            for (int n = 0; n < 2; ++n)
#pragma unroll
                for (int e = 0; e < 4; ++e) { const int i = wc * 32 + 8 * fq + 4 * n + e; invf[n][e] = __builtin_amdgcn_exp2f((float)i * (-13.287712379549449f / 127.0f)) * 0.15915494309189535f; }
#pragma unroll
            for (int ai = 0; ai < 2; ++ai)
#pragma unroll
                for (int m = 0; m < 4; ++m) { const int row = row0 + ai * HALF + m * 16; const float p = (float)pos[row]; bf16_t* rowp = O + (size_t)row * 6144 + col0;
                    f32x4 o1[2], o2[2];
#pragma unroll
                    for (int n = 0; n < 2; ++n)
#pragma unroll
                        for (int e = 0; e < 4; ++e) { float rev = p * invf[n][e]; rev = rev - __builtin_floorf(rev);
                            const float sn = __builtin_amdgcn_sinf(rev), cs = __builtin_amdgcn_cosf(rev);
                            const float u1 = accf_<IA>(acc[ai][0][m][n][e]), u2 = accf_<IA>(acc[ai][1][m][n][e]);
                            o1[n][e] = (u1 * cs - u2 * sn) * sc; o2[n][e] = (u1 * sn + u2 * cs) * sc; }
                    *(u32x4*)rowp = pack8(o1[0], o1[1]); *(u32x4*)(rowp + HALF) = pack8(o2[0], o2[1]); }
        }
    }
};
typedef EpiRtInT<false> EpiRtIn;

__device__ __forceinline__ float swz_xor16(float v) { return __builtin_bit_cast(float, __builtin_amdgcn_ds_swizzle(__builtin_bit_cast(int, v), 0x401f)); }
__device__ __forceinline__ float bperm(float v, int byteaddr) { return __builtin_bit_cast(float, __builtin_amdgcn_ds_bpermute(byteaddr, __builtin_bit_cast(int, v))); }
template <bool KEEPX>
struct EpiNormRes {
    static constexpr bool PERM = true, AFTER_DRAIN = false; static constexpr int NST = 16;
    unsigned char* ws; float* out; PG8_LAS unsigned char* lds; int s, mode; float hs;
    __device__ __forceinline__ void operator()(const f32x4 (&acc)[2][2][4][2], const Unit& u, int wr, int wc, int, int) const {
        int t_ = threadIdx.x, s_ = s; asm volatile("" : "+v"(t_), "+s"(s_));
        const int lane = t_ & 63, fr = lane & 15, fq = lane >> 4, tid = (wr * 4 + wc) * 64 + lane;
        const int r0 = wr * 64 + fr, col0 = u.pn * BM + wc * 32 + 8 * fq;
        bf16_t* const xb = (bf16_t*)out; bf16_t* const xb2 = (bf16_t*)(ws + WS_A + 256 * MiB);
        const bf16_t* xin = (mode & 1) ? xb2 : xb; bf16_t* xout = (mode & 2) ? xb2 : xb; float* fout = (mode & 4) ? out : nullptr;
        const float* rho_in = (const float*)(ws + 57 * MiB) + (s_ & 1) * M; float* rho_out = (float*)(ws + 57 * MiB) + ((s_ + 1) & 1) * M;
        float* stats = (float*)(ws + WS_MO) + (size_t)s_ * STATS_PER_PHASE;
        unsigned* cnt = (unsigned*)(ws + WS_CTL) + CW_CNT + s_ * 2048; unsigned* tmo = (unsigned*)(ws + WS_CTL) + CW_BAR + 128;
        const float c = (s_ % 3 == 1) ? 1.0f : 0.5f;
        PG8_LAS unsigned char* sm = lds + RING_BYTES; const PG8_LAS float* gl = (const PG8_LAS float*)(lds + GAIN_OFF);
        PG8_LAS float* part = (PG8_LAS float*)sm; PG8_LAS float* coef = part + 3072;
        const bf16_t* xrow = xin + (size_t)(u.pm * BM + r0) * DM + col0;
        const int a32 = (lane ^ 32) * 4;
        u32x4 xv[KEEPX ? 2 : 1][4][2];
        if constexpr (KEEPX) {
#pragma unroll
            for (int ai = 0; ai < 2; ++ai)
#pragma unroll
                for (int m = 0; m < 4; ++m)
#pragma unroll
                    for (int bj = 0; bj < 2; ++bj) xv[ai][m][bj] = *(const u32x4*)(xrow + (size_t)(ai * HALF + m * 16) * DM + bj * HALF);
        }
#pragma unroll
        for (int ai = 0; ai < 2; ++ai) {
            const int xi = KEEPX ? ai : 0;
            if constexpr (!KEEPX) {
#pragma unroll
                for (int m = 0; m < 4; ++m)
#pragma unroll
                    for (int bj = 0; bj < 2; ++bj) xv[0][m][bj] = *(const u32x4*)(xrow + (size_t)(ai * HALF + m * 16) * DM + bj * HALF);
            }
#pragma unroll
            for (int m = 0; m < 4; ++m) {
                float t1 = 0.f, s2 = 0.f, s3 = 0.f;
#pragma unroll
                for (int bj = 0; bj < 2; ++bj)
#pragma unroll
                    for (int n = 0; n < 2; ++n) { const f32x4 g = *(const PG8_LAS f32x4*)(gl + col0 + bj * HALF + 4 * n);
#pragma unroll
                        for (int e = 0; e < 4; ++e) { const float h = acc[ai][bj][m][n][e], hg = h * g[e]; const unsigned wd = xv[xi][m][bj][n * 2 + (e >> 1)];
                            const float x = (e & 1) ? bf_hi(wd) : bf_lo(wd); t1 += h * h; s2 += x * hg; s3 += hg * hg; } }
                t1 *= hs * hs;
                t1 += swz_xor16(t1); s2 += swz_xor16(s2); s3 += swz_xor16(s3);
                t1 += bperm(t1, a32); s2 += bperm(s2, a32); s3 += bperm(s3, a32);
                if (fq == 0) { PG8_LAS float* p = part + ((r0 + ai * HALF + m * 16) * 4 + wc) * 3; p[0] = t1; p[1] = s2; p[2] = s3; }
                asm volatile("" ::: "memory");
            }
        }
        if constexpr (KEEPX) {
#pragma unroll
            for (int ai = 0; ai < 2; ++ai)
#pragma unroll
                for (int m = 0; m < 4; ++m)
#pragma unroll
                    for (int bj = 0; bj < 2; ++bj) asm volatile("" : "+v"(xv[ai][m][bj]));
        }
        WG_BAR_L();
        if (tid < 256) {
            const PG8_LAS float* p = part + tid * 12;
            const float t1 = (p[0] + p[3]) + (p[6] + p[9]), t2 = (p[1] + p[4]) + (p[7] + p[10]), t3 = (p[2] + p[5]) + (p[8] + p[11]);
            float* sp = stats + (size_t)((u.pm * 4 + u.pn) * 3) * 256 + tid;
            __hip_atomic_store(sp, t1, __ATOMIC_RELAXED, __HIP_MEMORY_SCOPE_AGENT); __hip_atomic_store(sp + 256, t2, __ATOMIC_RELAXED, __HIP_MEMORY_SCOPE_AGENT); __hip_atomic_store(sp + 512, t3, __ATOMIC_RELAXED, __HIP_MEMORY_SCOPE_AGENT);
        }
        asm volatile("s_waitcnt vmcnt(0)" ::: "memory");
        WG_BAR_L();
        if (tid == 0) {
            unsigned* cp = cnt + u.pm * 16;
            (void)__hip_atomic_fetch_add(cp, 1u, __ATOMIC_RELAXED, __HIP_MEMORY_SCOPE_AGENT);
            unsigned spn = 0;
            while (__hip_atomic_load(cp, __ATOMIC_RELAXED, __HIP_MEMORY_SCOPE_AGENT) < 4u) { __builtin_amdgcn_s_sleep(1);
                if ((++spn & 255u) == 0u) { if (__hip_atomic_load(tmo, __ATOMIC_RELAXED, __HIP_MEMORY_SCOPE_AGENT)) break; if (spn > (1u << 18)) { atomicAdd(tmo, 1u); break; } } }
        }
        WG_BAR_L();
        if (tid < 256) {
            const float* sp = stats + (size_t)(u.pm * 12) * 256 + tid;
            float T1 = 0.f, T2 = 0.f, T3 = 0.f;
#pragma unroll
            for (int q = 0; q < 4; ++q) { T1 += __hip_atomic_load(sp + (q * 3 + 0) * 256, __ATOMIC_RELAXED, __HIP_MEMORY_SCOPE_AGENT); T2 += __hip_atomic_load(sp + (q * 3 + 1) * 256, __ATOMIC_RELAXED, __HIP_MEMORY_SCOPE_AGENT);
                T3 += __hip_atomic_load(sp + (q * 3 + 2) * 256, __ATOMIC_RELAXED, __HIP_MEMORY_SCOPE_AGENT); }
            const int row = u.pm * BM + tid;
            const float rho = rho_in[row], a = __builtin_amdgcn_rsqf(__builtin_fmaf(T1, 1.0f / DM, NORM_EPS)) * c;
            const float ms = __builtin_fmaxf(__builtin_fmaf(rho, rho, (a * (1.0f / DM)) * __builtin_fmaf(2.0f * rho, T2, a * T3)), NORM_EPS), rs = fout ? 1.0f : __builtin_amdgcn_rsqf(ms);
            *(PG8_LAS f32x2*)(coef + 2 * tid) = (f32x2){a, rho} * rs;
            if (u.pn == 0 && !fout) rho_out[row] = ms * rs;
        }
        WG_BAR_L();
        bf16_t* orow = xout + (size_t)(u.pm * BM + r0) * DM + col0;
#pragma unroll
        for (int ai = 0; ai < 2; ++ai) {
            const int xi = KEEPX ? ai : 0;
            if constexpr (!KEEPX) {
#pragma unroll
                for (int m = 0; m < 4; ++m)
#pragma unroll
                    for (int bj = 0; bj < 2; ++bj) xv[0][m][bj] = *(const u32x4*)(xrow + (size_t)(ai * HALF + m * 16) * DM + bj * HALF);
            }
#pragma unroll
            for (int m = 0; m < 4; ++m) {
                const f32x2 ab = *(const PG8_LAS f32x2*)(coef + 2 * (r0 + ai * HALF + m * 16));
#pragma unroll
                for (int bj = 0; bj < 2; ++bj) { f32x4 o[2];
#pragma unroll
                    for (int n = 0; n < 2; ++n) { const f32x4 ag = *(const PG8_LAS f32x4*)(gl + col0 + bj * HALF + 4 * n) * ab[0];
#pragma unroll
                        for (int e = 0; e < 4; ++e) { const unsigned wd = xv[xi][m][bj][n * 2 + (e >> 1)]; const float x = (e & 1) ? bf_hi(wd) : bf_lo(wd);
                            o[n][e] = __builtin_fmaf(ag[e], acc[ai][bj][m][n][e], ab[1] * x); } }
                    if (fout) { float* fr_ = fout + (size_t)(u.pm * BM + r0 + ai * HALF + m * 16) * DM + col0 + bj * HALF; *(f32x4*)fr_ = o[0]; *(f32x4*)(fr_ + 4) = o[1]; }
                    else { *(u32x4*)(orow + (size_t)(ai * HALF + m * 16) * DM + bj * HALF) = pack8(o[0], o[1]);
                        if (mode & 8) *(u32x2*)((unsigned char*)out + X8_OFF + (size_t)(u.pm * BM + r0 + ai * HALF + m * 16) * DM + col0 + bj * HALF) =
                            (u32x2){pk4_i8(o[0][0] * X8_SCALE, o[0][1] * X8_SCALE, o[0][2] * X8_SCALE, o[0][3] * X8_SCALE), pk4_i8(o[1][0] * X8_SCALE, o[1][1] * X8_SCALE, o[1][2] * X8_SCALE, o[1][3] * X8_SCALE)}; } }
            }
            if constexpr (!KEEPX) asm volatile("" ::: "memory");
        }
    }
};

template <class Epi, class Sched, bool ALIGN_EPI = false, bool SP2 = false, int F8 = 0>
__device__ __forceinline__ void gemm_phase(PG8_LAS unsigned char* lds, const Gemm g, const Sched& S, const Epi& E) {
    int tid_ = threadIdx.x; asm volatile("" : "+v"(tid_));
    const int tid = tid_, wid = __builtin_amdgcn_readfirstlane(tid >> 6), lane = tid & 63, wr = wid >> 2, wc = wid & 3, fr = lane & 15, fq = lane >> 4;
    const int K = g.K, nt = K / BK;
    unsigned voffA[2], voffB[2];
#pragma unroll
    for (int i = 0; i < 2; ++i) { int R, C; stage_rc(tid * 16 + i * 8192, R, C); const int Rb = Epi::PERM ? ((R & ~31) + perm32(R & 31)) : R;
        voffA[i] = (unsigned)(R * K + C) * 2u; voffB[i] = (unsigned)(Rb * K + C) * 2u; }
    const size_t kstep = (size_t)(BK * 2);
    const size_t hstep = (size_t)HALF * K * 2;
    const size_t tstep = 2 * hstep;
    const unsigned ldsw = (unsigned)wid * 1024u;
    const int aoff = lds_byte(wr * 64 + fr, fq * 8), boff = lds_byte(wc * 32 + fr, fq * 8);
#define PG8_SA(b, h) (((b) * 2 + (h)) * HTB)
#define PG8_SB(b, h) ((4 + (b) * 2 + (h)) * HTB)
#define PG8_STAGE(bufoff, gbase, voff) do { _Pragma("unroll") for (int _i = 0; _i < 2; ++_i) \
        __builtin_amdgcn_global_load_lds((const unsigned*)((const char*)(gbase) + (voff)[_i]), (PG8_LAS unsigned*)(lds + (bufoff) + ldsw + _i * 8192), 16, 0, 0); } while (0)
#define PG8_LDA(dst, b, h) do { _Pragma("unroll") for (int m = 0; m < 4; ++m) _Pragma("unroll") for (int k = 0; k < 2; ++k) dst[m][k] = *(const PG8_LAS bf16x8*)(lds + PG8_SA(b, h) + aoff + m * 2048 + k * 1024); } while (0)
#define PG8_LDB(dst, b, h) do { _Pragma("unroll") for (int n = 0; n < 2; ++n) _Pragma("unroll") for (int k = 0; k < 2; ++k) dst[n][k] = *(const PG8_LAS bf16x8*)(lds + PG8_SB(b, h) + boff + n * 2048 + k * 1024); } while (0)
#define PG8_MMA(ai, bj, At, Bt) do { __builtin_amdgcn_s_setprio(1); \
        if constexpr (F8 == 1) { _Pragma("unroll") for (int m = 0; m < 4; ++m) _Pragma("unroll") for (int n = 0; n < 2; ++n) acc[ai][bj][m][n] = mfma_f8(Bt[n][0], Bt[n][1], At[m][0], At[m][1], acc[ai][bj][m][n]); } \
        else if constexpr (F8 == 2) { _Pragma("unroll") for (int m = 0; m < 4; ++m) _Pragma("unroll") for (int n = 0; n < 2; ++n) _Pragma("unroll") for (int k = 0; k < 2; ++k) acc[ai][bj][m][n] = mfma_i8(Bt[n][k], At[m][k], acc[ai][bj][m][n]); } \
        else { _Pragma("unroll") for (int m = 0; m < 4; ++m) _Pragma("unroll") for (int n = 0; n < 2; ++n) _Pragma("unroll") for (int k = 0; k < 2; ++k) \
        acc[ai][bj][m][n] = __builtin_amdgcn_mfma_f32_16x16x32_bf16(Bt[n][k], At[m][k], acc[ai][bj][m][n], 0, 0, 0); } __builtin_amdgcn_s_setprio(0); } while (0)
#define PG8_WAIT_V(n) asm volatile("s_waitcnt vmcnt(" #n ")" ::: "memory")
#define PG8_WAIT_L(n) asm volatile("s_waitcnt lgkmcnt(" #n ")" ::: "memory")
#define PG8_BAR __builtin_amdgcn_s_barrier()
#define PG8_SCHED __builtin_amdgcn_sched_barrier(0)
    Unit cur, nxt; int ui = 0;
    if (!S.next(0, cur)) return;
    f32x4 acc[2][2][4][2];
#pragma unroll
    for (int a = 0; a < 2; ++a)
#pragma unroll
        for (int b = 0; b < 2; ++b)
#pragma unroll
            for (int m = 0; m < 4; ++m)
#pragma unroll
                for (int n = 0; n < 2; ++n) acc[a][b][m][n] = (f32x4){0.f, 0.f, 0.f, 0.f};
    bf16x8 At[4][2], B0[2][2], B1[2][2];
    const char* cA = (const char*)g.A + (size_t)(cur.pn >> g.a_shift) * g.a_stride + (size_t)cur.pm * tstep; const char* cB = (const char*)g.Bt + (size_t)cur.pn * tstep;
    S.a_ready(cur);
    if constexpr (SP2) {
        PG8_STAGE(PG8_SB(0, 0), cB, voffB); PG8_STAGE(PG8_SB(0, 1), cB + hstep, voffB); PG8_STAGE(PG8_SA(0, 0), cA, voffA); PG8_STAGE(PG8_SA(0, 1), cA + hstep, voffA);
        if (wr == 1) PG8_BAR;
        PG8_WAIT_V(2); PG8_BAR;
        PG8_STAGE(PG8_SB(1, 0), cB + kstep, voffB); PG8_STAGE(PG8_SA(1, 0), cA + kstep, voffA); PG8_STAGE(PG8_SB(1, 1), cB + hstep + kstep, voffB);
        PG8_WAIT_V(6); PG8_BAR;
    } else {
        PG8_STAGE(PG8_SB(0, 0), cB, voffB); PG8_STAGE(PG8_SA(0, 0), cA, voffA); PG8_STAGE(PG8_SB(0, 1), cB + hstep, voffB); PG8_STAGE(PG8_SA(0, 1), cA + hstep, voffA);
        if (wr == 1) PG8_BAR;
        PG8_WAIT_V(4); PG8_BAR;
        PG8_STAGE(PG8_SB(1, 0), cB + kstep, voffB); PG8_STAGE(PG8_SA(1, 0), cA + kstep, voffA); PG8_STAGE(PG8_SB(1, 1), cB + hstep + kstep, voffB);
        PG8_WAIT_V(6); PG8_BAR;
    }
    for (;;) {
        const bool has_next = S.next(ui + 1, nxt);
        const char* nA = has_next ? (const char*)g.A + (size_t)(nxt.pn >> g.a_shift) * g.a_stride + (size_t)nxt.pm * tstep : cA; const char* nB = has_next ? (const char*)g.Bt + (size_t)nxt.pn * tstep : cB;
        for (int t = 0; t < nt; t += 2) {
            const bool last = (t == nt - 2);
            const char* a1 = cA + (size_t)(t + 1) * kstep;
            const char* a2 = last ? nA : cA + (size_t)(t + 2) * kstep; const char* b2 = last ? nB : cB + (size_t)(t + 2) * kstep;
            const char* a3 = a2 + kstep; const char* b3 = b2 + kstep;
            if (last && has_next) S.a_ready(nxt);
            if constexpr (SP2) {
            const unsigned skipst = (unsigned)__builtin_amdgcn_readfirstlane((Epi::NST > 0 && t == 0 && ui > 0) ? 1 : 0);
#define PG8_WAIT_VS() do { if constexpr (Epi::NST == 16) asm volatile("s_cmp_eq_u32 %0, 0\n\ts_cbranch_scc1 .LWA%=\n\ts_waitcnt vmcnt(24)\n\ts_branch .LWB%=\n.LWA%=:\n\ts_waitcnt vmcnt(8)\n.LWB%=:" :: "s"(skipst) : "memory", "scc"); \
        else if constexpr (Epi::NST == 8) asm volatile("s_cmp_eq_u32 %0, 0\n\ts_cbranch_scc1 .LWA%=\n\ts_waitcnt vmcnt(16)\n\ts_branch .LWB%=\n.LWA%=:\n\ts_waitcnt vmcnt(8)\n.LWB%=:" :: "s"(skipst) : "memory", "scc"); \
        else PG8_WAIT_V(8); } while (0)
            PG8_LDB(B0, 0, 0); PG8_LDB(B1, 0, 1); PG8_SCHED; PG8_LDA(At, 0, 0); PG8_STAGE(PG8_SA(1, 1), a1 + hstep, voffA);
            PG8_WAIT_VS(); PG8_WAIT_L(0); PG8_BAR; PG8_MMA(0, 0, At, B0); PG8_MMA(0, 1, At, B1); PG8_BAR; PG8_SCHED;
            PG8_LDA(At, 0, 1); PG8_STAGE(PG8_SB(0, 0), b2, voffB); PG8_STAGE(PG8_SB(0, 1), b2 + hstep, voffB); PG8_STAGE(PG8_SA(0, 0), a2, voffA);
            PG8_WAIT_VS(); PG8_WAIT_L(0); PG8_BAR; PG8_MMA(1, 0, At, B0); PG8_MMA(1, 1, At, B1); PG8_BAR; PG8_SCHED;
#undef PG8_WAIT_VS
            PG8_LDB(B0, 1, 0); PG8_LDB(B1, 1, 1); PG8_SCHED; PG8_LDA(At, 1, 0); PG8_STAGE(PG8_SA(0, 1), a2 + hstep, voffA);
            PG8_WAIT_V(8); PG8_WAIT_L(0); PG8_BAR; PG8_MMA(0, 0, At, B0); PG8_MMA(0, 1, At, B1); PG8_BAR; PG8_SCHED;
            PG8_LDA(At, 1, 1); PG8_STAGE(PG8_SB(1, 0), b3, voffB); PG8_STAGE(PG8_SB(1, 1), b3 + hstep, voffB); PG8_STAGE(PG8_SA(1, 0), a3, voffA);
            PG8_WAIT_V(8); PG8_WAIT_L(0); PG8_BAR; PG8_MMA(1, 0, At, B0); PG8_MMA(1, 1, At, B1); PG8_BAR; PG8_SCHED;
            } else {
            PG8_LDB(B0, 0, 0); PG8_SCHED; PG8_LDA(At, 0, 0); PG8_STAGE(PG8_SA(1, 1), a1 + hstep, voffA);
            PG8_WAIT_L(8); PG8_BAR; PG8_WAIT_L(0); PG8_MMA(0, 0, At, B0); PG8_BAR; PG8_SCHED;
            PG8_LDB(B1, 0, 1); PG8_STAGE(PG8_SB(0, 0), b2, voffB);
            PG8_BAR; PG8_WAIT_L(0); PG8_MMA(0, 1, At, B1); PG8_BAR;
            PG8_LDA(At, 0, 1); PG8_STAGE(PG8_SA(0, 0), a2, voffA);
            PG8_BAR; PG8_WAIT_L(0); PG8_MMA(1, 0, At, B0); PG8_BAR; PG8_SCHED;
            PG8_STAGE(PG8_SB(0, 1), b2 + hstep, voffB);
            PG8_WAIT_V(6); PG8_BAR; PG8_MMA(1, 1, At, B1); PG8_BAR;
            PG8_LDB(B0, 1, 0); PG8_SCHED; PG8_LDA(At, 1, 0); PG8_STAGE(PG8_SA(0, 1), a2 + hstep, voffA);
            PG8_WAIT_L(8); PG8_BAR; PG8_WAIT_L(0); PG8_MMA(0, 0, At, B0); PG8_BAR; PG8_SCHED;
            PG8_LDB(B1, 1, 1); PG8_STAGE(PG8_SB(1, 0), b3, voffB);
            PG8_BAR; PG8_WAIT_L(0); PG8_MMA(0, 1, At, B1); PG8_BAR;
            PG8_LDA(At, 1, 1); PG8_STAGE(PG8_SA(1, 0), a3, voffA);
            PG8_BAR; PG8_WAIT_L(0); PG8_MMA(1, 0, At, B0); PG8_BAR; PG8_SCHED;
            PG8_STAGE(PG8_SB(1, 1), b3 + hstep, voffB);
            PG8_WAIT_V(6); PG8_BAR; PG8_MMA(1, 1, At, B1); PG8_BAR;
            }
        }
        if constexpr (ALIGN_EPI) { if (wr == 0) PG8_BAR; }
        if constexpr (!Epi::AFTER_DRAIN) { E(acc, cur, wr, wc, fr, fq); S.done(cur); }
        if (!has_next) break;
#pragma unroll
        for (int a = 0; a < 2; ++a)
#pragma unroll
            for (int b = 0; b < 2; ++b)
#pragma unroll
                for (int m = 0; m < 4; ++m)
#pragma unroll
                    for (int n = 0; n < 2; ++n) acc[a][b][m][n] = (f32x4){0.f, 0.f, 0.f, 0.f};
        cur = nxt; cA = nA; cB = nB; ++ui;
        if constexpr (ALIGN_EPI) { if (wr == 1) PG8_BAR; }
    }
    PG8_WAIT_V(0);
    if constexpr (!ALIGN_EPI) { if (wr == 0) PG8_BAR; }
    PG8_BAR;
#undef PG8_SA
#undef PG8_SB
#undef PG8_STAGE
#undef PG8_LDA
#undef PG8_LDB
#undef PG8_MMA
#undef PG8_WAIT_V
#undef PG8_WAIT_L
#undef PG8_BAR
#undef PG8_SCHED
}
}

#define XB_TMO      128
#define XB_XCNT(j)  (256  + 64 * (j))
#define XB_XSUB(j)  (1280 + 64 * (j))
#define XB_XGEN(j)  (2304 + 64 * (j))
#define XB_TOP      3328
#define XB_TOPGEN   3392
#define XCD_BAR_WORDS 3456
#define XB_SPIN_CAP (1u << 18)

__device__ __forceinline__ unsigned xb_ld(unsigned* p)              { return __hip_atomic_load(p, __ATOMIC_RELAXED, __HIP_MEMORY_SCOPE_AGENT); }
__device__ __forceinline__ unsigned xb_add(unsigned* p, unsigned v) { return __hip_atomic_fetch_add(p, v, __ATOMIC_RELAXED, __HIP_MEMORY_SCOPE_AGENT); }
__device__ __forceinline__ unsigned xb_xcc_id() { return (unsigned)__builtin_amdgcn_s_getreg((3 << 11) | 20) & 0xFu; }
#define XB_SPIN(cond, bar) do { unsigned _sp = 0; while (cond) { __builtin_amdgcn_s_sleep(1); \
    if ((++_sp & 255u) == 0u) { if (xb_ld(&(bar)[XB_TMO])) break; if (_sp > XB_SPIN_CAP) { atomicAdd(&(bar)[XB_TMO], 1u); break; } } } } while (0)

struct XcdBarrier { unsigned* bar; unsigned x; volatile LAS unsigned* st; };

__device__ __forceinline__ XcdBarrier xcd_barrier_post(unsigned* bar, volatile LAS unsigned* st) {
    XcdBarrier b; b.bar = bar; b.x = xb_xcc_id(); b.st = st;
    if (threadIdx.x == 0) (void)xb_add(&bar[XB_XCNT(b.x)], 1u);
    return b;
}
__device__ __forceinline__ void xcd_barrier_complete(unsigned* bar, unsigned x, unsigned& nloc, unsigned& nx) {
    const unsigned G = gridDim.x * gridDim.y * gridDim.z;
    unsigned sum, cnt, mine, sp = 0u;
    for (;;) {
        sum = 0u; cnt = 0u; mine = 0u;
#pragma unroll
        for (unsigned j = 0; j < 16; ++j) { const unsigned c = xb_ld(&bar[XB_XCNT(j)]); sum += c; cnt += (c > 0u) ? 1u : 0u; mine = (j == x) ? c : mine; }
        if (sum == G) break;
        __builtin_amdgcn_s_sleep(1);
        if ((++sp & 255u) == 0u) { if (xb_ld(&bar[XB_TMO])) break; if (sp > XB_SPIN_CAP) { atomicAdd(&bar[XB_TMO], 1u); break; } }
    }
    nloc = mine > 0u ? mine : 1u; nx = cnt > 0u ? cnt : 1u;
}
__device__ __forceinline__ void xcd_barrier(const XcdBarrier& b) {
    asm volatile("s_waitcnt vmcnt(0)" ::: "memory");
    __syncthreads();
    if (threadIdx.x == 0) {
        unsigned* bar = b.bar;
        __builtin_amdgcn_s_waitcnt(0);
        unsigned nloc = b.st[0], nx = b.st[1];
        if (nloc == 0u) { xcd_barrier_complete(bar, b.x, nloc, nx); b.st[0] = nloc; b.st[1] = nx; }
        const unsigned old = xb_add(&bar[XB_XSUB(b.x)], 1u);
        const unsigned gen = old / nloc;
        if (old + 1u == (gen + 1u) * nloc) {
            __builtin_amdgcn_fence(__ATOMIC_RELEASE, "agent");
            asm volatile("s_waitcnt vmcnt(0)" ::: "memory");
            const unsigned og = xb_add(&bar[XB_TOP], 1u);
            const unsigned tg = og / nx;
            if (og + 1u == (tg + 1u) * nx) xb_add(&bar[XB_TOPGEN], 1u);
            else XB_SPIN(xb_ld(&bar[XB_TOPGEN]) == tg, bar);
            __builtin_amdgcn_fence(__ATOMIC_ACQUIRE, "agent");
            xb_add(&bar[XB_XGEN(b.x)], 1u);
            asm volatile("s_waitcnt vmcnt(0)" ::: "memory");
        } else {
            XB_SPIN(xb_ld(&bar[XB_XGEN(b.x)]) == gen, bar);
            __builtin_amdgcn_fence(__ATOMIC_ACQUIRE, "agent");
            asm volatile("s_waitcnt vmcnt(0)" ::: "memory");
        }
    }
    __syncthreads();
}

struct Frame {
    LAS unsigned char* lds;
    int vcu, G;
};
__device__ __forceinline__ int opaque_tid() { int t = threadIdx.x; asm volatile("" : "+v"(t)); return t; }
#define PH_IDS const int tid = opaque_tid(), lane = tid & 63, w = __builtin_amdgcn_readfirstlane(tid >> 6); (void)tid; (void)lane; (void)w

template <class SrcF>
__device__ __forceinline__ void prep_matrix(const Frame& F, int K, int N, bf16* WT, SrcF src, const float* kgain = nullptr) {
    PH_IDS;
    LAS float* scr = (LAS float*)(F.lds + w * 8448);
    int gw_ = F.vcu * NWAVES + w; asm volatile("" : "+s"(gw_));
    const int gw = gw_, NGW = F.G * NWAVES;
    const int nblk = N / 32, nitems = (K / 64) * nblk;
    float tv[32], tn[32];
    { const int it0 = gw < nitems ? gw : nitems - 1; const int kb = it0 / nblk, nb = it0 % nblk;
#pragma unroll
        for (int i = 0; i < 32; ++i) tv[i] = src(64 * kb + 2 * i + (lane >> 5), 32 * nb + (lane & 31)); }
    for (int it = gw; it < nitems; it += NGW) {
        const int kb = it / nblk, nb = it % nblk, k0 = 64 * kb, n0 = 32 * nb;
        { const int it2 = (it + NGW < nitems) ? it + NGW : it; const int kb2 = it2 / nblk, nb2 = it2 % nblk;
#pragma unroll
            for (int i = 0; i < 32; ++i) tn[i] = src(64 * kb2 + 2 * i + (lane >> 5), 32 * nb2 + (lane & 31)); }
#pragma unroll
        for (int i = 0; i < 32; ++i) scr[(2 * i + (lane >> 5)) * 33 + (lane & 31)] = tv[i];
#pragma unroll
        for (int i = 0; i < 32; ++i) tv[i] = tn[i];
        LDS_WAIT();
        const int c = lane & 7;
        f32x4 g0 = {1.f, 1.f, 1.f, 1.f}, g1 = {1.f, 1.f, 1.f, 1.f};
        if (kgain) { g0 = *(const f32x4*)(kgain + k0 + 8 * c); g1 = *(const f32x4*)(kgain + k0 + 8 * c + 4); }
#pragma unroll
        for (int j = 0; j < 4; ++j) { const int n = (lane >> 3) + 8 * j; const LAS float* s = scr + (8 * c) * 33 + n;
            u32x4 o; o.x = cvt_pk_bf16(s[0 * 33] * g0[0], s[1 * 33] * g0[1]); o.y = cvt_pk_bf16(s[2 * 33] * g0[2], s[3 * 33] * g0[3]); o.z = cvt_pk_bf16(s[4 * 33] * g1[0], s[5 * 33] * g1[1]); o.w = cvt_pk_bf16(s[6 * 33] * g1[2], s[7 * 33] * g1[3]);
            *(u32x4*)(WT + (size_t)(n0 + n) * K + k0 + 8 * c) = o; }
        LDS_WAIT();
    }
}

template <bool I8, class SrcF>
__device__ __forceinline__ void prep_matrix_q(const Frame& F, int K, int N, unsigned char* WT, SrcF src, float sc, const float* kgain = nullptr) {
    PH_IDS;
    LAS float* scr = (LAS float*)(F.lds + w * 8448);
    int gw_ = F.vcu * NWAVES + w; asm volatile("" : "+s"(gw_));
    const int gw = gw_, NGW = F.G * NWAVES;
    const int nblk = N / 32, nitems = (K / 64) * nblk;
    float tv[32], tn[32];
    { const int it0 = gw < nitems ? gw : nitems - 1; const int kb = it0 / nblk, nb = it0 % nblk;
#pragma unroll
        for (int i = 0; i < 32; ++i) tv[i] = src(64 * kb + 2 * i + (lane >> 5), 32 * nb + (lane & 31)); }
    for (int it = gw; it < nitems; it += NGW) {
        const int kb = it / nblk, nb = it % nblk, k0 = 64 * kb, n0 = 32 * nb;
        { const int it2 = (it + NGW < nitems) ? it + NGW : it; const int kb2 = it2 / nblk, nb2 = it2 % nblk;
#pragma unroll
            for (int i = 0; i < 32; ++i) tn[i] = src(64 * kb2 + 2 * i + (lane >> 5), 32 * nb2 + (lane & 31)); }
#pragma unroll
        for (int i = 0; i < 32; ++i) scr[(2 * i + (lane >> 5)) * 33 + (lane & 31)] = tv[i];
#pragma unroll
        for (int i = 0; i < 32; ++i) tv[i] = tn[i];
        LDS_WAIT();
        const int c = lane & 7;
        f32x4 g0 = {sc, sc, sc, sc}, g1 = {sc, sc, sc, sc};
        if (kgain) { g0 = *(const f32x4*)(kgain + k0 + 8 * c) * sc; g1 = *(const f32x4*)(kgain + k0 + 8 * c + 4) * sc; }
#pragma unroll
        for (int j = 0; j < 4; ++j) { const int n = (lane >> 3) + 8 * j; const LAS float* s = scr + (8 * c) * 33 + n;
            u32x2 o;
            if constexpr (I8) { o.x = pg8::pk4_i8(s[0 * 33] * g0[0], s[1 * 33] * g0[1], s[2 * 33] * g0[2], s[3 * 33] * g0[3]); o.y = pg8::pk4_i8(s[4 * 33] * g1[0], s[5 * 33] * g1[1], s[6 * 33] * g1[2], s[7 * 33] * g1[3]); }
            else { o.x = pg8::pk4_fp8(s[0 * 33] * g0[0], s[1 * 33] * g0[1], s[2 * 33] * g0[2], s[3 * 33] * g0[3]); o.y = pg8::pk4_fp8(s[4 * 33] * g1[0], s[5 * 33] * g1[1], s[6 * 33] * g1[2], s[7 * 33] * g1[3]); }
            *(u32x2*)(WT + (size_t)(n0 + n) * K + k0 + 8 * c) = o; }
        LDS_WAIT();
    }
}

struct Args { const void* in[28]; float* out; unsigned char* ws; int p_lo, p_hi; };
__device__ __forceinline__ const float* kin(const Args& a, int i) { asm volatile("" : "+s"(i)); return (const float*)a.in[i]; }

__device__ __forceinline__ void prep_layer(const Frame& F, const Args& in, unsigned char* ws, unsigned char* wmix, int L, int mask) {
    const int kind = L % 3, j = L / 3;
#pragma unroll 1
    for (int f = 0; f < 2; ++f) {
        if (!((mask >> f) & 1)) continue;
        const float* wgu = kin(in, 3) + (size_t)(L * 2 + f) * DM * 2 * DFF;
        const float* gpre = kin(in, 2) + (size_t)(L * 6 + (f ? 4 : 0)) * DM;
        if (3 * L + 2 * f >= G8_FROM) prep_matrix_q<true>(F, DM, 2 * DFF, ws + (f ? W_GU1 : W_GU0), [=](int k, int n) { const int pn = n >> 8, r = n & 255; const int sc = (r < 128) ? (pn * 128 + r) : (DFF + pn * 128 + (r - 128)); return wgu[(size_t)k * (2 * DFF) + sc]; }, WI_SCALE, gpre);
        else prep_matrix(F, DM, 2 * DFF, (bf16*)(ws + (f ? W_GU1 : W_GU0)), [=](int k, int n) { const int pn = n >> 8, r = n & 255; const int sc = (r < 128) ? (pn * 128 + r) : (DFF + pn * 128 + (r - 128)); return wgu[(size_t)k * (2 * DFF) + sc]; }, gpre);
        const float* wdn = kin(in, 4) + (size_t)(L * 2 + f) * DFF * DM;
        if (3 * L + 2 * f >= F8_FROM) prep_matrix_q<false>(F, DFF, DM, ws + (f ? W_DN1 : W_DN0), [=](int k, int n) { return wdn[(size_t)k * DM + n]; }, W8_SCALE);
        else prep_matrix(F, DFF, DM, (bf16*)(ws + (f ? W_DN1 : W_DN0)), [=](int k, int n) { return wdn[(size_t)k * DM + n]; });
    }
    if (!(mask & 4)) return;
    if (kind == 0) {
        const float* win = kin(in, 5) + (size_t)j * DM * ML_IN;
        const float* g2 = kin(in, 2) + (size_t)(L * 6 + 2) * DM;
        if ((I8_MIX >> (3 * L + 1)) & 1u) prep_matrix_q<true>(F, DM, 3072, wmix, [=](int k, int n) { return win[(size_t)k * ML_IN + n]; }, WI_SCALE, g2);
        else prep_matrix(F, DM, 3072, (bf16*)(wmix), [=](int k, int n) { return win[(size_t)k * ML_IN + n]; }, g2);
        const float* wo = kin(in, 9) + (size_t)j * DM * DM;
        prep_matrix(F, DM, DM, (bf16*)(wmix + (size_t)3072 * 1024 * 2), [=](int k, int n) { return wo[(size_t)k * DM + n]; });
    } else if (kind == 1) {
        const float* mu = kin(in, 10) + (size_t)j * 6 * DM; const float* wrkv = kin(in, 11) + (size_t)j * 3 * DM * DM;
        const float* w1 = kin(in, 13) + (size_t)j * DM * 64; const float* a1 = kin(in, 16) + (size_t)j * DM * 64; const float* g1 = kin(in, 18) + (size_t)j * DM * 128;
        prep_matrix(F, DM, 3072, (bf16*)(wmix), [=](int k, int n) { return wrkv[((size_t)(n >> 10) * DM + k) * DM + (n & 1023)]; });
        prep_matrix(F, 2048, 256, (bf16*)(wmix + (size_t)3072 * 1024 * 2), [=](int k, int c) {
            const int kk = k & 1023; const bool hi = k >= 1024; float w; int mi;
            if (c < 64) { mi = 3; w = w1[kk * 64 + c]; } else if (c < 128) { mi = 4; w = a1[kk * 64 + (c - 64)]; } else { mi = 5; w = g1[kk * 128 + (c - 128)]; }
            const float m = mu[mi * DM + kk]; return w * (hi ? m : 1.0f - m); });
        const float* w2 = kin(in, 14) + (size_t)j * 64 * DM; const float* a2 = kin(in, 17) + (size_t)j * 64 * DM; const float* g2 = kin(in, 19) + (size_t)j * 128 * DM;
        prep_matrix(F, 256, 3072, (bf16*)(wmix + (size_t)3072 * 1024 * 2 + (size_t)256 * 2048 * 2), [=](int k, int n) {
            const int t = n >> 10, c = n & 1023;
            if (t == 0) return k < 64 ? w2[k * DM + c] : 0.f;
            if (t == 1) return (k >= 64 && k < 128) ? a2[(k - 64) * DM + c] : 0.f;
            return k >= 128 ? g2[(k - 128) * DM + c] : 0.f; });
        const float* wo = kin(in, 25) + (size_t)j * DM * DM;
        prep_matrix(F, DM, DM, (bf16*)(wmix + (size_t)3072 * 1024 * 2 + (size_t)256 * 2048 * 2 + (size_t)3072 * 256 * 2), [=](int k, int n) { return wo[(size_t)k * DM + n]; });
    } else {
        const float* win = kin(in, 26) + (size_t)j * DM * 6144;
        const float* g2 = kin(in, 2) + (size_t)(L * 6 + 2) * DM;
        if ((I8_MIX >> (3 * L + 1)) & 1u) prep_matrix_q<true>(F, DM, 6144, wmix, [=](int k, int n) { return win[(size_t)k * 6144 + n]; }, WI_SCALE, g2);
        else prep_matrix(F, DM, 6144, (bf16*)(wmix), [=](int k, int n) { return win[(size_t)k * 6144 + n]; }, g2);
        const float* wo = kin(in, 27) + (size_t)j * 2048 * DM;
        prep_matrix(F, 2048, DM, (bf16*)(wmix + (size_t)6144 * 1024 * 2), [=](int k, int n) { return wo[(size_t)k * DM + n]; });
    }
}

__device__ __forceinline__ void first_norm_phase(const Frame& F, const float* x0, bf16* xb, float* rho, unsigned char* x8) {
    PH_IDS;
    const int gw = F.vcu * NWAVES + w, NGW = F.G * NWAVES;
    for (int m0 = gw; m0 < M; m0 += 2 * NGW) {
        f32x4 v[2][4];
#pragma unroll
        for (int u = 0; u < 2; ++u)
#pragma unroll
            for (int j = 0; j < 4; ++j) v[u][j] = *(const f32x4*)(x0 + (size_t)(m0 + u * NGW) * DM + 4 * lane + 256 * j);
#pragma unroll
        for (int u = 0; u < 2; ++u) {
            const int m = m0 + u * NGW; float s = 0.f;
#pragma unroll
            for (int j = 0; j < 4; ++j) s += (v[u][j][0] * v[u][j][0] + v[u][j][1] * v[u][j][1]) + (v[u][j][2] * v[u][j][2] + v[u][j][3] * v[u][j][3]);
            const float ms = wave_sum(s) * (1.0f / DM) + NORM_EPS, rs = __builtin_amdgcn_rsqf(ms);
            if (lane == 0) rho[m] = ms * rs;
#pragma unroll
            for (int j = 0; j < 4; ++j) { const f32x4 y = v[u][j] * rs; u32x2 o; o.x = cvt_pk_bf16(y[0], y[1]); o.y = cvt_pk_bf16(y[2], y[3]); *(u32x2*)(xb + (size_t)m * DM + 4 * lane + 256 * j) = o;
                if (x8) *(unsigned*)(x8 + (size_t)m * DM + 4 * lane + 256 * j) = pg8::pk4_i8(y[0] * X8_SCALE, y[1] * X8_SCALE, y[2] * X8_SCALE, y[3] * X8_SCALE); }
        }
    }
}

__device__ __forceinline__ void rw_mix_phase(const Frame& F, const bf16* xb, const float* gpre, const float* mu, bf16* ap, bf16* mixes) {
    PH_IDS;
    const int gw = F.vcu * NWAVES + w, NGW = F.G * NWAVES, rpw = M / NGW;
    f32x4 gq[4], mu0[4], mu1[4], mu2[4];
#pragma unroll
    for (int j = 0; j < 4; ++j) { const int o = 4 * lane + 256 * j; gq[j] = *(const f32x4*)(gpre + o); mu0[j] = *(const f32x4*)(mu + o); mu1[j] = *(const f32x4*)(mu + DM + o); mu2[j] = *(const f32x4*)(mu + 2 * DM + o); }
    f32x4 prev[4];
    auto ldrow = [&](int r, u32x2 (&dst)[4]) {
        const int m = gw * rpw + r;
        if (r < rpw && m >= 0) {
#pragma unroll
            for (int j = 0; j < 4; ++j) dst[j] = *(const u32x2*)(xb + (size_t)m * DM + 4 * lane + 256 * j);
        } else {
#pragma unroll
            for (int j = 0; j < 4; ++j) dst[j] = (u32x2){0u, 0u};
        }
    };
    u32x2 cu[4];
    ldrow(-1, cu);
    for (int r = -1; r < rpw; ++r) {
        const int m = gw * rpw + r, t = m & (SEQ - 1);
        u32x2 nx[4]; ldrow(r + 1, nx);
        f32x4 y[4];
#pragma unroll
        for (int j = 0; j < 4; ++j) { const u32x2 a = cu[j]; y[j] = (f32x4){bf_lo(a.x), bf_hi(a.x), bf_lo(a.y), bf_hi(a.y)} * gq[j]; cu[j] = nx[j]; }
        if (r < 0 && t == SEQ - 1) {
#pragma unroll
            for (int j = 0; j < 4; ++j) prev[j] = (f32x4){0.f, 0.f, 0.f, 0.f};
            continue;
        }
        if (r >= 0) {
#pragma unroll
            for (int j = 0; j < 4; ++j) {
                const int o = 4 * lane + 256 * j;
                const f32x4 d = prev[j] - y[j], m0v = y[j] + d * mu0[j], m1v = y[j] + d * mu1[j], m2v = y[j] + d * mu2[j];
                *(u32x2*)(ap + (size_t)m * 2048 + o) = (u32x2){cvt_pk_bf16(y[j][0], y[j][1]), cvt_pk_bf16(y[j][2], y[j][3])};
                *(u32x2*)(ap + (size_t)m * 2048 + 1024 + o) = (u32x2){cvt_pk_bf16(prev[j][0], prev[j][1]), cvt_pk_bf16(prev[j][2], prev[j][3])};
                *(u32x2*)(mixes + (size_t)m * DM + o) = (u32x2){cvt_pk_bf16(m0v[0], m0v[1]), cvt_pk_bf16(m0v[2], m0v[3])};
                *(u32x2*)(mixes + ((size_t)M + m) * DM + o) = (u32x2){cvt_pk_bf16(m1v[0], m1v[1]), cvt_pk_bf16(m1v[2], m1v[3])};
                *(u32x2*)(mixes + ((size_t)2 * M + m) * DM + o) = (u32x2){cvt_pk_bf16(m2v[0], m2v[1]), cvt_pk_bf16(m2v[2], m2v[3])};
            }
        }
        if (t == SEQ - 1) {
#pragma unroll
            for (int j = 0; j < 4; ++j) prev[j] = (f32x4){0.f, 0.f, 0.f, 0.f};
        } else {
#pragma unroll
            for (int j = 0; j < 4; ++j) prev[j] = y[j];
        }
    }
}

__device__ __forceinline__ void ml_gate_phase(const Frame& F, const bf16* xn, const float* gpre, const float* w_in, const float* b_if, float* ifg) {
    PH_IDS;
    constexpr int WP = (1024 + 8) * 2;
    LAS unsigned char* lds = F.lds;
    for (int k = tid; k < 1024; k += 512) {
        const f32x4 a = *(const f32x4*)(w_in + (size_t)k * ML_IN + 3072), b = *(const f32x4*)(w_in + (size_t)k * ML_IN + 3076); const float gk = gpre[k];
#pragma unroll
        for (int n = 0; n < 4; ++n) { *(LAS unsigned short*)(lds + n * WP + k * 2) = (unsigned short)(cvt_pk_bf16(a[n] * gk, 0.f) & 0xffffu); *(LAS unsigned short*)(lds + (4 + n) * WP + k * 2) = (unsigned short)(cvt_pk_bf16(b[n] * gk, 0.f) & 0xffffu); }
#pragma unroll
        for (int n = 8; n < 16; ++n) *(LAS unsigned short*)(lds + n * WP + k * 2) = 0;
    }
    WG_BAR();
    const int gw = F.vcu * NWAVES + w, NGW = F.G * NWAVES, fr = lane & 15, fq = lane >> 4;
    const f32x4 bias = (fq < 2) ? *(const f32x4*)(b_if + 4 * fq) : (f32x4){0.f, 0.f, 0.f, 0.f};
    for (int g = gw; g < M / 16; g += NGW) {
        const char* rowp = (const char*)xn + ((size_t)(16 * g + fr) * DM + 8 * fq) * 2;
        f32x4 acc = {0.f, 0.f, 0.f, 0.f};
#pragma unroll
        for (int h = 0; h < 2; ++h) {
            u32x4 av[16];
#pragma unroll
            for (int kk = 0; kk < 16; ++kk) av[kk] = *(const u32x4*)(rowp + (size_t)(16 * h + kk) * 64);
#pragma unroll
            for (int kk = 0; kk < 16; ++kk) { const bf16x8 bw = *(const LAS bf16x8*)(lds + fr * WP + (32 * (16 * h + kk) + 8 * fq) * 2); acc = mma16(bw, __builtin_bit_cast(bf16x8, av[kk]), acc); }
        }
        if (fq < 2) {
            f32x4 o;
#pragma unroll
            for (int e = 0; e < 4; ++e) { float val = acc[e] + bias[e]; val = 15.0f * ftanh(val * (1.0f / 15.0f)); o[e] = (fq == 1) ? -0.6931471805599453f * __builtin_amdgcn_logf(1.0f + fexp(-val)) : val; }
            *(f32x4*)(ifg + (size_t)(16 * g + fr) * 8 + 4 * fq) = o;
        }
    }
    WG_BAR_L();
}

__device__ __forceinline__ void ml_conv_phase(const Frame& F, const bf16* proj, const float* conv_w, bf16* qka) {
    PH_IDS;
    const int gw = F.vcu * NWAVES + w, NGW = F.G * NWAVES, rpw = M / NGW;
    f32x4 cw[4][4];
#pragma unroll
    for (int k = 0; k < 4; ++k)
#pragma unroll
        for (int j = 0; j < 4; ++j) cw[k][j] = *(const f32x4*)(conv_w + k * 1024 + 4 * lane + 256 * j);
    u32x2 hist[3][4];
    auto ldrow = [&](int r, u32x2 (&dst)[4]) {
        const int m = gw * rpw + r;
        const bool valid = (r < rpw) && !(r < 0 && ((gw * rpw) & (SEQ - 1)) == 0);
        if (valid) {
#pragma unroll
            for (int j = 0; j < 4; ++j) dst[j] = *(const u32x2*)(proj + (size_t)m * 3072 + 4 * lane + 256 * j);
        } else {
#pragma unroll
            for (int j = 0; j < 4; ++j) dst[j] = (u32x2){0u, 0u};
        }
    };
    u32x2 pre0[4], pre1[4];
    ldrow(-3, pre0); ldrow(-2, pre1);
    for (int r = -3; r < rpw; ++r) {
        const int m = gw * rpw + r;
        u32x2 cur[4], nx[4];
        ldrow(r + 2, nx);
#pragma unroll
        for (int j = 0; j < 4; ++j) { cur[j] = pre0[j]; pre0[j] = pre1[j]; pre1[j] = nx[j]; }
        if (r >= 0) {
#pragma unroll
            for (int j = 0; j < 4; ++j) {
                f32x4 a = cw[3][j] * (f32x4){bf_lo(cur[j].x), bf_hi(cur[j].x), bf_lo(cur[j].y), bf_hi(cur[j].y)};
                a += cw[2][j] * (f32x4){bf_lo(hist[2][j].x), bf_hi(hist[2][j].x), bf_lo(hist[2][j].y), bf_hi(hist[2][j].y)};
                a += cw[1][j] * (f32x4){bf_lo(hist[1][j].x), bf_hi(hist[1][j].x), bf_lo(hist[1][j].y), bf_hi(hist[1][j].y)};
                a += cw[0][j] * (f32x4){bf_lo(hist[0][j].x), bf_hi(hist[0][j].x), bf_lo(hist[0][j].y), bf_hi(hist[0][j].y)};
                const float sc = j < 2 ? 0.08838834764831845f : 1.0f;
                *(u32x2*)(qka + (size_t)m * DM + 4 * lane + 256 * j) = (u32x2){cvt_pk_bf16(fsilu(a[0]) * sc, fsilu(a[1]) * sc), cvt_pk_bf16(fsilu(a[2]) * sc, fsilu(a[3]) * sc)};
            }
        }
#pragma unroll
        for (int j = 0; j < 4; ++j) { hist[0][j] = hist[1][j]; hist[1][j] = hist[2][j]; hist[2][j] = cur[j]; }
    }
}

__device__ __forceinline__ void ml_chunk_phase(const Frame& F, const bf16* proj, const bf16* qka, const float* ifg, bf16* hb) {
    constexpr int QP = 272, SP = 144;
    constexpr int QS = 0, KS = QS + 64 * QP, KWT = KS + 64 * QP, VT = KWT + 128 * SP, PS = VT + 80 * SP, CT = PS + 64 * SP, TAB = CT + 80 * QP;
    static_assert(TAB + 1024 <= RING_BYTES, "ml lds");
    LAS unsigned char* lds = F.lds;
    LAS float* tU = (LAS float*)(lds + TAB); LAS float* tM = tU + 64; LAS float* tB = tU + 128; LAS float* tD = tU + 192;
    PH_IDS;
    const int fr = lane & 15, fq = lane >> 4;
    for (int item = F.vcu; item < NB * 16; item += F.G) {
        const int b = item >> 4, hh = (item >> 2) & 3, vs = item & 3;
        const size_t rowb = (size_t)b * SEQ;
        for (int i = tid; i < 16 * 36; i += 512) { const int r = i / 36, cidx = i % 36; ((LAS unsigned*)(lds + VT + (64 + r) * SP))[cidx] = (r == 0) ? 0x3f803f80u : 0u; }
        const int which = tid >> 8, tq = (tid >> 4) & 15, c8 = tid & 15;
        const int ch = which * 512 + hh * 128 + c8 * 8;
        const int tqv = tid >> 5, vp = tid & 31;
        const int vcol = 1024 + hh * 256 + vs * 64 + 2 * vp;
        f32x4 C[5];
#pragma unroll
        for (int jj = 0; jj < 5; ++jj) C[jj] = (f32x4){0.f, 0.f, 0.f, 0.f};
        float mst = 0.f;
        struct Pre { u32x4 rq[4]; unsigned rv[4]; float gi, gf; };
        const unsigned loQ = (unsigned)((4 * tq) * DM + ch) * 2u, loV = (unsigned)((4 * tqv) * 3072 + vcol) * 2u;
        auto prefetch = [&](int c, Pre& p) {
            const char* bq = (const char*)qka + (rowb + 64 * c) * (size_t)(DM * 2);
            const char* base = (const char*)proj + (rowb + 64 * c) * (size_t)(3072 * 2);
#pragma unroll
            for (int r = 0; r < 4; ++r) { p.rq[r] = *(const u32x4*)(bq + (size_t)r * (DM * 2) + loQ); p.rv[r] = *(const unsigned*)(base + (size_t)r * (3072 * 2) + loV); }
            const float* gb = ifg + (rowb + 64 * c) * 8 + hh;
            p.gi = gb[lane * 8]; p.gf = gb[lane * 8 + 4];
        };
        Pre pa, pb;
        prefetch(0, pa); prefetch(1, pb);
        auto step = [&](int c, Pre& p) {
            const float gi = p.gi, gf = p.gf;
            const float bsum = scan_sum64(gf);
            const float uu = gi - bsum;
            const float Mx = fmaxf(mst, scan_max64(uu));
            const float M63 = lane63(Mx), b63 = lane63(bsum);
            if (w == 0) { tU[lane] = uu; tM[lane] = Mx; tB[lane] = bsum; }
#pragma unroll
            for (int jj = 0; jj < 5; ++jj) { u32x2 o; o.x = cvt_pk_bf16(C[jj][0], C[jj][1]); o.y = cvt_pk_bf16(C[jj][2], C[jj][3]);
                *(LAS u32x2*)(lds + CT + (16 * jj + fr) * QP + (16 * w + 4 * fq) * 2) = o; }
            WG_BAR_L();
            {
                float kws[4];
#pragma unroll
                for (int tt = 0; tt < 4; ++tt) kws[tt] = fexp(tU[4 * tq + tt] - M63);
#pragma unroll
                for (int tt = 0; tt < 4; ++tt) *(LAS u32x4*)(lds + (which ? KS : QS) + (4 * tq + tt) * QP + c8 * 16) = p.rq[tt];
                if (which) {
#pragma unroll
                    for (int e2 = 0; e2 < 4; ++e2) {
                        u32x2 lo, hi;
                        lo.x = cvt_pk_bf16(bf_lo(p.rq[0][e2]) * kws[0], bf_lo(p.rq[1][e2]) * kws[1]); lo.y = cvt_pk_bf16(bf_lo(p.rq[2][e2]) * kws[2], bf_lo(p.rq[3][e2]) * kws[3]);
                        hi.x = cvt_pk_bf16(bf_hi(p.rq[0][e2]) * kws[0], bf_hi(p.rq[1][e2]) * kws[1]); hi.y = cvt_pk_bf16(bf_hi(p.rq[2][e2]) * kws[2], bf_hi(p.rq[3][e2]) * kws[3]);
                        *(LAS u32x2*)(lds + KWT + (c8 * 8 + 2 * e2) * SP + (4 * tq) * 2) = lo; *(LAS u32x2*)(lds + KWT + (c8 * 8 + 2 * e2 + 1) * SP + (4 * tq) * 2) = hi;
                    }
                }
                u32x2 v0, v1;
                v0.x = (p.rv[0] & 0xffffu) | (p.rv[1] << 16); v0.y = (p.rv[2] & 0xffffu) | (p.rv[3] << 16);
                v1.x = (p.rv[0] >> 16) | (p.rv[1] & 0xffff0000u); v1.y = (p.rv[2] >> 16) | (p.rv[3] & 0xffff0000u);
                *(LAS u32x2*)(lds + VT + (2 * vp) * SP + (4 * tqv) * 2) = v0; *(LAS u32x2*)(lds + VT + (2 * vp + 1) * SP + (4 * tqv) * 2) = v1;
            }
            WG_BAR_L();
            if (c + 2 < SEQ / 64) prefetch(c + 2, p);
            {
                const int tt = w >> 1, st0 = 2 * (w & 1);
                f32x4 s0 = {0.f, 0.f, 0.f, 0.f}, s1 = {0.f, 0.f, 0.f, 0.f};
#pragma unroll
                for (int kk = 0; kk < 4; ++kk) {
                    const bf16x8 yq = *(const LAS bf16x8*)(lds + QS + (16 * tt + fr) * QP + (32 * kk + 8 * fq) * 2);
                    const bf16x8 x0 = *(const LAS bf16x8*)(lds + KS + (16 * st0 + fr) * QP + (32 * kk + 8 * fq) * 2);
                    const bf16x8 x1 = *(const LAS bf16x8*)(lds + KS + (16 * (st0 + 1) + fr) * QP + (32 * kk + 8 * fq) * 2);
                    s0 = mma16(x0, yq, s0); s1 = mma16(x1, yq, s1);
                }
                const int t = 16 * tt + fr; const float Mt = tM[t];
#pragma unroll
                for (int q = 0; q < 2; ++q) { const f32x4 sv = q ? s1 : s0; const int sb = 16 * (st0 + q) + 4 * fq; const f32x4 u4 = *(const LAS f32x4*)(tU + sb);
                    float p[4];
#pragma unroll
                    for (int e = 0; e < 4; ++e) p[e] = (sb + e <= t) ? sv[e] * fexp(u4[e] - Mt) : 0.f;
                    u32x2 pk; pk.x = cvt_pk_bf16(p[0], p[1]); pk.y = cvt_pk_bf16(p[2], p[3]);
                    *(LAS u32x2*)(lds + PS + t * SP + sb * 2) = pk; }
            }
            WG_BAR_L();
            {
                const int tt = w & 3, jb = (w < 4) ? 0 : 3, nj = (w < 4) ? 3 : 2;
                f32x4 a1[3], a2[3];
#pragma unroll
                for (int jj = 0; jj < 3; ++jj) { a1[jj] = (f32x4){0.f, 0.f, 0.f, 0.f}; a2[jj] = (f32x4){0.f, 0.f, 0.f, 0.f}; }
#pragma unroll
                for (int kk = 0; kk < 2; ++kk) { const bf16x8 yp = *(const LAS bf16x8*)(lds + PS + (16 * tt + fr) * SP + (32 * kk + 8 * fq) * 2);
#pragma unroll
                    for (int jj = 0; jj < 3; ++jj) if (jj < nj) { const bf16x8 xv = *(const LAS bf16x8*)(lds + VT + (16 * (jb + jj) + fr) * SP + (32 * kk + 8 * fq) * 2); a1[jj] = mma16(xv, yp, a1[jj]); } }
#pragma unroll
                for (int kk = 0; kk < 4; ++kk) { const bf16x8 yq = *(const LAS bf16x8*)(lds + QS + (16 * tt + fr) * QP + (32 * kk + 8 * fq) * 2);
#pragma unroll
                    for (int jj = 0; jj < 3; ++jj) if (jj < nj) { const bf16x8 xc = *(const LAS bf16x8*)(lds + CT + (16 * (jb + jj) + fr) * QP + (32 * kk + 8 * fq) * 2); a2[jj] = mma16(xc, yq, a2[jj]); } }
                const int t = 16 * tt + fr; const float Mt = tM[t], bt = tB[t]; const float inter = fexp(mst - Mt);
#pragma unroll
                for (int jj = 0; jj < 3; ++jj) a1[jj] = a1[jj] + a2[jj] * inter;
                if (w >= 4 && fq == 0) tD[t] = a1[1][0];
                WG_BAR_L();
                const float dn = fmaxf(fabsf(tD[t]), fexp(-(bt + Mt))); const float rdn = 1.0f / dn;
#pragma unroll
                for (int jj = 0; jj < 3; ++jj) if (jj < nj && jb + jj < 4) { u32x2 pk; pk.x = cvt_pk_bf16(a1[jj][0] * rdn, a1[jj][1] * rdn); pk.y = cvt_pk_bf16(a1[jj][2] * rdn, a1[jj][3] * rdn);
                    *(u32x2*)((char*)(hb + (rowb + 64 * c + 16 * tt) * DM + hh * 256 + vs * 64 + 16 * (jb + jj)) + (unsigned)(fr * DM + 4 * fq) * 2u) = pk; }
            }
            if (PROBE_DUP == 38) { WG_BAR_L(); WG_BAR_L(); WG_BAR_L(); WG_BAR_L(); }
            {
                const float decay = fexp(mst - M63);
#pragma unroll
                for (int jj = 0; jj < 5; ++jj) C[jj] = C[jj] * decay;
#pragma unroll
                for (int kk = 0; kk < 2; ++kk) { const bf16x8 xk = *(const LAS bf16x8*)(lds + KWT + (16 * w + fr) * SP + (32 * kk + 8 * fq) * 2);
#pragma unroll
                    for (int jj = 0; jj < 5; ++jj) { const bf16x8 yv = *(const LAS bf16x8*)(lds + VT + (16 * jj + fr) * SP + (32 * kk + 8 * fq) * 2); C[jj] = mma16(xk, yv, C[jj]); } }
                mst = b63 + M63;
            }
            WG_BAR_L();
        };
#pragma unroll 1
        for (int c = 0; c < SEQ / 64; c += 2) { step(c, pa); step(c + 1, pb); }
    }
}

__device__ __forceinline__ void ml_head_phase(const Frame& F, const bf16* hb, const bf16* proj, const float* ng, bf16* hg) {
    PH_IDS;
    const int gw = F.vcu * NWAVES + w, NGW = F.G * NWAVES;
    f32x4 g[4];
#pragma unroll
    for (int j = 0; j < 4; ++j) g[j] = *(const f32x4*)(ng + 4 * lane + 256 * j);
    for (int m0 = gw; m0 < M; m0 += 2 * NGW) {
        u32x2 rr[2][4], ro[2][4];
#pragma unroll
        for (int u = 0; u < 2; ++u)
#pragma unroll
            for (int j = 0; j < 4; ++j) { const int m = m0 + u * NGW; rr[u][j] = *(const u32x2*)(hb + (size_t)m * DM + 4 * lane + 256 * j); ro[u][j] = *(const u32x2*)(proj + (size_t)m * 3072 + 2048 + 4 * lane + 256 * j); }
#pragma unroll
        for (int u = 0; u < 2; ++u)
#pragma unroll
            for (int j = 0; j < 4; ++j) {
                const int m = m0 + u * NGW; const u32x2 r = rr[u][j], ro_ = ro[u][j];
                const f32x4 v = {bf_lo(r.x), bf_hi(r.x), bf_lo(r.y), bf_hi(r.y)}, o = {bf_lo(ro_.x), bf_hi(ro_.x), bf_lo(ro_.y), bf_hi(ro_.y)};
                const float s = wave_sum((v[0] * v[0] + v[1] * v[1]) + (v[2] * v[2] + v[3] * v[3]));
                const float rs = __builtin_amdgcn_rsqf(s * (1.0f / 256.0f) + NORM_EPS);
                u32x2 pk; pk.x = cvt_pk_bf16(v[0] * rs * g[j][0] * fsigmoid(o[0]), v[1] * rs * g[j][1] * fsigmoid(o[1])); pk.y = cvt_pk_bf16(v[2] * rs * g[j][2] * fsigmoid(o[2]), v[3] * rs * g[j][3] * fsigmoid(o[3]));
                *(u32x2*)(hg + (size_t)m * DM + 4 * lane + 256 * j) = pk;
            }
    }
}

__device__ __forceinline__ void rt_chunk_phase(const Frame& F, const bf16* proj, bf16* yb) {
    constexpr int QP = 528, SP = 144;
    constexpr int QS = 0, KS = QS + 64 * QP, KWT = KS + 64 * QP, VT = KWT + 256 * SP, PS = VT + 128 * SP, END = PS + 64 * SP;
    static_assert(END <= MISC_OFF, "rt lds");
    LAS unsigned char* lds = F.lds;
    PH_IDS;
    const int fr = lane & 15, fq = lane >> 4;
    for (int item = F.vcu; item < NB * 16; item += F.G) {
        const int b = item >> 4, hh = (item >> 2) & 3, vs = item & 3;
        const size_t rowb = (size_t)b * SEQ;
        const float lg = __builtin_log2f(1.0f - __builtin_amdgcn_exp2f(-5.0f - (float)hh));
        const int tq = tid >> 5, c8 = tid & 31;
        const int qcol = hh * 256, kcol = 1024 + hh * 256 + c8 * 8, vcol = 2048 + hh * 512 + vs * 128 + 4 * c8;
        f32x4 R[16];
#pragma unroll
        for (int i = 0; i < 16; ++i) R[i] = (f32x4){0.f, 0.f, 0.f, 0.f};
        u32x4 rq[4], rk[4]; u32x2 rv[4];
        const unsigned loQ = (unsigned)((tid >> 5) * 6144 + qcol + (tid & 31) * 8) * 2u, loK = (unsigned)((4 * tq) * 6144 + kcol) * 2u, loV = (unsigned)((4 * tq) * 6144 + vcol) * 2u;
        auto prefetch = [&](int c) {
            const char* base = (const char*)proj + (rowb + 64 * c) * (size_t)(6144 * 2);
#pragma unroll
            for (int i = 0; i < 4; ++i) rq[i] = *(const u32x4*)(base + (size_t)i * (16 * 6144 * 2) + loQ);
#pragma unroll
            for (int i = 0; i < 4; ++i) { rk[i] = *(const u32x4*)(base + (size_t)i * (6144 * 2) + loK); rv[i] = *(const u32x2*)(base + (size_t)i * (6144 * 2) + loV); }
        };
        prefetch(0);
        float kws[4];
#pragma unroll
        for (int i = 0; i < 4; ++i) kws[i] = __builtin_amdgcn_exp2f(lg * (float)(63 - (4 * tq + i)));
        const float cdecay = __builtin_amdgcn_exp2f(lg * 64.0f);
        for (int c = 0; c < SEQ / 64; ++c) {
#pragma unroll
            for (int i = 0; i < 4; ++i) { const int idx = tid + 512 * i; *(LAS u32x4*)(lds + QS + (idx >> 5) * QP + (idx & 31) * 16) = rq[i]; }
#pragma unroll
            for (int i = 0; i < 4; ++i) *(LAS u32x4*)(lds + KS + (4 * tq + i) * QP + c8 * 16) = rk[i];
#pragma unroll
            for (int e2 = 0; e2 < 4; ++e2) {
                u32x2 lo, hi;
                lo.x = cvt_pk_bf16(bf_lo(rk[0][e2]) * kws[0], bf_lo(rk[1][e2]) * kws[1]); lo.y = cvt_pk_bf16(bf_lo(rk[2][e2]) * kws[2], bf_lo(rk[3][e2]) * kws[3]);
                hi.x = cvt_pk_bf16(bf_hi(rk[0][e2]) * kws[0], bf_hi(rk[1][e2]) * kws[1]); hi.y = cvt_pk_bf16(bf_hi(rk[2][e2]) * kws[2], bf_hi(rk[3][e2]) * kws[3]);
                *(LAS u32x2*)(lds + KWT + (c8 * 8 + 2 * e2) * SP + (4 * tq) * 2) = lo; *(LAS u32x2*)(lds + KWT + (c8 * 8 + 2 * e2 + 1) * SP + (4 * tq) * 2) = hi;
            }
            {
                u32x2 v0, v1, v2, v3;
                v0.x = (rv[0].x & 0xffffu) | (rv[1].x << 16); v0.y = (rv[2].x & 0xffffu) | (rv[3].x << 16);
                v1.x = (rv[0].x >> 16) | (rv[1].x & 0xffff0000u); v1.y = (rv[2].x >> 16) | (rv[3].x & 0xffff0000u);
                v2.x = (rv[0].y & 0xffffu) | (rv[1].y << 16); v2.y = (rv[2].y & 0xffffu) | (rv[3].y << 16);
                v3.x = (rv[0].y >> 16) | (rv[1].y & 0xffff0000u); v3.y = (rv[2].y >> 16) | (rv[3].y & 0xffff0000u);
                LAS unsigned char* vb = lds + VT + (4 * c8) * SP + (4 * tq) * 2;
                *(LAS u32x2*)(vb) = v0; *(LAS u32x2*)(vb + SP) = v1; *(LAS u32x2*)(vb + 2 * SP) = v2; *(LAS u32x2*)(vb + 3 * SP) = v3;
            }
            if (c + 1 < SEQ / 64) prefetch(c + 1);
            WG_BAR_L();
            {
                const int tt = w >> 1, st0 = 2 * (w & 1);
                f32x4 s0 = {0.f, 0.f, 0.f, 0.f}, s1 = {0.f, 0.f, 0.f, 0.f};
#pragma unroll 8
                for (int kk = 0; kk < 8; ++kk) {
                    const bf16x8 yq = *(const LAS bf16x8*)(lds + QS + (16 * tt + fr) * QP + (32 * kk + 8 * fq) * 2);
                    const bf16x8 x0 = *(const LAS bf16x8*)(lds + KS + (16 * st0 + fr) * QP + (32 * kk + 8 * fq) * 2);
                    const bf16x8 x1 = *(const LAS bf16x8*)(lds + KS + (16 * (st0 + 1) + fr) * QP + (32 * kk + 8 * fq) * 2);
                    s0 = mma16(x0, yq, s0); s1 = mma16(x1, yq, s1);
                }
                const int t = 16 * tt + fr;
#pragma unroll
                for (int q = 0; q < 2; ++q) { const f32x4 sv = q ? s1 : s0; const int sb = 16 * (st0 + q) + 4 * fq;
                    float p[4];
#pragma unroll
                    for (int e = 0; e < 4; ++e) p[e] = (sb + e <= t) ? sv[e] * __builtin_amdgcn_exp2f(lg * (float)(t - sb - e)) : 0.f;
                    u32x2 pk; pk.x = cvt_pk_bf16(p[0], p[1]); pk.y = cvt_pk_bf16(p[2], p[3]);
                    *(LAS u32x2*)(lds + PS + t * SP + sb * 2) = pk; }
            }
            WG_BAR_L();
            u32x4 xr[8];
#pragma unroll
            for (int kk = 0; kk < 8; ++kk) { xr[kk].x = cvt_pk_bf16(R[2 * kk][0], R[2 * kk][1]); xr[kk].y = cvt_pk_bf16(R[2 * kk][2], R[2 * kk][3]); xr[kk].z = cvt_pk_bf16(R[2 * kk + 1][0], R[2 * kk + 1][1]); xr[kk].w = cvt_pk_bf16(R[2 * kk + 1][2], R[2 * kk + 1][3]); }
#pragma unroll 2
            for (int tt = 0; tt < 4; ++tt) {
                f32x4 aI = {0.f, 0.f, 0.f, 0.f}, aC = {0.f, 0.f, 0.f, 0.f};
#pragma unroll
                for (int kk = 0; kk < 2; ++kk) { const bf16x8 xv = *(const LAS bf16x8*)(lds + VT + (16 * w + fr) * SP + (32 * kk + 8 * fq) * 2);
                    const bf16x8 yp = *(const LAS bf16x8*)(lds + PS + (16 * tt + fr) * SP + (32 * kk + 8 * fq) * 2); aI = mma16(xv, yp, aI); }
#pragma unroll
                for (int kk = 0; kk < 8; ++kk) {
                    const u32x2 qa = *(const LAS u32x2*)(lds + QS + (16 * tt + fr) * QP + (32 * kk + 4 * fq) * 2), qb = *(const LAS u32x2*)(lds + QS + (16 * tt + fr) * QP + (32 * kk + 16 + 4 * fq) * 2);
                    const u32x4 yq = {qa.x, qa.y, qb.x, qb.y};
                    aC = mma16(__builtin_bit_cast(bf16x8, xr[kk]), __builtin_bit_cast(bf16x8, yq), aC);
                }
                const int t = 16 * tt + fr; const float qd = __builtin_amdgcn_exp2f(lg * (float)(t + 1)); const f32x4 val = aI + aC * qd;
                u32x2 pk; pk.x = cvt_pk_bf16(val[0], val[1]); pk.y = cvt_pk_bf16(val[2], val[3]);
                *(u32x2*)((char*)(yb + (rowb + 64 * c + 16 * tt) * 2048 + hh * 512 + vs * 128 + 16 * w) + (unsigned)(fr * 2048 + 4 * fq) * 2u) = pk;
            }
            {
                const bf16x8 yv0 = *(const LAS bf16x8*)(lds + VT + (16 * w + fr) * SP + (8 * fq) * 2), yv1 = *(const LAS bf16x8*)(lds + VT + (16 * w + fr) * SP + (32 + 8 * fq) * 2);
#pragma unroll
                for (int dt = 0; dt < 16; ++dt) {
                    const bf16x8 x0 = *(const LAS bf16x8*)(lds + KWT + (16 * dt + fr) * SP + (8 * fq) * 2), x1 = *(const LAS bf16x8*)(lds + KWT + (16 * dt + fr) * SP + (32 + 8 * fq) * 2);
                    R[dt] = R[dt] * cdecay; R[dt] = mma16(x0, yv0, R[dt]); R[dt] = mma16(x1, yv1, R[dt]);
                    if ((dt & 3) == 3) asm volatile("" ::: "memory");
                }
            }
            WG_BAR_L();
        }
    }
}

__device__ __forceinline__ void rt_head_phase(const Frame& F, bf16* yb, const bf16* proj) {
    PH_IDS;
    const int gw = F.vcu * NWAVES + w, NGW = F.G * NWAVES;
    for (int m0 = gw; m0 < M; m0 += 2 * NGW) {
        u32x2 ry[2][8], rg[2][8];
#pragma unroll
        for (int u = 0; u < 2; ++u)
#pragma unroll
            for (int i = 0; i < 8; ++i) { const int m = m0 + u * NGW, col = i * 256 + 4 * lane; ry[u][i] = *(const u32x2*)(yb + (size_t)m * 2048 + col); rg[u][i] = *(const u32x2*)(proj + (size_t)m * 6144 + 4096 + col); }
#pragma unroll
        for (int u = 0; u < 2; ++u)
#pragma unroll
            for (int hd = 0; hd < 4; ++hd) {
                const int m = m0 + u * NGW;
                f32x4 v[2], g[2]; float s = 0.f;
#pragma unroll
                for (int q = 0; q < 2; ++q) { const u32x2 r = ry[u][2 * hd + q], rgq = rg[u][2 * hd + q];
                    v[q] = (f32x4){bf_lo(r.x), bf_hi(r.x), bf_lo(r.y), bf_hi(r.y)}; g[q] = (f32x4){bf_lo(rgq.x), bf_hi(rgq.x), bf_lo(rgq.y), bf_hi(rgq.y)};
                    s += (v[q][0] * v[q][0] + v[q][1] * v[q][1]) + (v[q][2] * v[q][2] + v[q][3] * v[q][3]); }
                const float rs = __builtin_amdgcn_rsqf(wave_sum(s) * (1.0f / 512.0f) + NORM_EPS);
#pragma unroll
                for (int q = 0; q < 2; ++q) { const int col = hd * 512 + q * 256 + 4 * lane;
                    u32x2 pk; pk.x = cvt_pk_bf16(fsilu(g[q][0]) * v[q][0] * rs, fsilu(g[q][1]) * v[q][1] * rs); pk.y = cvt_pk_bf16(fsilu(g[q][2]) * v[q][2] * rs, fsilu(g[q][3]) * v[q][3] * rs);
                    *(u32x2*)(yb + (size_t)m * 2048 + col) = pk; }
            }
    }
}

__device__ __forceinline__ float bf1(unsigned short u) { return __uint_as_float((unsigned)u << 16); }
__device__ __forceinline__ unsigned short f2bf1(float f) { return (unsigned short)(cvt_pk_bf16(f, 0.f) & 0xffffu); }
__device__ __forceinline__ void rw_scan_phase(const Frame& F, const bf16* rkv, const bf16* wag, const float* k_k, const float* k_a, const float* r_k, const float* ln_g, const float* ln_b, bf16* yout) {
    constexpr int TB = 64, NBT = SEQ / TB;
    constexpr int PLW = 0, PK = 8192, PA = 16384, PB = 24576, PR = 32768, PVG = 40960  , PVGSZ = 16640, IMG = PVG + 2 * PVGSZ;
    constexpr int I_AH = 0, I_RT = 2048, I_BT = 4096, I_KT = 6144, I_VT = 8192, I_NKH = 10240, I_NBR = 10752, I_NKR = 11264, I_GL = 11776, IMGSZ = 12032;
    constexpr int YB = IMG + 4 * IMGSZ;
    constexpr int CST = YB + 4 * 4096;
    static_assert(CST + 5 * 256 <= MISC_OFF && (IMG % 16) == 0 && (IMGSZ % 16) == 0 && (PVGSZ % 16) == 0, "rw lds");
    LAS unsigned char* lds = F.lds;
    PH_IDS;
    const int fr = lane & 15, fq = lane >> 4;
    for (int item = F.vcu; item < NB * 16; item += F.G) {
        const int b = item >> 4, hh = item & 15;
        const size_t rowb = (size_t)b * SEQ;
        const int t4 = tid & 255, c4 = t4 & 15, chg = hh * 64 + 4 * c4;
        if (tid < 320) { const int a_ = tid >> 6, cc = tid & 63; const float* src = a_ == 0 ? k_k : (a_ == 1 ? k_a : (a_ == 2 ? r_k : (a_ == 3 ? ln_g : ln_b))); *(LAS float*)(lds + CST + tid * 4) = src[hh * 64 + cc]; }
        WG_BAR();
        f32x4 ST[4];
#pragma unroll
        for (int jt = 0; jt < 4; ++jt) ST[jt] = (f32x4){0.f, 0.f, 0.f, 0.f};
        u32x2 pr[4], pk[4], pv[4], pw[4], pa[4], pg[4];
        const unsigned lo0 = (unsigned)((t4 >> 4) * 3072 + chg) * 2u;
        auto prefetch = [&](int tb) {
            const char* br = (const char*)rkv + (rowb + (size_t)tb * TB) * (3072 * 2); const char* bw = (const char*)wag + (rowb + (size_t)tb * TB) * (3072 * 2);
#pragma unroll
            for (int q = 0; q < 4; ++q) { const char* brq = br + (size_t)q * (16 * 3072 * 2); const char* bwq = bw + (size_t)q * (16 * 3072 * 2);
                pr[q] = *(const u32x2*)(brq + lo0); pk[q] = *(const u32x2*)(brq + 2048 + lo0); pv[q] = *(const u32x2*)(brq + 4096 + lo0);
                pw[q] = *(const u32x2*)(bwq + lo0); pa[q] = *(const u32x2*)(bwq + 2048 + lo0); pg[q] = *(const u32x2*)(bwq + 4096 + lo0); }
        };
        auto p1 = [&](int tb) {
            LAS unsigned char* pvg = lds + PVG + (tb & 1) * PVGSZ;
            const f32x4 kk4 = *(const LAS f32x4*)(lds + CST + (4 * c4) * 4), ka4 = *(const LAS f32x4*)(lds + CST + (64 + 4 * c4) * 4), rk4 = *(const LAS f32x4*)(lds + CST + (128 + 4 * c4) * 4);
#pragma unroll
            for (int q = 0; q < 4; ++q) {
                const int tk = (t4 >> 4) + 16 * q;
                const f32x4 r = {bf_lo(pr[q].x), bf_hi(pr[q].x), bf_lo(pr[q].y), bf_hi(pr[q].y)}, k = {bf_lo(pk[q].x), bf_hi(pk[q].x), bf_lo(pk[q].y), bf_hi(pk[q].y)};
                const f32x4 av = {bf_lo(pa[q].x), bf_hi(pa[q].x), bf_lo(pa[q].y), bf_hi(pa[q].y)};
                const f32x4 kkv = k * kk4;
                const float ss = red16((kkv[0] * kkv[0] + kkv[1] * kkv[1]) + (kkv[2] * kkv[2] + kkv[3] * kkv[3]));
                const float inv = 1.0f / fmaxf(sqrtf(ss), 1e-12f);
                const f32x4 kkn = kkv * inv, kp = k * (1.0f + (av - 1.0f) * ka4), rkp = r * kp * rk4, bb = kkn * av;
                const float bd = red16((rkp[0] + rkp[1]) + (rkp[2] + rkp[3]));
                const int o = (tk * 64 + 4 * c4) * 2;
                *(LAS u32x2*)(lds + PLW + o) = pw[q]; *(LAS u32x2*)(lds + PR + o) = pr[q]; *(LAS u32x2*)(pvg + o) = pv[q]; *(LAS u32x2*)(pvg + 8192 + o) = pg[q];
                *(LAS u32x2*)(lds + PK + o) = (u32x2){cvt_pk_bf16(kp[0], kp[1]), cvt_pk_bf16(kp[2], kp[3])};
                *(LAS u32x2*)(lds + PA + o) = (u32x2){cvt_pk_bf16(-kkn[0], -kkn[1]), cvt_pk_bf16(-kkn[2], -kkn[3])};
                *(LAS u32x2*)(lds + PB + o) = (u32x2){cvt_pk_bf16(bb[0], bb[1]), cvt_pk_bf16(bb[2], bb[3])};
                if (c4 == 0) *(LAS float*)(pvg + 16384 + tk * 4) = bd;
            }
        };
        auto epilogue = [&](int tb) {
            const LAS unsigned char* pvg = lds + PVG + (tb & 1) * PVGSZ;
            const f32x4 lg4 = *(const LAS f32x4*)(lds + CST + (192 + 4 * c4) * 4), lb4 = *(const LAS f32x4*)(lds + CST + (256 + 4 * c4) * 4);
#pragma unroll
            for (int q = 0; q < 4; ++q) {
                const int tk = (t4 >> 4) + 16 * q, o = (tk * 64 + 4 * c4) * 2;
                const f32x4 y = *(const LAS f32x4*)(lds + YB + (tk >> 4) * 4096 + ((tk & 15) * 64 + 4 * c4) * 4);
                const u32x2 vb = *(const LAS u32x2*)(pvg + o), gb = *(const LAS u32x2*)(pvg + 8192 + o);
                const f32x4 v = {bf_lo(vb.x), bf_hi(vb.x), bf_lo(vb.y), bf_hi(vb.y)}, g = {bf_lo(gb.x), bf_hi(gb.x), bf_lo(gb.y), bf_hi(gb.y)};
                const float bd = *(const LAS float*)(pvg + 16384 + tk * 4);
                const float mean = red16((y[0] + y[1]) + (y[2] + y[3])) * (1.0f / 64.0f);
                const f32x4 d = y - mean;
                const float var = red16((d[0] * d[0] + d[1] * d[1]) + (d[2] * d[2] + d[3] * d[3])) * (1.0f / 64.0f);
                const float rs = __builtin_amdgcn_rsqf(var + 64e-5f);
                const f32x4 outv = ((d * rs) * lg4 + lb4 + v * bd) * g;
                *(u32x2*)((char*)yout + ((rowb + (size_t)tb * TB + tk) * DM + chg) * 2) = (u32x2){cvt_pk_bf16(outv[0], outv[1]), cvt_pk_bf16(outv[2], outv[3])};
            }
        };
        auto produce = [&](int tb, int c) {
            const int j = lane;
            LAS unsigned char* img = lds + IMG + c * IMGSZ;
            const LAS unsigned char* pvg = lds + PVG + (tb & 1) * PVGSZ;
            LAS unsigned char* nba = lds + PLW + c * 2048;
            float At[16]; unsigned Bp[8], Kp[8], Vp[8];
            float cum = 0.f, gprev = 1.0f;
#pragma unroll
            for (int t = 0; t < 16; ++t) {
                const int o = ((16 * c + t) * 64 + j) * 2;
                const float lwv = bf1(*(const LAS unsigned short*)(lds + PLW + o)), a = bf1(*(const LAS unsigned short*)(lds + PA + o)), bq = bf1(*(const LAS unsigned short*)(lds + PB + o));
                const float kq = bf1(*(const LAS unsigned short*)(lds + PK + o)), rq = bf1(*(const LAS unsigned short*)(lds + PR + o));
                const unsigned vq = *(const LAS unsigned short*)(pvg + o);
                cum += lwv;
                const float gcur = fexp(cum), ginv = fexp(-cum);
                At[t] = a * gprev;
                const unsigned short ab = f2bf1(At[t]), rb = f2bf1(rq * gcur), bt = f2bf1(bq * ginv), kt = f2bf1(kq * ginv);
                const int ot = (t * 64 + j) * 2;
                *(LAS unsigned short*)(img + I_AH + ot) = ab; *(LAS unsigned short*)(img + I_RT + ot) = rb;
                *(LAS unsigned short*)(lds + PB + o) = bt; *(LAS unsigned short*)(lds + PK + o) = kt;
                if (t & 1) { Bp[t >> 1] |= (unsigned)bt << 16; Kp[t >> 1] |= (unsigned)kt << 16; Vp[t >> 1] |= vq << 16; }
                else { Bp[t >> 1] = bt; Kp[t >> 1] = kt; Vp[t >> 1] = vq; }
                gprev = gcur;
            }
            *(LAS u32x4*)(img + I_BT + j * 32) = (u32x4){Bp[0], Bp[1], Bp[2], Bp[3]}; *(LAS u32x4*)(img + I_BT + j * 32 + 16) = (u32x4){Bp[4], Bp[5], Bp[6], Bp[7]};
            *(LAS u32x4*)(img + I_KT + j * 32) = (u32x4){Kp[0], Kp[1], Kp[2], Kp[3]}; *(LAS u32x4*)(img + I_KT + j * 32 + 16) = (u32x4){Kp[4], Kp[5], Kp[6], Kp[7]};
            *(LAS u32x4*)(img + I_VT + j * 32) = (u32x4){Vp[0], Vp[1], Vp[2], Vp[3]}; *(LAS u32x4*)(img + I_VT + j * 32 + 16) = (u32x4){Vp[4], Vp[5], Vp[6], Vp[7]};
            *(LAS float*)(img + I_GL + j * 4) = gprev;
            LDS_WAIT();
            {
                f32x4 n_ba = {0.f, 0.f, 0.f, 0.f}, n_br = n_ba, n_ka = n_ba, n_kr = n_ba;
#pragma unroll
                for (int m = 0; m < 2; ++m) { const int o = fr * 128 + (32 * m + 8 * fq) * 2;
                    const bf16x8 xb = *(const LAS bf16x8*)(lds + PB + c * 2048 + o), xk = *(const LAS bf16x8*)(lds + PK + c * 2048 + o), ya = *(const LAS bf16x8*)(img + I_AH + o), yr = *(const LAS bf16x8*)(img + I_RT + o);
                    n_ba = mma16(xb, ya, n_ba); n_br = mma16(xb, yr, n_br); n_ka = mma16(xk, ya, n_ka); n_kr = mma16(xk, yr, n_kr); }
#pragma unroll
                for (int e = 0; e < 4; ++e) { const int sidx = 4 * fq + e; if (!(sidx < fr)) { n_ba[e] = 0.f; n_ka[e] = 0.f; } if (!(sidx <= fr)) { n_br[e] = 0.f; n_kr[e] = 0.f; } }
                *(LAS f32x4*)(nba + (fr * 16 + 4 * fq) * 4) = n_ba; *(LAS f32x4*)(nba + 1024 + (fr * 16 + 4 * fq) * 4) = n_ka;
                *(LAS u32x2*)(img + I_NBR + (fr * 16 + 4 * fq) * 2) = (u32x2){cvt_pk_bf16(n_br[0], n_br[1]), cvt_pk_bf16(n_br[2], n_br[3])};
                *(LAS u32x2*)(img + I_NKR + (fr * 16 + 4 * fq) * 2) = (u32x2){cvt_pk_bf16(n_kr[0], n_kr[1]), cvt_pk_bf16(n_kr[2], n_kr[3])};
            }
            LDS_WAIT();
            {
                float H[16];
#pragma unroll
                for (int t = 0; t < 16; ++t) {
                    float h = At[t];
#pragma unroll
                    for (int s4 = 0; s4 < 4; ++s4) if (4 * s4 < t) { const f32x4 cf = *(const LAS f32x4*)(nba + (t * 16 + 4 * s4) * 4);
#pragma unroll
                        for (int e = 0; e < 4; ++e) if (4 * s4 + e < t) h += H[4 * s4 + e] * cf[e]; }
                    H[t] = h;
                }
                LDS_WAIT();
#pragma unroll
                for (int t = 0; t < 16; ++t) *(LAS unsigned short*)(img + I_AH + (t * 64 + j) * 2) = f2bf1(H[t]);
                asm volatile("" ::: "memory");
#pragma unroll
                for (int t = 0; t < 16; ++t) {
                    float g = *(const LAS float*)(nba + 1024 + (t * 16 + (lane & 15)) * 4);
#pragma unroll
                    for (int s4 = 0; s4 < 4; ++s4) if (4 * s4 < t) { const f32x4 cf = *(const LAS f32x4*)(nba + (t * 16 + 4 * s4) * 4);
#pragma unroll
                        for (int e = 0; e < 4; ++e) if (4 * s4 + e < t) g += H[4 * s4 + e] * cf[e]; }
                    H[t] = g;
                    if (lane < 16) *(LAS unsigned short*)(img + I_NKH + (t * 16 + lane) * 2) = f2bf1(g);
                }
            }
        };
        auto consume = [&]() {
            struct Ops { u32x2 ah[4], rt[4], bt[4], kt[4], vt, nk, nb, nr; f32x4 gl[4]; };
            auto load_ops = [&](int c, Ops& o) {
                const LAS unsigned char* img = lds + IMG + c * IMGSZ;
#pragma unroll
                for (int m = 0; m < 2; ++m) {
                    o.ah[2 * m] = *(const LAS u32x2*)(img + I_AH + fr * 128 + (32 * m + 4 * fq) * 2); o.ah[2 * m + 1] = *(const LAS u32x2*)(img + I_AH + fr * 128 + (32 * m + 16 + 4 * fq) * 2);
                    o.rt[2 * m] = *(const LAS u32x2*)(img + I_RT + fr * 128 + (32 * m + 4 * fq) * 2); o.rt[2 * m + 1] = *(const LAS u32x2*)(img + I_RT + fr * 128 + (32 * m + 16 + 4 * fq) * 2);
                }
                o.vt = *(const LAS u32x2*)(img + I_VT + (16 * w + fr) * 32 + (4 * fq) * 2); o.nk = *(const LAS u32x2*)(img + I_NKH + (fr * 16 + 4 * fq) * 2);
                o.nb = *(const LAS u32x2*)(img + I_NBR + (fr * 16 + 4 * fq) * 2); o.nr = *(const LAS u32x2*)(img + I_NKR + (fr * 16 + 4 * fq) * 2);
#pragma unroll
                for (int jt = 0; jt < 4; ++jt) { o.bt[jt] = *(const LAS u32x2*)(img + I_BT + (16 * jt + fr) * 32 + (4 * fq) * 2); o.kt[jt] = *(const LAS u32x2*)(img + I_KT + (16 * jt + fr) * 32 + (4 * fq) * 2);
                    o.gl[jt] = *(const LAS f32x4*)(img + I_GL + (16 * jt + 4 * fq) * 4); }
            };
#pragma unroll 1
            for (int c = 0; c < 4; ++c) {
                Ops cur; load_ops(c, cur);
                u32x4 sf[2];
#pragma unroll
                for (int m = 0; m < 2; ++m) { sf[m].x = cvt_pk_bf16(ST[2 * m][0], ST[2 * m][1]); sf[m].y = cvt_pk_bf16(ST[2 * m][2], ST[2 * m][3]); sf[m].z = cvt_pk_bf16(ST[2 * m + 1][0], ST[2 * m + 1][1]); sf[m].w = cvt_pk_bf16(ST[2 * m + 1][2], ST[2 * m + 1][3]); }
                f32x4 d1 = {0.f, 0.f, 0.f, 0.f}, d2 = {0.f, 0.f, 0.f, 0.f};
#pragma unroll
                for (int m = 0; m < 2; ++m) {
                    d1 = mma16(__builtin_bit_cast(bf16x8, (u32x4){cur.ah[2 * m].x, cur.ah[2 * m].y, cur.ah[2 * m + 1].x, cur.ah[2 * m + 1].y}), __builtin_bit_cast(bf16x8, sf[m]), d1);
                    d2 = mma16(__builtin_bit_cast(bf16x8, (u32x4){cur.rt[2 * m].x, cur.rt[2 * m].y, cur.rt[2 * m + 1].x, cur.rt[2 * m + 1].y}), __builtin_bit_cast(bf16x8, sf[m]), d2);
                }
                d1 = mma16(__builtin_bit_cast(bf16x8, (u32x4){cur.nk.x, cur.nk.y, 0u, 0u}), __builtin_bit_cast(bf16x8, (u32x4){cur.vt.x, cur.vt.y, 0u, 0u}), d1);
                const u32x4 ff = {cvt_pk_bf16(d1[0], d1[1]), cvt_pk_bf16(d1[2], d1[3]), cur.vt.x, cur.vt.y};
                d2 = mma16(__builtin_bit_cast(bf16x8, (u32x4){cur.nb.x, cur.nb.y, cur.nr.x, cur.nr.y}), __builtin_bit_cast(bf16x8, ff), d2);
#pragma unroll
                for (int e = 0; e < 4; ++e) *(LAS float*)(lds + YB + c * 4096 + ((4 * fq + e) * 64 + 16 * w + fr) * 4) = d2[e];
#pragma unroll
                for (int jt = 0; jt < 4; ++jt) {
                    ST[jt] = mma16(__builtin_bit_cast(bf16x8, (u32x4){cur.bt[jt].x, cur.bt[jt].y, cur.kt[jt].x, cur.kt[jt].y}), __builtin_bit_cast(bf16x8, ff), ST[jt]);
                    ST[jt] = ST[jt] * cur.gl[jt];
                }
            }
        };
        if (w >= 4) { prefetch(0); p1(0); }
        WG_BAR_L();
#pragma unroll 1
        for (int tb = 0; tb < NBT; ++tb) {
            if (w >= 4) { if (tb + 1 < NBT) prefetch(tb + 1); produce(tb, w - 4); }
            else if (tb > 0) epilogue(tb - 1);
            WG_BAR_L();
            if (w < 4) consume();
            else if (tb + 1 < NBT) p1(tb + 1);
            WG_BAR_L();
        }
        if (w < 4) epilogue(NBT - 1);
        WG_BAR_L();
    }
}

__device__ __forceinline__ void stage_gain(const Frame& F, const float* g, float hs) {
    PH_IDS;
    ((LAS float*)(F.lds + GAIN_OFF))[tid] = g[tid] * hs; ((LAS float*)(F.lds + GAIN_OFF))[tid + 512] = g[tid + 512] * hs;
    __syncthreads();
}

constexpr int N_PHASES = 36;

__global__ void __launch_bounds__(NWAVES * 64, 2) mk_fwd(Args args) {
    extern __shared__ __attribute__((aligned(16))) unsigned char lds_raw[];
    Frame F;
    F.lds = (LAS unsigned char*)lds_raw;
    __builtin_assume(blockIdx.x < 256u);
    F.G = 256; { const int bx = blockIdx.x; F.vcu = (bx & 7) * 32 + (bx >> 3); }
    volatile LAS unsigned* MISC = (volatile LAS unsigned*)(F.lds + MISC_OFF);
    for (int u = threadIdx.x; u < (LDS_BYTES - MISC_OFF) / 4; u += NWAVES * 64) ((LAS unsigned*)(F.lds + MISC_OFF))[u] = 0u;
    __syncthreads();
    unsigned char* ws = args.ws;
    unsigned* ctl = (unsigned*)(ws + WS_CTL);
    const int lo = args.p_lo, hi = args.p_hi;
    XcdBarrier bar; bar.bar = ctl + CW_BAR; bar.x = 0; bar.st = nullptr;
    if (hi - lo > 1) bar = xcd_barrier_post(ctl + CW_BAR, MISC + 8);
    const Args& in = args;
    bf16* xb = (bf16*)args.out;
    float* RHO = (float*)(ws + 57 * MiB);
    bf16* xb2 = (bf16*)(ws + WS_A + 256 * MiB);
    bf16* XN = (bf16*)(ws + WS_XN);
    unsigned char* walt = (unsigned char*)(xb + (size_t)M * DM);
    bf16* RA = (bf16*)(ws + WS_A); bf16* RB = (bf16*)(ws + WS_B);
    int p = 0;
#define PH_ON (p >= lo && p < hi)
#define PH_END do { if (p >= lo && p + 1 < hi) xcd_barrier(bar); ++p; } while (0)
#define PREP_AHEAD do { for (int rep_ = 0; rep_ < (PROBE_DUP == 4 ? 2 : 1); ++rep_) { if (L + 1 < DEPTH) prep_layer(F, in, ws, ((L + 1) & 1) ? walt : ws + W_MIX, L + 1, 5); if (L > 0) prep_layer(F, in, ws, nullptr, L, 2); } } while (0)
#define DUP(cat, ...) do { __VA_ARGS__; if (PROBE_DUP == (cat)) { xcd_barrier(bar); __VA_ARGS__; } } while (0)


    if (PH_ON) { prep_layer(F, in, ws, ws + W_MIX, 0, 7); if (PROBE_DUP == 4) prep_layer(F, in, ws, ws + W_MIX, 0, 7); first_norm_phase(F, kin(in, 0), xb, RHO, G8_FROM == 0 ? (unsigned char*)args.out + X8_OFF : nullptr);
    }
    PH_END;

#pragma unroll 1
    for (int s = 0; s < DEPTH * 3; ++s) {
        const int L = s / 3, sp = s % 3, kind = L % 3, jm = L / 3;
        const float* g6 = kin(in, 2) + (size_t)L * 6 * DM;
        const int x8m = (s + 1 < DEPTH * 3 && (((s + 1) % 3 != 1) ? (s + 1 >= G8_FROM) : (((I8_MIX >> (s + 1)) & 1u) != 0u))) ? 8 : 0;
        if (sp != 1) {
            const int f = sp >> 1;
            if (PH_ON) { pg8::Gemm g{(f == 1 && L == DEPTH - 1) ? xb2 : xb, (const bf16*)(ws + (f ? W_GU1 : W_GU0)), M, 2 * DFF, DM}; pg8::StaticOrder S; S.init(M, 2 * DFF, F.G, (int)(blockIdx.x & 255u));
                if (s >= G8_FROM) { pg8::Gemm g8{(const bf16*)((unsigned char*)args.out + X8_OFF), (const bf16*)(ws + (f ? W_GU1 : W_GU0)), M, 2 * DFF, DM / 2};
                    if (s >= F8_FROM) { pg8::EpiSwiglu8T<true> E{(unsigned char*)RA, DFF, H8_SCALE, 1.0f / (X8_SCALE * WI_SCALE)}; pg8::gemm_phase<pg8::EpiSwiglu8T<true>, pg8::StaticOrder, true, true, 2>(F.lds, g8, S, E); }
                    else { pg8::EpiSwigluT<true> E{RA, DFF, 1.0f / (X8_SCALE * WI_SCALE)}; pg8::gemm_phase<pg8::EpiSwigluT<true>, pg8::StaticOrder, true, true, 2>(F.lds, g8, S, E); } }
                else if (s >= F8_FROM) { pg8::EpiSwiglu8 E{(unsigned char*)RA, DFF, H8_SCALE, 1.0f}; pg8::gemm_phase<pg8::EpiSwiglu8, pg8::StaticOrder, true, true>(F.lds, g, S, E); }
                else { pg8::EpiSwiglu E{RA, DFF, 1.0f}; DUP(1, pg8::gemm_phase<pg8::EpiSwiglu, pg8::StaticOrder, true, true>(F.lds, g, S, E)); } }
            PH_END;
            const bool lastf = (f == 1 && L == DEPTH - 1);
            if (PH_ON) {
                if (s >= F8_FROM) { pg8::Gemm g{RA, (const bf16*)(ws + (f ? W_DN1 : W_DN0)), M, DM, DFF / 2}; pg8::StaticOrder S; S.init(M, DM, F.G, (int)(blockIdx.x & 255u));
                    stage_gain(F, g6 + (f ? 5 : 1) * DM, 1.0f / (H8_SCALE * W8_SCALE));
                    pg8::EpiNormRes<false> E{ws, args.out, F.lds, s, (lastf ? 5 : 0) | x8m, 1.0f / (H8_SCALE * W8_SCALE)};
                    pg8::gemm_phase<pg8::EpiNormRes<false>, pg8::StaticOrder, true, true, 1>(F.lds, g, S, E); }
                else { pg8::Gemm g{RA, (const bf16*)(ws + (f ? W_DN1 : W_DN0)), M, DM, DFF}; pg8::StaticOrder S; S.init(M, DM, F.G, (int)(blockIdx.x & 255u));
                    stage_gain(F, g6 + (f ? 5 : 1) * DM, 1.0f);
                    pg8::EpiNormRes<false> E{ws, args.out, F.lds, s, (lastf ? 5 : 0) | x8m, 1.0f};
                    pg8::gemm_phase<pg8::EpiNormRes<false>, pg8::StaticOrder, true, true>(F.lds, g, S, E); } }
            PH_END;
            if (f == 0) {
                if (kind == 1) { if (PH_ON) { rw_mix_phase(F, xb, g6 + 2 * DM, kin(in, 10) + (size_t)jm * 6 * DM, XN, RA + (size_t)M * 3072); PREP_AHEAD; } PH_END; }
            }
        } else {
            const bf16* WM = (const bf16*)((L & 1) ? walt : ws + W_MIX);
            const bf16* a_out; const bf16* w_out; int k_out;
            if (kind == 0) {
                if (PH_ON) { pg8::Gemm g{xb, WM, M, 3072, DM}; pg8::StaticOrder S; S.init(M, 3072, F.G, (int)(blockIdx.x & 255u));
                    if ((I8_MIX >> s) & 1u) { pg8::Gemm g8{(const bf16*)((unsigned char*)args.out + X8_OFF), WM, M, 3072, DM / 2};
                        pg8::EpiPlainI8 E{RA, 3072, 1.0f / (X8_SCALE * WI_SCALE)}; pg8::gemm_phase<pg8::EpiPlainI8, pg8::StaticOrder, true, true, 2>(F.lds, g8, S, E); }
                    else { pg8::EpiPlain E{RA, 3072}; DUP(5, pg8::gemm_phase<pg8::EpiPlain, pg8::StaticOrder, true, true>(F.lds, g, S, E)); }
                    DUP(15, ml_gate_phase(F, xb, g6 + 2 * DM, kin(in, 5) + (size_t)jm * DM * ML_IN, kin(in, 6) + jm * 8, (float*)(ws + WS_A + 192 * MiB))); }
                PH_END;
                if (PH_ON) { DUP(17, ml_conv_phase(F, RA, kin(in, 7) + (size_t)jm * 4 * DM, RB + (size_t)M * DM)); __syncthreads(); PREP_AHEAD; }
                PH_END;
                if (PH_ON) DUP(6, ml_chunk_phase(F, RA, RB + (size_t)M * DM, (const float*)(ws + WS_A + 192 * MiB), RB));
                PH_END;
                if (PH_ON) DUP(7, ml_head_phase(F, RB, RA, kin(in, 8) + (size_t)jm * DM, RB + (size_t)M * DM));
                PH_END;
                a_out = RB + (size_t)M * DM; w_out = WM + (size_t)3072 * 1024; k_out = DM;
            } else if (kind == 1) {
                bf16* lmid = RB; bf16* wag = RA + (size_t)M * 3072; bf16* yo = RB + (size_t)M * 256;
                if (PH_ON) { { pg8::Gemm g{RA + (size_t)M * 3072, WM, M, 3072, DM, 2, (size_t)M * DM * 2}; pg8::SplitOrder S; S.init(M, 3072, (int)(blockIdx.x & 255u));
                      pg8::EpiPlain E{RA, 3072}; pg8::gemm_phase<pg8::EpiPlain, pg8::SplitOrder, true, true>(F.lds, g, S, E); }
                    { pg8::Gemm g{XN, WM + (size_t)3072 * 1024, M, 256, 2048}; pg8::StaticOrder S; S.init(M, 256, F.G, (int)(blockIdx.x & 255u));
                      pg8::EpiLora E{lmid}; pg8::gemm_phase<pg8::EpiLora, pg8::StaticOrder, true, true>(F.lds, g, S, E); } }
                PH_END;
                if (PH_ON) { int k_rw2 = 256; asm volatile("" : "+s"(k_rw2));
                    pg8::Gemm g{lmid, WM + (size_t)3072 * 1024 + (size_t)256 * 2048, M, 3072, k_rw2}; pg8::StaticOrder S; S.init(M, 3072, F.G, (int)(blockIdx.x & 255u));
                    pg8::EpiRw2 E{wag, kin(in, 12) + (size_t)jm * DM, kin(in, 15) + (size_t)jm * DM}; DUP(10, pg8::gemm_phase<pg8::EpiRw2, pg8::StaticOrder, true, true>(F.lds, g, S, E)); }
                PH_END;
                if (PH_ON) DUP(11, rw_scan_phase(F, RA, wag, kin(in, 20) + (size_t)jm * DM, kin(in, 21) + (size_t)jm * DM, kin(in, 22) + (size_t)jm * DM, kin(in, 23) + (size_t)jm * DM, kin(in, 24) + (size_t)jm * DM, yo));
                PH_END;
                a_out = yo; w_out = WM + (size_t)3072 * 1024 + (size_t)256 * 2048 + (size_t)3072 * 256; k_out = DM;
            } else {
                if (PH_ON) { pg8::Gemm g{xb, WM, M, 6144, DM}; pg8::StaticOrder S; S.init(M, 6144, F.G, (int)(blockIdx.x & 255u));
                    if ((I8_MIX >> s) & 1u) { pg8::Gemm g8{(const bf16*)((unsigned char*)args.out + X8_OFF), WM, M, 6144, DM / 2};
                        pg8::EpiRtInT<true> E{RA, (const int*)kin(in, 1), 1.0f / (X8_SCALE * WI_SCALE)}; pg8::gemm_phase<pg8::EpiRtInT<true>, pg8::StaticOrder, true, true, 2>(F.lds, g8, S, E); }
                    else { pg8::EpiRtIn E{RA, (const int*)kin(in, 1), 1.0f}; DUP(12, pg8::gemm_phase<pg8::EpiRtIn, pg8::StaticOrder, true, true>(F.lds, g, S, E)); } }
                PH_END;
                if (PH_ON) DUP(13, rt_chunk_phase(F, RA, RB));
                PH_END;
                if (PH_ON) { rt_head_phase(F, RB, RA); __syncthreads(); PREP_AHEAD; }
                PH_END;
                a_out = RB; w_out = WM + (size_t)6144 * 1024; k_out = 2048;
            }
            if (PH_ON) { pg8::Gemm g{a_out, w_out, M, DM, k_out}; pg8::StaticOrder S; S.init(M, DM, F.G, (int)(blockIdx.x & 255u));
                stage_gain(F, g6 + 3 * DM, 1.0f);
                pg8::EpiNormRes<false> E{ws, args.out, F.lds, s, ((L == DEPTH - 1) ? 2 : 0) | x8m, 1.0f};
                pg8::gemm_phase<pg8::EpiNormRes<false>, pg8::StaticOrder, true, true>(F.lds, g, S, E); }
            PH_END;
        }
    }
#undef PH_ON
#undef PH_END
}

extern "C" void kernel_launch(void* const* d_in, const int* in_sizes, int n_in, void* d_out, int out_size, void* d_ws, size_t ws_size, hipStream_t stream) {
    static int grid = 0;
    if (grid == 0) {
        if (n_in != 28 || out_size != M * DM || ws_size < WS_END) { fprintf(stderr, "kernel_launch: unexpected shapes: n_in %d out %d ws %zu (need %zu)\n", n_in, out_size, ws_size, (size_t)WS_END); grid = -1; return; }
        int dev = 0, cus = 0, per_cu = 0;
        if (hipGetDevice(&dev) != hipSuccess || hipDeviceGetAttribute(&cus, hipDeviceAttributeMultiprocessorCount, dev) != hipSuccess) { grid = -1; return; }
        if (hipFuncSetAttribute((const void*)mk_fwd, hipFuncAttributeMaxDynamicSharedMemorySize, LDS_BYTES) != hipSuccess) { fprintf(stderr, "kernel_launch: hipFuncSetAttribute failed\n"); grid = -1; return; }
        if (hipOccupancyMaxActiveBlocksPerMultiprocessor(&per_cu, (const void*)mk_fwd, NWAVES * 64, LDS_BYTES) != hipSuccess || per_cu < 1) { fprintf(stderr, "kernel_launch: occupancy query says %d\n", per_cu); (void)hipGetLastError(); grid = -1; return; }
        if (cus < 256) { fprintf(stderr, "kernel_launch: %d CUs; this kernel needs 256 co-resident workgroups\n", cus); grid = -1; return; }
        grid = 256;
    }
    if (grid < 0) return;
    (void)hipMemsetAsync((char*)d_ws + WS_CTL, 0, CTL_ZERO_BYTES, stream);
    Args a{};
    for (int i = 0; i < 28; ++i) a.in[i] = d_in[i];
    a.out = (float*)d_out; a.ws = (unsigned char*)d_ws;
#if MK_PER_PHASE
    for (int p = 0; p < N_PHASES; ++p) { a.p_lo = p; a.p_hi = p + 1; hipLaunchKernelGGL(mk_fwd, dim3(grid), dim3(NWAVES * 64), LDS_BYTES, stream, a); }
#else
    a.p_lo = 0; a.p_hi = N_PHASES;
    hipLaunchKernelGGL(mk_fwd, dim3(grid), dim3(NWAVES * 64), LDS_BYTES, stream, a);
#endif
}
```

```cpp
#include <hip/hip_runtime.h>
#include <cstdio>
#include <cstdint>

#ifndef MK_PER_PHASE
#define MK_PER_PHASE 0
#endif
#ifndef PROBE_DUP
#define PROBE_DUP 0
#endif

#define LAS __attribute__((address_space(3)))
#define GAS __attribute__((address_space(1)))
typedef unsigned short bf16;
typedef short bf16x8 __attribute__((ext_vector_type(8)));
typedef float f32x4 __attribute__((ext_vector_type(4)));
typedef float f32x2 __attribute__((ext_vector_type(2)));
typedef unsigned u32x4 __attribute__((ext_vector_type(4)));
typedef unsigned u32x2 __attribute__((ext_vector_type(2)));

constexpr int DM = 1024, NB = 16, SEQ = 2048, DEPTH = 4, DFF = 2816;
constexpr int M = NB * SEQ;
constexpr float NORM_EPS = 1e-6f;
constexpr int ML_IN = 3080;
constexpr int NWAVES = 8;

constexpr size_t MiB = 1u << 20;
constexpr size_t WS_CTL = 0, CTL_ZERO_BYTES = 1 * MiB;
constexpr size_t WS_W = 1 * MiB;
constexpr size_t W_GU0 = WS_W, W_DN0 = W_GU0 + (size_t)5632 * 1024 * 2, W_GU1 = W_DN0 + (size_t)1024 * 2816 * 2, W_DN1 = W_GU1 + (size_t)5632 * 1024 * 2;
constexpr size_t W_MIX = W_DN1 + (size_t)1024 * 2816 * 2;
constexpr size_t WS_XN = 58 * MiB;
constexpr size_t WS_MO = WS_XN + 64 * MiB;
constexpr size_t WS_A = 186 * MiB;
constexpr size_t WS_B = 570 * MiB;
constexpr size_t WS_END = 698 * MiB;
static_assert(W_MIX + (size_t)17 * MiB <= WS_XN, "weight region");
constexpr int F8_FROM = 5;
constexpr int G8_FROM = 2;
constexpr float X8_SCALE = 32.0f, WI_SCALE = 1100.0f;
constexpr unsigned I8_MIX = (1u << 7) | (1u << 10);
constexpr size_t X8_OFF = (size_t)84 * MiB;
constexpr float H8_SCALE = 8.0f, W8_SCALE = 256.0f;
constexpr int CW_BAR = 4096;
constexpr size_t STATS_PER_PHASE = (size_t)128 * 4 * 3 * 256;
constexpr int CW_CNT = 8192;

constexpr int RING_BYTES = 131072;
constexpr int LDS_BYTES = 151552;
constexpr int MISC_OFF = 145408;
constexpr int GAIN_OFF = 147456;

typedef __bf16 bf16x2_t __attribute__((ext_vector_type(2)));
__device__ __forceinline__ unsigned cvt_pk_bf16(float lo, float hi) { const f32x2 v = {lo, hi}; return __builtin_bit_cast(unsigned, __builtin_convertvector(v, bf16x2_t)); }
__device__ __forceinline__ float bf_lo(unsigned u) { return __uint_as_float(u << 16); }
__device__ __forceinline__ float bf_hi(unsigned u) { return __uint_as_float(u & 0xffff0000u); }
__device__ __forceinline__ float fexp(float x) { return __builtin_amdgcn_exp2f(x * 1.4426950408889634f); }
__device__ __forceinline__ float fsigmoid(float x) { return __builtin_amdgcn_rcpf(1.0f + fexp(-x)); }
__device__ __forceinline__ float ftanh(float x) { return 2.0f * fsigmoid(2.0f * x) - 1.0f; }
__device__ __forceinline__ float fsilu(float x) { return x * fsigmoid(x); }
template <int CTRL, int ROWMASK> __device__ __forceinline__ float dppmov(float old, float v) {
    return __builtin_bit_cast(float, __builtin_amdgcn_update_dpp(__builtin_bit_cast(int, old), __builtin_bit_cast(int, v), CTRL, ROWMASK, 0xf, false));
}
__device__ __forceinline__ float red16(float v) {
    v += dppmov<0x128, 0xf>(0.f, v); v += dppmov<0x124, 0xf>(0.f, v); v += dppmov<0x122, 0xf>(0.f, v); v += dppmov<0x121, 0xf>(0.f, v); return v; }
__device__ __forceinline__ float wave_sum(float v) {
    v = red16(v);
    const float s0 = __builtin_bit_cast(float, __builtin_amdgcn_readlane(__builtin_bit_cast(int, v), 0)), s1 = __builtin_bit_cast(float, __builtin_amdgcn_readlane(__builtin_bit_cast(int, v), 16));
    const float s2 = __builtin_bit_cast(float, __builtin_amdgcn_readlane(__builtin_bit_cast(int, v), 32)), s3 = __builtin_bit_cast(float, __builtin_amdgcn_readlane(__builtin_bit_cast(int, v), 48));
    return (s0 + s1) + (s2 + s3);
}
__device__ __forceinline__ float scan_sum64(float v) {
    v += dppmov<0x111, 0xf>(0.f, v); v += dppmov<0x112, 0xf>(0.f, v); v += dppmov<0x114, 0xf>(0.f, v); v += dppmov<0x118, 0xf>(0.f, v);
    v += dppmov<0x142, 0xa>(0.f, v); v += dppmov<0x143, 0xc>(0.f, v); return v; }
__device__ __forceinline__ float scan_max64(float v) {
    const float ninf = -__builtin_inff();
    v = fmaxf(v, dppmov<0x111, 0xf>(ninf, v)); v = fmaxf(v, dppmov<0x112, 0xf>(ninf, v)); v = fmaxf(v, dppmov<0x114, 0xf>(ninf, v)); v = fmaxf(v, dppmov<0x118, 0xf>(ninf, v));
    v = fmaxf(v, dppmov<0x142, 0xa>(ninf, v)); v = fmaxf(v, dppmov<0x143, 0xc>(ninf, v)); return v; }
__device__ __forceinline__ float lane63(float v) { return __builtin_bit_cast(float, __builtin_amdgcn_readlane(__builtin_bit_cast(int, v), 63)); }
__device__ __forceinline__ f32x4 mma16(bf16x8 x, bf16x8 y, f32x4 c) { return __builtin_amdgcn_mfma_f32_16x16x32_bf16(x, y, c, 0, 0, 0); }
#define LDS_WAIT() asm volatile("s_waitcnt lgkmcnt(0)" ::: "memory")
#define WG_BAR() do { asm volatile("s_waitcnt vmcnt(0) lgkmcnt(0)" ::: "memory"); __builtin_amdgcn_s_barrier(); asm volatile("" ::: "memory"); } while (0)
#define WG_BAR_L() do { asm volatile("s_waitcnt lgkmcnt(0)" ::: "memory"); __builtin_amdgcn_s_barrier(); asm volatile("" ::: "memory"); } while (0)

namespace pg8 {
#define PG8_LAS __attribute__((address_space(3)))
typedef unsigned short bf16_t;
constexpr int BM = 256, BK = 64, HALF = 128, HTB = HALF * BK * 2, STAGE_BYTES = 8 * HTB, NXCD = 8, WGM = 8;
__host__ __device__ __forceinline__ int lds_byte(int r, int c) { const int st = (r >> 4) * 2 + (c >> 5), rr = r & 15, cc = c & 31, ob = rr * 64 + cc * 2; return st * 1024 + (ob ^ (((ob >> 9) & 1) << 5)); }
__host__ __device__ __forceinline__ void stage_rc(int b, int& R, int& C) { const int st = b / 1024, sb = b % 1024, swz = sb ^ (((sb >> 9) & 1) << 5); R = (st >> 1) * 16 + swz / 64; C = (st & 1) * 32 + (swz % 64) / 2; }
__host__ __device__ __forceinline__ int perm32(int rho) { const int n = rho >> 4, i = rho & 15; return 8 * (i >> 2) + 4 * n + (i & 3); }

typedef int i32x4 __attribute__((ext_vector_type(4)));
typedef int i32x8 __attribute__((ext_vector_type(8)));
__device__ __forceinline__ f32x4 mfma_f8(bf16x8 x0, bf16x8 x1, bf16x8 y0, bf16x8 y1, f32x4 c) {
    const i32x4 a0 = __builtin_bit_cast(i32x4, x0), a1 = __builtin_bit_cast(i32x4, x1), b0 = __builtin_bit_cast(i32x4, y0), b1 = __builtin_bit_cast(i32x4, y1);
    const i32x8 A = {a0.x, a0.y, a0.z, a0.w, a1.x, a1.y, a1.z, a1.w}, B = {b0.x, b0.y, b0.z, b0.w, b1.x, b1.y, b1.z, b1.w};
    asm volatile("v_mfma_f32_16x16x128_f8f6f4 %0, %1, %2, %0" : "+v"(c) : "v"(A), "v"(B));
    return c;
}
__device__ __forceinline__ unsigned pk4_fp8(float a, float b, float c, float d) {
    a = __builtin_fminf(__builtin_fmaxf(a, -448.f), 448.f); b = __builtin_fminf(__builtin_fmaxf(b, -448.f), 448.f); c = __builtin_fminf(__builtin_fmaxf(c, -448.f), 448.f); d = __builtin_fminf(__builtin_fmaxf(d, -448.f), 448.f);
    unsigned w = 0u; w = __builtin_amdgcn_cvt_pk_fp8_f32(a, b, w, false); w = __builtin_amdgcn_cvt_pk_fp8_f32(c, d, w, true); return w;
}

__device__ __forceinline__ f32x4 mfma_i8(bf16x8 x, bf16x8 y, f32x4 c) {
    return __builtin_bit_cast(f32x4, __builtin_amdgcn_mfma_i32_16x16x64_i8(__builtin_bit_cast(i32x4, x), __builtin_bit_cast(i32x4, y), __builtin_bit_cast(i32x4, c), 0, 0, 0));
}
__device__ __forceinline__ unsigned pk4_i8(float a, float b, float c, float d) {
    const float M_ = 12582912.0f;
    const unsigned ua = __float_as_uint(__builtin_fminf(__builtin_fmaxf(a, -127.f), 127.f) + M_), ub = __float_as_uint(__builtin_fminf(__builtin_fmaxf(b, -127.f), 127.f) + M_);
    const unsigned uc = __float_as_uint(__builtin_fminf(__builtin_fmaxf(c, -127.f), 127.f) + M_), ud = __float_as_uint(__builtin_fminf(__builtin_fmaxf(d, -127.f), 127.f) + M_);
    return (ua & 0xffu) | ((ub & 0xffu) << 8) | ((uc & 0xffu) << 16) | (ud << 24);
}

struct Unit { int pm, pn; };
struct Gemm { const bf16_t* A; const bf16_t* Bt; int M, N, K; int a_shift; size_t a_stride; };

struct StaticOrder {
    int nM, nN, nwg, G, c;
    __host__ __device__ void init(int M_, int N_, int G_, int c_) { nM = M_ / BM; nN = N_ / BM; nwg = nM * nN; G = G_; c = c_; }
    __host__ __device__ bool next(int i, Unit& u) const {
        const long L = (long)i * G + c; if (L >= nwg) return false;
        int wgid = (int)L; { const int q = nwg / NXCD, r = nwg % NXCD, xcd = wgid % NXCD, off = wgid / NXCD; wgid = (xcd < r ? xcd * (q + 1) : r * (q + 1) + (xcd - r) * q) + off; }
        const int nig = WGM * nN, gid = wgid / nig, fm = gid * WGM, gsz = (nM - fm) < WGM ? (nM - fm) : WGM;
        u.pm = fm + ((wgid % nig) % gsz); u.pn = (wgid % nig) / gsz; return true;
    }
    __device__ __forceinline__ void a_ready(const Unit&) const {}
    __device__ __forceinline__ void done(const Unit&) const {}
};

struct SplitOrder {
    int nM, nN, nwg, c;
    __host__ __device__ void init(int M_, int N_, int c_) { nM = M_ / BM; nN = N_ / BM; nwg = nM * nN; c = c_; }
    __host__ __device__ bool next(int i, Unit& u) const {
        int L;
        if (i < 5) L = i * 256 + c; else if (c >= 128 && i < 7) L = 1280 + (i - 5) * 128 + (c - 128); else return false;
        int wgid = L; { const int q = nwg / NXCD, xcd = wgid % NXCD, off = wgid / NXCD; wgid = xcd * q + off; }
        const int nig = WGM * nN, gid = wgid / nig, fm = gid * WGM;
        u.pm = fm + ((wgid % nig) % WGM); u.pn = (wgid % nig) / WGM; return true;
    }
    __device__ __forceinline__ void a_ready(const Unit&) const {}
    __device__ __forceinline__ void done(const Unit&) const {}
};

__device__ __forceinline__ u32x4 pack8(f32x4 v0, f32x4 v1) { u32x4 w; w.x = cvt_pk_bf16(v0[0], v0[1]); w.y = cvt_pk_bf16(v0[2], v0[3]); w.z = cvt_pk_bf16(v1[0], v1[1]); w.w = cvt_pk_bf16(v1[2], v1[3]); return w; }

struct EpiPlain {
    static constexpr bool PERM = true, AFTER_DRAIN = false; static constexpr int NST = 16;
    bf16_t* O; int ldc;
    __device__ __forceinline__ void operator()(const f32x4 (&acc)[2][2][4][2], const Unit& u, int wr, int wc, int fr, int fq) const {
        const int row0 = u.pm * BM + wr * 64 + fr, col0 = u.pn * BM + wc * 32 + 8 * fq;
#pragma unroll
        for (int ai = 0; ai < 2; ++ai)
#pragma unroll
            for (int m = 0; m < 4; ++m) { bf16_t* rowp = O + (size_t)(row0 + ai * HALF + m * 16) * ldc + col0;
#pragma unroll
                for (int bj = 0; bj < 2; ++bj) *(u32x4*)(rowp + bj * HALF) = pack8(acc[ai][bj][m][0], acc[ai][bj][m][1]); }
    }
};
template <bool IA> __device__ __forceinline__ float accf(float v) { if constexpr (IA) return (float)__builtin_bit_cast(int, v); else return v; }
template <bool IA>
struct EpiSwigluT {
    static constexpr bool PERM = true, AFTER_DRAIN = false; static constexpr int NST = 8;
    bf16_t* O; int ldc; float is;
    __device__ __forceinline__ void operator()(const f32x4 (&acc)[2][2][4][2], const Unit& u, int wr, int wc, int fr, int fq) const {
        const int row0 = u.pm * BM + wr * 64 + fr, col0 = u.pn * HALF + wc * 32 + 8 * fq;
#pragma unroll
        for (int ai = 0; ai < 2; ++ai)
#pragma unroll
            for (int m = 0; m < 4; ++m) { bf16_t* rowp = O + (size_t)(row0 + ai * HALF + m * 16) * ldc + col0;
                f32x4 o[2];
#pragma unroll
                for (int n = 0; n < 2; ++n)
#pragma unroll
                    for (int e = 0; e < 4; ++e) { const float g = accf<IA>(acc[ai][0][m][n][e]) * is; o[n][e] = g * fsigmoid(g) * (accf<IA>(acc[ai][1][m][n][e]) * is); }
                *(u32x4*)rowp = pack8(o[0], o[1]); }
    }
};
typedef EpiSwigluT<false> EpiSwiglu;
struct EpiPlainI8 {
    static constexpr bool PERM = true, AFTER_DRAIN = false; static constexpr int NST = 16;
    bf16_t* O; int ldc; float is;
    __device__ __forceinline__ void operator()(const f32x4 (&acc)[2][2][4][2], const Unit& u, int wr, int wc, int fr, int fq) const {
        const int row0 = u.pm * BM + wr * 64 + fr, col0 = u.pn * BM + wc * 32 + 8 * fq;
#pragma unroll
        for (int ai = 0; ai < 2; ++ai)
#pragma unroll
            for (int m = 0; m < 4; ++m) { bf16_t* rowp = O + (size_t)(row0 + ai * HALF + m * 16) * ldc + col0;
#pragma unroll
                for (int bj = 0; bj < 2; ++bj) { f32x4 o[2];
#pragma unroll
                    for (int n = 0; n < 2; ++n)
#pragma unroll
                        for (int e = 0; e < 4; ++e) o[n][e] = accf<true>(acc[ai][bj][m][n][e]) * is;
                    *(u32x4*)(rowp + bj * HALF) = pack8(o[0], o[1]); } }
    }
};
template <bool IA>
struct EpiSwiglu8T {
    static constexpr bool PERM = true, AFTER_DRAIN = false; static constexpr int NST = 8;
    unsigned char* O; int ldc; float sc, is;
    __device__ __forceinline__ void operator()(const f32x4 (&acc)[2][2][4][2], const Unit& u, int wr, int wc, int fr, int fq) const {
        const int row0 = u.pm * BM + wr * 64 + fr, col0 = u.pn * HALF + wc * 32 + 8 * fq; const float scu = sc * is;
#pragma unroll
        for (int ai = 0; ai < 2; ++ai)
#pragma unroll
            for (int m = 0; m < 4; ++m) { unsigned char* rowp = O + (size_t)(row0 + ai * HALF + m * 16) * ldc + col0;
                f32x4 o[2];
#pragma unroll
                for (int n = 0; n < 2; ++n)
#pragma unroll
                    for (int e = 0; e < 4; ++e) { const float g = accf<IA>(acc[ai][0][m][n][e]) * is; o[n][e] = g * fsigmoid(g) * accf<IA>(acc[ai][1][m][n][e]) * scu; }
                *(u32x2*)rowp = (u32x2){pk4_fp8(o[0][0], o[0][1], o[0][2], o[0][3]), pk4_fp8(o[1][0], o[1][1], o[1][2], o[1][3])}; }
    }
};
typedef EpiSwiglu8T<false> EpiSwiglu8;
struct EpiLora {
    static constexpr bool PERM = true, AFTER_DRAIN = false; static constexpr int NST = 16;
    bf16_t* lmid;
    __device__ __forceinline__ void operator()(const f32x4 (&acc)[2][2][4][2], const Unit& u, int wr, int wc, int fr, int fq) const {
        const int row0 = u.pm * BM + wr * 64 + fr, col0 = wc * 32 + 8 * fq;
#pragma unroll
        for (int ai = 0; ai < 2; ++ai)
#pragma unroll
            for (int m = 0; m < 4; ++m) { bf16_t* rowp = lmid + (size_t)(row0 + ai * HALF + m * 16) * 256 + col0;
#pragma unroll
                for (int bj = 0; bj < 2; ++bj) { f32x4 o[2];
#pragma unroll
                    for (int n = 0; n < 2; ++n)
#pragma unroll
                        for (int e = 0; e < 4; ++e) { const float v = acc[ai][bj][m][n][e]; o[n][e] = (bj == 1) ? fsigmoid(v) : (wc < 2 ? ftanh(v) : v); }
                    *(u32x4*)(rowp + bj * HALF) = pack8(o[0], o[1]); } }
    }
};
struct EpiRw2 {
    static constexpr bool PERM = true, AFTER_DRAIN = false; static constexpr int NST = 16;
    bf16_t* O; const float* w0; const float* a0;
    __device__ __forceinline__ void operator()(const f32x4 (&acc)[2][2][4][2], const Unit& u, int wr, int wc, int fr, int fq) const {
        const int row0 = u.pm * BM + wr * 64 + fr, col0 = u.pn * BM + wc * 32 + 8 * fq, kind = u.pn >> 2, cc0 = (u.pn & 3) * BM + wc * 32 + 8 * fq;
        if (kind == 2) {
#pragma unroll
            for (int ai = 0; ai < 2; ++ai)
#pragma unroll
                for (int m = 0; m < 4; ++m) { bf16_t* rowp = O + (size_t)(row0 + ai * HALF + m * 16) * 3072 + col0;
#pragma unroll
                    for (int bj = 0; bj < 2; ++bj) *(u32x4*)(rowp + bj * HALF) = pack8(acc[ai][bj][m][0], acc[ai][bj][m][1]); }
        } else {
            const float* bp = (kind == 0 ? w0 : a0) + cc0; const float sc = kind == 0 ? -0.60653065971f : 1.0f;
#pragma unroll
            for (int bj = 0; bj < 2; ++bj) {
                const f32x4 b0 = *(const f32x4*)(bp + bj * HALF), b1 = *(const f32x4*)(bp + bj * HALF + 4);
#pragma unroll
                for (int ai = 0; ai < 2; ++ai)
#pragma unroll
                    for (int m = 0; m < 4; ++m) { bf16_t* rowp = O + (size_t)(row0 + ai * HALF + m * 16) * 3072 + col0; f32x4 o0, o1;
#pragma unroll
                        for (int e = 0; e < 4; ++e) { o0[e] = sc * fsigmoid(acc[ai][bj][m][0][e] + b0[e]); o1[e] = sc * fsigmoid(acc[ai][bj][m][1][e] + b1[e]); }
                        *(u32x4*)(rowp + bj * HALF) = pack8(o0, o1); }
            }
        }
    }
};
template <bool IA> __device__ __forceinline__ float accf_(float v) { if constexpr (IA) return (float)__builtin_bit_cast(int, v); else return v; }
template <bool IA>
struct EpiRtInT {
    static constexpr bool PERM = true, AFTER_DRAIN = false; static constexpr int NST = 16;
    bf16_t* O; const int* pos; float is;
    __device__ __forceinline__ void operator()(const f32x4 (&acc)[2][2][4][2], const Unit& u, int wr, int wc, int fr, int fq) const {
        const int row0 = u.pm * BM + wr * 64 + fr, col0 = u.pn * BM + wc * 32 + 8 * fq;
        if (u.pn >= 8) {
#pragma unroll
            for (int ai = 0; ai < 2; ++ai)
#pragma unroll
                for (int m = 0; m < 4; ++m) { bf16_t* rowp = O + (size_t)(row0 + ai * HALF + m * 16) * 6144 + col0;
#pragma unroll
                    for (int bj = 0; bj < 2; ++bj) {
                        if constexpr (IA) { f32x4 o[2];
#pragma unroll
                            for (int n = 0; n < 2; ++n)
#pragma unroll
                                for (int e = 0; e < 4; ++e) o[n][e] = accf_<true>(acc[ai][bj][m][n][e]) * is;
                            *(u32x4*)(rowp + bj * HALF) = pack8(o[0], o[1]); }
                        else *(u32x4*)(rowp + bj * HALF) = pack8(acc[ai][bj][m][0], acc[ai][bj][m][1]); } }
        } else {
            const float sc = (u.pn >= 4 ? 0.0625f : 1.0f) * (IA ? is : 1.0f);
            float invf[2][4];
#pragma unroll
            for (int n = 0; n < 2; ++n)
#pragma unroll
                for (int e = 0; e < 4; ++e) { const int i = wc * 32 + 8 * fq + 4 * n + e; invf[n][e] = __builtin_amdgcn_exp2f((float)i * (-13.287712379549449f / 127.0f)) * 0.15915494309189535f; }
#pragma unroll
            for (int ai = 0; ai < 2; ++ai)
#pragma unroll
                for (int m = 0; m < 4; ++m) { const int row = row0 + ai * HALF + m * 16; const float p = (float)pos[row]; bf16_t* rowp = O + (size_t)row * 6144 + col0;
                    f32x4 o1[2], o2[2];
#pragma unroll
                    for (int n = 0; n < 2; ++n)
#pragma unroll
                        for (int e = 0; e < 4; ++e) { float rev = p * invf[n][e]; rev = rev - __builtin_floorf(rev);
                            const float sn = __builtin_amdgcn_sinf(rev), cs = __builtin_amdgcn_cosf(rev);
                            const float u1 = accf_<IA>(acc[ai][0][m][n][e]), u2 = accf_<IA>(acc[ai][1][m][n][e]);
                            o1[n][e] = (u1 * cs - u2 * sn) * sc; o2[n][e] = (u1 * sn + u2 * cs) * sc; }
                    *(u32x4*)rowp = pack8(o1[0], o1[1]); *(u32x4*)(rowp + HALF) = pack8(o2[0], o2[1]); }
        }
    }
};
typedef EpiRtInT<false> EpiRtIn;

__device__ __forceinline__ float swz_xor16(float v) { return __builtin_bit_cast(float, __builtin_amdgcn_ds_swizzle(__builtin_bit_cast(int, v), 0x401f)); }
__device__ __forceinline__ float bperm(float v, int byteaddr) { return __builtin_bit_cast(float, __builtin_amdgcn_ds_bpermute(byteaddr, __builtin_bit_cast(int, v))); }
template <bool KEEPX>
struct EpiNormRes {
    static constexpr bool PERM = true, AFTER_DRAIN = false; static constexpr int NST = 16;
    unsigned char* ws; float* out; PG8_LAS unsigned char* lds; int s, mode; float hs;
    __device__ __forceinline__ void operator()(const f32x4 (&acc)[2][2][4][2], const Unit& u, int wr, int wc, int, int) const {
        int t_ = threadIdx.x, s_ = s; asm volatile("" : "+v"(t_), "+s"(s_));
        const int lane = t_ & 63, fr = lane & 15, fq = lane >> 4, tid = (wr * 4 + wc) * 64 + lane;
        const int r0 = wr * 64 + fr, col0 = u.pn * BM + wc * 32 + 8 * fq;
        bf16_t* const xb = (bf16_t*)out; bf16_t* const xb2 = (bf16_t*)(ws + WS_A + 256 * MiB);
        const bf16_t* xin = (mode & 1) ? xb2 : xb; bf16_t* xout = (mode & 2) ? xb2 : xb; float* fout = (mode & 4) ? out : nullptr;
        const float* rho_in = (const float*)(ws + 57 * MiB) + (s_ & 1) * M; float* rho_out = (float*)(ws + 57 * MiB) + ((s_ + 1) & 1) * M;
        float* stats = (float*)(ws + WS_MO) + (size_t)s_ * STATS_PER_PHASE;
        unsigned* cnt = (unsigned*)(ws + WS_CTL) + CW_CNT + s_ * 2048; unsigned* tmo = (unsigned*)(ws + WS_CTL) + CW_BAR + 128;
        const float c = (s_ % 3 == 1) ? 1.0f : 0.5f;
        PG8_LAS unsigned char* sm = lds + RING_BYTES; const PG8_LAS float* gl = (const PG8_LAS float*)(lds + GAIN_OFF);
        PG8_LAS float* part = (PG8_LAS float*)sm; PG8_LAS float* coef = part + 3072;
        const bf16_t* xrow = xin + (size_t)(u.pm * BM + r0) * DM + col0;
        const int a32 = (lane ^ 32) * 4;
        u32x4 xv[KEEPX ? 2 : 1][4][2];
        if constexpr (KEEPX) {
#pragma unroll
            for (int ai = 0; ai < 2; ++ai)
#pragma unroll
                for (int m = 0; m < 4; ++m)
#pragma unroll
                    for (int bj = 0; bj < 2; ++bj) xv[ai][m][bj] = *(const u32x4*)(xrow + (size_t)(ai * HALF + m * 16) * DM + bj * HALF);
        }
#pragma unroll
        for (int ai = 0; ai < 2; ++ai) {
            const int xi = KEEPX ? ai : 0;
            if constexpr (!KEEPX) {
#pragma unroll
                for (int m = 0; m < 4; ++m)
#pragma unroll
                    for (int bj = 0; bj < 2; ++bj) xv[0][m][bj] = *(const u32x4*)(xrow + (size_t)(ai * HALF + m * 16) * DM + bj * HALF);
            }
#pragma unroll
            for (int m = 0; m < 4; ++m) {
                float t1 = 0.f, s2 = 0.f, s3 = 0.f;
#pragma unroll
                for (int bj = 0; bj < 2; ++bj)
#pragma unroll
                    for (int n = 0; n < 2; ++n) { const f32x4 g = *(const PG8_LAS f32x4*)(gl + col0 + bj * HALF + 4 * n);
#pragma unroll
                        for (int e = 0; e < 4; ++e) { const float h = acc[ai][bj][m][n][e], hg = h * g[e]; const unsigned wd = xv[xi][m][bj][n * 2 + (e >> 1)];
                            const float x = (e & 1) ? bf_hi(wd) : bf_lo(wd); t1 += h * h; s2 += x * hg; s3 += hg * hg; } }
                t1 *= hs * hs;
                t1 += swz_xor16(t1); s2 += swz_xor16(s2); s3 += swz_xor16(s3);
                t1 += bperm(t1, a32); s2 += bperm(s2, a32); s3 += bperm(s3, a32);
                if (fq == 0) { PG8_LAS float* p = part + ((r0 + ai * HALF + m * 16) * 4 + wc) * 3; p[0] = t1; p[1] = s2; p[2] = s3; }
                asm volatile("" ::: "memory");
            }
        }
        if constexpr (KEEPX) {
#pragma unroll
            for (int ai = 0; ai < 2; ++ai)
#pragma unroll
                for (int m = 0; m < 4; ++m)
#pragma unroll
                    for (int bj = 0; bj < 2; ++bj) asm volatile("" : "+v"(xv[ai][m][bj]));
        }
        WG_BAR_L();
        if (tid < 256) {
            const PG8_LAS float* p = part + tid * 12;
            const float t1 = (p[0] + p[3]) + (p[6] + p[9]), t2 = (p[1] + p[4]) + (p[7] + p[10]), t3 = (p[2] + p[5]) + (p[8] + p[11]);
            float* sp = stats + (size_t)((u.pm * 4 + u.pn) * 3) * 256 + tid;
            __hip_atomic_store(sp, t1, __ATOMIC_RELAXED, __HIP_MEMORY_SCOPE_AGENT); __hip_atomic_store(sp + 256, t2, __ATOMIC_RELAXED, __HIP_MEMORY_SCOPE_AGENT); __hip_atomic_store(sp + 512, t3, __ATOMIC_RELAXED, __HIP_MEMORY_SCOPE_AGENT);
        }
        asm volatile("s_waitcnt vmcnt(0)" ::: "memory");
        WG_BAR_L();
        if (tid == 0) {
            unsigned* cp = cnt + u.pm * 16;
            (void)__hip_atomic_fetch_add(cp, 1u, __ATOMIC_RELAXED, __HIP_MEMORY_SCOPE_AGENT);
            unsigned spn = 0;
            while (__hip_atomic_load(cp, __ATOMIC_RELAXED, __HIP_MEMORY_SCOPE_AGENT) < 4u) { __builtin_amdgcn_s_sleep(1);
                if ((++spn & 255u) == 0u) { if (__hip_atomic_load(tmo, __ATOMIC_RELAXED, __HIP_MEMORY_SCOPE_AGENT)) break; if (spn > (1u << 18)) { atomicAdd(tmo, 1u); break; } } }
        }
        WG_BAR_L();
        if (tid < 256) {
            const float* sp = stats + (size_t)(u.pm * 12) * 256 + tid;
            float T1 = 0.f, T2 = 0.f, T3 = 0.f;
#pragma unroll
            for (int q = 0; q < 4; ++q) { T1 += __hip_atomic_load(sp + (q * 3 + 0) * 256, __ATOMIC_RELAXED, __HIP_MEMORY_SCOPE_AGENT); T2 += __hip_atomic_load(sp + (q * 3 + 1) * 256, __ATOMIC_RELAXED, __HIP_MEMORY_SCOPE_AGENT);
                T3 += __hip_atomic_load(sp + (q * 3 + 2) * 256, __ATOMIC_RELAXED, __HIP_MEMORY_SCOPE_AGENT); }
            const int row = u.pm * BM + tid;
            const float rho = rho_in[row], a = __builtin_amdgcn_rsqf(__builtin_fmaf(T1, 1.0f / DM, NORM_EPS)) * c;
            const float ms = __builtin_fmaxf(__builtin_fmaf(rho, rho, (a * (1.0f / DM)) * __builtin_fmaf(2.0f * rho, T2, a * T3)), NORM_EPS), rs = fout ? 1.0f : __builtin_amdgcn_rsqf(ms);
            *(PG8_LAS f32x2*)(coef + 2 * tid) = (f32x2){a, rho} * rs;
            if (u.pn == 0 && !fout) rho_out[row] = ms * rs;
        }
        WG_BAR_L();
        bf16_t* orow = xout + (size_t)(u.pm * BM + r0) * DM + col0;
#pragma unroll
        for (int ai = 0; ai < 2; ++ai) {
            const int xi = KEEPX ? ai : 0;
            if constexpr (!KEEPX) {
#pragma unroll
                for (int m = 0; m < 4; ++m)
#pragma unroll
                    for (int bj = 0; bj < 2; ++bj) xv[0][m][bj] = *(const u32x4*)(xrow + (size_t)(ai * HALF + m * 16) * DM + bj * HALF);
            }
#pragma unroll
            for (int m = 0; m < 4; ++m) {
                const f32x2 ab = *(const PG8_LAS f32x2*)(coef + 2 * (r0 + ai * HALF + m * 16));
#pragma unroll
                for (int bj = 0; bj < 2; ++bj) { f32x4 o[2];
#pragma unroll
                    for (int n = 0; n < 2; ++n) { const f32x4 ag = *(const PG8_LAS f32x4*)(gl + col0 + bj * HALF + 4 * n) * ab[0];
#pragma unroll
                        for (int e = 0; e < 4; ++e) { const unsigned wd = xv[xi][m][bj][n * 2 + (e >> 1)]; const float x = (e & 1) ? bf_hi(wd) : bf_lo(wd);
                            o[n][e] = __builtin_fmaf(ag[e], acc[ai][bj][m][n][e], ab[1] * x); } }
                    if (fout) { float* fr_ = fout + (size_t)(u.pm * BM + r0 + ai * HALF + m * 16) * DM + col0 + bj * HALF; *(f32x4*)fr_ = o[0]; *(f32x4*)(fr_ + 4) = o[1]; }
                    else { *(u32x4*)(orow + (size_t)(ai * HALF + m * 16) * DM + bj * HALF) = pack8(o[0], o[1]);
                        if (mode & 8) *(u32x2*)((unsigned char*)out + X8_OFF + (size_t)(u.pm * BM + r0 + ai * HALF + m * 16) * DM + col0 + bj * HALF) =
                            (u32x2){pk4_i8(o[0][0] * X8_SCALE, o[0][1] * X8_SCALE, o[0][2] * X8_SCALE, o[0][3] * X8_SCALE), pk4_i8(o[1][0] * X8_SCALE, o[1][1] * X8_SCALE, o[1][2] * X8_SCALE, o[1][3] * X8_SCALE)}; } }
            }
            if constexpr (!KEEPX) asm volatile("" ::: "memory");
        }
    }
};

template <class Epi, class Sched, bool ALIGN_EPI = false, bool SP2 = false, int F8 = 0>
__device__ __forceinline__ void gemm_phase(PG8_LAS unsigned char* lds, const Gemm g, const Sched& S, const Epi& E) {
    int tid_ = threadIdx.x; asm volatile("" : "+v"(tid_));
    const int tid = tid_, wid = __builtin_amdgcn_readfirstlane(tid >> 6), lane = tid & 63, wr = wid >> 2, wc = wid & 3, fr = lane & 15, fq = lane >> 4;
    const int K = g.K, nt = K / BK;
    unsigned voffA[2], voffB[2];
#pragma unroll
    for (int i = 0; i < 2; ++i) { int R, C; stage_rc(tid * 16 + i * 8192, R, C); const int Rb = Epi::PERM ? ((R & ~31) + perm32(R & 31)) : R;
        voffA[i] = (unsigned)(R * K + C) * 2u; voffB[i] = (unsigned)(Rb * K + C) * 2u; }
    const size_t kstep = (size_t)(BK * 2);
    const size_t hstep = (size_t)HALF * K * 2;
    const size_t tstep = 2 * hstep;
    const unsigned ldsw = (unsigned)wid * 1024u;
    const int aoff = lds_byte(wr * 64 + fr, fq * 8), boff = lds_byte(wc * 32 + fr, fq * 8);
#define PG8_SA(b, h) (((b) * 2 + (h)) * HTB)
#define PG8_SB(b, h) ((4 + (b) * 2 + (h)) * HTB)
#define PG8_STAGE(bufoff, gbase, voff) do { _Pragma("unroll") for (int _i = 0; _i < 2; ++_i) \
        __builtin_amdgcn_global_load_lds((const unsigned*)((const char*)(gbase) + (voff)[_i]), (PG8_LAS unsigned*)(lds + (bufoff) + ldsw + _i * 8192), 16, 0, 0); } while (0)
#define PG8_LDA(dst, b, h) do { _Pragma("unroll") for (int m = 0; m < 4; ++m) _Pragma("unroll") for (int k = 0; k < 2; ++k) dst[m][k] = *(const PG8_LAS bf16x8*)(lds + PG8_SA(b, h) + aoff + m * 2048 + k * 1024); } while (0)
#define PG8_LDB(dst, b, h) do { _Pragma("unroll") for (int n = 0; n < 2; ++n) _Pragma("unroll") for (int k = 0; k < 2; ++k) dst[n][k] = *(const PG8_LAS bf16x8*)(lds + PG8_SB(b, h) + boff + n * 2048 + k * 1024); } while (0)
#define PG8_MMA(ai, bj, At, Bt) do { __builtin_amdgcn_s_setprio(1); \
        if constexpr (F8 == 1) { _Pragma("unroll") for (int m = 0; m < 4; ++m) _Pragma("unroll") for (int n = 0; n < 2; ++n) acc[ai][bj][m][n] = mfma_f8(Bt[n][0], Bt[n][1], At[m][0], At[m][1], acc[ai][bj][m][n]); } \
        else if constexpr (F8 == 2) { _Pragma("unroll") for (int m = 0; m < 4; ++m) _Pragma("unroll") for (int n = 0; n < 2; ++n) _Pragma("unroll") for (int k = 0; k < 2; ++k) acc[ai][bj][m][n] = mfma_i8(Bt[n][k], At[m][k], acc[ai][bj][m][n]); } \
        else { _Pragma("unroll") for (int m = 0; m < 4; ++m) _Pragma("unroll") for (int n = 0; n < 2; ++n) _Pragma("unroll") for (int k = 0; k < 2; ++k) \
        acc[ai][bj][m][n] = __builtin_amdgcn_mfma_f32_16x16x32_bf16(Bt[n][k], At[m][k], acc[ai][bj][m][n], 0, 0, 0); } __builtin_amdgcn_s_setprio(0); } while (0)
#define PG8_WAIT_V(n) asm volatile("s_waitcnt vmcnt(" #n ")" ::: "memory")
#define PG8_WAIT_L(n) asm volatile("s_waitcnt lgkmcnt(" #n ")" ::: "memory")
#define PG8_BAR __builtin_amdgcn_s_barrier()
#define PG8_SCHED __builtin_amdgcn_sched_barrier(0)
    Unit cur, nxt; int ui = 0;
    if (!S.next(0, cur)) return;
    f32x4 acc[2][2][4][2];
#pragma unroll
    for (int a = 0; a < 2; ++a)
#pragma unroll
        for (int b = 0; b < 2; ++b)
#pragma unroll
            for (int m = 0; m < 4; ++m)
#pragma unroll
                for (int n = 0; n < 2; ++n) acc[a][b][m][n] = (f32x4){0.f, 0.f, 0.f, 0.f};
    bf16x8 At[4][2], B0[2][2], B1[2][2];
    const char* cA = (const char*)g.A + (size_t)(cur.pn >> g.a_shift) * g.a_stride + (size_t)cur.pm * tstep; const char* cB = (const char*)g.Bt + (size_t)cur.pn * tstep;
    S.a_ready(cur);
    if constexpr (SP2) {
        PG8_STAGE(PG8_SB(0, 0), cB, voffB); PG8_STAGE(PG8_SB(0, 1), cB + hstep, voffB); PG8_STAGE(PG8_SA(0, 0), cA, voffA); PG8_STAGE(PG8_SA(0, 1), cA + hstep, voffA);
        if (wr == 1) PG8_BAR;
        PG8_WAIT_V(2); PG8_BAR;
        PG8_STAGE(PG8_SB(1, 0), cB + kstep, voffB); PG8_STAGE(PG8_SA(1, 0), cA + kstep, voffA); PG8_STAGE(PG8_SB(1, 1), cB + hstep + kstep, voffB);
        PG8_WAIT_V(6); PG8_BAR;
    } else {
        PG8_STAGE(PG8_SB(0, 0), cB, voffB); PG8_STAGE(PG8_SA(0, 0), cA, voffA); PG8_STAGE(PG8_SB(0, 1), cB + hstep, voffB); PG8_STAGE(PG8_SA(0, 1), cA + hstep, voffA);
        if (wr == 1) PG8_BAR;
        PG8_WAIT_V(4); PG8_BAR;
        PG8_STAGE(PG8_SB(1, 0), cB + kstep, voffB); PG8_STAGE(PG8_SA(1, 0), cA + kstep, voffA); PG8_STAGE(PG8_SB(1, 1), cB + hstep + kstep, voffB);
        PG8_WAIT_V(6); PG8_BAR;
    }
    for (;;) {
        const bool has_next = S.next(ui + 1, nxt);
        const char* nA = has_next ? (const char*)g.A + (size_t)(nxt.pn >> g.a_shift) * g.a_stride + (size_t)nxt.pm * tstep : cA; const char* nB = has_next ? (const char*)g.Bt + (size_t)nxt.pn * tstep : cB;
        for (int t = 0; t < nt; t += 2) {
            const bool last = (t == nt - 2);
            const char* a1 = cA + (size_t)(t + 1) * kstep;
            const char* a2 = last ? nA : cA + (size_t)(t + 2) * kstep; const char* b2 = last ? nB : cB + (size_t)(t + 2) * kstep;
            const char* a3 = a2 + kstep; const char* b3 = b2 + kstep;
            if (last && has_next) S.a_ready(nxt);
            if constexpr (SP2) {
            const unsigned skipst = (unsigned)__builtin_amdgcn_readfirstlane((Epi::NST > 0 && t == 0 && ui > 0) ? 1 : 0);
#define PG8_WAIT_VS() do { if constexpr (Epi::NST == 16) asm volatile("s_cmp_eq_u32 %0, 0\n\ts_cbranch_scc1 .LWA%=\n\ts_waitcnt vmcnt(24)\n\ts_branch .LWB%=\n.LWA%=:\n\ts_waitcnt vmcnt(8)\n.LWB%=:" :: "s"(skipst) : "memory", "scc"); \
        else if constexpr (Epi::NST == 8) asm volatile("s_cmp_eq_u32 %0, 0\n\ts_cbranch_scc1 .LWA%=\n\ts_waitcnt vmcnt(16)\n\ts_branch .LWB%=\n.LWA%=:\n\ts_waitcnt vmcnt(8)\n.LWB%=:" :: "s"(skipst) : "memory", "scc"); \
        else PG8_WAIT_V(8); } while (0)
            PG8_LDB(B0, 0, 0); PG8_LDB(B1, 0, 1); PG8_SCHED; PG8_LDA(At, 0, 0); PG8_STAGE(PG8_SA(1, 1), a1 + hstep, voffA);
            PG8_WAIT_VS(); PG8_WAIT_L(0); PG8_BAR; PG8_MMA(0, 0, At, B0); PG8_MMA(0, 1, At, B1); PG8_BAR; PG8_SCHED;
            PG8_LDA(At, 0, 1); PG8_STAGE(PG8_SB(0, 0), b2, voffB); PG8_STAGE(PG8_SB(0, 1), b2 + hstep, voffB); PG8_STAGE(PG8_SA(0, 0), a2, voffA);
            PG8_WAIT_VS(); PG8_WAIT_L(0); PG8_BAR; PG8_MMA(1, 0, At, B0); PG8_MMA(1, 1, At, B1); PG8_BAR; PG8_SCHED;
#undef PG8_WAIT_VS
            PG8_LDB(B0, 1, 0); PG8_LDB(B1, 1, 1); PG8_SCHED; PG8_LDA(At, 1, 0); PG8_STAGE(PG8_SA(0, 1), a2 + hstep, voffA);
            PG8_WAIT_V(8); PG8_WAIT_L(0); PG8_BAR; PG8_MMA(0, 0, At, B0); PG8_MMA(0, 1, At, B1); PG8_BAR; PG8_SCHED;
            PG8_LDA(At, 1, 1); PG8_STAGE(PG8_SB(1, 0), b3, voffB); PG8_STAGE(PG8_SB(1, 1), b3 + hstep, voffB); PG8_STAGE(PG8_SA(1, 0), a3, voffA);
            PG8_WAIT_V(8); PG8_WAIT_L(0); PG8_BAR; PG8_MMA(1, 0, At, B0); PG8_MMA(1, 1, At, B1); PG8_BAR; PG8_SCHED;
            } else {
            PG8_LDB(B0, 0, 0); PG8_SCHED; PG8_LDA(At, 0, 0); PG8_STAGE(PG8_SA(1, 1), a1 + hstep, voffA);
            PG8_WAIT_L(8); PG8_BAR; PG8_WAIT_L(0); PG8_MMA(0, 0, At, B0); PG8_BAR; PG8_SCHED;
            PG8_LDB(B1, 0, 1); PG8_STAGE(PG8_SB(0, 0), b2, voffB);
            PG8_BAR; PG8_WAIT_L(0); PG8_MMA(0, 1, At, B1); PG8_BAR;
            PG8_LDA(At, 0, 1); PG8_STAGE(PG8_SA(0, 0), a2, voffA);
            PG8_BAR; PG8_WAIT_L(0); PG8_MMA(1, 0, At, B0); PG8_BAR; PG8_SCHED;
            PG8_STAGE(PG8_SB(0, 1), b2 + hstep, voffB);
            PG8_WAIT_V(6); PG8_BAR; PG8_MMA(1, 1, At, B1); PG8_BAR;
            PG8_LDB(B0, 1, 0); PG8_SCHED; PG8_LDA(At, 1, 0); PG8_STAGE(PG8_SA(0, 1), a2 + hstep, voffA);
            PG8_WAIT_L(8); PG8_BAR; PG8_WAIT_L(0); PG8_MMA(0, 0, At, B0); PG8_BAR; PG8_SCHED;
            PG8_LDB(B1, 1, 1); PG8_STAGE(PG8_SB(1, 0), b3, voffB);
            PG8_BAR; PG8_WAIT_L(0); PG8_MMA(0, 1, At, B1); PG8_BAR;
            PG8_LDA(At, 1, 1); PG8_STAGE(PG8_SA(1, 0), a3, voffA);
            PG8_BAR; PG8_WAIT_L(0); PG8_MMA(1, 0, At, B0); PG8_BAR; PG8_SCHED;
            PG8_STAGE(PG8_SB(1, 1), b3 + hstep, voffB);
            PG8_WAIT_V(6); PG8_BAR; PG8_MMA(1, 1, At, B1); PG8_BAR;
            }
        }
        if constexpr (ALIGN_EPI) { if (wr == 0) PG8_BAR; }
        if constexpr (!Epi::AFTER_DRAIN) { E(acc, cur, wr, wc, fr, fq); S.done(cur); }
        if (!has_next) break;
#pragma unroll
        for (int a = 0; a < 2; ++a)
#pragma unroll
            for (int b = 0; b < 2; ++b)
#pragma unroll
                for (int m = 0; m < 4; ++m)
#pragma unroll
                    for (int n = 0; n < 2; ++n) acc[a][b][m][n] = (f32x4){0.f, 0.f, 0.f, 0.f};
        cur = nxt; cA = nA; cB = nB; ++ui;
        if constexpr (ALIGN_EPI) { if (wr == 1) PG8_BAR; }
    }
    PG8_WAIT_V(0);
    if constexpr (!ALIGN_EPI) { if (wr == 0) PG8_BAR; }
    PG8_BAR;
#undef PG8_SA
#undef PG8_SB
#undef PG8_STAGE
#undef PG8_LDA
#undef PG8_LDB
#undef PG8_MMA
#undef PG8_WAIT_V
#undef PG8_WAIT_L
#undef PG8_BAR
#undef PG8_SCHED
}
}

#define XB_TMO      128
#define XB_XCNT(j)  (256  + 64 * (j))
#define XB_XSUB(j)  (1280 + 64 * (j))
#define XB_XGEN(j)  (2304 + 64 * (j))
#define XB_TOP      3328
#define XB_TOPGEN   3392
#define XCD_BAR_WORDS 3456
#define XB_SPIN_CAP (1u << 18)

__device__ __forceinline__ unsigned xb_ld(unsigned* p)              { return __hip_atomic_load(p, __ATOMIC_RELAXED, __HIP_MEMORY_SCOPE_AGENT); }
__device__ __forceinline__ unsigned xb_add(unsigned* p, unsigned v) { return __hip_atomic_fetch_add(p, v, __ATOMIC_RELAXED, __HIP_MEMORY_SCOPE_AGENT); }
__device__ __forceinline__ unsigned xb_xcc_id() { return (unsigned)__builtin_amdgcn_s_getreg((3 << 11) | 20) & 0xFu; }
#define XB_SPIN(cond, bar) do { unsigned _sp = 0; while (cond) { __builtin_amdgcn_s_sleep(1); \
    if ((++_sp & 255u) == 0u) { if (xb_ld(&(bar)[XB_TMO])) break; if (_sp > XB_SPIN_CAP) { atomicAdd(&(bar)[XB_TMO], 1u); break; } } } } while (0)

struct XcdBarrier { unsigned* bar; unsigned x; volatile LAS unsigned* st; };

__device__ __forceinline__ XcdBarrier xcd_barrier_post(unsigned* bar, volatile LAS unsigned* st) {
    XcdBarrier b; b.bar = bar; b.x = xb_xcc_id(); b.st = st;
    if (threadIdx.x == 0) (void)xb_add(&bar[XB_XCNT(b.x)], 1u);
    return b;
}
__device__ __forceinline__ void xcd_barrier_complete(unsigned* bar, unsigned x, unsigned& nloc, unsigned& nx) {
    const unsigned G = gridDim.x * gridDim.y * gridDim.z;
    unsigned sum, cnt, mine, sp = 0u;
    for (;;) {
        sum = 0u; cnt = 0u; mine = 0u;
#pragma unroll
        for (unsigned j = 0; j < 16; ++j) { const unsigned c = xb_ld(&bar[XB_XCNT(j)]); sum += c; cnt += (c > 0u) ? 1u : 0u; mine = (j == x) ? c : mine; }
        if (sum == G) break;
        __builtin_amdgcn_s_sleep(1);
        if ((++sp & 255u) == 0u) { if (xb_ld(&bar[XB_TMO])) break; if (sp > XB_SPIN_CAP) { atomicAdd(&bar[XB_TMO], 1u); break; } }
    }
    nloc = mine > 0u ? mine : 1u; nx = cnt > 0u ? cnt : 1u;
}
__device__ __forceinline__ void xcd_barrier(const XcdBarrier& b) {
    asm volatile("s_waitcnt vmcnt(0)" ::: "memory");
    __syncthreads();
    if (threadIdx.x == 0) {
        unsigned* bar = b.bar;
        __builtin_amdgcn_s_waitcnt(0);
        unsigned nloc = b.st[0], nx = b.st[1];
        if (nloc == 0u) { xcd_barrier_complete(bar, b.x, nloc, nx); b.st[0] = nloc; b.st[1] = nx; }
        const unsigned old = xb_add(&bar[XB_XSUB(b.x)], 1u);
        const unsigned gen = old / nloc;
        if (old + 1u == (gen + 1u) * nloc) {
            __builtin_amdgcn_fence(__ATOMIC_RELEASE, "agent");
            asm volatile("s_waitcnt vmcnt(0)" ::: "memory");
            const unsigned og = xb_add(&bar[XB_TOP], 1u);
            const unsigned tg = og / nx;
            if (og + 1u == (tg + 1u) * nx) xb_add(&bar[XB_TOPGEN], 1u);
            else XB_SPIN(xb_ld(&bar[XB_TOPGEN]) == tg, bar);
            __builtin_amdgcn_fence(__ATOMIC_ACQUIRE, "agent");
            xb_add(&bar[XB_XGEN(b.x)], 1u);
            asm volatile("s_waitcnt vmcnt(0)" ::: "memory");
        } else {
            XB_SPIN(xb_ld(&bar[XB_XGEN(b.x)]) == gen, bar);
            __builtin_amdgcn_fence(__ATOMIC_ACQUIRE, "agent");
            asm volatile("s_waitcnt vmcnt(0)" ::: "memory");
        }
    }
    __syncthreads();
}

struct Frame {
    LAS unsigned char* lds;
    int vcu, G;
};
__device__ __forceinline__ int opaque_tid() { int t = threadIdx.x; asm volatile("" : "+v"(t)); return t; }
#define PH_IDS const int tid = opaque_tid(), lane = tid & 63, w = __builtin_amdgcn_readfirstlane(tid >> 6); (void)tid; (void)lane; (void)w

template <class SrcF>
__device__ __forceinline__ void prep_matrix(const Frame& F, int K, int N, bf16* WT, SrcF src, const float* kgain = nullptr) {
    PH_IDS;
    LAS float* scr = (LAS float*)(F.lds + w * 8448);
    int gw_ = F.vcu * NWAVES + w; asm volatile("" : "+s"(gw_));
    const int gw = gw_, NGW = F.G * NWAVES;
    const int nblk = N / 32, nitems = (K / 64) * nblk;
    float tv[32], tn[32];
    { const int it0 = gw < nitems ? gw : nitems - 1; const int kb = it0 / nblk, nb = it0 % nblk;
#pragma unroll
        for (int i = 0; i < 32; ++i) tv[i] = src(64 * kb + 2 * i + (lane >> 5), 32 * nb + (lane & 31)); }
    for (int it = gw; it < nitems; it += NGW) {
        const int kb = it / nblk, nb = it % nblk, k0 = 64 * kb, n0 = 32 * nb;
        { const int it2 = (it + NGW < nitems) ? it + NGW : it; const int kb2 = it2 / nblk, nb2 = it2 % nblk;
#pragma unroll
            for (int i = 0; i < 32; ++i) tn[i] = src(64 * kb2 + 2 * i + (lane >> 5), 32 * nb2 + (lane & 31)); }
#pragma unroll
        for (int i = 0; i < 32; ++i) scr[(2 * i + (lane >> 5)) * 33 + (lane & 31)] = tv[i];
#pragma unroll
        for (int i = 0; i < 32; ++i) tv[i] = tn[i];
        LDS_WAIT();
        const int c = lane & 7;
        f32x4 g0 = {1.f, 1.f, 1.f, 1.f}, g1 = {1.f, 1.f, 1.f, 1.f};
        if (kgain) { g0 = *(const f32x4*)(kgain + k0 + 8 * c); g1 = *(const f32x4*)(kgain + k0 + 8 * c + 4); }
#pragma unroll
        for (int j = 0; j < 4; ++j) { const int n = (lane >> 3) + 8 * j; const LAS float* s = scr + (8 * c) * 33 + n;
            u32x4 o; o.x = cvt_pk_bf16(s[0 * 33] * g0[0], s[1 * 33] * g0[1]); o.y = cvt_pk_bf16(s[2 * 33] * g0[2], s[3 * 33] * g0[3]); o.z = cvt_pk_bf16(s[4 * 33] * g1[0], s[5 * 33] * g1[1]); o.w = cvt_pk_bf16(s[6 * 33] * g1[2], s[7 * 33] * g1[3]);
            *(u32x4*)(WT + (size_t)(n0 + n) * K + k0 + 8 * c) = o; }
        LDS_WAIT();
    }
}

template <bool I8, class SrcF>
__device__ __forceinline__ void prep_matrix_q(const Frame& F, int K, int N, unsigned char* WT, SrcF src, float sc, const float* kgain = nullptr) {
    PH_IDS;
    LAS float* scr = (LAS float*)(F.lds + w * 8448);
    int gw_ = F.vcu * NWAVES + w; asm volatile("" : "+s"(gw_));
    const int gw = gw_, NGW = F.G * NWAVES;
    const int nblk = N / 32, nitems = (K / 64) * nblk;
    float tv[32], tn[32];
    { const int it0 = gw < nitems ? gw : nitems - 1; const int kb = it0 / nblk, nb = it0 % nblk;
#pragma unroll
        for (int i = 0; i < 32; ++i) tv[i] = src(64 * kb + 2 * i + (lane >> 5), 32 * nb + (lane & 31)); }
    for (int it = gw; it < nitems; it += NGW) {
        const int kb = it / nblk, nb = it % nblk, k0 = 64 * kb, n0 = 32 * nb;
        { const int it2 = (it + NGW < nitems) ? it + NGW : it; const int kb2 = it2 / nblk, nb2 = it2 % nblk;
#pragma unroll
            for (int i = 0; i < 32; ++i) tn[i] = src(64 * kb2 + 2 * i + (lane >> 5), 32 * nb2 + (lane & 31)); }
#pragma unroll
        for (int i = 0; i < 32; ++i) scr[(2 * i + (lane >> 5)) * 33 + (lane & 31)] = tv[i];
#pragma unroll
        for (int i = 0; i < 32; ++i) tv[i] = tn[i];
        LDS_WAIT();
        const int c = lane & 7;
        f32x4 g0 = {sc, sc, sc, sc}, g1 = {sc, sc, sc, sc};
        if (kgain) { g0 = *(const f32x4*)(kgain + k0 + 8 * c) * sc; g1 = *(const f32x4*)(kgain + k0 + 8 * c + 4) * sc; }
#pragma unroll
        for (int j = 0; j < 4; ++j) { const int n = (lane >> 3) + 8 * j; const LAS float* s = scr + (8 * c) * 33 + n;
            u32x2 o;
            if constexpr (I8) { o.x = pg8::pk4_i8(s[0 * 33] * g0[0], s[1 * 33] * g0[1], s[2 * 33] * g0[2], s[3 * 33] * g0[3]); o.y = pg8::pk4_i8(s[4 * 33] * g1[0], s[5 * 33] * g1[1], s[6 * 33] * g1[2], s[7 * 33] * g1[3]); }
            else { o.x = pg8::pk4_fp8(s[0 * 33] * g0[0], s[1 * 33] * g0[1], s[2 * 33] * g0[2], s[3 * 33] * g0[3]); o.y = pg8::pk4_fp8(s[4 * 33] * g1[0], s[5 * 33] * g1[1], s[6 * 33] * g1[2], s[7 * 33] * g1[3]); }
            *(u32x2*)(WT + (size_t)(n0 + n) * K + k0 + 8 * c) = o; }
        LDS_WAIT();
    }
}

struct Args { const void* in[28]; float* out; unsigned char* ws; int p_lo, p_hi; };
__device__ __forceinline__ const float* kin(const Args& a, int i) { asm volatile("" : "+s"(i)); return (const float*)a.in[i]; }

__device__ __forceinline__ void prep_layer(const Frame& F, const Args& in, unsigned char* ws, unsigned char* wmix, int L, int mask) {
    const int kind = L % 3, j = L / 3;
#pragma unroll 1
    for (int f = 0; f < 2; ++f) {
        if (!((mask >> f) & 1)) continue;
        const float* wgu = kin(in, 3) + (size_t)(L * 2 + f) * DM * 2 * DFF;
        const float* gpre = kin(in, 2) + (size_t)(L * 6 + (f ? 4 : 0)) * DM;
        if (3 * L + 2 * f >= G8_FROM) prep_matrix_q<true>(F, DM, 2 * DFF, ws + (f ? W_GU1 : W_GU0), [=](int k, int n) { const int pn = n >> 8, r = n & 255; const int sc = (r < 128) ? (pn * 128 + r) : (DFF + pn * 128 + (r - 128)); return wgu[(size_t)k * (2 * DFF) + sc]; }, WI_SCALE, gpre);
        else prep_matrix(F, DM, 2 * DFF, (bf16*)(ws + (f ? W_GU1 : W_GU0)), [=](int k, int n) { const int pn = n >> 8, r = n & 255; const int sc = (r < 128) ? (pn * 128 + r) : (DFF + pn * 128 + (r - 128)); return wgu[(size_t)k * (2 * DFF) + sc]; }, gpre);
        const float* wdn = kin(in, 4) + (size_t)(L * 2 + f) * DFF * DM;
        if (3 * L + 2 * f >= F8_FROM) prep_matrix_q<false>(F, DFF, DM, ws + (f ? W_DN1 : W_DN0), [=](int k, int n) { return wdn[(size_t)k * DM + n]; }, W8_SCALE);
        else prep_matrix(F, DFF, DM, (bf16*)(ws + (f ? W_DN1 : W_DN0)), [=](int k, int n) { return wdn[(size_t)k * DM + n]; });
    }
    if (!(mask & 4)) return;
    if (kind == 0) {
        const float* win = kin(in, 5) + (size_t)j * DM * ML_IN;
        const float* g2 = kin(in, 2) + (size_t)(L * 6 + 2) * DM;
        if ((I8_MIX >> (3 * L + 1)) & 1u) prep_matrix_q<true>(F, DM, 3072, wmix, [=](int k, int n) { return win[(size_t)k * ML_IN + n]; }, WI_SCALE, g2);
        else prep_matrix(F, DM, 3072, (bf16*)(wmix), [=](int k, int n) { return win[(size_t)k * ML_IN + n]; }, g2);
        const float* wo = kin(in, 9) + (size_t)j * DM * DM;
        prep_matrix(F, DM, DM, (bf16*)(wmix + (size_t)3072 * 1024 * 2), [=](int k, int n) { return wo[(size_t)k * DM + n]; });
    } else if (kind == 1) {
        const float* mu = kin(in, 10) + (size_t)j * 6 * DM; const float* wrkv = kin(in, 11) + (size_t)j * 3 * DM * DM;
        const float* w1 = kin(in, 13) + (size_t)j * DM * 64; const float* a1 = kin(in, 16) + (size_t)j * DM * 64; const float* g1 = kin(in, 18) + (size_t)j * DM * 128;
        prep_matrix(F, DM, 3072, (bf16*)(wmix), [=](int k, int n) { return wrkv[((size_t)(n >> 10) * DM + k) * DM + (n & 1023)]; });
        prep_matrix(F, 2048, 256, (bf16*)(wmix + (size_t)3072 * 1024 * 2), [=](int k, int c) {
            const int kk = k & 1023; const bool hi = k >= 1024; float w; int mi;
            if (c < 64) { mi = 3; w = w1[kk * 64 + c]; } else if (c < 128) { mi = 4; w = a1[kk * 64 + (c - 64)]; } else { mi = 5; w = g1[kk * 128 + (c - 128)]; }
            const float m = mu[mi * DM + kk]; return w * (hi ? m : 1.0f - m); });
        const float* w2 = kin(in, 14) + (size_t)j * 64 * DM; const float* a2 = kin(in, 17) + (size_t)j * 64 * DM; const float* g2 = kin(in, 19) + (size_t)j * 128 * DM;
        prep_matrix(F, 256, 3072, (bf16*)(wmix + (size_t)3072 * 1024 * 2 + (size_t)256 * 2048 * 2), [=](int k, int n) {
            const int t = n >> 10, c = n & 1023;
            if (t == 0) return k < 64 ? w2[k * DM + c] : 0.f;
            if (t == 1) return (k >= 64 && k < 128) ? a2[(k - 64) * DM + c] : 0.f;
            return k >= 128 ? g2[(k - 128) * DM + c] : 0.f; });
        const float* wo = kin(in, 25) + (size_t)j * DM * DM;
        prep_matrix(F, DM, DM, (bf16*)(wmix + (size_t)3072 * 1024 * 2 + (size_t)256 * 2048 * 2 + (size_t)3072 * 256 * 2), [=](int k, int n) { return wo[(size_t)k * DM + n]; });
    } else {
        const float* win = kin(in, 26) + (size_t)j * DM * 6144;
        const float* g2 = kin(in, 2) + (size_t)(L * 6 + 2) * DM;
        if ((I8_MIX >> (3 * L + 1)) & 1u) prep_matrix_q<true>(F, DM, 6144, wmix, [=](int k, int n) { return win[(size_t)k * 6144 + n]; }, WI_SCALE, g2);
        else prep_matrix(F, DM, 6144, (bf16*)(wmix), [=](int k, int n) { return win[(size_t)k * 6144 + n]; }, g2);
        const float* wo = kin(in, 27) + (size_t)j * 2048 * DM;
        prep_matrix(F, 2048, DM, (bf16*)(wmix + (size_t)6144 * 1024 * 2), [=](int k, int n) { return wo[(size_t)k * DM + n]; });
    }
}

__device__ __forceinline__ void first_norm_phase(const Frame& F, const float* x0, bf16* xb, float* rho, unsigned char* x8) {
    PH_IDS;
    const int gw = F.vcu * NWAVES + w, NGW = F.G * NWAVES;
    for (int m0 = gw; m0 < M; m0 += 2 * NGW) {
        f32x4 v[2][4];
#pragma unroll
        for (int u = 0; u < 2; ++u)
#pragma unroll
            for (int j = 0; j < 4; ++j) v[u][j] = *(const f32x4*)(x0 + (size_t)(m0 + u * NGW) * DM + 4 * lane + 256 * j);
#pragma unroll
        for (int u = 0; u < 2; ++u) {
            const int m = m0 + u * NGW; float s = 0.f;
#pragma unroll
            for (int j = 0; j < 4; ++j) s += (v[u][j][0] * v[u][j][0] + v[u][j][1] * v[u][j][1]) + (v[u][j][2] * v[u][j][2] + v[u][j][3] * v[u][j][3]);
            const float ms = wave_sum(s) * (1.0f / DM) + NORM_EPS, rs = __builtin_amdgcn_rsqf(ms);
            if (lane == 0) rho[m] = ms * rs;
#pragma unroll
            for (int j = 0; j < 4; ++j) { const f32x4 y = v[u][j] * rs; u32x2 o; o.x = cvt_pk_bf16(y[0], y[1]); o.y = cvt_pk_bf16(y[2], y[3]); *(u32x2*)(xb + (size_t)m * DM + 4 * lane + 256 * j) = o;
                if (x8) *(unsigned*)(x8 + (size_t)m * DM + 4 * lane + 256 * j) = pg8::pk4_i8(y[0] * X8_SCALE, y[1] * X8_SCALE, y[2] * X8_SCALE, y[3] * X8_SCALE); }
        }
    }
}

__device__ __forceinline__ void rw_mix_phase(const Frame& F, const bf16* xb, const float* gpre, const float* mu, bf16* ap, bf16* mixes) {
    PH_IDS;
    const int gw = F.vcu * NWAVES + w, NGW = F.G * NWAVES, rpw = M / NGW;
    f32x4 gq[4], mu0[4], mu1[4], mu2[4];
#pragma unroll
    for (int j = 0; j < 4; ++j) { const int o = 4 * lane + 256 * j; gq[j] = *(const f32x4*)(gpre + o); mu0[j] = *(const f32x4*)(mu + o); mu1[j] = *(const f32x4*)(mu + DM + o); mu2[j] = *(const f32x4*)(mu + 2 * DM + o); }
    f32x4 prev[4];
    auto ldrow = [&](int r, u32x2 (&dst)[4]) {
        const int m = gw * rpw + r;
        if (r < rpw && m >= 0) {
#pragma unroll
            for (int j = 0; j < 4; ++j) dst[j] = *(const u32x2*)(xb + (size_t)m * DM + 4 * lane + 256 * j);
        } else {
#pragma unroll
            for (int j = 0; j < 4; ++j) dst[j] = (u32x2){0u, 0u};
        }
    };
    u32x2 cu[4];
    ldrow(-1, cu);
    for (int r = -1; r < rpw; ++r) {
        const int m = gw * rpw + r, t = m & (SEQ - 1);
        u32x2 nx[4]; ldrow(r + 1, nx);
        f32x4 y[4];
#pragma unroll
        for (int j = 0; j < 4; ++j) { const u32x2 a = cu[j]; y[j] = (f32x4){bf_lo(a.x), bf_hi(a.x), bf_lo(a.y), bf_hi(a.y)} * gq[j]; cu[j] = nx[j]; }
        if (r < 0 && t == SEQ - 1) {
#pragma unroll
            for (int j = 0; j < 4; ++j) prev[j] = (f32x4){0.f, 0.f, 0.f, 0.f};
            continue;
        }
        if (r >= 0) {
#pragma unroll
            for (int j = 0; j < 4; ++j) {
                const int o = 4 * lane + 256 * j;
                const f32x4 d = prev[j] - y[j], m0v = y[j] + d * mu0[j], m1v = y[j] + d * mu1[j], m2v = y[j] + d * mu2[j];
                *(u32x2*)(ap + (size_t)m * 2048 + o) = (u32x2){cvt_pk_bf16(y[j][0], y[j][1]), cvt_pk_bf16(y[j][2], y[j][3])};
                *(u32x2*)(ap + (size_t)m * 2048 + 1024 + o) = (u32x2){cvt_pk_bf16(prev[j][0], prev[j][1]), cvt_pk_bf16(prev[j][2], prev[j][3])};
                *(u32x2*)(mixes + (size_t)m * DM + o) = (u32x2){cvt_pk_bf16(m0v[0], m0v[1]), cvt_pk_bf16(m0v[2], m0v[3])};
                *(u32x2*)(mixes + ((size_t)M + m) * DM + o) = (u32x2){cvt_pk_bf16(m1v[0], m1v[1]), cvt_pk_bf16(m1v[2], m1v[3])};
                *(u32x2*)(mixes + ((size_t)2 * M + m) * DM + o) = (u32x2){cvt_pk_bf16(m2v[0], m2v[1]), cvt_pk_bf16(m2v[2], m2v[3])};
            }
        }
        if (t == SEQ - 1) {
#pragma unroll
            for (int j = 0; j < 4; ++j) prev[j] = (f32x4){0.f, 0.f, 0.f, 0.f};
        } else {
#pragma unroll
            for (int j = 0; j < 4; ++j) prev[j] = y[j];
        }
    }
}

__device__ __forceinline__ void ml_gate_phase(const Frame& F, const bf16* xn, const float* gpre, const float* w_in, const float* b_if, float* ifg) {
    PH_IDS;
    constexpr int WP = (1024 + 8) * 2;
    LAS unsigned char* lds = F.lds;
    for (int k = tid; k < 1024; k += 512) {
        const f32x4 a = *(const f32x4*)(w_in + (size_t)k * ML_IN + 3072), b = *(const f32x4*)(w_in + (size_t)k * ML_IN + 3076); const float gk = gpre[k];
#pragma unroll
        for (int n = 0; n < 4; ++n) { *(LAS unsigned short*)(lds + n * WP + k * 2) = (unsigned short)(cvt_pk_bf16(a[n] * gk, 0.f) & 0xffffu); *(LAS unsigned short*)(lds + (4 + n) * WP + k * 2) = (unsigned short)(cvt_pk_bf16(b[n] * gk, 0.f) & 0xffffu); }
#pragma unroll
        for (int n = 8; n < 16; ++n) *(LAS unsigned short*)(lds + n * WP + k * 2) = 0;
    }
    WG_BAR();
    const int gw = F.vcu * NWAVES + w, NGW = F.G * NWAVES, fr = lane & 15, fq = lane >> 4;
    const f32x4 bias = (fq < 2) ? *(const f32x4*)(b_if + 4 * fq) : (f32x4){0.f, 0.f, 0.f, 0.f};
    for (int g = gw; g < M / 16; g += NGW) {
        const char* rowp = (const char*)xn + ((size_t)(16 * g + fr) * DM + 8 * fq) * 2;
        f32x4 acc = {0.f, 0.f, 0.f, 0.f};
#pragma unroll
        for (int h = 0; h < 2; ++h) {
            u32x4 av[16];
#pragma unroll
            for (int kk = 0; kk < 16; ++kk) av[kk] = *(const u32x4*)(rowp + (size_t)(16 * h + kk) * 64);
#pragma unroll
            for (int kk = 0; kk < 16; ++kk) { const bf16x8 bw = *(const LAS bf16x8*)(lds + fr * WP + (32 * (16 * h + kk) + 8 * fq) * 2); acc = mma16(bw, __builtin_bit_cast(bf16x8, av[kk]), acc); }
        }
        if (fq < 2) {
            f32x4 o;
#pragma unroll
            for (int e = 0; e < 4; ++e) { float val = acc[e] + bias[e]; val = 15.0f * ftanh(val * (1.0f / 15.0f)); o[e] = (fq == 1) ? -0.6931471805599453f * __builtin_amdgcn_logf(1.0f + fexp(-val)) : val; }
            *(f32x4*)(ifg + (size_t)(16 * g + fr) * 8 + 4 * fq) = o;
        }
    }
    WG_BAR_L();
}

__device__ __forceinline__ void ml_conv_phase(const Frame& F, const bf16* proj, const float* conv_w, bf16* qka) {
    PH_IDS;
    const int gw = F.vcu * NWAVES + w, NGW = F.G * NWAVES, rpw = M / NGW;
    f32x4 cw[4][4];
#pragma unroll
    for (int k = 0; k < 4; ++k)
#pragma unroll
        for (int j = 0; j < 4; ++j) cw[k][j] = *(const f32x4*)(conv_w + k * 1024 + 4 * lane + 256 * j);
    u32x2 hist[3][4];
    auto ldrow = [&](int r, u32x2 (&dst)[4]) {
        const int m = gw * rpw + r;
        const bool valid = (r < rpw) && !(r < 0 && ((gw * rpw) & (SEQ - 1)) == 0);
        if (valid) {
#pragma unroll
            for (int j = 0; j < 4; ++j) dst[j] = *(const u32x2*)(proj + (size_t)m * 3072 + 4 * lane + 256 * j);
        } else {
#pragma unroll
            for (int j = 0; j < 4; ++j) dst[j] = (u32x2){0u, 0u};
        }
    };
    u32x2 pre0[4], pre1[4];
    ldrow(-3, pre0); ldrow(-2, pre1);
    for (int r = -3; r < rpw; ++r) {
        const int m = gw * rpw + r;
        u32x2 cur[4], nx[4];
        ldrow(r + 2, nx);
#pragma unroll
        for (int j = 0; j < 4; ++j) { cur[j] = pre0[j]; pre0[j] = pre1[j]; pre1[j] = nx[j]; }
        if (r >= 0) {
#pragma unroll
            for (int j = 0; j < 4; ++j) {
                f32x4 a = cw[3][j] * (f32x4){bf_lo(cur[j].x), bf_hi(cur[j].x), bf_lo(cur[j].y), bf_hi(cur[j].y)};
                a += cw[2][j] * (f32x4){bf_lo(hist[2][j].x), bf_hi(hist[2][j].x), bf_lo(hist[2][j].y), bf_hi(hist[2][j].y)};
                a += cw[1][j] * (f32x4){bf_lo(hist[1][j].x), bf_hi(hist[1][j].x), bf_lo(hist[1][j].y), bf_hi(hist[1][j].y)};
                a += cw[0][j] * (f32x4){bf_lo(hist[0][j].x), bf_hi(hist[0][j].x), bf_lo(hist[0][j].y), bf_hi(hist[0][j].y)};
                const float sc = j < 2 ? 0.08838834764831845f : 1.0f;
                *(u32x2*)(qka + (size_t)m * DM + 4 * lane + 256 * j) = (u32x2){cvt_pk_bf16(fsilu(a[0]) * sc, fsilu(a[1]) * sc), cvt_pk_bf16(fsilu(a[2]) * sc, fsilu(a[3]) * sc)};
            }
        }
#pragma unroll
        for (int j = 0; j < 4; ++j) { hist[0][j] = hist[1][j]; hist[1][j] = hist[2][j]; hist[2][j] = cur[j]; }
    }
}

__device__ __forceinline__ void ml_chunk_phase(const Frame& F, const bf16* proj, const bf16* qka, const float* ifg, bf16* hb) {
    constexpr int QP = 272, SP = 144;
    constexpr int QS = 0, KS = QS + 64 * QP, KWT = KS + 64 * QP, VT = KWT + 128 * SP, PS = VT + 80 * SP, CT = PS + 64 * SP, TAB = CT + 80 * QP;
    static_assert(TAB + 1024 <= RING_BYTES, "ml lds");
    LAS unsigned char* lds = F.lds;
    LAS float* tU = (LAS float*)(lds + TAB); LAS float* tM = tU + 64; LAS float* tB = tU + 128; LAS float* tD = tU + 192;
    PH_IDS;
    const int fr = lane & 15, fq = lane >> 4;
    for (int item = F.vcu; item < NB * 16; item += F.G) {
        const int b = item >> 4, hh = (item >> 2) & 3, vs = item & 3;
        const size_t rowb = (size_t)b * SEQ;
        for (int i = tid; i < 16 * 36; i += 512) { const int r = i / 36, cidx = i % 36; ((LAS unsigned*)(lds + VT + (64 + r) * SP))[cidx] = (r == 0) ? 0x3f803f80u : 0u; }
        const int which = tid >> 8, tq = (tid >> 4) & 15, c8 = tid & 15;
        const int ch = which * 512 + hh * 128 + c8 * 8;
        const int tqv = tid >> 5, vp = tid & 31;
        const int vcol = 1024 + hh * 256 + vs * 64 + 2 * vp;
        f32x4 C[5];
#pragma unroll
        for (int jj = 0; jj < 5; ++jj) C[jj] = (f32x4){0.f, 0.f, 0.f, 0.f};
        float mst = 0.f;
        struct Pre { u32x4 rq[4]; unsigned rv[4]; float gi, gf; };
        const unsigned loQ = (unsigned)((4 * tq) * DM + ch) * 2u, loV = (unsigned)((4 * tqv) * 3072 + vcol) * 2u;
        auto prefetch = [&](int c, Pre& p) {
            const char* bq = (const char*)qka + (rowb + 64 * c) * (size_t)(DM * 2);
            const char* base = (const char*)proj + (rowb + 64 * c) * (size_t)(3072 * 2);
#pragma unroll
            for (int r = 0; r < 4; ++r) { p.rq[r] = *(const u32x4*)(bq + (size_t)r * (DM * 2) + loQ); p.rv[r] = *(const unsigned*)(base + (size_t)r * (3072 * 2) + loV); }
            const float* gb = ifg + (rowb + 64 * c) * 8 + hh;
            p.gi = gb[lane * 8]; p.gf = gb[lane * 8 + 4];
        };
        Pre pa, pb;
        prefetch(0, pa); prefetch(1, pb);
        auto step = [&](int c, Pre& p) {
            const float gi = p.gi, gf = p.gf;
            const float bsum = scan_sum64(gf);
            const float uu = gi - bsum;
            const float Mx = fmaxf(mst, scan_max64(uu));
            const float M63 = lane63(Mx), b63 = lane63(bsum);
            if (w == 0) { tU[lane] = uu; tM[lane] = Mx; tB[lane] = bsum; }
#pragma unroll
            for (int jj = 0; jj < 5; ++jj) { u32x2 o; o.x = cvt_pk_bf16(C[jj][0], C[jj][1]); o.y = cvt_pk_bf16(C[jj][2], C[jj][3]);
                *(LAS u32x2*)(lds + CT + (16 * jj + fr) * QP + (16 * w + 4 * fq) * 2) = o; }
            WG_BAR_L();
            {
                float kws[4];
#pragma unroll
                for (int tt = 0; tt < 4; ++tt) kws[tt] = fexp(tU[4 * tq + tt] - M63);
#pragma unroll
                for (int tt = 0; tt < 4; ++tt) *(LAS u32x4*)(lds + (which ? KS : QS) + (4 * tq + tt) * QP + c8 * 16) = p.rq[tt];
                if (which) {
#pragma unroll
                    for (int e2 = 0; e2 < 4; ++e2) {
                        u32x2 lo, hi;
                        lo.x = cvt_pk_bf16(bf_lo(p.rq[0][e2]) * kws[0], bf_lo(p.rq[1][e2]) * kws[1]); lo.y = cvt_pk_bf16(bf_lo(p.rq[2][e2]) * kws[2], bf_lo(p.rq[3][e2]) * kws[3]);
                        hi.x = cvt_pk_bf16(bf_hi(p.rq[0][e2]) * kws[0], bf_hi(p.rq[1][e2]) * kws[1]); hi.y = cvt_pk_bf16(bf_hi(p.rq[2][e2]) * kws[2], bf_hi(p.rq[3][e2]) * kws[3]);
                        *(LAS u32x2*)(lds + KWT + (c8 * 8 + 2 * e2) * SP + (4 * tq) * 2) = lo; *(LAS u32x2*)(lds + KWT + (c8 * 8 + 2 * e2 + 1) * SP + (4 * tq) * 2) = hi;
                    }
                }
                u32x2 v0, v1;
                v0.x = (p.rv[0] & 0xffffu) | (p.rv[1] << 16); v0.y = (p.rv[2] & 0xffffu) | (p.rv[3] << 16);
                v1.x = (p.rv[0] >> 16) | (p.rv[1] & 0xffff0000u); v1.y = (p.rv[2] >> 16) | (p.rv[3] & 0xffff0000u);
                *(LAS u32x2*)(lds + VT + (2 * vp) * SP + (4 * tqv) * 2) = v0; *(LAS u32x2*)(lds + VT + (2 * vp + 1) * SP + (4 * tqv) * 2) = v1;
            }
            WG_BAR_L();
            if (c + 2 < SEQ / 64) prefetch(c + 2, p);
            {
                const int tt = w >> 1, st0 = 2 * (w & 1);
                f32x4 s0 = {0.f, 0.f, 0.f, 0.f}, s1 = {0.f, 0.f, 0.f, 0.f};
#pragma unroll
                for (int kk = 0; kk < 4; ++kk) {
                    const bf16x8 yq = *(const LAS bf16x8*)(lds + QS + (16 * tt + fr) * QP + (32 * kk + 8 * fq) * 2);
                    const bf16x8 x0 = *(const LAS bf16x8*)(lds + KS + (16 * st0 + fr) * QP + (32 * kk + 8 * fq) * 2);
                    const bf16x8 x1 = *(const LAS bf16x8*)(lds + KS + (16 * (st0 + 1) + fr) * QP + (32 * kk + 8 * fq) * 2);
                    s0 = mma16(x0, yq, s0); s1 = mma16(x1, yq, s1);
                }
                const int t = 16 * tt + fr; const float Mt = tM[t];
#pragma unroll
                for (int q = 0; q < 2; ++q) { const f32x4 sv = q ? s1 : s0; const int sb = 16 * (st0 + q) + 4 * fq; const f32x4 u4 = *(const LAS f32x4*)(tU + sb);
                    float p[4];
#pragma unroll
                    for (int e = 0; e < 4; ++e) p[e] = (sb + e <= t) ? sv[e] * fexp(u4[e] - Mt) : 0.f;
                    u32x2 pk; pk.x = cvt_pk_bf16(p[0], p[1]); pk.y = cvt_pk_bf16(p[2], p[3]);
                    *(LAS u32x2*)(lds + PS + t * SP + sb * 2) = pk; }
            }
            WG_BAR_L();
            {
                const int tt = w & 3, jb = (w < 4) ? 0 : 3, nj = (w < 4) ? 3 : 2;
                f32x4 a1[3], a2[3];
#pragma unroll
                for (int jj = 0; jj < 3; ++jj) { a1[jj] = (f32x4){0.f, 0.f, 0.f, 0.f}; a2[jj] = (f32x4){0.f, 0.f, 0.f, 0.f}; }
#pragma unroll
                for (int kk = 0; kk < 2; ++kk) { const bf16x8 yp = *(const LAS bf16x8*)(lds + PS + (16 * tt + fr) * SP + (32 * kk + 8 * fq) * 2);
#pragma unroll
                    for (int jj = 0; jj < 3; ++jj) if (jj < nj) { const bf16x8 xv = *(const LAS bf16x8*)(lds + VT + (16 * (jb + jj) + fr) * SP + (32 * kk + 8 * fq) * 2); a1[jj] = mma16(xv, yp, a1[jj]); } }
#pragma unroll
                for (int kk = 0; kk < 4; ++kk) { const bf16x8 yq = *(const LAS bf16x8*)(lds + QS + (16 * tt + fr) * QP + (32 * kk + 8 * fq) * 2);
#pragma unroll
                    for (int jj = 0; jj < 3; ++jj) if (jj < nj) { const bf16x8 xc = *(const LAS bf16x8*)(lds + CT + (16 * (jb + jj) + fr) * QP + (32 * kk + 8 * fq) * 2); a2[jj] = mma16(xc, yq, a2[jj]); } }
                const int t = 16 * tt + fr; const float Mt = tM[t], bt = tB[t]; const float inter = fexp(mst - Mt);
#pragma unroll
                for (int jj = 0; jj < 3; ++jj) a1[jj] = a1[jj] + a2[jj] * inter;
                if (w >= 4 && fq == 0) tD[t] = a1[1][0];
                WG_BAR_L();
                const float dn = fmaxf(fabsf(tD[t]), fexp(-(bt + Mt))); const float rdn = 1.0f / dn;
#pragma unroll
                for (int jj = 0; jj < 3; ++jj) if (jj < nj && jb + jj < 4) { u32x2 pk; pk.x = cvt_pk_bf16(a1[jj][0] * rdn, a1[jj][1] * rdn); pk.y = cvt_pk_bf16(a1[jj][2] * rdn, a1[jj][3] * rdn);
                    *(u32x2*)((char*)(hb + (rowb + 64 * c + 16 * tt) * DM + hh * 256 + vs * 64 + 16 * (jb + jj)) + (unsigned)(fr * DM + 4 * fq) * 2u) = pk; }
            }
            if (PROBE_DUP == 38) { WG_BAR_L(); WG_BAR_L(); WG_BAR_L(); WG_BAR_L(); }
            {
                const float decay = fexp(mst - M63);
#pragma unroll
                for (int jj = 0; jj < 5; ++jj) C[jj] = C[jj] * decay;
#pragma unroll
                for (int kk = 0; kk < 2; ++kk) { const bf16x8 xk = *(const LAS bf16x8*)(lds + KWT + (16 * w + fr) * SP + (32 * kk + 8 * fq) * 2);
#pragma unroll
                    for (int jj = 0; jj < 5; ++jj) { const bf16x8 yv = *(const LAS bf16x8*)(lds + VT + (16 * jj + fr) * SP + (32 * kk + 8 * fq) * 2); C[jj] = mma16(xk, yv, C[jj]); } }
                mst = b63 + M63;
            }
            WG_BAR_L();
        };
#pragma unroll 1
        for (int c = 0; c < SEQ / 64; c += 2) { step(c, pa); step(c + 1, pb); }
    }
}

__device__ __forceinline__ void ml_head_phase(const Frame& F, const bf16* hb, const bf16* proj, const float* ng, bf16* hg) {
    PH_IDS;
    const int gw = F.vcu * NWAVES + w, NGW = F.G * NWAVES;
    f32x4 g[4];
#pragma unroll
    for (int j = 0; j < 4; ++j) g[j] = *(const f32x4*)(ng + 4 * lane + 256 * j);
    for (int m0 = gw; m0 < M; m0 += 2 * NGW) {
        u32x2 rr[2][4], ro[2][4];
#pragma unroll
        for (int u = 0; u < 2; ++u)
#pragma unroll
            for (int j = 0; j < 4; ++j) { const int m = m0 + u * NGW; rr[u][j] = *(const u32x2*)(hb + (size_t)m * DM + 4 * lane + 256 * j); ro[u][j] = *(const u32x2*)(proj + (size_t)m * 3072 + 2048 + 4 * lane + 256 * j); }
#pragma unroll
        for (int u = 0; u < 2; ++u)
#pragma unroll
            for (int j = 0; j < 4; ++j) {
                const int m = m0 + u * NGW; const u32x2 r = rr[u][j], ro_ = ro[u][j];
                const f32x4 v = {bf_lo(r.x), bf_hi(r.x), bf_lo(r.y), bf_hi(r.y)}, o = {bf_lo(ro_.x), bf_hi(ro_.x), bf_lo(ro_.y), bf_hi(ro_.y)};
                const float s = wave_sum((v[0] * v[0] + v[1] * v[1]) + (v[2] * v[2] + v[3] * v[3]));
                const float rs = __builtin_amdgcn_rsqf(s * (1.0f / 256.0f) + NORM_EPS);
                u32x2 pk; pk.x = cvt_pk_bf16(v[0] * rs * g[j][0] * fsigmoid(o[0]), v[1] * rs * g[j][1] * fsigmoid(o[1])); pk.y = cvt_pk_bf16(v[2] * rs * g[j][2] * fsigmoid(o[2]), v[3] * rs * g[j][3] * fsigmoid(o[3]));
                *(u32x2*)(hg + (size_t)m * DM + 4 * lane + 256 * j) = pk;
            }
    }
}

__device__ __forceinline__ void rt_chunk_phase(const Frame& F, const bf16* proj, bf16* yb) {
    constexpr int QP = 528, SP = 144;
    constexpr int QS = 0, KS = QS + 64 * QP, KWT = KS + 64 * QP, VT = KWT + 256 * SP, PS = VT + 128 * SP, END = PS + 64 * SP;
    static_assert(END <= MISC_OFF, "rt lds");
    LAS unsigned char* lds = F.lds;
    PH_IDS;
    const int fr = lane & 15, fq = lane >> 4;
    for (int item = F.vcu; item < NB * 16; item += F.G) {
        const int b = item >> 4, hh = (item >> 2) & 3, vs = item & 3;
        const size_t rowb = (size_t)b * SEQ;
        const float lg = __builtin_log2f(1.0f - __builtin_amdgcn_exp2f(-5.0f - (float)hh));
        const int tq = tid >> 5, c8 = tid & 31;
        const int qcol = hh * 256, kcol = 1024 + hh * 256 + c8 * 8, vcol = 2048 + hh * 512 + vs * 128 + 4 * c8;
        f32x4 R[16];
#pragma unroll
        for (int i = 0; i < 16; ++i) R[i] = (f32x4){0.f, 0.f, 0.f, 0.f};
        u32x4 rq[4], rk[4]; u32x2 rv[4];
        const unsigned loQ = (unsigned)((tid >> 5) * 6144 + qcol + (tid & 31) * 8) * 2u, loK = (unsigned)((4 * tq) * 6144 + kcol) * 2u, loV = (unsigned)((4 * tq) * 6144 + vcol) * 2u;
        auto prefetch = [&](int c) {
            const char* base = (const char*)proj + (rowb + 64 * c) * (size_t)(6144 * 2);
#pragma unroll
            for (int i = 0; i < 4; ++i) rq[i] = *(const u32x4*)(base + (size_t)i * (16 * 6144 * 2) + loQ);
#pragma unroll
            for (int i = 0; i < 4; ++i) { rk[i] = *(const u32x4*)(base + (size_t)i * (6144 * 2) + loK); rv[i] = *(const u32x2*)(base + (size_t)i * (6144 * 2) + loV); }
        };
        prefetch(0);
        float kws[4];
#pragma unroll
        for (int i = 0; i < 4; ++i) kws[i] = __builtin_amdgcn_exp2f(lg * (float)(63 - (4 * tq + i)));
        const float cdecay = __builtin_amdgcn_exp2f(lg * 64.0f);
        for (int c = 0; c < SEQ / 64; ++c) {
#pragma unroll
            for (int i = 0; i < 4; ++i) { const int idx = tid + 512 * i; *(LAS u32x4*)(lds + QS + (idx >> 5) * QP + (idx & 31) * 16) = rq[i]; }
#pragma unroll
            for (int i = 0; i < 4; ++i) *(LAS u32x4*)(lds + KS + (4 * tq + i) * QP + c8 * 16) = rk[i];
#pragma unroll
            for (int e2 = 0; e2 < 4; ++e2) {
                u32x2 lo, hi;
                lo.x = cvt_pk_bf16(bf_lo(rk[0][e2]) * kws[0], bf_lo(rk[1][e2]) * kws[1]); lo.y = cvt_pk_bf16(bf_lo(rk[2][e2]) * kws[2], bf_lo(rk[3][e2]) * kws[3]);
                hi.x = cvt_pk_bf16(bf_hi(rk[0][e2]) * kws[0], bf_hi(rk[1][e2]) * kws[1]); hi.y = cvt_pk_bf16(bf_hi(rk[2][e2]) * kws[2], bf_hi(rk[3][e2]) * kws[3]);
                *(LAS u32x2*)(lds + KWT + (c8 * 8 + 2 * e2) * SP + (4 * tq) * 2) = lo; *(LAS u32x2*)(lds + KWT + (c8 * 8 + 2 * e2 + 1) * SP + (4 * tq) * 2) = hi;
            }
            {
                u32x2 v0, v1, v2, v3;
                v0.x = (rv[0].x & 0xffffu) | (rv[1].x << 16); v0.y = (rv[2].x & 0xffffu) | (rv[3].x << 16);
                v1.x = (rv[0].x >> 16) | (rv[1].x & 0xffff0000u); v1.y = (rv[2].x >> 16) | (rv[3].x & 0xffff0000u);
                v2.x = (rv[0].y & 0xffffu) | (rv[1].y << 16); v2.y = (rv[2].y & 0xffffu) | (rv[3].y << 16);
                v3.x = (rv[0].y >> 16) | (rv[1].y & 0xffff0000u); v3.y = (rv[2].y >> 16) | (rv[3].y & 0xffff0000u);
                LAS unsigned char* vb = lds + VT + (4 * c8) * SP + (4 * tq) * 2;
                *(LAS u32x2*)(vb) = v0; *(LAS u32x2*)(vb + SP) = v1; *(LAS u32x2*)(vb + 2 * SP) = v2; *(LAS u32x2*)(vb + 3 * SP) = v3;
            }
            if (c + 1 < SEQ / 64) prefetch(c + 1);
            WG_BAR_L();
            {
                const int tt = w >> 1, st0 = 2 * (w & 1);
                f32x4 s0 = {0.f, 0.f, 0.f, 0.f}, s1 = {0.f, 0.f, 0.f, 0.f};
#pragma unroll 8
                for (int kk = 0; kk < 8; ++kk) {
                    const bf16x8 yq = *(const LAS bf16x8*)(lds + QS + (16 * tt + fr) * QP + (32 * kk + 8 * fq) * 2);
                    const bf16x8 x0 = *(const LAS bf16x8*)(lds + KS + (16 * st0 + fr) * QP + (32 * kk + 8 * fq) * 2);
                    const bf16x8 x1 = *(const LAS bf16x8*)(lds + KS + (16 * (st0 + 1) + fr) * QP + (32 * kk + 8 * fq) * 2);
                    s0 = mma16(x0, yq, s0); s1 = mma16(x1, yq, s1);
                }
                const int t = 16 * tt + fr;
#pragma unroll
                for (int q = 0; q < 2; ++q) { const f32x4 sv = q ? s1 : s0; const int sb = 16 * (st0 + q) + 4 * fq;
                    float p[4];
#pragma unroll
                    for (int e = 0; e < 4; ++e) p[e] = (sb + e <= t) ? sv[e] * __builtin_amdgcn_exp2f(lg * (float)(t - sb - e)) : 0.f;
                    u32x2 pk; pk.x = cvt_pk_bf16(p[0], p[1]); pk.y = cvt_pk_bf16(p[2], p[3]);
                    *(LAS u32x2*)(lds + PS + t * SP + sb * 2) = pk; }
            }
            WG_BAR_L();
            u32x4 xr[8];
#pragma unroll
            for (int kk = 0; kk < 8; ++kk) { xr[kk].x = cvt_pk_bf16(R[2 * kk][0], R[2 * kk][1]); xr[kk].y = cvt_pk_bf16(R[2 * kk][2], R[2 * kk][3]); xr[kk].z = cvt_pk_bf16(R[2 * kk + 1][0], R[2 * kk + 1][1]); xr[kk].w = cvt_pk_bf16(R[2 * kk + 1][2], R[2 * kk + 1][3]); }
#pragma unroll 2
            for (int tt = 0; tt < 4; ++tt) {
                f32x4 aI = {0.f, 0.f, 0.f, 0.f}, aC = {0.f, 0.f, 0.f, 0.f};
#pragma unroll
                for (int kk = 0; kk < 2; ++kk) { const bf16x8 xv = *(const LAS bf16x8*)(lds + VT + (16 * w + fr) * SP + (32 * kk + 8 * fq) * 2);
                    const bf16x8 yp = *(const LAS bf16x8*)(lds + PS + (16 * tt + fr) * SP + (32 * kk + 8 * fq) * 2); aI = mma16(xv, yp, aI); }
#pragma unroll
                for (int kk = 0; kk < 8; ++kk) {
                    const u32x2 qa = *(const LAS u32x2*)(lds + QS + (16 * tt + fr) * QP + (32 * kk + 4 * fq) * 2), qb = *(const LAS u32x2*)(lds + QS + (16 * tt + fr) * QP + (32 * kk + 16 + 4 * fq) * 2);
                    const u32x4 yq = {qa.x, qa.y, qb.x, qb.y};
                    aC = mma16(__builtin_bit_cast(bf16x8, xr[kk]), __builtin_bit_cast(bf16x8, yq), aC);
                }
                const int t = 16 * tt + fr; const float qd = __builtin_amdgcn_exp2f(lg * (float)(t + 1)); const f32x4 val = aI + aC * qd;
                u32x2 pk; pk.x = cvt_pk_bf16(val[0], val[1]); pk.y = cvt_pk_bf16(val[2], val[3]);
                *(u32x2*)((char*)(yb + (rowb + 64 * c + 16 * tt) * 2048 + hh * 512 + vs * 128 + 16 * w) + (unsigned)(fr * 2048 + 4 * fq) * 2u) = pk;
            }
            {
                const bf16x8 yv0 = *(const LAS bf16x8*)(lds + VT + (16 * w + fr) * SP + (8 * fq) * 2), yv1 = *(const LAS bf16x8*)(lds + VT + (16 * w + fr) * SP + (32 + 8 * fq) * 2);
#pragma unroll
                for (int dt = 0; dt < 16; ++dt) {
                    const bf16x8 x0 = *(const LAS bf16x8*)(lds + KWT + (16 * dt + fr) * SP + (8 * fq) * 2), x1 = *(const LAS bf16x8*)(lds + KWT + (16 * dt + fr) * SP + (32 + 8 * fq) * 2);
                    R[dt] = R[dt] * cdecay; R[dt] = mma16(x0, yv0, R[dt]); R[dt] = mma16(x1, yv1, R[dt]);
                    if ((dt & 3) == 3) asm volatile("" ::: "memory");
                }
            }
            WG_BAR_L();
        }
    }
}

__device__ __forceinline__ void rt_head_phase(const Frame& F, bf16* yb, const bf16* proj) {
    PH_IDS;
    const int gw = F.vcu * NWAVES + w, NGW = F.G * NWAVES;
    for (int m0 = gw; m0 < M; m0 += 2 * NGW) {
        u32x2 ry[2][8], rg[2][8];
#pragma unroll
        for (int u = 0; u < 2; ++u)
#pragma unroll
            for (int i = 0; i < 8; ++i) { const int m = m0 + u * NGW, col = i * 256 + 4 * lane; ry[u][i] = *(const u32x2*)(yb + (size_t)m * 2048 + col); rg[u][i] = *(const u32x2*)(proj + (size_t)m * 6144 + 4096 + col); }
#pragma unroll
        for (int u = 0; u < 2; ++u)
#pragma unroll
            for (int hd = 0; hd < 4; ++hd) {
                const int m = m0 + u * NGW;
                f32x4 v[2], g[2]; float s = 0.f;
#pragma unroll
                for (int q = 0; q < 2; ++q) { const u32x2 r = ry[u][2 * hd + q], rgq = rg[u][2 * hd + q];
                    v[q] = (f32x4){bf_lo(r.x), bf_hi(r.x), bf_lo(r.y), bf_hi(r.y)}; g[q] = (f32x4){bf_lo(rgq.x), bf_hi(rgq.x), bf_lo(rgq.y), bf_hi(rgq.y)};
                    s += (v[q][0] * v[q][0] + v[q][1] * v[q][1]) + (v[q][2] * v[q][2] + v[q][3] * v[q][3]); }
                const float rs = __builtin_amdgcn_rsqf(wave_sum(s) * (1.0f / 512.0f) + NORM_EPS);
#pragma unroll
                for (int q = 0; q < 2; ++q) { const int col = hd * 512 + q * 256 + 4 * lane;
                    u32x2 pk; pk.x = cvt_pk_bf16(fsilu(g[q][0]) * v[q][0] * rs, fsilu(g[q][1]) * v[q][1] * rs); pk.y = cvt_pk_bf16(fsilu(g[q][2]) * v[q][2] * rs, fsilu(g[q][3]) * v[q][3] * rs);
                    *(u32x2*)(yb + (size_t)m * 2048 + col) = pk; }
            }
    }
}

__device__ __forceinline__ float bf1(unsigned short u) { return __uint_as_float((unsigned)u << 16); }
__device__ __forceinline__ unsigned short f2bf1(float f) { return (unsigned short)(cvt_pk_bf16(f, 0.f) & 0xffffu); }
__device__ __forceinline__ void rw_scan_phase(const Frame& F, const bf16* rkv, const bf16* wag, const float* k_k, const float* k_a, const float* r_k, const float* ln_g, const float* ln_b, bf16* yout) {
    constexpr int TB = 64, NBT = SEQ / TB;
    constexpr int PLW = 0, PK = 8192, PA = 16384, PB = 24576, PR = 32768, PVG = 40960  , PVGSZ = 16640, IMG = PVG + 2 * PVGSZ;
    constexpr int I_AH = 0, I_RT = 2048, I_BT = 4096, I_KT = 6144, I_VT = 8192, I_NKH = 10240, I_NBR = 10752, I_NKR = 11264, I_GL = 11776, IMGSZ = 12032;
    constexpr int YB = IMG + 4 * IMGSZ;
    constexpr int CST = YB + 4 * 4096;
    static_assert(CST + 5 * 256 <= MISC_OFF && (IMG % 16) == 0 && (IMGSZ % 16) == 0 && (PVGSZ % 16) == 0, "rw lds");
    LAS unsigned char* lds = F.lds;
    PH_IDS;
    const int fr = lane & 15, fq = lane >> 4;
    for (int item = F.vcu; item < NB * 16; item += F.G) {
        const int b = item >> 4, hh = item & 15;
        const size_t rowb = (size_t)b * SEQ;
        const int t4 = tid & 255, c4 = t4 & 15, chg = hh * 64 + 4 * c4;
        if (tid < 320) { const int a_ = tid >> 6, cc = tid & 63; const float* src = a_ == 0 ? k_k : (a_ == 1 ? k_a : (a_ == 2 ? r_k : (a_ == 3 ? ln_g : ln_b))); *(LAS float*)(lds + CST + tid * 4) = src[hh * 64 + cc]; }
        WG_BAR();
        f32x4 ST[4];
#pragma unroll
        for (int jt = 0; jt < 4; ++jt) ST[jt] = (f32x4){0.f, 0.f, 0.f, 0.f};
        u32x2 pr[4], pk[4], pv[4], pw[4], pa[4], pg[4];
        const unsigned lo0 = (unsigned)((t4 >> 4) * 3072 + chg) * 2u;
        auto prefetch = [&](int tb) {
            const char* br = (const char*)rkv + (rowb + (size_t)tb * TB) * (3072 * 2); const char* bw = (const char*)wag + (rowb + (size_t)tb * TB) * (3072 * 2);
#pragma unroll
            for (int q = 0; q < 4; ++q) { const char* brq = br + (size_t)q * (16 * 3072 * 2); const char* bwq = bw + (size_t)q * (16 * 3072 * 2);
                pr[q] = *(const u32x2*)(brq + lo0); pk[q] = *(const u32x2*)(brq + 2048 + lo0); pv[q] = *(const u32x2*)(brq + 4096 + lo0);
                pw[q] = *(const u32x2*)(bwq + lo0); pa[q] = *(const u32x2*)(bwq + 2048 + lo0); pg[q] = *(const u32x2*)(bwq + 4096 + lo0); }
        };
        auto p1 = [&](int tb) {
            LAS unsigned char* pvg = lds + PVG + (tb & 1) * PVGSZ;
            const f32x4 kk4 = *(const LAS f32x4*)(lds + CST + (4 * c4) * 4), ka4 = *(const LAS f32x4*)(lds + CST + (64 + 4 * c4) * 4), rk4 = *(const LAS f32x4*)(lds + CST + (128 + 4 * c4) * 4);
#pragma unroll
            for (int q = 0; q < 4; ++q) {
                const int tk = (t4 >> 4) + 16 * q;
                const f32x4 r = {bf_lo(pr[q].x), bf_hi(pr[q].x), bf_lo(pr[q].y), bf_hi(pr[q].y)}, k = {bf_lo(pk[q].x), bf_hi(pk[q].x), bf_lo(pk[q].y), bf_hi(pk[q].y)};
                const f32x4 av = {bf_lo(pa[q].x), bf_hi(pa[q].x), bf_lo(pa[q].y), bf_hi(pa[q].y)};
                const f32x4 kkv = k * kk4;
                const float ss = red16((kkv[0] * kkv[0] + kkv[1] * kkv[1]) + (kkv[2] * kkv[2] + kkv[3] * kkv[3]));
                const float inv = 1.0f / fmaxf(sqrtf(ss), 1e-12f);
                const f32x4 kkn = kkv * inv, kp = k * (1.0f + (av - 1.0f) * ka4), rkp = r * kp * rk4, bb = kkn * av;
                const float bd = red16((rkp[0] + rkp[1]) + (rkp[2] + rkp[3]));
                const int o = (tk * 64 + 4 * c4) * 2;
                *(LAS u32x2*)(lds + PLW + o) = pw[q]; *(LAS u32x2*)(lds + PR + o) = pr[q]; *(LAS u32x2*)(pvg + o) = pv[q]; *(LAS u32x2*)(pvg + 8192 + o) = pg[q];
                *(LAS u32x2*)(lds + PK + o) = (u32x2){cvt_pk_bf16(kp[0], kp[1]), cvt_pk_bf16(kp[2], kp[3])};
                *(LAS u32x2*)(lds + PA + o) = (u32x2){cvt_pk_bf16(-kkn[0], -kkn[1]), cvt_pk_bf16(-kkn[2], -kkn[3])};
                *(LAS u32x2*)(lds + PB + o) = (u32x2){cvt_pk_bf16(bb[0], bb[1]), cvt_pk_bf16(bb[2], bb[3])};
                if (c4 == 0) *(LAS float*)(pvg + 16384 + tk * 4) = bd;
            }
        };
        auto epilogue = [&](int tb) {
            const LAS unsigned char* pvg = lds + PVG + (tb & 1) * PVGSZ;
            const f32x4 lg4 = *(const LAS f32x4*)(lds + CST + (192 + 4 * c4) * 4), lb4 = *(const LAS f32x4*)(lds + CST + (256 + 4 * c4) * 4);
#pragma unroll
            for (int q = 0; q < 4; ++q) {
                const int tk = (t4 >> 4) + 16 * q, o = (tk * 64 + 4 * c4) * 2;
                const f32x4 y = *(const LAS f32x4*)(lds + YB + (tk >> 4) * 4096 + ((tk & 15) * 64 + 4 * c4) * 4);
                const u32x2 vb = *(const LAS u32x2*)(pvg + o), gb = *(const LAS u32x2*)(pvg + 8192 + o);
                const f32x4 v = {bf_lo(vb.x), bf_hi(vb.x), bf_lo(vb.y), bf_hi(vb.y)}, g = {bf_lo(gb.x), bf_hi(gb.x), bf_lo(gb.y), bf_hi(gb.y)};
                const float bd = *(const LAS float*)(pvg + 16384 + tk * 4);
                const float mean = red16((y[0] + y[1]) + (y[2] + y[3])) * (1.0f / 64.0f);
                const f32x4 d = y - mean;
                const float var = red16((d[0] * d[0] + d[1] * d[1]) + (d[2] * d[2] + d[3] * d[3])) * (1.0f / 64.0f);
                const float rs = __builtin_amdgcn_rsqf(var + 64e-5f);
                const f32x4 outv = ((d * rs) * lg4 + lb4 + v * bd) * g;
                *(u32x2*)((char*)yout + ((rowb + (size_t)tb * TB + tk) * DM + chg) * 2) = (u32x2){cvt_pk_bf16(outv[0], outv[1]), cvt_pk_bf16(outv[2], outv[3])};
            }
        };
        auto produce = [&](int tb, int c) {
            const int j = lane;
            LAS unsigned char* img = lds + IMG + c * IMGSZ;
            const LAS unsigned char* pvg = lds + PVG + (tb & 1) * PVGSZ;
            LAS unsigned char* nba = lds + PLW + c * 2048;
            float At[16]; unsigned Bp[8], Kp[8], Vp[8];
            float cum = 0.f, gprev = 1.0f;
#pragma unroll
            for (int t = 0; t < 16; ++t) {
                const int o = ((16 * c + t) * 64 + j) * 2;
                const float lwv = bf1(*(const LAS unsigned short*)(lds + PLW + o)), a = bf1(*(const LAS unsigned short*)(lds + PA + o)), bq = bf1(*(const LAS unsigned short*)(lds + PB + o));
                const float kq = bf1(*(const LAS unsigned short*)(lds + PK + o)), rq = bf1(*(const LAS unsigned short*)(lds + PR + o));
                const unsigned vq = *(const LAS unsigned short*)(pvg + o);
                cum += lwv;
                const float gcur = fexp(cum), ginv = fexp(-cum);
                At[t] = a * gprev;
                const unsigned short ab = f2bf1(At[t]), rb = f2bf1(rq * gcur), bt = f2bf1(bq * ginv), kt = f2bf1(kq * ginv);
                const int ot = (t * 64 + j) * 2;
                *(LAS unsigned short*)(img + I_AH + ot) = ab; *(LAS unsigned short*)(img + I_RT + ot) = rb;
                *(LAS unsigned short*)(lds + PB + o) = bt; *(LAS unsigned short*)(lds + PK + o) = kt;
                if (t & 1) { Bp[t >> 1] |= (unsigned)bt << 16; Kp[t >> 1] |= (unsigned)kt << 16; Vp[t >> 1] |= vq << 16; }
                else { Bp[t >> 1] = bt; Kp[t >> 1] = kt; Vp[t >> 1] = vq; }
                gprev = gcur;
            }
            *(LAS u32x4*)(img + I_BT + j * 32) = (u32x4){Bp[0], Bp[1], Bp[2], Bp[3]}; *(LAS u32x4*)(img + I_BT + j * 32 + 16) = (u32x4){Bp[4], Bp[5], Bp[6], Bp[7]};
            *(LAS u32x4*)(img + I_KT + j * 32) = (u32x4){Kp[0], Kp[1], Kp[2], Kp[3]}; *(LAS u32x4*)(img + I_KT + j * 32 + 16) = (u32x4){Kp[4], Kp[5], Kp[6], Kp[7]};
            *(LAS u32x4*)(img + I_VT + j * 32) = (u32x4){Vp[0], Vp[1], Vp[2], Vp[3]}; *(LAS u32x4*)(img + I_VT + j * 32 + 16) = (u32x4){Vp[4], Vp[5], Vp[6], Vp[7]};
            *(LAS float*)(img + I_GL + j * 4) = gprev;
            LDS_WAIT();
            {
                f32x4 n_ba = {0.f, 0.f, 0.f, 0.f}, n_br = n_ba, n_ka = n_ba, n_kr = n_ba;
#pragma unroll
                for (int m = 0; m < 2; ++m) { const int o = fr * 128 + (32 * m + 8 * fq) * 2;
                    const bf16x8 xb = *(const LAS bf16x8*)(lds + PB + c * 2048 + o), xk = *(const LAS bf16x8*)(lds + PK + c * 2048 + o), ya = *(const LAS bf16x8*)(img + I_AH + o), yr = *(const LAS bf16x8*)(img + I_RT + o);
                    n_ba = mma16(xb, ya, n_ba); n_br = mma16(xb, yr, n_br); n_ka = mma16(xk, ya, n_ka); n_kr = mma16(xk, yr, n_kr); }
#pragma unroll
                for (int e = 0; e < 4; ++e) { const int sidx = 4 * fq + e; if (!(sidx < fr)) { n_ba[e] = 0.f; n_ka[e] = 0.f; } if (!(sidx <= fr)) { n_br[e] = 0.f; n_kr[e] = 0.f; } }
                *(LAS f32x4*)(nba + (fr * 16 + 4 * fq) * 4) = n_ba; *(LAS f32x4*)(nba + 1024 + (fr * 16 + 4 * fq) * 4) = n_ka;
                *(LAS u32x2*)(img + I_NBR + (fr * 16 + 4 * fq) * 2) = (u32x2){cvt_pk_bf16(n_br[0], n_br[1]), cvt_pk_bf16(n_br[2], n_br[3])};
                *(LAS u32x2*)(img + I_NKR + (fr * 16 + 4 * fq) * 2) = (u32x2){cvt_pk_bf16(n_kr[0], n_kr[1]), cvt_pk_bf16(n_kr[2], n_kr[3])};
            }
            LDS_WAIT();
            {
                float H[16];
#pragma unroll
                for (int t = 0; t < 16; ++t) {
                    float h = At[t];
#pragma unroll
                    for (int s4 = 0; s4 < 4; ++s4) if (4 * s4 < t) { const f32x4 cf = *(const LAS f32x4*)(nba + (t * 16 + 4 * s4) * 4);
#pragma unroll
                        for (int e = 0; e < 4; ++e) if (4 * s4 + e < t) h += H[4 * s4 + e] * cf[e]; }
                    H[t] = h;
                }
                LDS_WAIT();
#pragma unroll
                for (int t = 0; t < 16; ++t) *(LAS unsigned short*)(img + I_AH + (t * 64 + j) * 2) = f2bf1(H[t]);
                asm volatile("" ::: "memory");
#pragma unroll
                for (int t = 0; t < 16; ++t) {
                    float g = *(const LAS float*)(nba + 1024 + (t * 16 + (lane & 15)) * 4);
#pragma unroll
                    for (int s4 = 0; s4 < 4; ++s4) if (4 * s4 < t) { const f32x4 cf = *(const LAS f32x4*)(nba + (t * 16 + 4 * s4) * 4);
#pragma unroll
                        for (int e = 0; e < 4; ++e) if (4 * s4 + e < t) g += H[4 * s4 + e] * cf[e]; }
                    H[t] = g;
                    if (lane < 16) *(LAS unsigned short*)(img + I_NKH + (t * 16 + lane) * 2) = f2bf1(g);
                }
            }
        };
        auto consume = [&]() {
            struct Ops { u32x2 ah[4], rt[4], bt[4], kt[4], vt, nk, nb, nr; f32x4 gl[4]; };
            auto load_ops = [&](int c, Ops& o) {
                const LAS unsigned char* img = lds + IMG + c * IMGSZ;
#pragma unroll
                for (int m = 0; m < 2; ++m) {
                    o.ah[2 * m] = *(const LAS u32x2*)(img + I_AH + fr * 128 + (32 * m + 4 * fq) * 2); o.ah[2 * m + 1] = *(const LAS u32x2*)(img + I_AH + fr * 128 + (32 * m + 16 + 4 * fq) * 2);
                    o.rt[2 * m] = *(const LAS u32x2*)(img + I_RT + fr * 128 + (32 * m + 4 * fq) * 2); o.rt[2 * m + 1] = *(const LAS u32x2*)(img + I_RT + fr * 128 + (32 * m + 16 + 4 * fq) * 2);
                }
                o.vt = *(const LAS u32x2*)(img + I_VT + (16 * w + fr) * 32 + (4 * fq) * 2); o.nk = *(const LAS u32x2*)(img + I_NKH + (fr * 16 + 4 * fq) * 2);
                o.nb = *(const LAS u32x2*)(img + I_NBR + (fr * 16 + 4 * fq) * 2); o.nr = *(const LAS u32x2*)(img + I_NKR + (fr * 16 + 4 * fq) * 2);
#pragma unroll
                for (int jt = 0; jt < 4; ++jt) { o.bt[jt] = *(const LAS u32x2*)(img + I_BT + (16 * jt + fr) * 32 + (4 * fq) * 2); o.kt[jt] = *(const LAS u32x2*)(img + I_KT + (16 * jt + fr) * 32 + (4 * fq) * 2);
                    o.gl[jt] = *(const LAS f32x4*)(img + I_GL + (16 * jt + 4 * fq) * 4); }
            };
#pragma unroll 1
            for (int c = 0; c < 4; ++c) {
                Ops cur; load_ops(c, cur);
                u32x4 sf[2];
#pragma unroll
                for (int m = 0; m < 2; ++m) { sf[m].x = cvt_pk_bf16(ST[2 * m][0], ST[2 * m][1]); sf[m].y = cvt_pk_bf16(ST[2 * m][2], ST[2 * m][3]); sf[m].z = cvt_pk_bf16(ST[2 * m + 1][0], ST[2 * m + 1][1]); sf[m].w = cvt_pk_bf16(ST[2 * m + 1][2], ST[2 * m + 1][3]); }
                f32x4 d1 = {0.f, 0.f, 0.f, 0.f}, d2 = {0.f, 0.f, 0.f, 0.f};
#pragma unroll
                for (int m = 0; m < 2; ++m) {
                    d1 = mma16(__builtin_bit_cast(bf16x8, (u32x4){cur.ah[2 * m].x, cur.ah[2 * m].y, cur.ah[2 * m + 1].x, cur.ah[2 * m + 1].y}), __builtin_bit_cast(bf16x8, sf[m]), d1);
                    d2 = mma16(__builtin_bit_cast(bf16x8, (u32x4){cur.rt[2 * m].x, cur.rt[2 * m].y, cur.rt[2 * m + 1].x, cur.rt[2 * m + 1].y}), __builtin_bit_cast(bf16x8, sf[m]), d2);
                }
                d1 = mma16(__builtin_bit_cast(bf16x8, (u32x4){cur.nk.x, cur.nk.y, 0u, 0u}), __builtin_bit_cast(bf16x8, (u32x4){cur.vt.x, cur.vt.y, 0u, 0u}), d1);
                const u32x4 ff = {cvt_pk_bf16(d1[0], d1[1]), cvt_pk_bf16(d1[2], d1[3]), cur.vt.x, cur.vt.y};
                d2 = mma16(__builtin_bit_cast(bf16x8, (u32x4){cur.nb.x, cur.nb.y, cur.nr.x, cur.nr.y}), __builtin_bit_cast(bf16x8, ff), d2);
#pragma unroll
                for (int e = 0; e < 4; ++e) *(LAS float*)(lds + YB + c * 4096 + ((4 * fq + e) * 64 + 16 * w + fr) * 4) = d2[e];
#pragma unroll
                for (int jt = 0; jt < 4; ++jt) {
                    ST[jt] = mma16(__builtin_bit_cast(bf16x8, (u32x4){cur.bt[jt].x, cur.bt[jt].y, cur.kt[jt].x, cur.kt[jt].y}), __builtin_bit_cast(bf16x8, ff), ST[jt]);
                    ST[jt] = ST[jt] * cur.gl[jt];
                }
            }
        };
        if (w >= 4) { prefetch(0); p1(0); }
        WG_BAR_L();
#pragma unroll 1
        for (int tb = 0; tb < NBT; ++tb) {
            if (w >= 4) { if (tb + 1 < NBT) prefetch(tb + 1); produce(tb, w - 4); }
            else if (tb > 0) epilogue(tb - 1);
            WG_BAR_L();
            if (w < 4) consume();
            else if (tb + 1 < NBT) p1(tb + 1);
            WG_BAR_L();
        }
        if (w < 4) epilogue(NBT - 1);
        WG_BAR_L();
    }
}

__device__ __forceinline__ void stage_gain(const Frame& F, const float* g, float hs) {
    PH_IDS;
    ((LAS float*)(F.lds + GAIN_OFF))[tid] = g[tid] * hs; ((LAS float*)(F.lds + GAIN_OFF))[tid + 512] = g[tid + 512] * hs;
    __syncthreads();
}

constexpr int N_PHASES = 36;

__global__ void __launch_bounds__(NWAVES * 64, 2) mk_fwd(Args args) {
    extern __shared__ __attribute__((aligned(16))) unsigned char lds_raw[];
    Frame F;
    F.lds = (LAS unsigned char*)lds_raw;
    __builtin_assume(blockIdx.x < 256u);
    F.G = 256; { const int bx = blockIdx.x; F.vcu = (bx & 7) * 32 + (bx >> 3); }
    volatile LAS unsigned* MISC = (volatile LAS unsigned*)(F.lds + MISC_OFF);
    for (int u = threadIdx.x; u < (LDS_BYTES - MISC_OFF) / 4; u += NWAVES * 64) ((LAS unsigned*)(F.lds + MISC_OFF))[u] = 0u;
    __syncthreads();
    unsigned char* ws = args.ws;
    unsigned* ctl = (unsigned*)(ws + WS_CTL);
    const int lo = args.p_lo, hi = args.p_hi;
    XcdBarrier bar; bar.bar = ctl + CW_BAR; bar.x = 0; bar.st = nullptr;
    if (hi - lo > 1) bar = xcd_barrier_post(ctl + CW_BAR, MISC + 8);
    const Args& in = args;
    bf16* xb = (bf16*)args.out;
    float* RHO = (float*)(ws + 57 * MiB);
    bf16* xb2 = (bf16*)(ws + WS_A + 256 * MiB);
    bf16* XN = (bf16*)(ws + WS_XN);
    unsigned char* walt = (unsigned char*)(xb + (size_t)M * DM);
    bf16* RA = (bf16*)(ws + WS_A); bf16* RB = (bf16*)(ws + WS_B);
    int p = 0;
#define PH_ON (p >= lo && p < hi)
#define PH_END do { if (p >= lo && p + 1 < hi) xcd_barrier(bar); ++p; } while (0)
#define PREP_AHEAD do { for (int rep_ = 0; rep_ < (PROBE_DUP == 4 ? 2 : 1); ++rep_) { if (L + 1 < DEPTH) prep_layer(F, in, ws, ((L + 1) & 1) ? walt : ws + W_MIX, L + 1, 5); if (L > 0) prep_layer(F, in, ws, nullptr, L, 2); } } while (0)
#define DUP(cat, ...) do { __VA_ARGS__; if (PROBE_DUP == (cat)) { xcd_barrier(bar); __VA_ARGS__; } } while (0)


    if (PH_ON) { prep_layer(F, in, ws, ws + W_MIX, 0, 7); if (PROBE_DUP == 4) prep_layer(F, in, ws, ws + W_MIX, 0, 7); first_norm_phase(F, kin(in, 0), xb, RHO, G8_FROM == 0 ? (unsigned char*)args.out + X8_OFF : nullptr);
    }
    PH_END;

#pragma unroll 1
    for (int s = 0; s < DEPTH * 3; ++s) {
        const int L = s / 3, sp = s % 3, kind = L % 3, jm = L / 3;
        const float* g6 = kin(in, 2) + (size_t)L * 6 * DM;
        const int x8m = (s + 1 < DEPTH * 3 && (((s + 1) % 3 != 1) ? (s + 1 >= G8_FROM) : (((I8_MIX >> (s + 1)) & 1u) != 0u))) ? 8 : 0;
        if (sp != 1) {
            const int f = sp >> 1;
            if (PH_ON) { pg8::Gemm g{(f == 1 && L == DEPTH - 1) ? xb2 : xb, (const bf16*)(ws + (f ? W_GU1 : W_GU0)), M, 2 * DFF, DM}; pg8::StaticOrder S; S.init(M, 2 * DFF, F.G, (int)(blockIdx.x & 255u));
                if (s >= G8_FROM) { pg8::Gemm g8{(const bf16*)((unsigned char*)args.out + X8_OFF), (const bf16*)(ws + (f ? W_GU1 : W_GU0)), M, 2 * DFF, DM / 2};
                    if (s >= F8_FROM) { pg8::EpiSwiglu8T<true> E{(unsigned char*)RA, DFF, H8_SCALE, 1.0f / (X8_SCALE * WI_SCALE)}; pg8::gemm_phase<pg8::EpiSwiglu8T<true>, pg8::StaticOrder, true, true, 2>(F.lds, g8, S, E); }
                    else { pg8::EpiSwigluT<true> E{RA, DFF, 1.0f / (X8_SCALE * WI_SCALE)}; pg8::gemm_phase<pg8::EpiSwigluT<true>, pg8::StaticOrder, true, true, 2>(F.lds, g8, S, E); } }
                else if (s >= F8_FROM) { pg8::EpiSwiglu8 E{(unsigned char*)RA, DFF, H8_SCALE, 1.0f}; pg8::gemm_phase<pg8::EpiSwiglu8, pg8::StaticOrder, true, true>(F.lds, g, S, E); }
                else { pg8::EpiSwiglu E{RA, DFF, 1.0f}; DUP(1, pg8::gemm_phase<pg8::EpiSwiglu, pg8::StaticOrder, true, true>(F.lds, g, S, E)); } }
            PH_END;
            const bool lastf = (f == 1 && L == DEPTH - 1);
            if (PH_ON) {
                if (s >= F8_FROM) { pg8::Gemm g{RA, (const bf16*)(ws + (f ? W_DN1 : W_DN0)), M, DM, DFF / 2}; pg8::StaticOrder S; S.init(M, DM, F.G, (int)(blockIdx.x & 255u));
                    stage_gain(F, g6 + (f ? 5 : 1) * DM, 1.0f / (H8_SCALE * W8_SCALE));
                    pg8::EpiNormRes<false> E{ws, args.out, F.lds, s, (lastf ? 5 : 0) | x8m, 1.0f / (H8_SCALE * W8_SCALE)};
                    pg8::gemm_phase<pg8::EpiNormRes<false>, pg8::StaticOrder, true, true, 1>(F.lds, g, S, E); }
                else { pg8::Gemm g{RA, (const bf16*)(ws + (f ? W_DN1 : W_DN0)), M, DM, DFF}; pg8::StaticOrder S; S.init(M, DM, F.G, (int)(blockIdx.x & 255u));
                    stage_gain(F, g6 + (f ? 5 : 1) * DM, 1.0f);
                    pg8::EpiNormRes<false> E{ws, args.out, F.lds, s, (lastf ? 5 : 0) | x8m, 1.0f};
                    pg8::gemm_phase<pg8::EpiNormRes<false>, pg8::StaticOrder, true, true>(F.lds, g, S, E); } }
            PH_END;
            if (f == 0) {
                if (kind == 1) { if (PH_ON) { rw_mix_phase(F, xb, g6 + 2 * DM, kin(in, 10) + (size_t)jm * 6 * DM, XN, RA + (size_t)M * 3072); PREP_AHEAD; } PH_END; }
            }
        } else {
            const bf16* WM = (const bf16*)((L & 1) ? walt : ws + W_MIX);
            const bf16* a_out; const bf16* w_out; int k_out;
            if (kind == 0) {
                if (PH_ON) { pg8::Gemm g{xb, WM, M, 3072, DM}; pg8::StaticOrder S; S.init(M, 3072, F.G, (int)(blockIdx.x & 255u));
                    if ((I8_MIX >> s) & 1u) { pg8::Gemm g8{(const bf16*)((unsigned char*)args.out + X8_OFF), WM, M, 3072, DM / 2};
                        pg8::EpiPlainI8 E{RA, 3072, 1.0f / (X8_SCALE * WI_SCALE)}; pg8::gemm_phase<pg8::EpiPlainI8, pg8::StaticOrder, true, true, 2>(F.lds, g8, S, E); }
                    else { pg8::EpiPlain E{RA, 3072}; DUP(5, pg8::gemm_phase<pg8::EpiPlain, pg8::StaticOrder, true, true>(F.lds, g, S, E)); }
                    DUP(15, ml_gate_phase(F, xb, g6 + 2 * DM, kin(in, 5) + (size_t)jm * DM * ML_IN, kin(in, 6) + jm * 8, (float*)(ws + WS_A + 192 * MiB))); }
                PH_END;
                if (PH_ON) { DUP(17, ml_conv_phase(F, RA, kin(in, 7) + (size_t)jm * 4 * DM, RB + (size_t)M * DM)); __syncthreads(); PREP_AHEAD; }
                PH_END;
                if (PH_ON) DUP(6, ml_chunk_phase(F, RA, RB + (size_t)M * DM, (const float*)(ws + WS_A + 192 * MiB), RB));
                PH_END;
                if (PH_ON) DUP(7, ml_head_phase(F, RB, RA, kin(in, 8) + (size_t)jm * DM, RB + (size_t)M * DM));
                PH_END;
                a_out = RB + (size_t)M * DM; w_out = WM + (size_t)3072 * 1024; k_out = DM;
            } else if (kind == 1) {
                bf16* lmid = RB; bf16* wag = RA + (size_t)M * 3072; bf16* yo = RB + (size_t)M * 256;
                if (PH_ON) { { pg8::Gemm g{RA + (size_t)M * 3072, WM, M, 3072, DM, 2, (size_t)M * DM * 2}; pg8::SplitOrder S; S.init(M, 3072, (int)(blockIdx.x & 255u));
                      pg8::EpiPlain E{RA, 3072}; pg8::gemm_phase<pg8::EpiPlain, pg8::SplitOrder, true, true>(F.lds, g, S, E); }
                    { pg8::Gemm g{XN, WM + (size_t)3072 * 1024, M, 256, 2048}; pg8::StaticOrder S; S.init(M, 256, F.G, (int)(blockIdx.x & 255u));
                      pg8::EpiLora E{lmid}; pg8::gemm_phase<pg8::EpiLora, pg8::StaticOrder, true, true>(F.lds, g, S, E); } }
                PH_END;
                if (PH_ON) { int k_rw2 = 256; asm volatile("" : "+s"(k_rw2));
                    pg8::Gemm g{lmid, WM + (size_t)3072 * 1024 + (size_t)256 * 2048, M, 3072, k_rw2}; pg8::StaticOrder S; S.init(M, 3072, F.G, (int)(blockIdx.x & 255u));
                    pg8::EpiRw2 E{wag, kin(in, 12) + (size_t)jm * DM, kin(in, 15) + (size_t)jm * DM}; DUP(10, pg8::gemm_phase<pg8::EpiRw2, pg8::StaticOrder, true, true>(F.lds, g, S, E)); }
                PH_END;
                if (PH_ON) DUP(11, rw_scan_phase(F, RA, wag, kin(in, 20) + (size_t)jm * DM, kin(in, 21) + (size_t)jm * DM, kin(in, 22) + (size_t)jm * DM, kin(in, 23) + (size_t)jm * DM, kin(in, 24) + (size_t)jm * DM, yo));
                PH_END;
                a_out = yo; w_out = WM + (size_t)3072 * 1024 + (size_t)256 * 2048 + (size_t)3072 * 256; k_out = DM;
            } else {
                if (PH_ON) { pg8::Gemm g{xb, WM, M, 6144, DM}; pg8::StaticOrder S; S.init(M, 6144, F.G, (int)(blockIdx.x & 255u));
                    if ((I8_MIX >> s) & 1u) { pg8::Gemm g8{(const bf16*)((unsigned char*)args.out + X8_OFF), WM, M, 6144, DM / 2};
                        pg8::EpiRtInT<true> E{RA, (const int*)kin(in, 1), 1.0f / (X8_SCALE * WI_SCALE)}; pg8::gemm_phase<pg8::EpiRtInT<true>, pg8::StaticOrder, true, true, 2>(F.lds, g8, S, E); }
                    else { pg8::EpiRtIn E{RA, (const int*)kin(in, 1), 1.0f}; DUP(12, pg8::gemm_phase<pg8::EpiRtIn, pg8::StaticOrder, true, true>(F.lds, g, S, E)); } }
                PH_END;
                if (PH_ON) DUP(13, rt_chunk_phase(F, RA, RB));
                PH_END;
                if (PH_ON) { rt_head_phase(F, RB, RA); __syncthreads(); PREP_AHEAD; }
                PH_END;
                a_out = RB; w_out = WM + (size_t)6144 * 1024; k_out = 2048;
            }
            if (PH_ON) { pg8::Gemm g{a_out, w_out, M, DM, k_out}; pg8::StaticOrder S; S.init(M, DM, F.G, (int)(blockIdx.x & 255u));
                stage_gain(F, g6 + 3 * DM, 1.0f);
                pg8::EpiNormRes<false> E{ws, args.out, F.lds, s, ((L == DEPTH - 1) ? 2 : 0) | x8m, 1.0f};
                pg8::gemm_phase<pg8::EpiNormRes<false>, pg8::StaticOrder, true, true>(F.lds, g, S, E); }
            PH_END;
        }
    }
#undef PH_ON
#undef PH_END
}

extern "C" void kernel_launch(void* const* d_in, const int* in_sizes, int n_in, void* d_out, int out_size, void* d_ws, size_t ws_size, hipStream_t stream) {
    static int grid = 0;
    if (grid == 0) {
        if (n_in != 28 || out_size != M * DM || ws_size < WS_END) { fprintf(stderr, "kernel_launch: unexpected shapes: n_in %d out %d ws %zu (need %zu)\n", n_in, out_size, ws_size, (size_t)WS_END); grid = -1; return; }
        int dev = 0, cus = 0, per_cu = 0;
        if (hipGetDevice(&dev) != hipSuccess || hipDeviceGetAttribute(&cus, hipDeviceAttributeMultiprocessorCount, dev) != hipSuccess) { grid = -1; return; }
        if (hipFuncSetAttribute((const void*)mk_fwd, hipFuncAttributeMaxDynamicSharedMemorySize, LDS_BYTES) != hipSuccess) { fprintf(stderr, "kernel_launch: hipFuncSetAttribute failed\n"); grid = -1; return; }
        if (hipOccupancyMaxActiveBlocksPerMultiprocessor(&per_cu, (const void*)mk_fwd, NWAVES * 64, LDS_BYTES) != hipSuccess || per_cu < 1) { fprintf(stderr, "kernel_launch: occupancy query says %d\n", per_cu); (void)hipGetLastError(); grid = -1; return; }
        if (cus < 256) { fprintf(stderr, "kernel_launch: %d CUs; this kernel needs 256 co-resident workgroups\n", cus); grid = -1; return; }
        grid = 256;
    }
    if (grid < 0) return;
    (void)hipMemsetAsync((char*)d_ws + WS_CTL, 0, CTL_ZERO_BYTES, stream);
    Args a{};
    for (int i = 0; i < 28; ++i) a.in[i] = d_in[i];
    a.out = (float*)d_out; a.ws = (unsigned char*)d_ws;
#if MK_PER_PHASE
    for (int p = 0; p < N_PHASES; ++p) { a.p_lo = p; a.p_hi = p + 1; hipLaunchKernelGGL(mk_fwd, dim3(grid), dim3(NWAVES * 64), LDS_BYTES, stream, a); }
#else
    a.p_lo = 0; a.p_hi = N_PHASES;
    hipLaunchKernelGGL(mk_fwd, dim3(grid), dim3(NWAVES * 64), LDS_BYTES, stream, a);
#endif
}
```
